# Optimizing an MI355X kernel written in HIP

```python
import math
import jax, jax.numpy as jnp
from jax import lax
import numpy as np

D_MODEL = 1024
BATCH = 8
SEQ = 8192
DEPTH = 4
DEC_BATCH = 8
DEC_SEQ = 64
PAST_LEN = 1024

CHUNK = 64
N_META = 16
N_HEADS = 8
HEAD_DIM = 64
HD2 = 2 * HEAD_DIM
ATTN_WIDTH = N_HEADS * HD2
N_BUCKETS = 32
MAX_DISTANCE = 128
POOL_WINDOWS = (2, 4, 8, 16)
N_POOL_GROUPS = len(POOL_WINDOWS)
POOL_GROUP = D_MODEL // N_POOL_GROUPS
POOL_STATE = max(POOL_WINDOWS) - 1
D_FF = 4 * D_MODEL
N_ATTN_LAYERS = (DEPTH + 1) // 2
N_POOL_LAYERS = DEPTH // 2
Q_BLOCK = 128
EPS = 1e-6
SUBLN_EPS = 1e-5
NEG_INF = -1e30

kernel_name = "hybrid_diffattn_pool_streaming_step"


def rms_norm(x, g, eps=EPS):
    xf = x.astype(jnp.float32)
    y = xf * lax.rsqrt(jnp.mean(xf * xf, axis=-1, keepdims=True) + eps)
    return (y * g.astype(jnp.float32)).astype(x.dtype)


def t5_bucket(rel):
    nb = N_BUCKETS // 2
    max_exact = nb // 2
    ret = jnp.where(rel > 0, nb, 0)
    n = jnp.abs(rel)
    nf = jnp.maximum(n, 1).astype(jnp.float32)
    large = max_exact + (jnp.log(nf / max_exact) / math.log(MAX_DISTANCE / max_exact)
                         * (nb - max_exact)).astype(jnp.int32)
    large = jnp.minimum(large, nb - 1)
    return ret + jnp.where(n < max_exact, n, large)


def rel_bias(q_pos, k_pos, table):
    bucket = t5_bucket(k_pos[None, :] - q_pos[:, None])
    return jnp.transpose(table[bucket].astype(jnp.float32), (2, 0, 1))


def diff_lambda(lq1, lk1, lq2, lk2, lam_init):
    f32 = lambda a: a.astype(jnp.float32)
    return (jnp.exp(jnp.sum(f32(lq1) * f32(lk1))) - jnp.exp(jnp.sum(f32(lq2) * f32(lk2)))
            + lam_init)


def qkv_proj(h, w_qkv):
    B, L, _ = h.shape
    qkv = jnp.einsum('bld,de->ble', h, w_qkv).reshape(B, L, 3, N_HEADS, HD2)
    return qkv[:, :, 0], qkv[:, :, 1], qkv[:, :, 2]


def diff_attend(q, k, v, bias, mask, lam, subln_g, lam_init):
    scale = HEAD_DIM ** -0.5
    s1 = jnp.einsum('bqhd,bkhd->bhqk', q[..., :HEAD_DIM], k[..., :HEAD_DIM]).astype(jnp.float32) * scale + bias
    s2 = jnp.einsum('bqhd,bkhd->bhqk', q[..., HEAD_DIM:], k[..., HEAD_DIM:]).astype(jnp.float32) * scale + bias
    s1 = jnp.where(mask, s1, NEG_INF)
    s2 = jnp.where(mask, s2, NEG_INF)
    p = jax.nn.softmax(s1, axis=-1) - lam * jax.nn.softmax(s2, axis=-1)
    o = jnp.einsum('bhqk,bkhd->bqhd', p.astype(v.dtype), v)
    o = rms_norm(o, subln_g, SUBLN_EPS) * (1.0 - lam_init)
    B, Lq = q.shape[:2]
    return o.reshape(B, Lq, ATTN_WIDTH)


def attend_rows(q, k_new, v_new, prev_k, prev_v, prev_pos, pos0, lam, subln_g, lam_init, rel_table):
    B, L = q.shape[:2]
    P = prev_k.shape[1]
    k_all = jnp.concatenate([jnp.broadcast_to(prev_k, (B,) + prev_k.shape[1:]), k_new], axis=1)
    v_all = jnp.concatenate([jnp.broadcast_to(prev_v, (B,) + prev_v.shape[1:]), v_new], axis=1)
    k_pos = jnp.concatenate([prev_pos.astype(jnp.int32), pos0 + jnp.arange(L, dtype=jnp.int32)])
    k_chunk = jnp.concatenate([jnp.full((P,), -1, jnp.int32), jnp.arange(L, dtype=jnp.int32) // CHUNK])

    def block(q_blk, start):
        idx = start + jnp.arange(q_blk.shape[1], dtype=jnp.int32)
        mask = k_chunk[None, :] <= (idx // CHUNK)[:, None]
        bias = rel_bias(pos0 + idx, k_pos, rel_table)
        return diff_attend(q_blk, k_all, v_all, bias, mask, lam, subln_g, lam_init)

    if L > Q_BLOCK:
        nblk = L // Q_BLOCK
        qb = q.reshape(B, nblk, Q_BLOCK, N_HEADS, HD2).swapaxes(0, 1)
        o = lax.map(lambda a: block(a[0], a[1] * Q_BLOCK), (qb, jnp.arange(nblk, dtype=jnp.int32)))
        return o.swapaxes(0, 1).reshape(B, L, ATTN_WIDTH)
    return block(q, 0)


def pool_mix(ext, n_prev, w_pool, scale):
    B, T, _ = ext.shape
    h = ext[:, n_prev:]
    L = T - n_prev
    c = jnp.cumsum(ext.astype(jnp.float32), axis=1)
    cnt = jnp.arange(1, T + 1, dtype=jnp.float32)[None, :, None]
    means = []
    for g, w in enumerate(POOL_WINDOWS):
        cg = c[..., g * POOL_GROUP:(g + 1) * POOL_GROUP]
        lower = jnp.pad(cg, ((0, 0), (w, 0), (0, 0)))[:, :T]
        means.append((cg - lower) / jnp.minimum(cnt, w))
    pooled = jnp.concatenate(means, axis=-1)[:, n_prev:]
    d = (pooled - h.astype(jnp.float32)).astype(ext.dtype).reshape(B, L, N_POOL_GROUPS, POOL_GROUP)
    y = jnp.einsum('blgc,gce->blge', d, w_pool).reshape(B, L, D_MODEL)
    return y * scale


def sq_relu_mlp(h, w_up, w_down):
    u = jnp.einsum('bld,df->blf', h, w_up)
    return jnp.einsum('blf,fd->bld', jnp.square(jax.nn.relu(u)), w_down)


def trunk(x, prev_k, prev_v, prev_pos, pos0, pool_prev, state_only_last,
          rel_table, norm_mix_pre, norm_mix_post, norm_ffn_pre, norm_ffn_post,
          w_qkv, lambda_q1, lambda_k1, lambda_q2, lambda_k2, subln_g, w_o,
          w_pool, pool_scale, w_up, w_down):
    ks, vs, tails = [], [], []
    for i in range(DEPTH):
        h = rms_norm(x, norm_mix_pre[i])
        last_state_only = state_only_last and i == DEPTH - 1
        if i % 2 == 0:
            a = i // 2
            q, k, v = qkv_proj(h, w_qkv[a])
            ks.append(k)
            vs.append(v)
            if last_state_only:
                break
            lam_init = 0.8 - 0.6 * math.exp(-0.3 * i)
            lam = diff_lambda(lambda_q1[a], lambda_k1[a], lambda_q2[a], lambda_k2[a], lam_init)
            o = attend_rows(q, k, v, prev_k[a], prev_v[a], prev_pos, pos0, lam, subln_g[a], lam_init, rel_table)
            y = jnp.einsum('ble,ed->bld', o, w_o[a])
        else:
            p = i // 2
            prev = pool_prev[p]
            ext = jnp.concatenate([jnp.broadcast_to(prev, (h.shape[0],) + prev.shape[1:]), h], axis=1)
            tails.append(ext[:, -POOL_STATE:])
            if last_state_only:
                break
            y = pool_mix(ext, prev.shape[1], w_pool[p], pool_scale[p])
        x = x + rms_norm(y, norm_mix_post[i])
        x = x + rms_norm(sq_relu_mlp(rms_norm(x, norm_ffn_pre[i]), w_up[i], w_down[i]), norm_ffn_post[i])
    return x, ks, vs, tails


def setup_inputs(seed: int = 0) -> dict:
    key = jax.random.key(seed)
    ks = jax.random.split(key, 24)
    n = lambda k, s, sc: jax.random.normal(k, s, jnp.float32) * sc
    return {
        "x_prompt": n(ks[0], (BATCH, SEQ, D_MODEL), 1.0),
        "x_sample": n(ks[1], (DEC_BATCH, DEC_SEQ, D_MODEL), 1.0),
        "cache_k": n(ks[2], (N_ATTN_LAYERS, DEC_BATCH, PAST_LEN, N_HEADS, HD2), 1.0),
        "cache_v": n(ks[3], (N_ATTN_LAYERS, DEC_BATCH, PAST_LEN, N_HEADS, HD2), 1.0),
        "state_pool": n(ks[4], (N_POOL_LAYERS, DEC_BATCH, POOL_STATE, D_MODEL), 1.0),
        "meta_tokens": n(ks[5], (N_META, D_MODEL), 1.0),
        "rel_bias_table": n(ks[6], (N_BUCKETS, N_HEADS), 0.5),
        "norm_mix_pre": 1.0 + n(ks[7], (DEPTH, D_MODEL), 0.05),
        "norm_mix_post": 1.0 + n(ks[8], (DEPTH, D_MODEL), 0.05),
        "norm_ffn_pre": 1.0 + n(ks[9], (DEPTH, D_MODEL), 0.05),
        "norm_ffn_post": 1.0 + n(ks[10], (DEPTH, D_MODEL), 0.05),
        "w_qkv": n(ks[11], (N_ATTN_LAYERS, D_MODEL, 3 * ATTN_WIDTH), D_MODEL ** -0.5),
        "lambda_q1": n(ks[12], (N_ATTN_LAYERS, HEAD_DIM), 0.1),
        "lambda_k1": n(ks[13], (N_ATTN_LAYERS, HEAD_DIM), 0.1),
        "lambda_q2": n(ks[14], (N_ATTN_LAYERS, HEAD_DIM), 0.1),
        "lambda_k2": n(ks[15], (N_ATTN_LAYERS, HEAD_DIM), 0.1),
        "subln_g": 1.0 + n(ks[16], (N_ATTN_LAYERS, HD2), 0.05),
        "w_o": n(ks[17], (N_ATTN_LAYERS, ATTN_WIDTH, D_MODEL), ATTN_WIDTH ** -0.5),
        "w_pool": n(ks[18], (N_POOL_LAYERS, N_POOL_GROUPS, POOL_GROUP, POOL_GROUP), POOL_GROUP ** -0.5),
        "pool_scale": 1.0 + n(ks[19], (N_POOL_LAYERS, D_MODEL), 0.1),
        "w_up": n(ks[20], (DEPTH, D_MODEL, D_FF), D_MODEL ** -0.5),
        "w_down": n(ks[21], (DEPTH, D_FF, D_MODEL), D_FF ** -0.5),
    }


def reference(x_prompt, x_sample, cache_k, cache_v, state_pool, meta_tokens, rel_bias_table,
              norm_mix_pre, norm_mix_post, norm_ffn_pre, norm_ffn_post, w_qkv,
              lambda_q1, lambda_k1, lambda_q2, lambda_k2, subln_g, w_o, w_pool, pool_scale,
              w_up, w_down):
    weights = (rel_bias_table, norm_mix_pre, norm_mix_post, norm_ffn_pre, norm_ffn_post,
               w_qkv, lambda_q1, lambda_k1, lambda_q2, lambda_k2, subln_g, w_o,
               w_pool, pool_scale, w_up, w_down)
    mdt = meta_tokens.dtype

    empty_kv = [jnp.zeros((1, 0, N_HEADS, HD2), mdt) for _ in range(N_ATTN_LAYERS)]
    empty_pool = [jnp.zeros((1, 0, D_MODEL), mdt) for _ in range(N_POOL_LAYERS)]
    _, meta_k, meta_v, meta_tail = trunk(meta_tokens[None], empty_kv, empty_kv,
                                         jnp.zeros((0,), jnp.int32), 0, empty_pool, True, *weights)

    y_prompt, k_p, v_p, tail_p = trunk(x_prompt, meta_k, meta_v, jnp.arange(N_META, dtype=jnp.int32),
                                       N_META, meta_tail, False, *weights)

    past = cache_k.shape[2]
    bd = x_sample.shape[0]
    prev_k_s = [jnp.concatenate([jnp.broadcast_to(meta_k[a], (bd,) + meta_k[a].shape[1:]), cache_k[a]], axis=1)
                for a in range(N_ATTN_LAYERS)]
    prev_v_s = [jnp.concatenate([jnp.broadcast_to(meta_v[a], (bd,) + meta_v[a].shape[1:]), cache_v[a]], axis=1)
                for a in range(N_ATTN_LAYERS)]
    prev_pos_s = jnp.concatenate([jnp.arange(N_META, dtype=jnp.int32) - N_META,
                                  jnp.arange(past, dtype=jnp.int32)])
    y_sample, k_s, v_s, tail_s = trunk(x_sample, prev_k_s, prev_v_s, prev_pos_s, past,
                                       [state_pool[p] for p in range(N_POOL_LAYERS)], False, *weights)

    bp = x_prompt.shape[0]
    k_prompt = jnp.stack([jnp.concatenate([jnp.broadcast_to(meta_k[a], (bp,) + meta_k[a].shape[1:]), k_p[a]], axis=1)
                          for a in range(N_ATTN_LAYERS)])
    v_prompt = jnp.stack([jnp.concatenate([jnp.broadcast_to(meta_v[a], (bp,) + meta_v[a].shape[1:]), v_p[a]], axis=1)
                          for a in range(N_ATTN_LAYERS)])
    pool_prompt = jnp.stack(tail_p)
    k_sample = jnp.stack(k_s)
    v_sample = jnp.stack(v_s)
    pool_sample = jnp.stack(tail_s)
    return (y_prompt, y_sample, k_prompt, v_prompt, pool_prompt, k_sample, v_sample, pool_sample)
```

```cpp
#include <hip/hip_runtime.h>
#include <hip/hip_cooperative_groups.h>
#include <hip/hip_bf16.h>
#include <cstdio>
#include <cstdint>
namespace cg = cooperative_groups;
namespace pg8 {
#define PG8_LAS __attribute__((address_space(3)))
typedef unsigned short bf16_t;
typedef short bf16x8 __attribute__((ext_vector_type(8)));
typedef float f32x4 __attribute__((ext_vector_type(4)));
typedef unsigned u32x4 __attribute__((ext_vector_type(4)));
constexpr int BM = 256, BK = 64, HALF = 128, HTB = HALF * BK * 2  , STAGE_BYTES = 8 * HTB, NXCD = 8, WGM = 8;

__host__ __device__ __forceinline__ int lds_byte(int r, int c) { const int st = (r >> 4) * 2 + (c >> 5), rr = r & 15, cc = c & 31, ob = rr * 64 + cc * 2; return st * 1024 + (ob ^ (((ob >> 9) & 1) << 5)); }
__host__ __device__ __forceinline__ void stage_rc(int b, int& R, int& C) { const int st = b / 1024, sb = b % 1024, swz = sb ^ (((sb >> 9) & 1) << 5); R = (st >> 1) * 16 + swz / 64; C = (st & 1) * 32 + (swz % 64) / 2; }
__host__ __device__ __forceinline__ int perm32(int rho) { const int n = rho >> 4, i = rho & 15; return 8 * (i >> 2) + 4 * n + (i & 3); }

struct Unit { int pm, pn; };
struct Gemm { const bf16_t* A; const bf16_t* Bt; int M, N, K, lda, ldb, acs; };

struct StaticOrder {
    int nM, nN, nwg, G, c;
    __host__ __device__ void init(int M, int N, int G_, int c_) { nM = M / BM; nN = N / BM; nwg = nM * nN; G = G_; c = c_; }
    __host__ __device__ bool next(int i, Unit& u) const {
        const long L = (long)i * G + c; if (L >= nwg) return false;
        int wgid = (int)L; { const int q = nwg / NXCD, r = nwg % NXCD, xcd = wgid % NXCD, off = wgid / NXCD; wgid = (xcd < r ? xcd * (q + 1) : r * (q + 1) + (xcd - r) * q) + off; }
        const int nig = WGM * nN, gid = wgid / nig, fm = gid * WGM, gsz = (nM - fm) < WGM ? (nM - fm) : WGM;
        u.pm = fm + ((wgid % nig) % gsz); u.pn = (wgid % nig) / gsz; return true;
    }
    __device__ __forceinline__ void a_ready(const Unit&) const {}
    __device__ __forceinline__ void done(const Unit&) const {}
};

__device__ __forceinline__ unsigned cvt_pk_bf16(float lo, float hi) { unsigned r; asm volatile("v_cvt_pk_bf16_f32 %0, %1, %2" : "=v"(r) : "v"(lo), "v"(hi)); return r; }
template <int ACT  > struct EpiBf16 {
    static constexpr bool PERM = true, AFTER_DRAIN = false;
    bf16_t* O; int ldc;
    __device__ __forceinline__ void operator()(const f32x4 (&acc)[2][2][4][2], const Unit& u, int wr, int wc, int fr, int fq) const {
        asm volatile("" : "+v"(fr), "+v"(fq));
        const int row0 = u.pm * BM + wr * 64 + fr; const int col0 = u.pn * BM + wc * 32 + 8 * fq;
#pragma unroll
        for (int ai = 0; ai < 2; ++ai)
#pragma unroll
            for (int m = 0; m < 4; ++m) { bf16_t* rowp = O + (size_t)(row0 + ai * HALF + m * 16) * ldc + col0;
#pragma unroll
                for (int bj = 0; bj < 2; ++bj) { f32x4 v0 = acc[ai][bj][m][0], v1 = acc[ai][bj][m][1];
                    if (ACT == 2) {
#pragma unroll
                        for (int e = 0; e < 4; ++e) { float a = fmaxf(v0[e], 0.f), b = fmaxf(v1[e], 0.f); v0[e] = a * a; v1[e] = b * b; } }
                    u32x4 w; w.x = cvt_pk_bf16(v0[0], v0[1]); w.y = cvt_pk_bf16(v0[2], v0[3]); w.z = cvt_pk_bf16(v1[0], v1[1]); w.w = cvt_pk_bf16(v1[2], v1[3]);
                    *(u32x4*)(rowp + bj * HALF) = w; } }
    }
};
struct EpiQKV {
    static constexpr bool PERM = true, AFTER_DRAIN = false;
    unsigned char* ws; float* out; int a;
    __device__ __forceinline__ void operator()(const f32x4 (&acc)[2][2][4][2], const Unit& u, int wr, int wc, int fr, int fq) const {
        const size_t MiB_ = 1u << 20;
        asm volatile("" : "+v"(fr), "+v"(fq));
        const int t3 = u.pn >> 2; const int colb = (u.pn & 3) * 256 + wc * 32 + 8 * fq;
        bf16_t* X; float* Fp = nullptr; int rbase, jump = 0, s0 = 0; float sc = 1.f;
        if (t3 == 0) { X = (bf16_t*)(ws + 213 * MiB_); rbase = u.pm * BM; sc = 0.125f * 1.4426950408889634f; }
        else if (u.pm < 256) { const int b = u.pm >> 5; rbase = b * 8208 + 16 + (u.pm & 31) * 256; X = (bf16_t*)(ws + (t3 == 1 ? 473 : 602) * MiB_);
            Fp = out + (t3 == 1 ? (size_t)67633152 : (size_t)202113024) + (size_t)a * 8 * 8208 * 1024 + (size_t)rbase * 1024; }
        else if (u.pm < 258) { s0 = (u.pm - 256) * 256; rbase = 1040 + s0; jump = 1040; X = (bf16_t*)(ws + (t3 == 1 ? 731 : 767) * MiB_) + (size_t)a * (9 * MiB_);
            Fp = out + (t3 == 1 ? (size_t)336838656 : (size_t)337887232) + (size_t)a * 512 * 1024 + (size_t)s0 * 1024; }
        else { rbase = 0; X = (bf16_t*)(ws + (t3 == 1 ? 803 : 804) * MiB_); Fp = (float*)(ws + (t3 == 1 ? 1323 : 1324) * MiB_); }
#pragma unroll
        for (int ai = 0; ai < 2; ++ai)
#pragma unroll
            for (int m = 0; m < 4; ++m) { const int rit = ai * HALF + wr * 64 + m * 16 + fr;
                bf16_t* xr = X + (unsigned)((rbase + rit + ((s0 + rit) >> 6) * jump) * 1024 + colb); float* fr_ = Fp + (unsigned)(rit * 1024 + colb);
#pragma unroll
                for (int bj = 0; bj < 2; ++bj) { const f32x4 v0 = acc[ai][bj][m][0], v1 = acc[ai][bj][m][1]; const f32x4 s0v = v0 * sc, s1v = v1 * sc;
                    u32x4 w; w.x = cvt_pk_bf16(s0v[0], s0v[1]); w.y = cvt_pk_bf16(s0v[2], s0v[3]); w.z = cvt_pk_bf16(s1v[0], s1v[1]); w.w = cvt_pk_bf16(s1v[2], s1v[3]);
                    *(u32x4*)(xr + bj * HALF) = w;
                    if (t3 != 0) { *(f32x4*)(fr_ + bj * HALF) = v0; *(f32x4*)(fr_ + bj * HALF + 4) = v1; } } }
    }
};
template <class Epi, class Sched, bool ALIGN_EPI = false, bool SP2 = false>
__device__ __forceinline__ void gemm_phase(PG8_LAS unsigned char* lds, const Gemm g, const Sched& S, const Epi& E) {
    int tid_ = threadIdx.x; asm volatile("" : "+v"(tid_));
    const int tid = tid_, wid = __builtin_amdgcn_readfirstlane(tid >> 6), lane = tid & 63, wr = wid >> 2, wc = wid & 3, fr = lane & 15, fq = lane >> 4;
    const int K = g.K, nt = K / BK;
    unsigned voffA[2], voffB[2];
#pragma unroll
    for (int i = 0; i < 2; ++i) { int R, C; stage_rc(tid * 16 + i * 8192, R, C); const int Rb = Epi::PERM ? ((R & ~31) + perm32(R & 31)) : R;
        voffA[i] = (unsigned)(R * g.lda + C) * 2u; voffB[i] = (unsigned)(Rb * g.ldb + C) * 2u; }
    const size_t kstep = (size_t)(BK * 2);
    const size_t hstepA = (size_t)HALF * g.lda * 2, hstepB = (size_t)HALF * g.ldb * 2;
    const size_t tstepA = 2 * hstepA, tstepB = 2 * hstepB;
    const unsigned ldsw = (unsigned)wid * 1024u;
    const int aoff = lds_byte(wr * 64 + fr, fq * 8), boff = lds_byte(wc * 32 + fr, fq * 8);
#define PG8_SA(b, h) (((b) * 2 + (h)) * HTB)
#define PG8_SB(b, h) ((4 + (b) * 2 + (h)) * HTB)
#define PG8_STAGE(bufoff, gbase, voff) do { _Pragma("unroll") for (int _i = 0; _i < 2; ++_i) \
        __builtin_amdgcn_global_load_lds((const unsigned*)((const char*)(gbase) + (voff)[_i]), (PG8_LAS unsigned*)(lds + (bufoff) + ldsw + _i * 8192), 16, 0, 0); } while (0)
#define PG8_LDA(dst, b, h) do { _Pragma("unroll") for (int m = 0; m < 4; ++m) _Pragma("unroll") for (int k = 0; k < 2; ++k) dst[m][k] = *(const PG8_LAS bf16x8*)(lds + PG8_SA(b, h) + aoff + m * 2048 + k * 1024); } while (0)
#define PG8_LDB(dst, b, h) do { _Pragma("unroll") for (int n = 0; n < 2; ++n) _Pragma("unroll") for (int k = 0; k < 2; ++k) dst[n][k] = *(const PG8_LAS bf16x8*)(lds + PG8_SB(b, h) + boff + n * 2048 + k * 1024); } while (0)
#define PG8_MMA(ai, bj, At, Bt) do { __builtin_amdgcn_s_setprio(1); _Pragma("unroll") for (int m = 0; m < 4; ++m) _Pragma("unroll") for (int n = 0; n < 2; ++n) _Pragma("unroll") for (int k = 0; k < 2; ++k) \
        acc[ai][bj][m][n] = __builtin_amdgcn_mfma_f32_16x16x32_bf16(Bt[n][k], At[m][k], acc[ai][bj][m][n], 0, 0, 0); __builtin_amdgcn_s_setprio(0); } while (0)
#define PG8_WAIT_V(n) asm volatile("s_waitcnt vmcnt(" #n ")" ::: "memory")
#define PG8_WAIT_L(n) asm volatile("s_waitcnt lgkmcnt(" #n ")" ::: "memory")
#define PG8_BAR __builtin_amdgcn_s_barrier()
#define PG8_SCHED __builtin_amdgcn_sched_barrier(0)
    Unit cur, nxt; int ui = 0;
    if (!S.next(0, cur)) return;
    f32x4 acc[2][2][4][2];
#pragma unroll
    for (int a = 0; a < 2; ++a)
#pragma unroll
        for (int b = 0; b < 2; ++b)
#pragma unroll
            for (int m = 0; m < 4; ++m)
#pragma unroll
                for (int n = 0; n < 2; ++n) acc[a][b][m][n] = (f32x4){0.f, 0.f, 0.f, 0.f};
    bf16x8 At[4][2], B0[2][2], B1[2][2];
    const char* cA = (const char*)g.A + (size_t)cur.pm * tstepA + (size_t)cur.pn * g.acs; const char* cB = (const char*)g.Bt + (size_t)cur.pn * tstepB;
    S.a_ready(cur);
    if constexpr (SP2) {
        PG8_STAGE(PG8_SB(0, 0), cB, voffB); PG8_STAGE(PG8_SB(0, 1), cB + hstepB, voffB); PG8_STAGE(PG8_SA(0, 0), cA, voffA); PG8_STAGE(PG8_SA(0, 1), cA + hstepA, voffA);
        if (wr == 1) PG8_BAR;
        PG8_WAIT_V(2); PG8_BAR;
        PG8_STAGE(PG8_SB(1, 0), cB + kstep, voffB); PG8_STAGE(PG8_SA(1, 0), cA + kstep, voffA); PG8_STAGE(PG8_SB(1, 1), cB + hstepB + kstep, voffB);
        PG8_WAIT_V(6); PG8_BAR;
    } else {
        PG8_STAGE(PG8_SB(0, 0), cB, voffB); PG8_STAGE(PG8_SA(0, 0), cA, voffA); PG8_STAGE(PG8_SB(0, 1), cB + hstepB, voffB); PG8_STAGE(PG8_SA(0, 1), cA + hstepA, voffA);
        if (wr == 1) PG8_BAR;
        PG8_WAIT_V(4); PG8_BAR;
        PG8_STAGE(PG8_SB(1, 0), cB + kstep, voffB); PG8_STAGE(PG8_SA(1, 0), cA + kstep, voffA); PG8_STAGE(PG8_SB(1, 1), cB + hstepB + kstep, voffB);
        PG8_WAIT_V(6); PG8_BAR;
    }
    for (;;) {
        const bool has_next = S.next(ui + 1, nxt);
        const char* nA = has_next ? (const char*)g.A + (size_t)nxt.pm * tstepA + (size_t)nxt.pn * g.acs : cA; const char* nB = has_next ? (const char*)g.Bt + (size_t)nxt.pn * tstepB : cB;
        for (int t = 0; t < nt; t += 2) {
            const bool last = (t == nt - 2);
            const char* a1 = cA + (size_t)(t + 1) * kstep;
            const char* a2 = last ? nA : cA + (size_t)(t + 2) * kstep; const char* b2 = last ? nB : cB + (size_t)(t + 2) * kstep;
            const char* a3 = a2 + kstep; const char* b3 = b2 + kstep;
            if (last && has_next) S.a_ready(nxt);
            if constexpr (SP2) {
            PG8_LDB(B0, 0, 0); PG8_LDB(B1, 0, 1); PG8_SCHED; PG8_LDA(At, 0, 0); PG8_STAGE(PG8_SA(1, 1), a1 + hstepA, voffA);
            PG8_WAIT_V(8); PG8_WAIT_L(0); PG8_BAR; PG8_MMA(0, 0, At, B0); PG8_MMA(0, 1, At, B1); PG8_BAR; PG8_SCHED;
            PG8_LDA(At, 0, 1); PG8_STAGE(PG8_SB(0, 0), b2, voffB); PG8_STAGE(PG8_SB(0, 1), b2 + hstepB, voffB); PG8_STAGE(PG8_SA(0, 0), a2, voffA);
            PG8_WAIT_V(8); PG8_WAIT_L(0); PG8_BAR; PG8_MMA(1, 0, At, B0); PG8_MMA(1, 1, At, B1); PG8_BAR; PG8_SCHED;
            PG8_LDB(B0, 1, 0); PG8_LDB(B1, 1, 1); PG8_SCHED; PG8_LDA(At, 1, 0); PG8_STAGE(PG8_SA(0, 1), a2 + hstepA, voffA);
            PG8_WAIT_V(8); PG8_WAIT_L(0); PG8_BAR; PG8_MMA(0, 0, At, B0); PG8_MMA(0, 1, At, B1); PG8_BAR; PG8_SCHED;
            PG8_LDA(At, 1, 1); PG8_STAGE(PG8_SB(1, 0), b3, voffB); PG8_STAGE(PG8_SB(1, 1), b3 + hstepB, voffB); PG8_STAGE(PG8_SA(1, 0), a3, voffA);
            PG8_WAIT_V(8); PG8_WAIT_L(0); PG8_BAR; PG8_MMA(1, 0, At, B0); PG8_MMA(1, 1, At, B1); PG8_BAR; PG8_SCHED;
            } else {
            PG8_LDB(B0, 0, 0); PG8_SCHED; PG8_LDA(At, 0, 0); PG8_STAGE(PG8_SA(1, 1), a1 + hstepA, voffA);
            PG8_WAIT_L(8); PG8_BAR; PG8_WAIT_L(0); PG8_MMA(0, 0, At, B0); PG8_BAR; PG8_SCHED;
            PG8_LDB(B1, 0, 1); PG8_STAGE(PG8_SB(0, 0), b2, voffB);
            PG8_BAR; PG8_WAIT_L(0); PG8_MMA(0, 1, At, B1); PG8_BAR;
            PG8_LDA(At, 0, 1); PG8_STAGE(PG8_SA(0, 0), a2, voffA);
            PG8_BAR; PG8_WAIT_L(0); PG8_MMA(1, 0, At, B0); PG8_BAR; PG8_SCHED;
            PG8_STAGE(PG8_SB(0, 1), b2 + hstepB, voffB);
            PG8_WAIT_V(6); PG8_BAR; PG8_MMA(1, 1, At, B1); PG8_BAR;
            PG8_LDB(B0, 1, 0); PG8_SCHED; PG8_LDA(At, 1, 0); PG8_STAGE(PG8_SA(0, 1), a2 + hstepA, voffA);
            PG8_WAIT_L(8); PG8_BAR; PG8_WAIT_L(0); PG8_MMA(0, 0, At, B0); PG8_BAR; PG8_SCHED;
            PG8_LDB(B1, 1, 1); PG8_STAGE(PG8_SB(1, 0), b3, voffB);
            PG8_BAR; PG8_WAIT_L(0); PG8_MMA(0, 1, At, B1); PG8_BAR;
            PG8_LDA(At, 1, 1); PG8_STAGE(PG8_SA(1, 0), a3, voffA);
            PG8_BAR; PG8_WAIT_L(0); PG8_MMA(1, 0, At, B0); PG8_BAR; PG8_SCHED;
            PG8_STAGE(PG8_SB(1, 1), b3 + hstepB, voffB);
            PG8_WAIT_V(6); PG8_BAR; PG8_MMA(1, 1, At, B1); PG8_BAR;
            }
        }
        if constexpr (ALIGN_EPI) { if (wr == 0) PG8_BAR; }
        if constexpr (!Epi::AFTER_DRAIN) { E(acc, cur, wr, wc, fr, fq); S.done(cur); }
        if (!has_next) break;
#pragma unroll
        for (int a = 0; a < 2; ++a)
#pragma unroll
            for (int b = 0; b < 2; ++b)
#pragma unroll
                for (int m = 0; m < 4; ++m)
#pragma unroll
                    for (int n = 0; n < 2; ++n) acc[a][b][m][n] = (f32x4){0.f, 0.f, 0.f, 0.f};
        cur = nxt; cA = nA; cB = nB; ++ui;
        if constexpr (ALIGN_EPI) { if (wr == 1) PG8_BAR; }
    }
    PG8_WAIT_V(0);
    if constexpr (!ALIGN_EPI) { if (wr == 0) PG8_BAR; }
    PG8_BAR;
    if constexpr (Epi::AFTER_DRAIN) { E.fused(acc, cur, wr, wc, fr, fq, lds, wid, lane); S.done(cur); }
#undef PG8_SA
#undef PG8_SB
#undef PG8_STAGE
#undef PG8_LDA
#undef PG8_LDB
#undef PG8_MMA
#undef PG8_WAIT_V
#undef PG8_WAIT_L
#undef PG8_BAR
#undef PG8_SCHED
}
}
#define LAS __attribute__((address_space(3)))
typedef unsigned short bf16;
typedef unsigned u32x4 __attribute__((ext_vector_type(4)));
typedef unsigned u32x2 __attribute__((ext_vector_type(2)));
typedef float f32x4 __attribute__((ext_vector_type(4)));
typedef float f32x2 __attribute__((ext_vector_type(2)));
typedef float f32x16 __attribute__((ext_vector_type(16)));
typedef short bf16x8 __attribute__((ext_vector_type(8)));
typedef short s16x4 __attribute__((ext_vector_type(4)));
constexpr int D = 1024, FF = 4096, NH = 8;
constexpr int ROW_S = 65536, ROW_M = 66048, ROWS_VALID = 66064, MPAD = 66304;
constexpr int EXT_P = 8208, EXT_S = 1104;
constexpr float LOG2E = 1.4426950408889634f;
constexpr float QSCALE = 0.125f * LOG2E;
constexpr float EPS = 1e-6f, SUBLN_EPS = 1e-5f;
constexpr size_t OFF_YP = 0, OFF_YS = 67108864, OFF_KP = OFF_YS + 524288, OFF_VP = OFF_KP + 134479872, OFF_PP = OFF_VP + 134479872,
                 OFF_KS = OFF_PP + 245760, OFF_VS = OFF_KS + 1048576, OFF_PS = OFF_VS + 1048576, OUT_TOTAL = OFF_PS + 245760;
constexpr size_t MiB = 1u << 20;
constexpr size_t WS_WQKV = 1 * MiB, WS_WO = 13 * MiB, WS_WPOOL = 17 * MiB, WS_WUP = 18 * MiB, WS_WDN = 50 * MiB, WS_XM = 82 * MiB,
                 WS_XN = 83 * MiB, WS_QB = 213 * MiB, WS_YB = 343 * MiB, WS_KX = 473 * MiB, WS_VX = 602 * MiB, WS_KXS = 731 * MiB, WS_VXS = 767 * MiB,
                 WS_KXM = 803 * MiB, WS_VXM = 804 * MiB, WS_U = 805 * MiB, WS_MFK = 1323 * MiB, WS_MFV = 1324 * MiB, WS_END = 1325 * MiB;
constexpr size_t KXS_LAYER = 18 * MiB / 2;
constexpr int LDS_BYTES = 147456;
constexpr int NSTEPS = 27;
#ifndef ONE_LAUNCH
#define ONE_LAUNCH 1
#endif

__device__ __forceinline__ unsigned f2bf(float f) { unsigned u = __builtin_bit_cast(unsigned, f); return (u + 0x7fffu + ((u >> 16) & 1u)) >> 16; }
__device__ __forceinline__ unsigned pk2(float lo, float hi) { return f2bf(lo) | (f2bf(hi) << 16); }
__device__ __forceinline__ float bflo(unsigned w) { return __builtin_bit_cast(float, w << 16); }
__device__ __forceinline__ float bfhi(unsigned w) { return __builtin_bit_cast(float, w & 0xffff0000u); }
__device__ __forceinline__ float wave_sum(float v) {
#pragma unroll
    for (int o = 1; o < 64; o <<= 1) v += __shfl_xor(v, o);
    return v;
}

struct Args { const float* in[22]; float* out; unsigned char* ws; int lo, hi; };
typedef const __attribute__((address_space(4))) Args& ArgsRef;
struct Frame {
    LAS unsigned char* lds; int tid, lane, wave, vcu, G;
    float* out; unsigned char* ws;
};

__device__ __forceinline__ void transpose_item(const float* W, int K, int N, bf16* WT, LAS float* scr, int item, int lane, const float* nscale) {
    const int nblk = N / 32, kb = item / nblk, nb = item % nblk, k0 = 64 * kb, n0 = 32 * nb;
#pragma unroll 8
    for (int i = 0; i < 32; ++i) { const int kk = 2 * i + (lane >> 5); scr[kk * 33 + (lane & 31)] = W[(size_t)(k0 + kk) * N + n0 + (lane & 31)]; }
    asm volatile("s_waitcnt lgkmcnt(0)" ::: "memory");
    const int c = lane & 7;
#pragma unroll
    for (int j = 0; j < 4; ++j) { const int n = (lane >> 3) + 8 * j; const LAS float* s = scr + (8 * c) * 33 + n; const float sc = nscale ? nscale[n0 + n] : 1.f;
        u32x4 o; o.x = pk2(s[0 * 33] * sc, s[1 * 33] * sc); o.y = pk2(s[2 * 33] * sc, s[3 * 33] * sc); o.z = pk2(s[4 * 33] * sc, s[5 * 33] * sc); o.w = pk2(s[6 * 33] * sc, s[7 * 33] * sc);
        *(u32x4*)(WT + (size_t)(n0 + n) * K + k0 + 8 * c) = o; }
    asm volatile("s_waitcnt lgkmcnt(0)" ::: "memory");
}
__device__ __forceinline__ const float* xin_row(ArgsRef A, int row) {
    return row < ROW_S ? A.in[0] + (size_t)row * D : row < ROW_M ? A.in[1] + (size_t)(row - ROW_S) * D : A.in[5] + (size_t)(row - ROW_M) * D;
}
__device__ __forceinline__ float* xres_row(const Frame& F, int row) {
    return row < ROW_S ? F.out + OFF_YP + (size_t)row * D : row < ROW_M ? F.out + OFF_YS + (size_t)(row - ROW_S) * D : (float*)(F.ws + WS_XM) + (size_t)(row - ROW_M) * D;
}
__device__ __forceinline__ void prologue(ArgsRef A, Frame& F) {
    LAS float* scr = (LAS float*)(F.lds + F.wave * 16384);
    const int gw = F.vcu * 8 + F.wave, NGW = F.G * 8;
    constexpr int I_QKV = 16 * 96, I_O = 16 * 32, I_UP = 16 * 128, I_DN = 64 * 32, I_PL = 4 * 8;
    constexpr int NITEMS = 2 * I_QKV + 2 * I_O + 4 * I_UP + 4 * I_DN + 8 * I_PL;
    for (int it = gw; it < NITEMS; it += NGW) {
        int r = it;
        if (r < 2 * I_QKV) { const int a = r / I_QKV; transpose_item(A.in[11] + (size_t)a * D * 3072, D, 3072, (bf16*)(F.ws + WS_WQKV) + (size_t)a * 3072 * D, scr, r % I_QKV, F.lane, nullptr); continue; } r -= 2 * I_QKV;
        if (r < 2 * I_O) { const int a = r / I_O; transpose_item(A.in[17] + (size_t)a * D * D, D, D, (bf16*)(F.ws + WS_WO) + (size_t)a * D * D, scr, r % I_O, F.lane, nullptr); continue; } r -= 2 * I_O;
        if (r < 4 * I_UP) { const int i = r / I_UP; transpose_item(A.in[20] + (size_t)i * D * FF, D, FF, (bf16*)(F.ws + WS_WUP) + (size_t)i * D * FF, scr, r % I_UP, F.lane, nullptr); continue; } r -= 4 * I_UP;
        if (r < 4 * I_DN) { const int i = r / I_DN; transpose_item(A.in[21] + (size_t)i * D * FF, FF, D, (bf16*)(F.ws + WS_WDN) + (size_t)i * D * FF, scr, r % I_DN, F.lane, nullptr); continue; } r -= 4 * I_DN;
        { const int pg = r / I_PL; transpose_item(A.in[18] + (size_t)pg * 65536, 256, 256, (bf16*)(F.ws + WS_WPOOL) + (size_t)pg * 65536, scr, r % I_PL, F.lane, A.in[19] + pg * 256); }
    }
    for (int it = gw; it < 32768; it += NGW) {
        const int j = it & 1023, b = (it >> 10) & 7, kv = (it >> 13) & 1, a = it >> 14;
        const float* src = (kv ? A.in[3] : A.in[2]) + ((size_t)(a * 8 + b) * 1024 + j) * D;
        bf16* dst = (bf16*)(F.ws + (kv ? WS_VXS : WS_KXS)) + (size_t)a * KXS_LAYER + (size_t)(b * EXT_S + 16 + j) * D;
#pragma unroll
        for (int q = 0; q < 4; ++q) { const f32x4 v = *(const f32x4*)(src + 4 * F.lane + 256 * q); u32x2 w; w.x = pk2(v.x, v.y); w.y = pk2(v.z, v.w); *(u32x2*)(dst + 4 * F.lane + 256 * q) = w; }
    }
    const float* g = A.in[7];
    for (int row = gw; row < MPAD; row += NGW) {
        bf16* xn = (bf16*)(F.ws + WS_XN) + (size_t)row * D;
        if (row >= ROWS_VALID) {
#pragma unroll
            for (int q = 0; q < 4; ++q) *(u32x2*)(xn + 4 * F.lane + 256 * q) = (u32x2){0u, 0u};
            continue; }
        const float* x = xin_row(A, row); f32x4 v[4]; float ss = 0.f;
#pragma unroll
        for (int q = 0; q < 4; ++q) { v[q] = *(const f32x4*)(x + 4 * F.lane + 256 * q); ss += v[q].x * v[q].x + v[q].y * v[q].y + v[q].z * v[q].z + v[q].w * v[q].w; }
        const float r = 1.0f / sqrtf(wave_sum(ss) * (1.f / D) + EPS);
#pragma unroll
        for (int q = 0; q < 4; ++q) { const f32x4 gg = *(const f32x4*)(g + 4 * F.lane + 256 * q); u32x2 w; w.x = pk2(v[q].x * r * gg.x, v[q].y * r * gg.y); w.y = pk2(v[q].z * r * gg.z, v[q].w * r * gg.w);
            *(u32x2*)(xn + 4 * F.lane + 256 * q) = w; }
    }
}
__device__ __forceinline__ void fin_phase(ArgsRef A, Frame& F, bool from_inputs, const float* gpost, const float* gnext) {
    const int gw = F.vcu * 8 + F.wave, NGW = F.G * 8;
    const bf16* YB = (const bf16*)(F.ws + WS_YB);
    for (int row = gw; row < ROWS_VALID; row += NGW) {
        const bf16* y = YB + (size_t)row * D; const float* xi = from_inputs ? xin_row(A, row) : xres_row(F, row); float* xo = xres_row(F, row);
        f32x4 yv[4], xv[4]; float ss = 0.f;
#pragma unroll
        for (int q = 0; q < 4; ++q) { const u32x2 w = *(const u32x2*)(y + 4 * F.lane + 256 * q); yv[q] = (f32x4){bflo(w.x), bfhi(w.x), bflo(w.y), bfhi(w.y)};
            xv[q] = *(const f32x4*)(xi + 4 * F.lane + 256 * q); ss += yv[q].x * yv[q].x + yv[q].y * yv[q].y + yv[q].z * yv[q].z + yv[q].w * yv[q].w; }
        const float r = 1.0f / sqrtf(wave_sum(ss) * (1.f / D) + EPS); float s2 = 0.f;
#pragma unroll
        for (int q = 0; q < 4; ++q) { const f32x4 gg = *(const f32x4*)(gpost + 4 * F.lane + 256 * q); xv[q] = xv[q] + yv[q] * r * gg; *(f32x4*)(xo + 4 * F.lane + 256 * q) = xv[q];
            s2 += xv[q].x * xv[q].x + xv[q].y * xv[q].y + xv[q].z * xv[q].z + xv[q].w * xv[q].w; }
        if (gnext) { const float r2 = 1.0f / sqrtf(wave_sum(s2) * (1.f / D) + EPS); bf16* xn = (bf16*)(F.ws + WS_XN) + (size_t)row * D;
#pragma unroll
            for (int q = 0; q < 4; ++q) { const f32x4 gg = *(const f32x4*)(gnext + 4 * F.lane + 256 * q); u32x2 w; w.x = pk2(xv[q].x * r2 * gg.x, xv[q].y * r2 * gg.y); w.y = pk2(xv[q].z * r2 * gg.z, xv[q].w * r2 * gg.w);
                *(u32x2*)(xn + 4 * F.lane + 256 * q) = w; } }
    }
}
__device__ __forceinline__ f32x2 pool_h(ArgsRef A, const Frame& F, int grp, int b, int t, int col, int p) {
    const bf16* XN = (const bf16*)(F.ws + WS_XN);
    if (t >= 0) { const int row = grp == 0 ? b * 8192 + t : grp == 1 ? ROW_S + b * 64 + t : ROW_M + t; const unsigned w = *(const unsigned*)(XN + (size_t)row * D + col); return (f32x2){bflo(w), bfhi(w)}; }
    if (grp == 0) { const unsigned w = *(const unsigned*)(XN + (size_t)(ROW_M + 16 + t) * D + col); return (f32x2){bflo(w), bfhi(w)}; }
    if (grp == 1) return *(const f32x2*)(A.in[4] + ((size_t)(p * 8 + b) * 15 + 15 + t) * D + col);
    return (f32x2){0.f, 0.f};
}
__device__ __forceinline__ void pool_phase(ArgsRef A, Frame& F, int p) {
    bf16* DB = (bf16*)(F.ws + WS_QB);
    const int col = 2 * F.tid, w = 2 << (col >> 8);
    for (int it = F.vcu; it < 2065; it += F.G) {
        int grp, b, t0, nr;
        if (it < 2048) { grp = 0; b = it >> 8; t0 = (it & 255) * 32; nr = 32; } else if (it < 2064) { const int s = it - 2048; grp = 1; b = s >> 1; t0 = (s & 1) * 32; nr = 32; } else { grp = 2; b = 0; t0 = 0; nr = 16; }
        f32x2 sum = {0.f, 0.f};
        for (int j = 1; j < w; ++j) sum += pool_h(A, F, grp, b, t0 - j, col, p);
        for (int t = t0; t < t0 + nr; ++t) {
            const f32x2 cur = pool_h(A, F, grp, b, t, col, p); sum += cur;
            const float inv = 1.0f / (float)(grp == 2 ? min(t + 1, w) : w);
            const int row = grp == 0 ? b * 8192 + t : grp == 1 ? ROW_S + b * 64 + t : ROW_M + t;
            *(unsigned*)(DB + (size_t)row * D + col) = pk2(sum.x * inv - cur.x, sum.y * inv - cur.y);
            sum -= pool_h(A, F, grp, b, t - w + 1, col, p);
            if (grp == 0 && t >= 8177) *(f32x2*)(F.out + OFF_PP + ((size_t)(p * 8 + b) * 15 + (t - 8177)) * D + col) = cur;
            if (grp == 1 && t >= 49) *(f32x2*)(F.out + OFF_PS + ((size_t)(p * 8 + b) * 15 + (t - 49)) * D + col) = cur;
        }
    }
}

namespace att {
constexpr int KSTR = 272, VSTR = 320, KT = 64 * KSTR, VT = 64 * VSTR;
constexpr int OFF_K0 = 0, OFF_K1 = KT, OFF_V0 = 2 * KT, OFF_V1 = 2 * KT + VT, OFF_BT = 2 * KT + 2 * VT, OFF_GT = OFF_BT + 1024, XB = 16384;
static_assert(OFF_BT >= 4 * XB && OFF_GT + 512 <= 131072, "attention LDS map");
constexpr float NEG = -1e30f;
struct AUnit { const bf16* K; const bf16* V; const bf16* KM; const bf16* VM; bf16* Q; int P, L, x, h; };
__device__ __forceinline__ float swapmax(float v) { auto rr = __builtin_amdgcn_permlane32_swap(__float_as_uint(v), __float_as_uint(v), false, false); return fmaxf(__uint_as_float(rr[0]), __uint_as_float(rr[1])); }
__device__ __forceinline__ float swapsum(float v) { auto rr = __builtin_amdgcn_permlane32_swap(__float_as_uint(v), __float_as_uint(v), false, false); return __uint_as_float(rr[0]) + __uint_as_float(rr[1]); }
typedef __bf16 bf16x2_t __attribute__((ext_vector_type(2)));
__device__ __forceinline__ unsigned cvtpk(float lo, float hi) { f32x2 v = {lo, hi}; bf16x2_t b = __builtin_convertvector(v, bf16x2_t); return __builtin_bit_cast(unsigned, b); }
__device__ __forceinline__ s16x4 vtr(const LAS unsigned char* p) { return __builtin_bit_cast(s16x4, __builtin_amdgcn_ds_read_tr16_b64_v4i16((LAS s16x4*)p)); }
__device__ __forceinline__ bf16x8 pack8(const f32x16& S, int o) {
    u32x4 w; w.x = cvtpk(S[o], S[o + 1]); w.y = cvtpk(S[o + 2], S[o + 3]); w.z = cvtpk(S[o + 4], S[o + 5]); w.w = cvtpk(S[o + 6], S[o + 7]); return __builtin_bit_cast(bf16x8, w);
}

__device__ __forceinline__ void attn_unit(LAS unsigned char* lds, const AUnit& u, const float lam, const float lam_init, const float* relb, const float* subg) {
    int tid_ = threadIdx.x; asm volatile("" : "+v"(tid_));
    const int tid = tid_, lane = tid & 63, wid = __builtin_amdgcn_readfirstlane(tid >> 6), mp = wid >> 2, rg = wid & 3, q32 = lane & 31, hi = lane >> 5;
    LAS float* BT = (LAS float*)(lds + OFF_BT); LAS float* GT = (LAS float*)(lds + OFF_GT);
    if (tid < 256) { const int rel = tid - 128, n = rel < 0 ? -rel : rel;
        int bk = n < 8 ? n : n < 12 ? 8 : n < 16 ? 9 : n < 23 ? 10 : n < 32 ? 11 : n < 46 ? 12 : n < 64 ? 13 : n < 91 ? 14 : 15; if (rel > 0) bk += 16;
        BT[tid] = relb[bk * 8 + u.h] * LOG2E; }
    else if (tid < 384) GT[tid - 256] = subg[tid - 256] * (1.0f - lam_init);
    const int vrows = min(128, u.L - 128 * u.x);
    const bool active = rg * 32 < vrows;
    const int ch = rg >> 1;
    const int NTw = active ? (u.P + min((2 * u.x + ch + 1) * 64, u.L) + 48) >> 6 : 0;
    const int NT = (u.P + min((2 * u.x + 2) * 64, u.L) + 48) >> 6;
    const int eq0 = u.P + 128 * u.x + rg * 32, eq = eq0 + q32;
    bf16x8 qf[4];
    { const bf16* qp = u.Q + (size_t)(128 * u.x + rg * 32 + q32) * 1024 + u.h * 128 + mp * 64 + hi * 8;
#pragma unroll
      for (int d0 = 0; d0 < 4; ++d0) qf[d0] = active ? *(const bf16x8*)(qp + d0 * 16) : (bf16x8){0, 0, 0, 0, 0, 0, 0, 0}; }
    const int lrow = tid >> 3, lc = (tid & 7) * 2;
    const bf16* kg = u.K + (size_t)lrow * 1024 + u.h * 128 + lc * 8; const bf16* vg = u.V + (size_t)lrow * 1024 + u.h * 128 + lc * 8;
    const int kwo = lrow * KSTR + lc * 16, vwo = lrow * VSTR + lc * 16;
    const bf16* kg0 = lrow < 16 ? u.KM + (size_t)lrow * 1024 + u.h * 128 + lc * 8 : kg; const bf16* vg0 = lrow < 16 ? u.VM + (size_t)lrow * 1024 + u.h * 128 + lc * 8 : vg;
    u32x4 kr0 = *(const u32x4*)kg0, kr1 = *(const u32x4*)(kg0 + 8), vr0 = *(const u32x4*)vg0, vr1 = *(const u32x4*)(vg0 + 8);
    *(LAS u32x4*)(lds + OFF_K0 + kwo) = kr0; *(LAS u32x4*)(lds + OFF_K0 + kwo + 16) = kr1; *(LAS u32x4*)(lds + OFF_V0 + vwo) = vr0; *(LAS u32x4*)(lds + OFF_V0 + vwo + 16) = vr1;
    __syncthreads();
    const float c15 = BT[0];
    f32x16 O[4];
#pragma unroll
    for (int i = 0; i < 4; ++i)
#pragma unroll
        for (int r = 0; r < 16; ++r) O[i][r] = 0.f;
    float m = NEG, l = 0.f;
    const int kro = q32 * KSTR + mp * 128 + hi * 16;
    const int vro = (((lane & 15) >> 2) + 4 * hi) * VSTR + ((lane >> 4) & 1) * 32 + (lane & 3) * 8;
    for (int t = 0; t < NT; ++t) {
        const int cur = t & 1;
        if (t + 1 < NT) { const size_t go = (size_t)(t + 1) * 64 * 1024; kr0 = *(const u32x4*)(kg + go); kr1 = *(const u32x4*)(kg + go + 8); vr0 = *(const u32x4*)(vg + go); vr1 = *(const u32x4*)(vg + go + 8); }
        if (t < NTw) {
            const int k0 = t * 64; const bool near = (k0 + 154 > eq0); const bool last = (t == NTw - 1);
            const LAS unsigned char* kb = lds + (cur ? OFF_K1 : OFF_K0) + kro;
            f32x16 S0, S1; const float ini = near ? 0.f : c15;
#pragma unroll
            for (int r = 0; r < 16; ++r) { S0[r] = ini; S1[r] = ini; }
#pragma unroll
            for (int d0 = 0; d0 < 4; ++d0) { const bf16x8 kf0 = *(const LAS bf16x8*)(kb + d0 * 32), kf1 = *(const LAS bf16x8*)(kb + 32 * KSTR + d0 * 32);
                S0 = __builtin_amdgcn_mfma_f32_32x32x16_bf16(kf0, qf[d0], S0, 0, 0, 0); S1 = __builtin_amdgcn_mfma_f32_32x32x16_bf16(kf1, qf[d0], S1, 0, 0, 0); }
            if (near) { const int base = k0 - eq + 128 + 4 * hi;
#pragma unroll
                for (int r = 0; r < 16; ++r) { const int i0 = base + (r & 3) + 8 * (r >> 2); S0[r] += BT[min(max(i0, 0), 255)]; S1[r] += BT[min(max(i0 + 32, 0), 255)]; } }
            if (last) {
#pragma unroll
                for (int r = 0; r < 16; ++r) { if (r >= 8) S0[r] = NEG; S1[r] = NEG; } }
            float mx = fmaxf(S0[0], S1[0]);
#pragma unroll
            for (int r = 1; r < 16; ++r) mx = fmaxf(mx, fmaxf(S0[r], S1[r]));
            mx = swapmax(mx);
            if (__any(mx > m)) { const float mn = fmaxf(m, mx), al = __builtin_amdgcn_exp2f(m - mn); l *= al; m = mn;
#pragma unroll
                for (int i = 0; i < 4; ++i)
#pragma unroll
                    for (int r = 0; r < 16; ++r) O[i][r] *= al; }
            float ls = 0.f;
#pragma unroll
            for (int r = 0; r < 16; ++r) { S0[r] = __builtin_amdgcn_exp2f(S0[r] - m); S1[r] = __builtin_amdgcn_exp2f(S1[r] - m); ls += S0[r] + S1[r]; }
            l += ls;
            const LAS unsigned char* vb = lds + (cur ? OFF_V1 : OFF_V0) + vro;
#pragma unroll
            for (int ks = 0; ks < 4; ++ks) { const bf16x8 pb = pack8((ks < 2) ? S0 : S1, 8 * (ks & 1));
#pragma unroll
                for (int dvb = 0; dvb < 4; ++dvb) { const s16x4 a = vtr(vb + (16 * ks) * VSTR + dvb * 64), c = vtr(vb + (16 * ks + 8) * VSTR + dvb * 64);
                    const bf16x8 vf = (bf16x8){a[0], a[1], a[2], a[3], c[0], c[1], c[2], c[3]};
                    O[dvb] = __builtin_amdgcn_mfma_f32_32x32x16_bf16(vf, pb, O[dvb], 0, 0, 0); } }
        }
        if (t + 1 < NT) { const int ko = cur ? OFF_K0 : OFF_K1, vo = cur ? OFF_V0 : OFF_V1;
            *(LAS u32x4*)(lds + ko + kwo) = kr0; *(LAS u32x4*)(lds + ko + kwo + 16) = kr1; *(LAS u32x4*)(lds + vo + vwo) = vr0; *(LAS u32x4*)(lds + vo + vwo + 16) = vr1; }
        __syncthreads();
    }
    l = swapsum(l); const float inv = active ? 1.0f / l : 0.f;
    LAS float* xb = (LAS float*)(lds + rg * XB);
    if (mp == 1) { const float f = inv * lam;
#pragma unroll
        for (int i = 0; i < 4; ++i)
#pragma unroll
            for (int r = 0; r < 16; ++r) xb[(i * 16 + r) * 64 + lane] = O[i][r] * f; }
    __syncthreads();
    if (mp == 0 && active) {
        float ss = 0.f;
#pragma unroll
        for (int i = 0; i < 4; ++i)
#pragma unroll
            for (int r = 0; r < 16; ++r) { const float o = O[i][r] * inv - xb[(i * 16 + r) * 64 + lane]; O[i][r] = o; ss += o * o; }
        ss = swapsum(ss); const float rs = 1.0f / sqrtf(ss * (1.f / 128.f) + SUBLN_EPS);
        asm volatile("s_waitcnt lgkmcnt(0)" ::: "memory");
        LAS unsigned char* stg = (LAS unsigned char*)xb;
#pragma unroll
        for (int i = 0; i < 4; ++i)
#pragma unroll
            for (int r4 = 0; r4 < 4; ++r4) { const int dv0 = 32 * i + 8 * r4 + 4 * hi; const f32x4 gg = *(const LAS f32x4*)(GT + dv0);
                u32x2 w; w.x = cvtpk(O[i][4 * r4] * rs * gg.x, O[i][4 * r4 + 1] * rs * gg.y); w.y = cvtpk(O[i][4 * r4 + 2] * rs * gg.z, O[i][4 * r4 + 3] * rs * gg.w);
                *(LAS u32x2*)(stg + q32 * KSTR + dv0 * 2) = w; }
        asm volatile("s_waitcnt lgkmcnt(0)" ::: "memory");
        bf16* og = u.Q + (size_t)(128 * u.x + rg * 32) * 1024 + u.h * 128;
#pragma unroll
        for (int i = 0; i < 8; ++i) { const int row = i * 4 + (lane >> 4), c16 = lane & 15; const u32x4 v = *(const LAS u32x4*)(stg + row * KSTR + c16 * 16);
            if (rg * 32 + row < vrows) *(u32x4*)(og + (size_t)row * 1024 + c16 * 8) = v; }
    }
    __syncthreads();
}
__device__ __forceinline__ void attn_phase(ArgsRef A, Frame& F, int a) {
    const float lam_init = a == 0 ? 0.2f : 0.47071302f;
    float s1 = A.in[12][a * 64 + F.lane] * A.in[13][a * 64 + F.lane], s2 = A.in[14][a * 64 + F.lane] * A.in[15][a * 64 + F.lane];
    s1 = wave_sum(s1); s2 = wave_sum(s2);
    const float lam = expf(s1) - expf(s2) + lam_init;
    bf16* QB = (bf16*)(F.ws + WS_QB); const bf16* KX = (const bf16*)(F.ws + WS_KX); const bf16* VX = (const bf16*)(F.ws + WS_VX);
    const bf16* KXS = (const bf16*)(F.ws + WS_KXS) + (size_t)a * KXS_LAYER; const bf16* VXS = (const bf16*)(F.ws + WS_VXS) + (size_t)a * KXS_LAYER;
    { const int gt = blockIdx.x * 512 + F.tid;
      for (int i = gt; i < 65536; i += F.G * 512) { const int c4 = i & 255, r = (i >> 8) & 15, b = (i >> 12) & 7, kv = i >> 15;
          const f32x4 v = *(const f32x4*)((const float*)(F.ws + (kv ? WS_MFV : WS_MFK)) + r * 1024 + c4 * 4);
          *(f32x4*)(F.out + (kv ? OFF_VP : OFF_KP) + (size_t)a * 8 * EXT_P * 1024 + (size_t)(b * EXT_P + r) * 1024 + c4 * 4) = v; } }
    for (int n = F.vcu; n < 4168; n += F.G) {
        AUnit u; u.KM = (const bf16*)(F.ws + WS_KXM); u.VM = (const bf16*)(F.ws + WS_VXM);
        if (n < 4096) { const int i = n >> 8, v = n & 255, bh = v >> 2, s = v & 3, j = i >> 1; int x = s + 4 * j; if (i & 1) x = 63 - x; const int b = bh >> 3;
            u.K = KX + (size_t)b * EXT_P * 1024; u.V = VX + (size_t)b * EXT_P * 1024; u.Q = QB + (size_t)b * 8192 * 1024; u.P = 16; u.L = 8192; u.x = x; u.h = bh & 7; }
        else if (n < 4160) { const int j = n - 4096, b = j >> 3; u.K = KXS + (size_t)b * EXT_S * 1024; u.V = VXS + (size_t)b * EXT_S * 1024; u.Q = QB + (size_t)(ROW_S + b * 64) * 1024; u.P = 1040; u.L = 64; u.x = 0; u.h = j & 7; }
        else { u.K = (const bf16*)(F.ws + WS_KXM); u.V = (const bf16*)(F.ws + WS_VXM); u.Q = QB + (size_t)ROW_M * 1024; u.P = 0; u.L = 16; u.x = 0; u.h = n - 4160; }
        attn_unit(F.lds, u, lam, lam_init, A.in[6], A.in[16] + a * 128);
    }
}
}

__device__ __forceinline__ void run_step(ArgsRef args, const int step) {
    extern __shared__ __attribute__((aligned(16))) unsigned char lds_raw[];
    Frame F;
    int tid_ = threadIdx.x; asm volatile("" : "+v"(tid_));
    F.lds = (LAS unsigned char*)lds_raw; F.tid = tid_; F.lane = F.tid & 63; F.wave = __builtin_amdgcn_readfirstlane(F.tid >> 6);
    F.G = gridDim.x; { const int bx = blockIdx.x; F.vcu = (F.G % 8 == 0) ? (bx % 8) * (F.G / 8) + bx / 8 : bx; }
    F.out = args.out; F.ws = args.ws;
    bf16* XN = (bf16*)(F.ws + WS_XN); bf16* QB = (bf16*)(F.ws + WS_QB); bf16* YB = (bf16*)(F.ws + WS_YB); bf16* U = (bf16*)(F.ws + WS_U);
    int layer = 0, k = -1;
    if (step > 0) { const int s = step - 1; if (s < 7) { layer = 0; k = s; } else if (s < 13) { layer = 1; k = s - 7; } else if (s < 20) { layer = 2; k = s - 13; } else { layer = 3; k = s - 20; } }
    const bool attn = (layer & 1) == 0; const int a = layer >> 1;
    int type;
    if (step == 0) type = 0; else if (attn) type = k == 0 ? 1 : k == 1 ? 2 : k == 2 ? 4 : k == 3 ? 5 : k == 4 ? 6 : k == 5 ? 7 : 8;
    else type = k == 0 ? 3 : k == 1 ? 4 : k == 2 ? 5 : k == 3 ? 6 : k == 4 ? 7 : 8;
    if (type == 0) prologue(args, F);
    else if (type == 1) {
        pg8::Gemm g{XN, (const bf16*)(F.ws + WS_WQKV) + (size_t)a * 3072 * D, MPAD, 3072, D, D, D, 0}; pg8::StaticOrder S; S.init(MPAD, 3072, F.G, (int)blockIdx.x);
        pg8::EpiQKV E{F.ws, F.out, a};
        pg8::gemm_phase<pg8::EpiQKV, pg8::StaticOrder, true, true>(F.lds, g, S, E);
    } else if (type == 2) { att::attn_phase(args, F, a); }
    else if (type == 3) { pool_phase(args, F, a); }
    else if (type == 4 || type == 7) {
        pg8::Gemm g;
        if (type == 7) g = pg8::Gemm{U, (const bf16*)(F.ws + WS_WDN) + (size_t)layer * D * FF, MPAD, D, FF, FF, FF, 0};
        else if (attn) g = pg8::Gemm{QB, (const bf16*)(F.ws + WS_WO) + (size_t)a * D * D, MPAD, D, D, D, D, 0};
        else g = pg8::Gemm{QB, (const bf16*)(F.ws + WS_WPOOL) + (size_t)a * 4 * 65536, MPAD, D, 256, D, 256, 512};
        pg8::StaticOrder S; S.init(MPAD, D, F.G, (int)blockIdx.x);
        pg8::EpiBf16<0> E{YB, D};
        pg8::gemm_phase<pg8::EpiBf16<0>, pg8::StaticOrder, true, true>(F.lds, g, S, E);
    } else if (type == 5) { fin_phase(args, F, layer == 0, args.in[8] + layer * D, args.in[9] + layer * D); }
    else if (type == 6) {
        pg8::Gemm g{XN, (const bf16*)(F.ws + WS_WUP) + (size_t)layer * D * FF, MPAD, FF, D, D, D, 0}; pg8::StaticOrder S; S.init(MPAD, FF, F.G, (int)blockIdx.x);
        pg8::EpiBf16<2> E{U, FF};
        pg8::gemm_phase<pg8::EpiBf16<2>, pg8::StaticOrder, true, true>(F.lds, g, S, E);
    } else { fin_phase(args, F, false, args.in[10] + layer * D, layer < 3 ? args.in[7] + (layer + 1) * D : nullptr); }
}
__global__ void __launch_bounds__(512, 2) fwd_kernel(Args args_) {
    const int lo = args_.lo, hi = args_.hi;
    for (int step = lo; step < hi; ++step) {
        const __attribute__((address_space(4))) Args* ap = (const __attribute__((address_space(4))) Args*)__builtin_amdgcn_kernarg_segment_ptr();
        asm volatile("" : "+s"(ap));
        run_step(*ap, step);
        if (step + 1 < hi) { __threadfence(); cg::this_grid().sync(); }
    }
}

extern "C" void kernel_launch(void* const* d_in, const int* in_sizes, int n_in, void* d_out, int out_size, void* d_ws, size_t ws_size, hipStream_t stream) {
    static int grid = 0;
    if (grid == 0) {
        if (n_in != 22 || (size_t)out_size != OUT_TOTAL || ws_size < WS_END) { fprintf(stderr, "kernel_launch: unexpected shapes n_in %d out %d ws %zu\n", n_in, out_size, ws_size); grid = -1; return; }
        int dev = 0, cus = 0, per_cu = 0;
        hipGetDevice(&dev); hipDeviceGetAttribute(&cus, hipDeviceAttributeMultiprocessorCount, dev);
        hipFuncSetAttribute((const void*)fwd_kernel, hipFuncAttributeMaxDynamicSharedMemorySize, LDS_BYTES);
        hipOccupancyMaxActiveBlocksPerMultiprocessor(&per_cu, (const void*)fwd_kernel, 512, LDS_BYTES);
        if (per_cu < 1) { fprintf(stderr, "kernel_launch: occupancy query says %d blocks/CU\n", per_cu); per_cu = 1; }
        (void)hipGetLastError();
        grid = cus;
    }
    if (grid < 0) return;
    Args a{};
    for (int i = 0; i < 22; ++i) a.in[i] = (const float*)d_in[i];
    a.out = (float*)d_out; a.ws = (unsigned char*)d_ws;
#if ONE_LAUNCH
    a.lo = 0; a.hi = NSTEPS;
    void* kargs[] = {&a};
    hipError_t e = hipLaunchCooperativeKernel((const void*)fwd_kernel, dim3(grid), dim3(512), kargs, LDS_BYTES, stream);
    if (e != hipSuccess) fprintf(stderr, "cooperative launch failed: %s (grid %d)\n", hipGetErrorString(e), grid);
#else
    for (int s = 0; s < NSTEPS; ++s) { a.lo = s; a.hi = s + 1; hipLaunchKernelGGL(fwd_kernel, dim3(grid), dim3(512), LDS_BYTES, stream, a); }
#endif
}
static_assert(WS_QB == 213 * MiB && WS_KX == 473 * MiB && WS_VX == 602 * MiB && WS_KXS == 731 * MiB && WS_VXS == 767 * MiB && WS_KXM == 803 * MiB && WS_VXM == 804 * MiB && KXS_LAYER == 9 * MiB && WS_MFK == 1323 * MiB && WS_MFV == 1324 * MiB, "EpiQKV hard-coded map");
static_assert(OFF_KP == 67633152 && OFF_VP == 202113024 && OFF_KS == 336838656 && OFF_VS == 337887232, "EpiQKV hard-coded output offsets");
```

```cpp
#include <hip/hip_runtime.h>
#include <hip/hip_cooperative_groups.h>
#include <hip/hip_bf16.h>
#include <cstdio>
#include <cstdint>
namespace cg = cooperative_groups;
namespace pg8 {
#define PG8_LAS __attribute__((address_space(3)))
typedef unsigned short bf16_t;
typedef short bf16x8 __attribute__((ext_vector_type(8)));
typedef float f32x4 __attribute__((ext_vector_type(4)));
typedef unsigned u32x4 __attribute__((ext_vector_type(4)));
constexpr int BM = 256, BK = 64, HALF = 128, HTB = HALF * BK * 2  , STAGE_BYTES = 8 * HTB, NXCD = 8, WGM = 8;

__host__ __device__ __forceinline__ int lds_byte(int r, int c) { const int st = (r >> 4) * 2 + (c >> 5), rr = r & 15, cc = c & 31, ob = rr * 64 + cc * 2; return st * 1024 + (ob ^ (((ob >> 9) & 1) << 5)); }
__host__ __device__ __forceinline__ void stage_rc(int b, int& R, int& C) { const int st = b / 1024, sb = b % 1024, swz = sb ^ (((sb >> 9) & 1) << 5); R = (st >> 1) * 16 + swz / 64; C = (st & 1) * 32 + (swz % 64) / 2; }
__host__ __device__ __forceinline__ int perm32(int rho) { const int n = rho >> 4, i = rho & 15; return 8 * (i >> 2) + 4 * n + (i & 3); }

struct Unit { int pm, pn; };
struct Gemm { const bf16_t* A; const bf16_t* Bt; int M, N, K, lda, ldb, acs; };

struct StaticOrder {
    int nM, nN, nwg, G, c;
    __host__ __device__ void init(int M, int N, int G_, int c_) { nM = M / BM; nN = N / BM; nwg = nM * nN; G = G_; c = c_; }
    __host__ __device__ bool next(int i, Unit& u) const {
        const long L = (long)i * G + c; if (L >= nwg) return false;
        int wgid = (int)L; { const int q = nwg / NXCD, r = nwg % NXCD, xcd = wgid % NXCD, off = wgid / NXCD; wgid = (xcd < r ? xcd * (q + 1) : r * (q + 1) + (xcd - r) * q) + off; }
        const int nig = WGM * nN, gid = wgid / nig, fm = gid * WGM, gsz = (nM - fm) < WGM ? (nM - fm) : WGM;
        u.pm = fm + ((wgid % nig) % gsz); u.pn = (wgid % nig) / gsz; return true;
    }
    __device__ __forceinline__ void a_ready(const Unit&) const {}
    __device__ __forceinline__ void done(const Unit&) const {}
};

__device__ __forceinline__ unsigned cvt_pk_bf16(float lo, float hi) { unsigned r; asm volatile("v_cvt_pk_bf16_f32 %0, %1, %2" : "=v"(r) : "v"(lo), "v"(hi)); return r; }
template <int ACT  > struct EpiBf16 {
    static constexpr bool PERM = true, AFTER_DRAIN = false;
    bf16_t* O; int ldc;
    __device__ __forceinline__ void operator()(const f32x4 (&acc)[2][2][4][2], const Unit& u, int wr, int wc, int fr, int fq) const {
        asm volatile("" : "+v"(fr), "+v"(fq));
        const int row0 = u.pm * BM + wr * 64 + fr; const int col0 = u.pn * BM + wc * 32 + 8 * fq;
#pragma unroll
        for (int ai = 0; ai < 2; ++ai)
#pragma unroll
            for (int m = 0; m < 4; ++m) { bf16_t* rowp = O + (size_t)(row0 + ai * HALF + m * 16) * ldc + col0;
#pragma unroll
                for (int bj = 0; bj < 2; ++bj) { f32x4 v0 = acc[ai][bj][m][0], v1 = acc[ai][bj][m][1];
                    if (ACT == 2) {
#pragma unroll
                        for (int e = 0; e < 4; ++e) { float a = fmaxf(v0[e], 0.f), b = fmaxf(v1[e], 0.f); v0[e] = a * a; v1[e] = b * b; } }
                    u32x4 w; w.x = cvt_pk_bf16(v0[0], v0[1]); w.y = cvt_pk_bf16(v0[2], v0[3]); w.z = cvt_pk_bf16(v1[0], v1[1]); w.w = cvt_pk_bf16(v1[2], v1[3]);
                    *(u32x4*)(rowp + bj * HALF) = w; } }
    }
};
struct EpiQKV {
    static constexpr bool PERM = true, AFTER_DRAIN = false;
    unsigned char* ws; float* out; int a;
    __device__ __forceinline__ void operator()(const f32x4 (&acc)[2][2][4][2], const Unit& u, int wr, int wc, int fr, int fq) const {
        const size_t MiB_ = 1u << 20;
        asm volatile("" : "+v"(fr), "+v"(fq));
        const int t3 = u.pn >> 2; const int colb = (u.pn & 3) * 256 + wc * 32 + 8 * fq;
        bf16_t* X; float* Fp = nullptr; int rbase, jump = 0, s0 = 0; float sc = 1.f;
        if (t3 == 0) { X = (bf16_t*)(ws + 213 * MiB_); rbase = u.pm * BM; sc = 0.125f * 1.4426950408889634f; }
        else if (u.pm < 256) { const int b = u.pm >> 5; rbase = b * 8208 + 16 + (u.pm & 31) * 256; X = (bf16_t*)(ws + (t3 == 1 ? 473 : 602) * MiB_);
            Fp = out + (t3 == 1 ? (size_t)67633152 : (size_t)202113024) + (size_t)a * 8 * 8208 * 1024 + (size_t)rbase * 1024; }
        else if (u.pm < 258) { s0 = (u.pm - 256) * 256; rbase = 1040 + s0; jump = 1040; X = (bf16_t*)(ws + (t3 == 1 ? 731 : 767) * MiB_) + (size_t)a * (9 * MiB_);
            Fp = out + (t3 == 1 ? (size_t)336838656 : (size_t)337887232) + (size_t)a * 512 * 1024 + (size_t)s0 * 1024; }
        else { rbase = 0; X = (bf16_t*)(ws + (t3 == 1 ? 803 : 804) * MiB_); Fp = (float*)(ws + (t3 == 1 ? 1323 : 1324) * MiB_); }
#pragma unroll
        for (int ai = 0; ai < 2; ++ai)
#pragma unroll
            for (int m = 0; m < 4; ++m) { const int rit = ai * HALF + wr * 64 + m * 16 + fr;
                bf16_t* xr = X + (unsigned)((rbase + rit + ((s0 + rit) >> 6) * jump) * 1024 + colb); float* fr_ = Fp + (unsigned)(rit * 1024 + colb);
#pragma unroll
                for (int bj = 0; bj < 2; ++bj) { const f32x4 v0 = acc[ai][bj][m][0], v1 = acc[ai][bj][m][1]; const f32x4 s0v = v0 * sc, s1v = v1 * sc;
                    u32x4 w; w.x = cvt_pk_bf16(s0v[0], s0v[1]); w.y = cvt_pk_bf16(s0v[2], s0v[3]); w.z = cvt_pk_bf16(s1v[0], s1v[1]); w.w = cvt_pk_bf16(s1v[2], s1v[3]);
                    *(u32x4*)(xr + bj * HALF) = w;
                    if (t3 != 0) { *(f32x4*)(fr_ + bj * HALF) = v0; *(f32x4*)(fr_ + bj * HALF + 4) = v1; } } }
    }
};
template <class Epi, class Sched, bool ALIGN_EPI = false, bool SP2 = false>
__device__ __forceinline__ void gemm_phase(PG8_LAS unsigned char* lds, const Gemm g, const Sched& S, const Epi& E) {
    int tid_ = threadIdx.x; asm volatile("" : "+v"(tid_));
    const int tid = tid_, wid = __builtin_amdgcn_readfirstlane(tid >> 6), lane = tid & 63, wr = wid >> 2, wc = wid & 3, fr = lane & 15, fq = lane >> 4;
    const int K = g.K, nt = K / BK;
    unsigned voffA[2], voffB[2];
#pragma unroll
    for (int i = 0; i < 2; ++i) { int R, C; stage_rc(tid * 16 + i * 8192, R, C); const int Rb = Epi::PERM ? ((R & ~31) + perm32(R & 31)) : R;
        voffA[i] = (unsigned)(R * g.lda + C) * 2u; voffB[i] = (unsigned)(Rb * g.ldb + C) * 2u; }
    const size_t kstep = (size_t)(BK * 2);
    const size_t hstepA = (size_t)HALF * g.lda * 2, hstepB = (size_t)HALF * g.ldb * 2;
    const size_t tstepA = 2 * hstepA, tstepB = 2 * hstepB;
    const unsigned ldsw = (unsigned)wid * 1024u;
    const int aoff = lds_byte(wr * 64 + fr, fq * 8), boff = lds_byte(wc * 32 + fr, fq * 8);
#define PG8_SA(b, h) (((b) * 2 + (h)) * HTB)
#define PG8_SB(b, h) ((4 + (b) * 2 + (h)) * HTB)
#define PG8_STAGE(bufoff, gbase, voff) do { _Pragma("unroll") for (int _i = 0; _i < 2; ++_i) \
        __builtin_amdgcn_global_load_lds((const unsigned*)((const char*)(gbase) + (voff)[_i]), (PG8_LAS unsigned*)(lds + (bufoff) + ldsw + _i * 8192), 16, 0, 0); } while (0)
#define PG8_LDA(dst, b, h) do { _Pragma("unroll") for (int m = 0; m < 4; ++m) _Pragma("unroll") for (int k = 0; k < 2; ++k) dst[m][k] = *(const PG8_LAS bf16x8*)(lds + PG8_SA(b, h) + aoff + m * 2048 + k * 1024); } while (0)
#define PG8_LDB(dst, b, h) do { _Pragma("unroll") for (int n = 0; n < 2; ++n) _Pragma("unroll") for (int k = 0; k < 2; ++k) dst[n][k] = *(const PG8_LAS bf16x8*)(lds + PG8_SB(b, h) + boff + n * 2048 + k * 1024); } while (0)
#define PG8_MMA(ai, bj, At, Bt) do { __builtin_amdgcn_s_setprio(1); _Pragma("unroll") for (int m = 0; m < 4; ++m) _Pragma("unroll") for (int n = 0; n < 2; ++n) _Pragma("unroll") for (int k = 0; k < 2; ++k) \
        acc[ai][bj][m][n] = __builtin_amdgcn_mfma_f32_16x16x32_bf16(Bt[n][k], At[m][k], acc[ai][bj][m][n], 0, 0, 0); __builtin_amdgcn_s_setprio(0); } while (0)
#define PG8_WAIT_V(n) asm volatile("s_waitcnt vmcnt(" #n ")" ::: "memory")
#define PG8_WAIT_L(n) asm volatile("s_waitcnt lgkmcnt(" #n ")" ::: "memory")
#define PG8_BAR __builtin_amdgcn_s_barrier()
#define PG8_SCHED __builtin_amdgcn_sched_barrier(0)
    Unit cur, nxt; int ui = 0;
    if (!S.next(0, cur)) return;
    f32x4 acc[2][2][4][2];
#pragma unroll
    for (int a = 0; a < 2; ++a)
#pragma unroll
        for (int b = 0; b < 2; ++b)
#pragma unroll
            for (int m = 0; m < 4; ++m)
#pragma unroll
                for (int n = 0; n < 2; ++n) acc[a][b][m][n] = (f32x4){0.f, 0.f, 0.f, 0.f};
    bf16x8 At[4][2], B0[2][2], B1[2][2];
    const char* cA = (const char*)g.A + (size_t)cur.pm * tstepA + (size_t)cur.pn * g.acs; const char* cB = (const char*)g.Bt + (size_t)cur.pn * tstepB;
    S.a_ready(cur);
    if constexpr (SP2) {
        PG8_STAGE(PG8_SB(0, 0), cB, voffB); PG8_STAGE(PG8_SB(0, 1), cB + hstepB, voffB); PG8_STAGE(PG8_SA(0, 0), cA, voffA); PG8_STAGE(PG8_SA(0, 1), cA + hstepA, voffA);
        if (wr == 1) PG8_BAR;
        PG8_WAIT_V(2); PG8_BAR;
        PG8_STAGE(PG8_SB(1, 0), cB + kstep, voffB); PG8_STAGE(PG8_SA(1, 0), cA + kstep, voffA); PG8_STAGE(PG8_SB(1, 1), cB + hstepB + kstep, voffB);
        PG8_WAIT_V(6); PG8_BAR;
    } else {
        PG8_STAGE(PG8_SB(0, 0), cB, voffB); PG8_STAGE(PG8_SA(0, 0), cA, voffA); PG8_STAGE(PG8_SB(0, 1), cB + hstepB, voffB); PG8_STAGE(PG8_SA(0, 1), cA + hstepA, voffA);
        if (wr == 1) PG8_BAR;
        PG8_WAIT_V(4); PG8_BAR;
        PG8_STAGE(PG8_SB(1, 0), cB + kstep, voffB); PG8_STAGE(PG8_SA(1, 0), cA + kstep, voffA); PG8_STAGE(PG8_SB(1, 1), cB + hstepB + kstep, voffB);
        PG8_WAIT_V(6); PG8_BAR;
    }
    for (;;) {
        const bool has_next = S.next(ui + 1, nxt);
        const char* nA = has_next ? (const char*)g.A + (size_t)nxt.pm * tstepA + (size_t)nxt.pn * g.acs : cA; const char* nB = has_next ? (const char*)g.Bt + (size_t)nxt.pn * tstepB : cB;
        for (int t = 0; t < nt; t += 2) {
            const bool last = (t == nt - 2);
            const char* a1 = cA + (size_t)(t + 1) * kstep;
            const char* a2 = last ? nA : cA + (size_t)(t + 2) * kstep; const char* b2 = last ? nB : cB + (size_t)(t + 2) * kstep;
            const char* a3 = a2 + kstep; const char* b3 = b2 + kstep;
            if (last && has_next) S.a_ready(nxt);
            if constexpr (SP2) {
            PG8_LDB(B0, 0, 0); PG8_LDB(B1, 0, 1); PG8_SCHED; PG8_LDA(At, 0, 0); PG8_STAGE(PG8_SA(1, 1), a1 + hstepA, voffA);
            PG8_WAIT_V(8); PG8_WAIT_L(0); PG8_BAR; PG8_MMA(0, 0, At, B0); PG8_MMA(0, 1, At, B1); PG8_BAR; PG8_SCHED;
            PG8_LDA(At, 0, 1); PG8_STAGE(PG8_SB(0, 0), b2, voffB); PG8_STAGE(PG8_SB(0, 1), b2 + hstepB, voffB); PG8_STAGE(PG8_SA(0, 0), a2, voffA);
            PG8_WAIT_V(8); PG8_WAIT_L(0); PG8_BAR; PG8_MMA(1, 0, At, B0); PG8_MMA(1, 1, At, B1); PG8_BAR; PG8_SCHED;
            PG8_LDB(B0, 1, 0); PG8_LDB(B1, 1, 1); PG8_SCHED; PG8_LDA(At, 1, 0); PG8_STAGE(PG8_SA(0, 1), a2 + hstepA, voffA);
            PG8_WAIT_V(8); PG8_WAIT_L(0); PG8_BAR; PG8_MMA(0, 0, At, B0); PG8_MMA(0, 1, At, B1); PG8_BAR; PG8_SCHED;
            PG8_LDA(At, 1, 1); PG8_STAGE(PG8_SB(1, 0), b3, voffB); PG8_STAGE(PG8_SB(1, 1), b3 + hstepB, voffB); PG8_STAGE(PG8_SA(1, 0), a3, voffA);
            PG8_WAIT_V(8); PG8_WAIT_L(0); PG8_BAR; PG8_MMA(1, 0, At, B0); PG8_MMA(1, 1, At, B1); PG8_BAR; PG8_SCHED;
            } else {
            PG8_LDB(B0, 0, 0); PG8_SCHED; PG8_LDA(At, 0, 0); PG8_STAGE(PG8_SA(1, 1), a1 + hstepA, voffA);
            PG8_WAIT_L(8); PG8_BAR; PG8_WAIT_L(0); PG8_MMA(0, 0, At, B0); PG8_BAR; PG8_SCHED;
            PG8_LDB(B1, 0, 1); PG8_STAGE(PG8_SB(0, 0), b2, voffB);
            PG8_BAR; PG8_WAIT_L(0); PG8_MMA(0, 1, At, B1); PG8_BAR;
            PG8_LDA(At, 0, 1); PG8_STAGE(PG8_SA(0, 0), a2, voffA);
            PG8_BAR; PG8_WAIT_L(0); PG8_MMA(1, 0, At, B0); PG8_BAR; PG8_SCHED;
            PG8_STAGE(PG8_SB(0, 1), b2 + hstepB, voffB);
            PG8_WAIT_V(6); PG8_BAR; PG8_MMA(1, 1, At, B1); PG8_BAR;
            PG8_LDB(B0, 1, 0); PG8_SCHED; PG8_LDA(At, 1, 0); PG8_STAGE(PG8_SA(0, 1), a2 + hstepA, voffA);
            PG8_WAIT_L(8); PG8_BAR; PG8_WAIT_L(0); PG8_MMA(0, 0, At, B0); PG8_BAR; PG8_SCHED;
            PG8_LDB(B1, 1, 1); PG8_STAGE(PG8_SB(1, 0), b3, voffB);
            PG8_BAR; PG8_WAIT_L(0); PG8_MMA(0, 1, At, B1); PG8_BAR;
            PG8_LDA(At, 1, 1); PG8_STAGE(PG8_SA(1, 0), a3, voffA);
            PG8_BAR; PG8_WAIT_L(0); PG8_MMA(1, 0, At, B0); PG8_BAR; PG8_SCHED;
            PG8_STAGE(PG8_SB(1, 1), b3 + hstepB, voffB);
            PG8_WAIT_V(6); PG8_BAR; PG8_MMA(1, 1, At, B1); PG8_BAR;
            }
        }
        if constexpr (ALIGN_EPI) { if (wr == 0) PG8_BAR; }
        if constexpr (!Epi::AFTER_DRAIN) { E(acc, cur, wr, wc, fr, fq); S.done(cur); }
        if (!has_next) break;
#pragma unroll
        for (int a = 0; a < 2; ++a)
#pragma unroll
            for (int b = 0; b < 2; ++b)
#pragma unroll
                for (int m = 0; m < 4; ++m)
#pragma unroll
                    for (int n = 0; n < 2; ++n) acc[a][b][m][n] = (f32x4){0.f, 0.f, 0.f, 0.f};
        cur = nxt; cA = nA; cB = nB; ++ui;
        if constexpr (ALIGN_EPI) { if (wr == 1) PG8_BAR; }
    }
    PG8_WAIT_V(0);
    if constexpr (!ALIGN_EPI) { if (wr == 0) PG8_BAR; }
    PG8_BAR;
    if constexpr (Epi::AFTER_DRAIN) { E.fused(acc, cur, wr, wc, fr, fq, lds, wid, lane); S.done(cur); }
#undef PG8_SA
#undef PG8_SB
#undef PG8_STAGE
#undef PG8_LDA
#undef PG8_LDB
#undef PG8_MMA
#undef PG8_WAIT_V
#undef PG8_WAIT_L
#undef PG8_BAR
#undef PG8_SCHED
}
}
#define LAS __attribute__((address_space(3)))
#define GAS __attribute__((address_space(1)))
typedef unsigned short bf16;
typedef unsigned u32x4 __attribute__((ext_vector_type(4)));
typedef unsigned u32x2 __attribute__((ext_vector_type(2)));
typedef float f32x4 __attribute__((ext_vector_type(4)));
typedef float f32x2 __attribute__((ext_vector_type(2)));
typedef float f32x16 __attribute__((ext_vector_type(16)));
typedef short bf16x8 __attribute__((ext_vector_type(8)));
typedef short s16x4 __attribute__((ext_vector_type(4)));
constexpr int D = 1024, FF = 4096, NH = 8;
constexpr int ROW_S = 65536, ROW_M = 66048, ROWS_VALID = 66064, MPAD = 66304;
constexpr int EXT_P = 8208, EXT_S = 1104;
constexpr float LOG2E = 1.4426950408889634f;
constexpr float QSCALE = 0.125f * LOG2E;
constexpr float EPS = 1e-6f, SUBLN_EPS = 1e-5f;
constexpr size_t OFF_YP = 0, OFF_YS = 67108864, OFF_KP = OFF_YS + 524288, OFF_VP = OFF_KP + 134479872, OFF_PP = OFF_VP + 134479872,
                 OFF_KS = OFF_PP + 245760, OFF_VS = OFF_KS + 1048576, OFF_PS = OFF_VS + 1048576, OUT_TOTAL = OFF_PS + 245760;
constexpr size_t MiB = 1u << 20;
constexpr size_t WS_WQKV = 1 * MiB, WS_WO = 13 * MiB, WS_WPOOL = 17 * MiB, WS_WUP = 18 * MiB, WS_WDN = 50 * MiB, WS_XM = 82 * MiB,
                 WS_XN = 83 * MiB, WS_QB = 213 * MiB, WS_YB = 343 * MiB, WS_KX = 473 * MiB, WS_VX = 602 * MiB, WS_KXS = 731 * MiB, WS_VXS = 767 * MiB,
                 WS_KXM = 803 * MiB, WS_VXM = 804 * MiB, WS_U = 805 * MiB, WS_MFK = 1323 * MiB, WS_MFV = 1324 * MiB, WS_END = 1325 * MiB;
constexpr size_t KXS_LAYER = 18 * MiB / 2;
constexpr int LDS_BYTES = 147456;
constexpr int NSTEPS = 27;
#ifndef ONE_LAUNCH
#define ONE_LAUNCH 1
#endif

__device__ __forceinline__ unsigned f2bf(float f) { unsigned u = __builtin_bit_cast(unsigned, f); return (u + 0x7fffu + ((u >> 16) & 1u)) >> 16; }
__device__ __forceinline__ unsigned pk2(float lo, float hi) { return f2bf(lo) | (f2bf(hi) << 16); }
__device__ __forceinline__ float bflo(unsigned w) { return __builtin_bit_cast(float, w << 16); }
__device__ __forceinline__ float bfhi(unsigned w) { return __builtin_bit_cast(float, w & 0xffff0000u); }
__device__ __forceinline__ float wave_sum(float v) {
#pragma unroll
    for (int o = 1; o < 64; o <<= 1) v += __shfl_xor(v, o);
    return v;
}

struct Args { const float* in[22]; float* out; unsigned char* ws; int lo, hi; };
typedef const __attribute__((address_space(4))) Args& ArgsRef;
struct Frame {
    LAS unsigned char* lds; int tid, lane, wave, vcu, G;
    float* out; unsigned char* ws;
};

__device__ __forceinline__ void transpose_item(const float* W, int K, int N, bf16* WT, LAS float* scr, int item, int lane, const float* nscale) {
    const int nblk = N / 32, kb = item / nblk, nb = item % nblk, k0 = 64 * kb, n0 = 32 * nb;
#pragma unroll 8
    for (int i = 0; i < 32; ++i) { const int kk = 2 * i + (lane >> 5); scr[kk * 33 + (lane & 31)] = W[(size_t)(k0 + kk) * N + n0 + (lane & 31)]; }
    asm volatile("s_waitcnt lgkmcnt(0)" ::: "memory");
    const int c = lane & 7;
#pragma unroll
    for (int j = 0; j < 4; ++j) { const int n = (lane >> 3) + 8 * j; const LAS float* s = scr + (8 * c) * 33 + n; const float sc = nscale ? nscale[n0 + n] : 1.f;
        u32x4 o; o.x = pk2(s[0 * 33] * sc, s[1 * 33] * sc); o.y = pk2(s[2 * 33] * sc, s[3 * 33] * sc); o.z = pk2(s[4 * 33] * sc, s[5 * 33] * sc); o.w = pk2(s[6 * 33] * sc, s[7 * 33] * sc);
        *(u32x4*)(WT + (size_t)(n0 + n) * K + k0 + 8 * c) = o; }
    asm volatile("s_waitcnt lgkmcnt(0)" ::: "memory");
}
__device__ __forceinline__ const float* xin_row(ArgsRef A, int row) {
    return row < ROW_S ? A.in[0] + (size_t)row * D : row < ROW_M ? A.in[1] + (size_t)(row - ROW_S) * D : A.in[5] + (size_t)(row - ROW_M) * D;
}
__device__ __forceinline__ float* xres_row(const Frame& F, int row) {
    return row < ROW_S ? F.out + OFF_YP + (size_t)row * D : row < ROW_M ? F.out + OFF_YS + (size_t)(row - ROW_S) * D : (float*)(F.ws + WS_XM) + (size_t)(row - ROW_M) * D;
}
__device__ __forceinline__ void prologue(ArgsRef A, Frame& F) {
    LAS float* scr = (LAS float*)(F.lds + F.wave * 16384);
    const int gw = F.vcu * 8 + F.wave, NGW = F.G * 8;
    constexpr int I_QKV = 16 * 96, I_O = 16 * 32, I_UP = 16 * 128, I_DN = 64 * 32, I_PL = 4 * 8;
    constexpr int NITEMS = 2 * I_QKV + 2 * I_O + 4 * I_UP + 4 * I_DN + 8 * I_PL;
    for (int it = gw; it < NITEMS; it += NGW) {
        int r = it;
        if (r < 2 * I_QKV) { const int a = r / I_QKV; transpose_item(A.in[11] + (size_t)a * D * 3072, D, 3072, (bf16*)(F.ws + WS_WQKV) + (size_t)a * 3072 * D, scr, r % I_QKV, F.lane, nullptr); continue; } r -= 2 * I_QKV;
        if (r < 2 * I_O) { const int a = r / I_O; transpose_item(A.in[17] + (size_t)a * D * D, D, D, (bf16*)(F.ws + WS_WO) + (size_t)a * D * D, scr, r % I_O, F.lane, nullptr); continue; } r -= 2 * I_O;
        if (r < 4 * I_UP) { const int i = r / I_UP; transpose_item(A.in[20] + (size_t)i * D * FF, D, FF, (bf16*)(F.ws + WS_WUP) + (size_t)i * D * FF, scr, r % I_UP, F.lane, nullptr); continue; } r -= 4 * I_UP;
        if (r < 4 * I_DN) { const int i = r / I_DN; transpose_item(A.in[21] + (size_t)i * D * FF, FF, D, (bf16*)(F.ws + WS_WDN) + (size_t)i * D * FF, scr, r % I_DN, F.lane, nullptr); continue; } r -= 4 * I_DN;
        { const int pg = r / I_PL; transpose_item(A.in[18] + (size_t)pg * 65536, 256, 256, (bf16*)(F.ws + WS_WPOOL) + (size_t)pg * 65536, scr, r % I_PL, F.lane, A.in[19] + pg * 256); }
    }
    for (int it = gw; it < 32768; it += NGW) {
        const int j = it & 1023, b = (it >> 10) & 7, kv = (it >> 13) & 1, a = it >> 14;
        const float* src = (kv ? A.in[3] : A.in[2]) + ((size_t)(a * 8 + b) * 1024 + j) * D;
        bf16* dst = (bf16*)(F.ws + (kv ? WS_VXS : WS_KXS)) + (size_t)a * KXS_LAYER + (size_t)(b * EXT_S + 16 + j) * D;
#pragma unroll
        for (int q = 0; q < 4; ++q) { const f32x4 v = *(const f32x4*)(src + 4 * F.lane + 256 * q); u32x2 w; w.x = pk2(v.x, v.y); w.y = pk2(v.z, v.w); *(u32x2*)(dst + 4 * F.lane + 256 * q) = w; }
    }
    const float* g = A.in[7];
    for (int row = gw; row < MPAD; row += NGW) {
        bf16* xn = (bf16*)(F.ws + WS_XN) + (size_t)row * D;
        if (row >= ROWS_VALID) {
#pragma unroll
            for (int q = 0; q < 4; ++q) *(u32x2*)(xn + 4 * F.lane + 256 * q) = (u32x2){0u, 0u};
            continue; }
        const float* x = xin_row(A, row); f32x4 v[4]; float ss = 0.f;
#pragma unroll
        for (int q = 0; q < 4; ++q) { v[q] = *(const f32x4*)(x + 4 * F.lane + 256 * q); ss += v[q].x * v[q].x + v[q].y * v[q].y + v[q].z * v[q].z + v[q].w * v[q].w; }
        const float r = 1.0f / sqrtf(wave_sum(ss) * (1.f / D) + EPS);
#pragma unroll
        for (int q = 0; q < 4; ++q) { const f32x4 gg = *(const f32x4*)(g + 4 * F.lane + 256 * q); u32x2 w; w.x = pk2(v[q].x * r * gg.x, v[q].y * r * gg.y); w.y = pk2(v[q].z * r * gg.z, v[q].w * r * gg.w);
            *(u32x2*)(xn + 4 * F.lane + 256 * q) = w; }
    }
}
__device__ __forceinline__ void fin_phase(ArgsRef A, Frame& F, bool from_inputs, const float* gpost, const float* gnext) {
    const int gw = F.vcu * 8 + F.wave, NGW = F.G * 8;
    const bf16* YB = (const bf16*)(F.ws + WS_YB);
    for (int row = gw; row < ROWS_VALID; row += NGW) {
        const bf16* y = YB + (size_t)row * D; const float* xi = from_inputs ? xin_row(A, row) : xres_row(F, row); float* xo = xres_row(F, row);
        f32x4 yv[4], xv[4]; float ss = 0.f;
#pragma unroll
        for (int q = 0; q < 4; ++q) { const u32x2 w = *(const u32x2*)(y + 4 * F.lane + 256 * q); yv[q] = (f32x4){bflo(w.x), bfhi(w.x), bflo(w.y), bfhi(w.y)};
            xv[q] = *(const f32x4*)(xi + 4 * F.lane + 256 * q); ss += yv[q].x * yv[q].x + yv[q].y * yv[q].y + yv[q].z * yv[q].z + yv[q].w * yv[q].w; }
        const float r = 1.0f / sqrtf(wave_sum(ss) * (1.f / D) + EPS); float s2 = 0.f;
#pragma unroll
        for (int q = 0; q < 4; ++q) { const f32x4 gg = *(const f32x4*)(gpost + 4 * F.lane + 256 * q); xv[q] = xv[q] + yv[q] * r * gg; *(f32x4*)(xo + 4 * F.lane + 256 * q) = xv[q];
            s2 += xv[q].x * xv[q].x + xv[q].y * xv[q].y + xv[q].z * xv[q].z + xv[q].w * xv[q].w; }
        if (gnext) { const float r2 = 1.0f / sqrtf(wave_sum(s2) * (1.f / D) + EPS); bf16* xn = (bf16*)(F.ws + WS_XN) + (size_t)row * D;
#pragma unroll
            for (int q = 0; q < 4; ++q) { const f32x4 gg = *(const f32x4*)(gnext + 4 * F.lane + 256 * q); u32x2 w; w.x = pk2(xv[q].x * r2 * gg.x, xv[q].y * r2 * gg.y); w.y = pk2(xv[q].z * r2 * gg.z, xv[q].w * r2 * gg.w);
                *(u32x2*)(xn + 4 * F.lane + 256 * q) = w; } }
    }
}
__device__ __forceinline__ f32x2 pool_h(ArgsRef A, const Frame& F, int grp, int b, int t, int col, int p) {
    const bf16* XN = (const bf16*)(F.ws + WS_XN);
    if (t >= 0) { const int row = grp == 0 ? b * 8192 + t : grp == 1 ? ROW_S + b * 64 + t : ROW_M + t; const unsigned w = *(const unsigned*)(XN + (size_t)row * D + col); return (f32x2){bflo(w), bfhi(w)}; }
    if (grp == 0) { const unsigned w = *(const unsigned*)(XN + (size_t)(ROW_M + 16 + t) * D + col); return (f32x2){bflo(w), bfhi(w)}; }
    if (grp == 1) return *(const f32x2*)(A.in[4] + ((size_t)(p * 8 + b) * 15 + 15 + t) * D + col);
    return (f32x2){0.f, 0.f};
}
__device__ __forceinline__ void pool_phase(ArgsRef A, Frame& F, int p) {
    bf16* DB = (bf16*)(F.ws + WS_QB);
    const int col = 2 * F.tid, w = 2 << (col >> 8);
    for (int it = F.vcu; it < 2065; it += F.G) {
        int grp, b, t0, nr;
        if (it < 2048) { grp = 0; b = it >> 8; t0 = (it & 255) * 32; nr = 32; } else if (it < 2064) { const int s = it - 2048; grp = 1; b = s >> 1; t0 = (s & 1) * 32; nr = 32; } else { grp = 2; b = 0; t0 = 0; nr = 16; }
        f32x2 sum = {0.f, 0.f};
        for (int j = 1; j < w; ++j) sum += pool_h(A, F, grp, b, t0 - j, col, p);
        for (int t = t0; t < t0 + nr; ++t) {
            const f32x2 cur = pool_h(A, F, grp, b, t, col, p); sum += cur;
            const float inv = 1.0f / (float)(grp == 2 ? min(t + 1, w) : w);
            const int row = grp == 0 ? b * 8192 + t : grp == 1 ? ROW_S + b * 64 + t : ROW_M + t;
            *(unsigned*)(DB + (size_t)row * D + col) = pk2(sum.x * inv - cur.x, sum.y * inv - cur.y);
            sum -= pool_h(A, F, grp, b, t - w + 1, col, p);
            if (grp == 0 && t >= 8177) *(f32x2*)(F.out + OFF_PP + ((size_t)(p * 8 + b) * 15 + (t - 8177)) * D + col) = cur;
            if (grp == 1 && t >= 49) *(f32x2*)(F.out + OFF_PS + ((size_t)(p * 8 + b) * 15 + (t - 49)) * D + col) = cur;
        }
    }
}

namespace att {
constexpr int KSTR = 272, VSTR = 320, KT = 64 * KSTR, VT = 64 * VSTR;
constexpr int OFF_K0 = 0, OFF_K1 = KT, OFF_V0 = 2 * KT, OFF_V1 = 2 * KT + VT, OFF_BT = 2 * KT + 2 * VT, OFF_GT = OFF_BT + 1024, XB = 16384;
static_assert(OFF_BT >= 4 * XB && OFF_GT + 512 <= 131072, "attention LDS map");
constexpr float NEG = -1e30f;
struct AUnit { const bf16* K; const bf16* V; const bf16* KM; const bf16* VM; bf16* Q; int P, L, x, h; };
__device__ __forceinline__ float swapmax(float v) { auto rr = __builtin_amdgcn_permlane32_swap(__float_as_uint(v), __float_as_uint(v), false, false); return fmaxf(__uint_as_float(rr[0]), __uint_as_float(rr[1])); }
__device__ __forceinline__ float swapsum(float v) { auto rr = __builtin_amdgcn_permlane32_swap(__float_as_uint(v), __float_as_uint(v), false, false); return __uint_as_float(rr[0]) + __uint_as_float(rr[1]); }
typedef __bf16 bf16x2_t __attribute__((ext_vector_type(2)));
__device__ __forceinline__ unsigned cvtpk(float lo, float hi) { f32x2 v = {lo, hi}; bf16x2_t b = __builtin_convertvector(v, bf16x2_t); return __builtin_bit_cast(unsigned, b); }
__device__ __forceinline__ s16x4 vtr(const LAS unsigned char* p) { return __builtin_bit_cast(s16x4, __builtin_amdgcn_ds_read_tr16_b64_v4i16((LAS s16x4*)p)); }
__device__ __forceinline__ bf16x8 pack8(const f32x16& S, int o) {
    u32x4 w; w.x = cvtpk(S[o], S[o + 1]); w.y = cvtpk(S[o + 2], S[o + 3]); w.z = cvtpk(S[o + 4], S[o + 5]); w.w = cvtpk(S[o + 6], S[o + 7]); return __builtin_bit_cast(bf16x8, w);
}

__device__ __forceinline__ void attn_unit(LAS unsigned char* lds, const AUnit& u, const float lam, const float lam_init, const float* relb, const float* subg) {
    int tid_ = threadIdx.x; asm volatile("" : "+v"(tid_));
    const int tid = tid_, lane = tid & 63, wid = __builtin_amdgcn_readfirstlane(tid >> 6), mp = wid >> 2, rg = wid & 3, q32 = lane & 31, hi = lane >> 5;
    LAS float* BT = (LAS float*)(lds + OFF_BT); LAS float* GT = (LAS float*)(lds + OFF_GT);
    if (tid < 256) { const int rel = tid - 128, n = rel < 0 ? -rel : rel;
        int bk = n < 8 ? n : n < 12 ? 8 : n < 16 ? 9 : n < 23 ? 10 : n < 32 ? 11 : n < 46 ? 12 : n < 64 ? 13 : n < 91 ? 14 : 15; if (rel > 0) bk += 16;
        BT[tid] = relb[bk * 8 + u.h] * LOG2E; }
    else if (tid < 384) GT[tid - 256] = subg[tid - 256] * (1.0f - lam_init);
    const int vrows = min(128, u.L - 128 * u.x);
    const bool active = rg * 32 < vrows;
    const int ch = rg >> 1;
    const int NTw = active ? (u.P + min((2 * u.x + ch + 1) * 64, u.L) + 48) >> 6 : 0;
    const int NT = (u.P + min((2 * u.x + 2) * 64, u.L) + 48) >> 6;
    const int eq0 = u.P + 128 * u.x + rg * 32, eq = eq0 + q32;
    bf16x8 qf[4];
    { const bf16* qp = u.Q + (size_t)(128 * u.x + rg * 32 + q32) * 1024 + u.h * 128 + mp * 64 + hi * 8;
#pragma unroll
      for (int d0 = 0; d0 < 4; ++d0) qf[d0] = active ? *(const bf16x8*)(qp + d0 * 16) : (bf16x8){0, 0, 0, 0, 0, 0, 0, 0}; }
    const int lrow = tid >> 3, lc = (tid & 7) * 2;
    const bf16* kg = u.K + (size_t)lrow * 1024 + u.h * 128 + lc * 8; const bf16* vg = u.V + (size_t)lrow * 1024 + u.h * 128 + lc * 8;
    const int kwo = lrow * KSTR + lc * 16, vwo = lrow * VSTR + lc * 16;
    const bf16* kg0 = lrow < 16 ? u.KM + (size_t)lrow * 1024 + u.h * 128 + lc * 8 : kg; const bf16* vg0 = lrow < 16 ? u.VM + (size_t)lrow * 1024 + u.h * 128 + lc * 8 : vg;
    u32x4 kr0 = *(const u32x4*)kg0, kr1 = *(const u32x4*)(kg0 + 8), vr0 = *(const u32x4*)vg0, vr1 = *(const u32x4*)(vg0 + 8);
    *(LAS u32x4*)(lds + OFF_K0 + kwo) = kr0; *(LAS u32x4*)(lds + OFF_K0 + kwo + 16) = kr1; *(LAS u32x4*)(lds + OFF_V0 + vwo) = vr0; *(LAS u32x4*)(lds + OFF_V0 + vwo + 16) = vr1;
    __syncthreads();
    const float c15 = BT[0];
    f32x16 O[4];
#pragma unroll
    for (int i = 0; i < 4; ++i)
#pragma unroll
        for (int r = 0; r < 16; ++r) O[i][r] = 0.f;
    float m = NEG, l = 0.f;
    const int kro = q32 * KSTR + mp * 128 + hi * 16;
    const int vro = (((lane & 15) >> 2) + 4 * hi) * VSTR + ((lane >> 4) & 1) * 32 + (lane & 3) * 8;
    for (int t = 0; t < NT; ++t) {
        const int cur = t & 1;
        if (t + 1 < NT) { const size_t go = (size_t)(t + 1) * 64 * 1024; kr0 = *(const u32x4*)(kg + go); kr1 = *(const u32x4*)(kg + go + 8); vr0 = *(const u32x4*)(vg + go); vr1 = *(const u32x4*)(vg + go + 8); }
        if (t < NTw) {
            const int k0 = t * 64; const bool near = (k0 + 154 > eq0); const bool last = (t == NTw - 1);
            const LAS unsigned char* kb = lds + (cur ? OFF_K1 : OFF_K0) + kro;
            f32x16 S0, S1; const float ini = near ? 0.f : c15;
#pragma unroll
            for (int r = 0; r < 16; ++r) { S0[r] = ini; S1[r] = ini; }
#pragma unroll
            for (int d0 = 0; d0 < 4; ++d0) { const bf16x8 kf0 = *(const LAS bf16x8*)(kb + d0 * 32), kf1 = *(const LAS bf16x8*)(kb + 32 * KSTR + d0 * 32);
                S0 = __builtin_amdgcn_mfma_f32_32x32x16_bf16(kf0, qf[d0], S0, 0, 0, 0); S1 = __builtin_amdgcn_mfma_f32_32x32x16_bf16(kf1, qf[d0], S1, 0, 0, 0); }
            if (near) { const int base = k0 - eq + 128 + 4 * hi;
#pragma unroll
                for (int r = 0; r < 16; ++r) { const int i0 = base + (r & 3) + 8 * (r >> 2); S0[r] += BT[min(max(i0, 0), 255)]; S1[r] += BT[min(max(i0 + 32, 0), 255)]; } }
            if (last) {
#pragma unroll
                for (int r = 0; r < 16; ++r) { if (r >= 8) S0[r] = NEG; S1[r] = NEG; } }
            float mx = fmaxf(S0[0], S1[0]);
#pragma unroll
            for (int r = 1; r < 16; ++r) mx = fmaxf(mx, fmaxf(S0[r], S1[r]));
            mx = swapmax(mx);
            if (__any(mx > m)) { const float mn = fmaxf(m, mx), al = __builtin_amdgcn_exp2f(m - mn); l *= al; m = mn;
#pragma unroll
                for (int i = 0; i < 4; ++i)
#pragma unroll
                    for (int r = 0; r < 16; ++r) O[i][r] *= al; }
            float ls = 0.f;
#pragma unroll
            for (int r = 0; r < 16; ++r) { S0[r] = __builtin_amdgcn_exp2f(S0[r] - m); S1[r] = __builtin_amdgcn_exp2f(S1[r] - m); ls += S0[r] + S1[r]; }
            l += ls;
            const LAS unsigned char* vb = lds + (cur ? OFF_V1 : OFF_V0) + vro;
#pragma unroll
            for (int ks = 0; ks < 4; ++ks) { const bf16x8 pb = pack8((ks < 2) ? S0 : S1, 8 * (ks & 1));
#pragma unroll
                for (int dvb = 0; dvb < 4; ++dvb) { const s16x4 a = vtr(vb + (16 * ks) * VSTR + dvb * 64), c = vtr(vb + (16 * ks + 8) * VSTR + dvb * 64);
                    const bf16x8 vf = (bf16x8){a[0], a[1], a[2], a[3], c[0], c[1], c[2], c[3]};
                    O[dvb] = __builtin_amdgcn_mfma_f32_32x32x16_bf16(vf, pb, O[dvb], 0, 0, 0); } }
        }
        if (t + 1 < NT) { const int ko = cur ? OFF_K0 : OFF_K1, vo = cur ? OFF_V0 : OFF_V1;
            *(LAS u32x4*)(lds + ko + kwo) = kr0; *(LAS u32x4*)(lds + ko + kwo + 16) = kr1; *(LAS u32x4*)(lds + vo + vwo) = vr0; *(LAS u32x4*)(lds + vo + vwo + 16) = vr1; }
        __syncthreads();
    }
    l = swapsum(l); const float inv = active ? 1.0f / l : 0.f;
    LAS float* xb = (LAS float*)(lds + rg * XB);
    if (mp == 1) { const float f = inv * lam;
#pragma unroll
        for (int i = 0; i < 4; ++i)
#pragma unroll
            for (int r = 0; r < 16; ++r) xb[(i * 16 + r) * 64 + lane] = O[i][r] * f; }
    __syncthreads();
    if (mp == 0 && active) {
        float ss = 0.f;
#pragma unroll
        for (int i = 0; i < 4; ++i)
#pragma unroll
            for (int r = 0; r < 16; ++r) { const float o = O[i][r] * inv - xb[(i * 16 + r) * 64 + lane]; O[i][r] = o; ss += o * o; }
        ss = swapsum(ss); const float rs = 1.0f / sqrtf(ss * (1.f / 128.f) + SUBLN_EPS);
        asm volatile("s_waitcnt lgkmcnt(0)" ::: "memory");
        LAS unsigned char* stg = (LAS unsigned char*)xb;
#pragma unroll
        for (int i = 0; i < 4; ++i)
#pragma unroll
            for (int r4 = 0; r4 < 4; ++r4) { const int dv0 = 32 * i + 8 * r4 + 4 * hi; const f32x4 gg = *(const LAS f32x4*)(GT + dv0);
                u32x2 w; w.x = cvtpk(O[i][4 * r4] * rs * gg.x, O[i][4 * r4 + 1] * rs * gg.y); w.y = cvtpk(O[i][4 * r4 + 2] * rs * gg.z, O[i][4 * r4 + 3] * rs * gg.w);
                *(LAS u32x2*)(stg + q32 * KSTR + dv0 * 2) = w; }
        asm volatile("s_waitcnt lgkmcnt(0)" ::: "memory");
        bf16* og = u.Q + (size_t)(128 * u.x + rg * 32) * 1024 + u.h * 128;
#pragma unroll
        for (int i = 0; i < 8; ++i) { const int row = i * 4 + (lane >> 4), c16 = lane & 15; const u32x4 v = *(const LAS u32x4*)(stg + row * KSTR + c16 * 16);
            if (rg * 32 + row < vrows) *(u32x4*)(og + (size_t)row * 1024 + c16 * 8) = v; }
    }
    __syncthreads();
}
__device__ __forceinline__ void attn_phase(ArgsRef A, Frame& F, int a) {
    const float lam_init = a == 0 ? 0.2f : 0.47071302f;
    float s1 = A.in[12][a * 64 + F.lane] * A.in[13][a * 64 + F.lane], s2 = A.in[14][a * 64 + F.lane] * A.in[15][a * 64 + F.lane];
    s1 = wave_sum(s1); s2 = wave_sum(s2);
    const float lam = expf(s1) - expf(s2) + lam_init;
    bf16* QB = (bf16*)(F.ws + WS_QB); const bf16* KX = (const bf16*)(F.ws + WS_KX); const bf16* VX = (const bf16*)(F.ws + WS_VX);
    const bf16* KXS = (const bf16*)(F.ws + WS_KXS) + (size_t)a * KXS_LAYER; const bf16* VXS = (const bf16*)(F.ws + WS_VXS) + (size_t)a * KXS_LAYER;
    { const int gt = blockIdx.x * 512 + F.tid;
      for (int i = gt; i < 65536; i += F.G * 512) { const int c4 = i & 255, r = (i >> 8) & 15, b = (i >> 12) & 7, kv = i >> 15;
          const f32x4 v = *(const f32x4*)((const float*)(F.ws + (kv ? WS_MFV : WS_MFK)) + r * 1024 + c4 * 4);
          *(f32x4*)(F.out + (kv ? OFF_VP : OFF_KP) + (size_t)a * 8 * EXT_P * 1024 + (size_t)(b * EXT_P + r) * 1024 + c4 * 4) = v; } }
    for (int n = F.vcu; n < 4168; n += F.G) {
        AUnit u; u.KM = (const bf16*)(F.ws + WS_KXM); u.VM = (const bf16*)(F.ws + WS_VXM);
        if (n < 4096) { const int i = n >> 8, v = n & 255, bh = v >> 2, s = v & 3, j = i >> 1; int x = s + 4 * j; if (i & 1) x = 63 - x; const int b = bh >> 3;
            u.K = KX + (size_t)b * EXT_P * 1024; u.V = VX + (size_t)b * EXT_P * 1024; u.Q = QB + (size_t)b * 8192 * 1024; u.P = 16; u.L = 8192; u.x = x; u.h = bh & 7; }
        else if (n < 4160) { const int j = n - 4096, b = j >> 3; u.K = KXS + (size_t)b * EXT_S * 1024; u.V = VXS + (size_t)b * EXT_S * 1024; u.Q = QB + (size_t)(ROW_S + b * 64) * 1024; u.P = 1040; u.L = 64; u.x = 0; u.h = j & 7; }
        else { u.K = (const bf16*)(F.ws + WS_KXM); u.V = (const bf16*)(F.ws + WS_VXM); u.Q = QB + (size_t)ROW_M * 1024; u.P = 0; u.L = 16; u.x = 0; u.h = n - 4160; }
        attn_unit(F.lds, u, lam, lam_init, A.in[6], A.in[16] + a * 128);
    }
}
}

#define XB_TMO      128
#define XB_XCNT(j)  (256  + 64 * (j))
#define XB_XSUB(j)  (1280 + 64 * (j))
#define XB_XGEN(j)  (2304 + 64 * (j))
#define XB_TOP      3328
#define XB_TOPGEN   3392
#define XCD_BAR_WORDS 3456
#define XB_SPIN_CAP (1u << 18)

__device__ __forceinline__ unsigned xb_ld(unsigned* p)              { return __hip_atomic_load(p, __ATOMIC_RELAXED, __HIP_MEMORY_SCOPE_AGENT); }
__device__ __forceinline__ unsigned xb_add(unsigned* p, unsigned v) { return __hip_atomic_fetch_add(p, v, __ATOMIC_RELAXED, __HIP_MEMORY_SCOPE_AGENT); }
__device__ __forceinline__ unsigned xb_xcc_id() { return (unsigned)__builtin_amdgcn_s_getreg((3 << 11) | 20) & 0xFu; }
#define XB_SPIN(cond, bar) do { unsigned _sp = 0; while (cond) { __builtin_amdgcn_s_sleep(1); \
    if ((++_sp & 255u) == 0u) { if (xb_ld(&(bar)[XB_TMO])) break; if (_sp > XB_SPIN_CAP) { atomicAdd(&(bar)[XB_TMO], 1u); break; } } } } while (0)

struct XcdBarrier {
    unsigned* bar; unsigned x;
    volatile LAS unsigned* st;
};

__device__ __forceinline__ XcdBarrier xcd_barrier_post(unsigned* bar, volatile LAS unsigned* st) {
    XcdBarrier b; b.bar = bar; b.x = xb_xcc_id(); b.st = st;
    if (threadIdx.x == 0) (void)xb_add(&bar[XB_XCNT(b.x)], 1u);
    return b;
}
__device__ __forceinline__ void xcd_barrier_complete(unsigned* bar, unsigned x, unsigned& nloc, unsigned& nx) {
    const unsigned G = gridDim.x * gridDim.y * gridDim.z;
    unsigned sum, cnt, mine, sp = 0u;
    for (;;) {
        sum = 0u; cnt = 0u; mine = 0u;
#pragma unroll
        for (unsigned j = 0; j < 16; ++j) { const unsigned c = xb_ld(&bar[XB_XCNT(j)]); sum += c; cnt += (c > 0u) ? 1u : 0u; mine = (j == x) ? c : mine; }
        if (sum == G) break;
        __builtin_amdgcn_s_sleep(1);
        if ((++sp & 255u) == 0u) { if (xb_ld(&bar[XB_TMO])) break; if (sp > XB_SPIN_CAP) { atomicAdd(&bar[XB_TMO], 1u); break; } }
    }
    nloc = mine > 0u ? mine : 1u; nx = cnt > 0u ? cnt : 1u;
}

__device__ __forceinline__ void xcd_barrier(const XcdBarrier& b) {
    asm volatile("s_waitcnt vmcnt(0)" ::: "memory");
    __syncthreads();
    if (threadIdx.x == 0) {
        unsigned* bar = b.bar;
        __builtin_amdgcn_s_waitcnt(0);
        unsigned nloc = b.st[0], nx = b.st[1];
        if (nloc == 0u) { xcd_barrier_complete(bar, b.x, nloc, nx); b.st[0] = nloc; b.st[1] = nx; }
        const unsigned old = xb_add(&bar[XB_XSUB(b.x)], 1u);
        const unsigned gen = old / nloc;
        if (old + 1u == (gen + 1u) * nloc) {
            __builtin_amdgcn_fence(__ATOMIC_RELEASE, "agent");
            asm volatile("s_waitcnt vmcnt(0)" ::: "memory");
            const unsigned og = xb_add(&bar[XB_TOP], 1u);
            const unsigned tg = og / nx;
            if (og + 1u == (tg + 1u) * nx) xb_add(&bar[XB_TOPGEN], 1u);
            else XB_SPIN(xb_ld(&bar[XB_TOPGEN]) == tg, bar);
            __builtin_amdgcn_fence(__ATOMIC_ACQUIRE, "agent");
            xb_add(&bar[XB_XGEN(b.x)], 1u);
            asm volatile("s_waitcnt vmcnt(0)" ::: "memory");
        } else {
            XB_SPIN(xb_ld(&bar[XB_XGEN(b.x)]) == gen, bar);
            __builtin_amdgcn_fence(__ATOMIC_ACQUIRE, "agent");
            asm volatile("s_waitcnt vmcnt(0)" ::: "memory");
        }
    }
    __syncthreads();
}

__device__ __forceinline__ void run_step(ArgsRef args, const int step) {
    extern __shared__ __attribute__((aligned(16))) unsigned char lds_raw[];
    Frame F;
    int tid_ = threadIdx.x; asm volatile("" : "+v"(tid_));
    F.lds = (LAS unsigned char*)lds_raw; F.tid = tid_; F.lane = F.tid & 63; F.wave = __builtin_amdgcn_readfirstlane(F.tid >> 6);
    F.G = gridDim.x; { const int bx = blockIdx.x; F.vcu = (F.G % 8 == 0) ? (bx % 8) * (F.G / 8) + bx / 8 : bx; }
    F.out = args.out; F.ws = args.ws;
    bf16* XN = (bf16*)(F.ws + WS_XN); bf16* QB = (bf16*)(F.ws + WS_QB); bf16* YB = (bf16*)(F.ws + WS_YB); bf16* U = (bf16*)(F.ws + WS_U);
    int layer = 0, k = -1;
    if (step > 0) { const int s = step - 1; if (s < 7) { layer = 0; k = s; } else if (s < 13) { layer = 1; k = s - 7; } else if (s < 20) { layer = 2; k = s - 13; } else { layer = 3; k = s - 20; } }
    const bool attn = (layer & 1) == 0; const int a = layer >> 1;
    int type;
    if (step == 0) type = 0; else if (attn) type = k == 0 ? 1 : k == 1 ? 2 : k == 2 ? 4 : k == 3 ? 5 : k == 4 ? 6 : k == 5 ? 7 : 8;
    else type = k == 0 ? 3 : k == 1 ? 4 : k == 2 ? 5 : k == 3 ? 6 : k == 4 ? 7 : 8;
    if (type == 0) prologue(args, F);
    else if (type == 1) {
        pg8::Gemm g{XN, (const bf16*)(F.ws + WS_WQKV) + (size_t)a * 3072 * D, MPAD, 3072, D, D, D, 0}; pg8::StaticOrder S; S.init(MPAD, 3072, F.G, (int)blockIdx.x);
        pg8::EpiQKV E{F.ws, F.out, a};
        pg8::gemm_phase<pg8::EpiQKV, pg8::StaticOrder, true, true>(F.lds, g, S, E);
    } else if (type == 2) { att::attn_phase(args, F, a); }
    else if (type == 3) { pool_phase(args, F, a); }
    else if (type == 4 || type == 7) {
        pg8::Gemm g;
        if (type == 7) g = pg8::Gemm{U, (const bf16*)(F.ws + WS_WDN) + (size_t)layer * D * FF, MPAD, D, FF, FF, FF, 0};
        else if (attn) g = pg8::Gemm{QB, (const bf16*)(F.ws + WS_WO) + (size_t)a * D * D, MPAD, D, D, D, D, 0};
        else g = pg8::Gemm{QB, (const bf16*)(F.ws + WS_WPOOL) + (size_t)a * 4 * 65536, MPAD, D, 256, D, 256, 512};
        pg8::StaticOrder S; S.init(MPAD, D, F.G, (int)blockIdx.x);
        pg8::EpiBf16<0> E{YB, D};
        pg8::gemm_phase<pg8::EpiBf16<0>, pg8::StaticOrder, true, true>(F.lds, g, S, E);
    } else if (type == 5) { fin_phase(args, F, layer == 0, args.in[8] + layer * D, args.in[9] + layer * D); }
    else if (type == 6) {
        pg8::Gemm g{XN, (const bf16*)(F.ws + WS_WUP) + (size_t)layer * D * FF, MPAD, FF, D, D, D, 0}; pg8::StaticOrder S; S.init(MPAD, FF, F.G, (int)blockIdx.x);
        pg8::EpiBf16<2> E{U, FF};
        pg8::gemm_phase<pg8::EpiBf16<2>, pg8::StaticOrder, true, true>(F.lds, g, S, E);
    } else { fin_phase(args, F, false, args.in[10] + layer * D, layer < 3 ? args.in[7] + (layer + 1) * D : nullptr); }
}
__global__ void __launch_bounds__(512, 2) fwd_kernel(Args args_) {
    const int lo = args_.lo, hi = args_.hi;
    extern __shared__ __attribute__((aligned(16))) unsigned char lds_raw[];
    volatile LAS unsigned* bst = (volatile LAS unsigned*)((LAS unsigned char*)lds_raw + 131072);
    if (threadIdx.x < 2) bst[threadIdx.x] = 0u;
    __syncthreads();
    XcdBarrier bar = xcd_barrier_post((unsigned*)args_.ws + 4096, bst);
    for (int step = lo; step < hi; ++step) {
        const __attribute__((address_space(4))) Args* ap = (const __attribute__((address_space(4))) Args*)__builtin_amdgcn_kernarg_segment_ptr();
        asm volatile("" : "+s"(ap));
        run_step(*ap, step);
        if (step + 1 < hi) { if (step == lo) { __threadfence(); cg::this_grid().sync(); } else xcd_barrier(bar); }
    }
}

extern "C" void kernel_launch(void* const* d_in, const int* in_sizes, int n_in, void* d_out, int out_size, void* d_ws, size_t ws_size, hipStream_t stream) {
    static int grid = 0;
    if (grid == 0) {
        if (n_in != 22 || (size_t)out_size != OUT_TOTAL || ws_size < WS_END) { fprintf(stderr, "kernel_launch: unexpected shapes n_in %d out %d ws %zu\n", n_in, out_size, ws_size); grid = -1; return; }
        int dev = 0, cus = 0, per_cu = 0;
        hipGetDevice(&dev); hipDeviceGetAttribute(&cus, hipDeviceAttributeMultiprocessorCount, dev);
        hipFuncSetAttribute((const void*)fwd_kernel, hipFuncAttributeMaxDynamicSharedMemorySize, LDS_BYTES);
        hipOccupancyMaxActiveBlocksPerMultiprocessor(&per_cu, (const void*)fwd_kernel, 512, LDS_BYTES);
        if (per_cu < 1) { fprintf(stderr, "kernel_launch: occupancy query says %d blocks/CU\n", per_cu); per_cu = 1; }
        (void)hipGetLastError();
        grid = cus;
    }
    if (grid < 0) return;
    if (hipMemsetAsync(d_ws, 0, 65536, stream) != hipSuccess) { fprintf(stderr, "kernel_launch: memset failed\n"); return; }
    Args a{};
    for (int i = 0; i < 22; ++i) a.in[i] = (const float*)d_in[i];
    a.out = (float*)d_out; a.ws = (unsigned char*)d_ws;
#if ONE_LAUNCH
    a.lo = 0; a.hi = NSTEPS;
    void* kargs[] = {&a};
    hipError_t e = hipLaunchCooperativeKernel((const void*)fwd_kernel, dim3(grid), dim3(512), kargs, LDS_BYTES, stream);
    if (e != hipSuccess) fprintf(stderr, "cooperative launch failed: %s (grid %d)\n", hipGetErrorString(e), grid);
#else
    for (int s = 0; s < NSTEPS; ++s) { a.lo = s; a.hi = s + 1; hipLaunchKernelGGL(fwd_kernel, dim3(grid), dim3(512), LDS_BYTES, stream, a); }
#endif
}
static_assert(WS_QB == 213 * MiB && WS_KX == 473 * MiB && WS_VX == 602 * MiB && WS_KXS == 731 * MiB && WS_VXS == 767 * MiB && WS_KXM == 803 * MiB && WS_VXM == 804 * MiB && KXS_LAYER == 9 * MiB && WS_MFK == 1323 * MiB && WS_MFV == 1324 * MiB, "EpiQKV hard-coded map");
static_assert(OFF_KP == 67633152 && OFF_VP == 202113024 && OFF_KS == 336838656 && OFF_VS == 337887232, "EpiQKV hard-coded output offsets");
```

```cpp
#include <hip/hip_runtime.h>
#include <hip/hip_cooperative_groups.h>
#include <hip/hip_bf16.h>
#include <cstdio>
#include <cstdint>
namespace cg = cooperative_groups;
namespace pg8 {
#define PG8_LAS __attribute__((address_space(3)))
typedef unsigned short bf16_t;
typedef short bf16x8 __attribute__((ext_vector_type(8)));
typedef float f32x4 __attribute__((ext_vector_type(4)));
typedef unsigned u32x4 __attribute__((ext_vector_type(4)));
constexpr int BM = 256, BK = 64, HALF = 128, HTB = HALF * BK * 2  , STAGE_BYTES = 8 * HTB, NXCD = 8, WGM = 8;

__host__ __device__ __forceinline__ int lds_byte(int r, int c) { const int st = (r >> 4) * 2 + (c >> 5), rr = r & 15, cc = c & 31, ob = rr * 64 + cc * 2; return st * 1024 + (ob ^ (((ob >> 9) & 1) << 5)); }
__host__ __device__ __forceinline__ void stage_rc(int b, int& R, int& C) { const int st = b / 1024, sb = b % 1024, swz = sb ^ (((sb >> 9) & 1) << 5); R = (st >> 1) * 16 + swz / 64; C = (st & 1) * 32 + (swz % 64) / 2; }
__host__ __device__ __forceinline__ int perm32(int rho) { const int n = rho >> 4, i = rho & 15; return 8 * (i >> 2) + 4 * n + (i & 3); }

struct Unit { int pm, pn; };
struct Gemm { const bf16_t* A; const bf16_t* Bt; int M, N, K, lda, ldb, acs; };

struct StaticOrder {
    int nM, nN, nwg, G, c;
    __host__ __device__ void init(int M, int N, int G_, int c_) { nM = M / BM; nN = N / BM; nwg = nM * nN; G = G_; c = c_; }
    __host__ __device__ bool next(int i, Unit& u) const {
        const long L = (long)i * G + c; if (L >= nwg) return false;
        int wgid = (int)L; { const int q = nwg / NXCD, r = nwg % NXCD, xcd = wgid % NXCD, off = wgid / NXCD; wgid = (xcd < r ? xcd * (q + 1) : r * (q + 1) + (xcd - r) * q) + off; }
        const int nig = WGM * nN, gid = wgid / nig, fm = gid * WGM, gsz = (nM - fm) < WGM ? (nM - fm) : WGM;
        u.pm = fm + ((wgid % nig) % gsz); u.pn = (wgid % nig) / gsz; return true;
    }
    __device__ __forceinline__ void a_ready(const Unit&) const {}
    __device__ __forceinline__ void done(const Unit&) const {}
};

__device__ __forceinline__ unsigned cvt_pk_bf16(float lo, float hi) { unsigned r; asm volatile("v_cvt_pk_bf16_f32 %0, %1, %2" : "=v"(r) : "v"(lo), "v"(hi)); return r; }
template <int ACT  > struct EpiBf16 {
    static constexpr bool PERM = true, AFTER_DRAIN = false;
    bf16_t* O; int ldc;
    __device__ __forceinline__ void operator()(const f32x4 (&acc)[2][2][4][2], const Unit& u, int wr, int wc, int fr, int fq) const {
        asm volatile("" : "+v"(fr), "+v"(fq));
        const int row0 = u.pm * BM + wr * 64 + fr; const int col0 = u.pn * BM + wc * 32 + 8 * fq;
#pragma unroll
        for (int ai = 0; ai < 2; ++ai)
#pragma unroll
            for (int m = 0; m < 4; ++m) { bf16_t* rowp = O + (size_t)(row0 + ai * HALF + m * 16) * ldc + col0;
#pragma unroll
                for (int bj = 0; bj < 2; ++bj) { f32x4 v0 = acc[ai][bj][m][0], v1 = acc[ai][bj][m][1];
                    if (ACT == 2) {
#pragma unroll
                        for (int e = 0; e < 4; ++e) { float a = fmaxf(v0[e], 0.f), b = fmaxf(v1[e], 0.f); v0[e] = a * a; v1[e] = b * b; } }
                    u32x4 w; w.x = cvt_pk_bf16(v0[0], v0[1]); w.y = cvt_pk_bf16(v0[2], v0[3]); w.z = cvt_pk_bf16(v1[0], v1[1]); w.w = cvt_pk_bf16(v1[2], v1[3]);
                    *(u32x4*)(rowp + bj * HALF) = w; } }
    }
};
struct EpiQKV {
    static constexpr bool PERM = true, AFTER_DRAIN = false;
    unsigned char* ws; float* out; int a;
    __device__ __forceinline__ void operator()(const f32x4 (&acc)[2][2][4][2], const Unit& u, int wr, int wc, int fr, int fq) const {
        const size_t MiB_ = 1u << 20;
        asm volatile("" : "+v"(fr), "+v"(fq));
        const int t3 = u.pn >> 2; const int colb = (u.pn & 3) * 256 + wc * 32 + 8 * fq;
        bf16_t* X; float* Fp = nullptr; int rbase, jump = 0, s0 = 0; float sc = 1.f;
        if (t3 == 0) { X = (bf16_t*)(ws + 213 * MiB_); rbase = u.pm * BM; sc = 0.125f * 1.4426950408889634f; }
        else if (u.pm < 256) { const int b = u.pm >> 5; rbase = b * 8208 + 16 + (u.pm & 31) * 256; X = (bf16_t*)(ws + (t3 == 1 ? 473 : 602) * MiB_);
            Fp = out + (t3 == 1 ? (size_t)67633152 : (size_t)202113024) + (size_t)a * 8 * 8208 * 1024 + (size_t)rbase * 1024; }
        else if (u.pm < 258) { s0 = (u.pm - 256) * 256; rbase = 1040 + s0; jump = 1040; X = (bf16_t*)(ws + (t3 == 1 ? 731 : 767) * MiB_) + (size_t)a * (9 * MiB_);
            Fp = out + (t3 == 1 ? (size_t)336838656 : (size_t)337887232) + (size_t)a * 512 * 1024 + (size_t)s0 * 1024; }
        else { rbase = 0; X = (bf16_t*)(ws + (t3 == 1 ? 803 : 804) * MiB_); Fp = (float*)(ws + (t3 == 1 ? 1323 : 1324) * MiB_); }
#pragma unroll
        for (int ai = 0; ai < 2; ++ai)
#pragma unroll
            for (int m = 0; m < 4; ++m) { const int rit = ai * HALF + wr * 64 + m * 16 + fr;
                bf16_t* xr = X + (unsigned)((rbase + rit + ((s0 + rit) >> 6) * jump) * 1024 + colb); float* fr_ = Fp + (unsigned)(rit * 1024 + colb);
#pragma unroll
                for (int bj = 0; bj < 2; ++bj) { const f32x4 v0 = acc[ai][bj][m][0], v1 = acc[ai][bj][m][1]; const f32x4 s0v = v0 * sc, s1v = v1 * sc;
                    u32x4 w; w.x = cvt_pk_bf16(s0v[0], s0v[1]); w.y = cvt_pk_bf16(s0v[2], s0v[3]); w.z = cvt_pk_bf16(s1v[0], s1v[1]); w.w = cvt_pk_bf16(s1v[2], s1v[3]);
                    *(u32x4*)(xr + bj * HALF) = w;
                    if (t3 != 0) { *(f32x4*)(fr_ + bj * HALF) = v0; *(f32x4*)(fr_ + bj * HALF + 4) = v1; } } }
    }
};
template <class Epi, class Sched, bool ALIGN_EPI = false, bool SP2 = false>
__device__ __forceinline__ void gemm_phase(PG8_LAS unsigned char* lds, const Gemm g, const Sched& S, const Epi& E, const int tid_in) {
    int tid_ = tid_in; asm volatile("" : "+v"(tid_));
    const int tid = tid_, wid = __builtin_amdgcn_readfirstlane(tid >> 6), lane = tid & 63, wr = wid >> 2, wc = wid & 3, fr = lane & 15, fq = lane >> 4;
    const int K = g.K, nt = K / BK;
    unsigned voffA[2], voffB[2];
#pragma unroll
    for (int i = 0; i < 2; ++i) { int R, C; stage_rc(tid * 16 + i * 8192, R, C); const int Rb = Epi::PERM ? ((R & ~31) + perm32(R & 31)) : R;
        voffA[i] = (unsigned)(R * g.lda + C) * 2u; voffB[i] = (unsigned)(Rb * g.ldb + C) * 2u; }
    const size_t kstep = (size_t)(BK * 2);
    const size_t hstepA = (size_t)HALF * g.lda * 2, hstepB = (size_t)HALF * g.ldb * 2;
    const size_t tstepA = 2 * hstepA, tstepB = 2 * hstepB;
    const unsigned ldsw = (unsigned)wid * 1024u;
    const int aoff = lds_byte(wr * 64 + fr, fq * 8), boff = lds_byte(wc * 32 + fr, fq * 8);
#define PG8_SA(b, h) (((b) * 2 + (h)) * HTB)
#define PG8_SB(b, h) ((4 + (b) * 2 + (h)) * HTB)
#define PG8_STAGE(bufoff, gbase, voff) do { _Pragma("unroll") for (int _i = 0; _i < 2; ++_i) \
        __builtin_amdgcn_global_load_lds((const unsigned*)((const char*)(gbase) + (voff)[_i]), (PG8_LAS unsigned*)(lds + (bufoff) + ldsw + _i * 8192), 16, 0, 0); } while (0)
#define PG8_LDA(dst, b, h) do { _Pragma("unroll") for (int m = 0; m < 4; ++m) _Pragma("unroll") for (int k = 0; k < 2; ++k) dst[m][k] = *(const PG8_LAS bf16x8*)(lds + PG8_SA(b, h) + aoff + m * 2048 + k * 1024); } while (0)
#define PG8_LDB(dst, b, h) do { _Pragma("unroll") for (int n = 0; n < 2; ++n) _Pragma("unroll") for (int k = 0; k < 2; ++k) dst[n][k] = *(const PG8_LAS bf16x8*)(lds + PG8_SB(b, h) + boff + n * 2048 + k * 1024); } while (0)
#define PG8_MMA(ai, bj, At, Bt) do { __builtin_amdgcn_s_setprio(1); _Pragma("unroll") for (int m = 0; m < 4; ++m) _Pragma("unroll") for (int n = 0; n < 2; ++n) _Pragma("unroll") for (int k = 0; k < 2; ++k) \
        acc[ai][bj][m][n] = __builtin_amdgcn_mfma_f32_16x16x32_bf16(Bt[n][k], At[m][k], acc[ai][bj][m][n], 0, 0, 0); __builtin_amdgcn_s_setprio(0); } while (0)
#define PG8_WAIT_V(n) asm volatile("s_waitcnt vmcnt(" #n ")" ::: "memory")
#define PG8_WAIT_L(n) asm volatile("s_waitcnt lgkmcnt(" #n ")" ::: "memory")
#define PG8_BAR __builtin_amdgcn_s_barrier()
#define PG8_SCHED __builtin_amdgcn_sched_barrier(0)
    Unit cur, nxt; int ui = 0;
    if (!S.next(0, cur)) return;
    f32x4 acc[2][2][4][2];
#pragma unroll
    for (int a = 0; a < 2; ++a)
#pragma unroll
        for (int b = 0; b < 2; ++b)
#pragma unroll
            for (int m = 0; m < 4; ++m)
#pragma unroll
                for (int n = 0; n < 2; ++n) acc[a][b][m][n] = (f32x4){0.f, 0.f, 0.f, 0.f};
    bf16x8 At[4][2], B0[2][2], B1[2][2];
    const char* cA = (const char*)g.A + (size_t)cur.pm * tstepA + (size_t)cur.pn * g.acs; const char* cB = (const char*)g.Bt + (size_t)cur.pn * tstepB;
    S.a_ready(cur);
    if constexpr (SP2) {
        PG8_STAGE(PG8_SB(0, 0), cB, voffB); PG8_STAGE(PG8_SB(0, 1), cB + hstepB, voffB); PG8_STAGE(PG8_SA(0, 0), cA, voffA); PG8_STAGE(PG8_SA(0, 1), cA + hstepA, voffA);
        if (wr == 1) PG8_BAR;
        PG8_WAIT_V(2); PG8_BAR;
        PG8_STAGE(PG8_SB(1, 0), cB + kstep, voffB); PG8_STAGE(PG8_SA(1, 0), cA + kstep, voffA); PG8_STAGE(PG8_SB(1, 1), cB + hstepB + kstep, voffB);
        PG8_WAIT_V(6); PG8_BAR;
    } else {
        PG8_STAGE(PG8_SB(0, 0), cB, voffB); PG8_STAGE(PG8_SA(0, 0), cA, voffA); PG8_STAGE(PG8_SB(0, 1), cB + hstepB, voffB); PG8_STAGE(PG8_SA(0, 1), cA + hstepA, voffA);
        if (wr == 1) PG8_BAR;
        PG8_WAIT_V(4); PG8_BAR;
        PG8_STAGE(PG8_SB(1, 0), cB + kstep, voffB); PG8_STAGE(PG8_SA(1, 0), cA + kstep, voffA); PG8_STAGE(PG8_SB(1, 1), cB + hstepB + kstep, voffB);
        PG8_WAIT_V(6); PG8_BAR;
    }
    for (;;) {
        const bool has_next = S.next(ui + 1, nxt);
        const char* nA = has_next ? (const char*)g.A + (size_t)nxt.pm * tstepA + (size_t)nxt.pn * g.acs : cA; const char* nB = has_next ? (const char*)g.Bt + (size_t)nxt.pn * tstepB : cB;
        for (int t = 0; t < nt; t += 2) {
            const bool last = (t == nt - 2);
            const char* a1 = cA + (size_t)(t + 1) * kstep;
            const char* a2 = last ? nA : cA + (size_t)(t + 2) * kstep; const char* b2 = last ? nB : cB + (size_t)(t + 2) * kstep;
            const char* a3 = a2 + kstep; const char* b3 = b2 + kstep;
            if (last && has_next) S.a_ready(nxt);
            if constexpr (SP2) {
            PG8_LDB(B0, 0, 0); PG8_LDB(B1, 0, 1); PG8_SCHED; PG8_LDA(At, 0, 0); PG8_STAGE(PG8_SA(1, 1), a1 + hstepA, voffA);
            PG8_WAIT_V(8); PG8_WAIT_L(0); PG8_BAR; PG8_MMA(0, 0, At, B0); PG8_MMA(0, 1, At, B1); PG8_BAR; PG8_SCHED;
            PG8_LDA(At, 0, 1); PG8_STAGE(PG8_SB(0, 0), b2, voffB); PG8_STAGE(PG8_SB(0, 1), b2 + hstepB, voffB); PG8_STAGE(PG8_SA(0, 0), a2, voffA);
            PG8_WAIT_V(8); PG8_WAIT_L(0); PG8_BAR; PG8_MMA(1, 0, At, B0); PG8_MMA(1, 1, At, B1); PG8_BAR; PG8_SCHED;
            PG8_LDB(B0, 1, 0); PG8_LDB(B1, 1, 1); PG8_SCHED; PG8_LDA(At, 1, 0); PG8_STAGE(PG8_SA(0, 1), a2 + hstepA, voffA);
            PG8_WAIT_V(8); PG8_WAIT_L(0); PG8_BAR; PG8_MMA(0, 0, At, B0); PG8_MMA(0, 1, At, B1); PG8_BAR; PG8_SCHED;
            PG8_LDA(At, 1, 1); PG8_STAGE(PG8_SB(1, 0), b3, voffB); PG8_STAGE(PG8_SB(1, 1), b3 + hstepB, voffB); PG8_STAGE(PG8_SA(1, 0), a3, voffA);
            PG8_WAIT_V(8); PG8_WAIT_L(0); PG8_BAR; PG8_MMA(1, 0, At, B0); PG8_MMA(1, 1, At, B1); PG8_BAR; PG8_SCHED;
            } else {
            PG8_LDB(B0, 0, 0); PG8_SCHED; PG8_LDA(At, 0, 0); PG8_STAGE(PG8_SA(1, 1), a1 + hstepA, voffA);
            PG8_WAIT_L(8); PG8_BAR; PG8_WAIT_L(0); PG8_MMA(0, 0, At, B0); PG8_BAR; PG8_SCHED;
            PG8_LDB(B1, 0, 1); PG8_STAGE(PG8_SB(0, 0), b2, voffB);
            PG8_BAR; PG8_WAIT_L(0); PG8_MMA(0, 1, At, B1); PG8_BAR;
            PG8_LDA(At, 0, 1); PG8_STAGE(PG8_SA(0, 0), a2, voffA);
            PG8_BAR; PG8_WAIT_L(0); PG8_MMA(1, 0, At, B0); PG8_BAR; PG8_SCHED;
            PG8_STAGE(PG8_SB(0, 1), b2 + hstepB, voffB);
            PG8_WAIT_V(6); PG8_BAR; PG8_MMA(1, 1, At, B1); PG8_BAR;
            PG8_LDB(B0, 1, 0); PG8_SCHED; PG8_LDA(At, 1, 0); PG8_STAGE(PG8_SA(0, 1), a2 + hstepA, voffA);
            PG8_WAIT_L(8); PG8_BAR; PG8_WAIT_L(0); PG8_MMA(0, 0, At, B0); PG8_BAR; PG8_SCHED;
            PG8_LDB(B1, 1, 1); PG8_STAGE(PG8_SB(1, 0), b3, voffB);
            PG8_BAR; PG8_WAIT_L(0); PG8_MMA(0, 1, At, B1); PG8_BAR;
            PG8_LDA(At, 1, 1); PG8_STAGE(PG8_SA(1, 0), a3, voffA);
            PG8_BAR; PG8_WAIT_L(0); PG8_MMA(1, 0, At, B0); PG8_BAR; PG8_SCHED;
            PG8_STAGE(PG8_SB(1, 1), b3 + hstepB, voffB);
            PG8_WAIT_V(6); PG8_BAR; PG8_MMA(1, 1, At, B1); PG8_BAR;
            }
        }
        if constexpr (ALIGN_EPI) { if (wr == 0) PG8_BAR; }
        if constexpr (!Epi::AFTER_DRAIN) { E(acc, cur, wr, wc, fr, fq); S.done(cur); }
        if (!has_next) break;
#pragma unroll
        for (int a = 0; a < 2; ++a)
#pragma unroll
            for (int b = 0; b < 2; ++b)
#pragma unroll
                for (int m = 0; m < 4; ++m)
#pragma unroll
                    for (int n = 0; n < 2; ++n) acc[a][b][m][n] = (f32x4){0.f, 0.f, 0.f, 0.f};
        cur = nxt; cA = nA; cB = nB; ++ui;
        if constexpr (ALIGN_EPI) { if (wr == 1) PG8_BAR; }
    }
    PG8_WAIT_V(0);
    if constexpr (!ALIGN_EPI) { if (wr == 0) PG8_BAR; }
    PG8_BAR;
    if constexpr (Epi::AFTER_DRAIN) { E.fused(acc, cur, wr, wc, fr, fq, lds, wid, lane); S.done(cur); }
#undef PG8_SA
#undef PG8_SB
#undef PG8_STAGE
#undef PG8_LDA
#undef PG8_LDB
#undef PG8_MMA
#undef PG8_WAIT_V
#undef PG8_WAIT_L
#undef PG8_BAR
#undef PG8_SCHED
}
}
#define LAS __attribute__((address_space(3)))
#define GAS __attribute__((address_space(1)))
typedef unsigned short bf16;
typedef unsigned u32x4 __attribute__((ext_vector_type(4)));
typedef unsigned u32x2 __attribute__((ext_vector_type(2)));
typedef float f32x4 __attribute__((ext_vector_type(4)));
typedef float f32x2 __attribute__((ext_vector_type(2)));
typedef float f32x16 __attribute__((ext_vector_type(16)));
typedef short bf16x8 __attribute__((ext_vector_type(8)));
typedef short s16x4 __attribute__((ext_vector_type(4)));
constexpr int D = 1024, FF = 4096, NH = 8;
constexpr int ROW_S = 65536, ROW_M = 66048, ROWS_VALID = 66064, MPAD = 66304;
constexpr int EXT_P = 8208, EXT_S = 1104;
constexpr float LOG2E = 1.4426950408889634f;
constexpr float QSCALE = 0.125f * LOG2E;
constexpr float EPS = 1e-6f, SUBLN_EPS = 1e-5f;
constexpr size_t OFF_YP = 0, OFF_YS = 67108864, OFF_KP = OFF_YS + 524288, OFF_VP = OFF_KP + 134479872, OFF_PP = OFF_VP + 134479872,
                 OFF_KS = OFF_PP + 245760, OFF_VS = OFF_KS + 1048576, OFF_PS = OFF_VS + 1048576, OUT_TOTAL = OFF_PS + 245760;
constexpr size_t MiB = 1u << 20;
constexpr size_t WS_WQKV = 1 * MiB, WS_WO = 13 * MiB, WS_WPOOL = 17 * MiB, WS_WUP = 18 * MiB, WS_WDN = 50 * MiB, WS_XM = 82 * MiB,
                 WS_XN = 83 * MiB, WS_QB = 213 * MiB, WS_YB = 343 * MiB, WS_KX = 473 * MiB, WS_VX = 602 * MiB, WS_KXS = 731 * MiB, WS_VXS = 767 * MiB,
                 WS_KXM = 803 * MiB, WS_VXM = 804 * MiB, WS_U = 805 * MiB, WS_MFK = 1323 * MiB, WS_MFV = 1324 * MiB, WS_END = 1325 * MiB;
constexpr size_t KXS_LAYER = 18 * MiB / 2;
constexpr int LDS_BYTES = 147456;
constexpr int NSTEPS = 27;
#ifndef ONE_LAUNCH
#define ONE_LAUNCH 1
#endif

__device__ __forceinline__ unsigned f2bf(float f) { unsigned u = __builtin_bit_cast(unsigned, f); return (u + 0x7fffu + ((u >> 16) & 1u)) >> 16; }
__device__ __forceinline__ unsigned pk2(float lo, float hi) { return f2bf(lo) | (f2bf(hi) << 16); }
__device__ __forceinline__ float bflo(unsigned w) { return __builtin_bit_cast(float, w << 16); }
__device__ __forceinline__ float bfhi(unsigned w) { return __builtin_bit_cast(float, w & 0xffff0000u); }
__device__ __forceinline__ float wave_sum(float v) {
#pragma unroll
    for (int o = 1; o < 64; o <<= 1) v += __shfl_xor(v, o);
    return v;
}

struct Args { const float* in[22]; float* out; unsigned char* ws; int lo, hi; };
typedef const __attribute__((address_space(4))) Args& ArgsRef;
__device__ __forceinline__ int mk_tid(int wv) { int t; asm volatile("v_mbcnt_lo_u32_b32 %0, -1, 0\n\tv_mbcnt_hi_u32_b32 %0, -1, %0" : "=v"(t)); return wv * 64 + t; }
struct Frame {
    LAS unsigned char* lds; int tid, lane, wave, vcu, G;
    float* out; unsigned char* ws;
};

__device__ __forceinline__ void transpose_item(const float* W, int K, int N, bf16* WT, LAS float* scr, int item, int lane, const float* nscale) {
    const int nblk = N / 32, kb = item / nblk, nb = item % nblk, k0 = 64 * kb, n0 = 32 * nb;
#pragma unroll 8
    for (int i = 0; i < 32; ++i) { const int kk = 2 * i + (lane >> 5); scr[kk * 33 + (lane & 31)] = W[(size_t)(k0 + kk) * N + n0 + (lane & 31)]; }
    asm volatile("s_waitcnt lgkmcnt(0)" ::: "memory");
    const int c = lane & 7;
#pragma unroll
    for (int j = 0; j < 4; ++j) { const int n = (lane >> 3) + 8 * j; const LAS float* s = scr + (8 * c) * 33 + n; const float sc = nscale ? nscale[n0 + n] : 1.f;
        u32x4 o; o.x = pk2(s[0 * 33] * sc, s[1 * 33] * sc); o.y = pk2(s[2 * 33] * sc, s[3 * 33] * sc); o.z = pk2(s[4 * 33] * sc, s[5 * 33] * sc); o.w = pk2(s[6 * 33] * sc, s[7 * 33] * sc);
        *(u32x4*)(WT + (size_t)(n0 + n) * K + k0 + 8 * c) = o; }
    asm volatile("s_waitcnt lgkmcnt(0)" ::: "memory");
}
__device__ __forceinline__ const float* xin_row(ArgsRef A, int row) {
    return row < ROW_S ? A.in[0] + (size_t)row * D : row < ROW_M ? A.in[1] + (size_t)(row - ROW_S) * D : A.in[5] + (size_t)(row - ROW_M) * D;
}
__device__ __forceinline__ float* xres_row(const Frame& F, int row) {
    return row < ROW_S ? F.out + OFF_YP + (size_t)row * D : row < ROW_M ? F.out + OFF_YS + (size_t)(row - ROW_S) * D : (float*)(F.ws + WS_XM) + (size_t)(row - ROW_M) * D;
}
__device__ __forceinline__ void prologue(ArgsRef A, Frame& F) {
    { const int t_ = mk_tid(F.wave); F.tid = t_; F.lane = t_ & 63; }
    LAS float* scr = (LAS float*)(F.lds + F.wave * 16384);
    const int gw = F.vcu * 8 + F.wave, NGW = F.G * 8;
    constexpr int I_QKV = 16 * 96, I_O = 16 * 32, I_UP = 16 * 128, I_DN = 64 * 32, I_PL = 4 * 8;
    constexpr int NITEMS = 2 * I_QKV + 2 * I_O + 4 * I_UP + 4 * I_DN + 8 * I_PL;
    for (int it = gw; it < NITEMS; it += NGW) {
        int r = it;
        if (r < 2 * I_QKV) { const int a = r / I_QKV; transpose_item(A.in[11] + (size_t)a * D * 3072, D, 3072, (bf16*)(F.ws + WS_WQKV) + (size_t)a * 3072 * D, scr, r % I_QKV, F.lane, nullptr); continue; } r -= 2 * I_QKV;
        if (r < 2 * I_O) { const int a = r / I_O; transpose_item(A.in[17] + (size_t)a * D * D, D, D, (bf16*)(F.ws + WS_WO) + (size_t)a * D * D, scr, r % I_O, F.lane, nullptr); continue; } r -= 2 * I_O;
        if (r < 4 * I_UP) { const int i = r / I_UP; transpose_item(A.in[20] + (size_t)i * D * FF, D, FF, (bf16*)(F.ws + WS_WUP) + (size_t)i * D * FF, scr, r % I_UP, F.lane, nullptr); continue; } r -= 4 * I_UP;
        if (r < 4 * I_DN) { const int i = r / I_DN; transpose_item(A.in[21] + (size_t)i * D * FF, FF, D, (bf16*)(F.ws + WS_WDN) + (size_t)i * D * FF, scr, r % I_DN, F.lane, nullptr); continue; } r -= 4 * I_DN;
        { const int pg = r / I_PL; transpose_item(A.in[18] + (size_t)pg * 65536, 256, 256, (bf16*)(F.ws + WS_WPOOL) + (size_t)pg * 65536, scr, r % I_PL, F.lane, A.in[19] + pg * 256); }
    }
    for (int it = gw; it < 32768; it += NGW) {
        const int j = it & 1023, b = (it >> 10) & 7, kv = (it >> 13) & 1, a = it >> 14;
        const float* src = (kv ? A.in[3] : A.in[2]) + ((size_t)(a * 8 + b) * 1024 + j) * D;
        bf16* dst = (bf16*)(F.ws + (kv ? WS_VXS : WS_KXS)) + (size_t)a * KXS_LAYER + (size_t)(b * EXT_S + 16 + j) * D;
#pragma unroll
        for (int q = 0; q < 4; ++q) { const f32x4 v = *(const f32x4*)(src + 4 * F.lane + 256 * q); u32x2 w; w.x = pk2(v.x, v.y); w.y = pk2(v.z, v.w); *(u32x2*)(dst + 4 * F.lane + 256 * q) = w; }
    }
    const float* g = A.in[7];
    for (int row = gw; row < MPAD; row += NGW) {
        bf16* xn = (bf16*)(F.ws + WS_XN) + (size_t)row * D;
        if (row >= ROWS_VALID) {
#pragma unroll
            for (int q = 0; q < 4; ++q) *(u32x2*)(xn + 4 * F.lane + 256 * q) = (u32x2){0u, 0u};
            continue; }
        const float* x = xin_row(A, row); f32x4 v[4]; float ss = 0.f;
#pragma unroll
        for (int q = 0; q < 4; ++q) { v[q] = *(const f32x4*)(x + 4 * F.lane + 256 * q); ss += v[q].x * v[q].x + v[q].y * v[q].y + v[q].z * v[q].z + v[q].w * v[q].w; }
        const float r = 1.0f / sqrtf(wave_sum(ss) * (1.f / D) + EPS);
#pragma unroll
        for (int q = 0; q < 4; ++q) { const f32x4 gg = *(const f32x4*)(g + 4 * F.lane + 256 * q); u32x2 w; w.x = pk2(v[q].x * r * gg.x, v[q].y * r * gg.y); w.y = pk2(v[q].z * r * gg.z, v[q].w * r * gg.w);
            *(u32x2*)(xn + 4 * F.lane + 256 * q) = w; }
    }
}
__device__ __forceinline__ void fin_phase(ArgsRef A, Frame& F, bool from_inputs, const float* gpost, const float* gnext) {
    { const int t_ = mk_tid(F.wave); F.tid = t_; F.lane = t_ & 63; }
    const int gw = F.vcu * 8 + F.wave, NGW = F.G * 8;
    const bf16* YB = (const bf16*)(F.ws + WS_YB);
    for (int row = gw; row < ROWS_VALID; row += NGW) {
        const bf16* y = YB + (size_t)row * D; const float* xi = from_inputs ? xin_row(A, row) : xres_row(F, row); float* xo = xres_row(F, row);
        f32x4 yv[4], xv[4]; float ss = 0.f;
#pragma unroll
        for (int q = 0; q < 4; ++q) { const u32x2 w = *(const u32x2*)(y + 4 * F.lane + 256 * q); yv[q] = (f32x4){bflo(w.x), bfhi(w.x), bflo(w.y), bfhi(w.y)};
            xv[q] = *(const f32x4*)(xi + 4 * F.lane + 256 * q); ss += yv[q].x * yv[q].x + yv[q].y * yv[q].y + yv[q].z * yv[q].z + yv[q].w * yv[q].w; }
        const float r = 1.0f / sqrtf(wave_sum(ss) * (1.f / D) + EPS); float s2 = 0.f;
#pragma unroll
        for (int q = 0; q < 4; ++q) { const f32x4 gg = *(const f32x4*)(gpost + 4 * F.lane + 256 * q); xv[q] = xv[q] + yv[q] * r * gg; *(f32x4*)(xo + 4 * F.lane + 256 * q) = xv[q];
            s2 += xv[q].x * xv[q].x + xv[q].y * xv[q].y + xv[q].z * xv[q].z + xv[q].w * xv[q].w; }
        if (gnext) { const float r2 = 1.0f / sqrtf(wave_sum(s2) * (1.f / D) + EPS); bf16* xn = (bf16*)(F.ws + WS_XN) + (size_t)row * D;
#pragma unroll
            for (int q = 0; q < 4; ++q) { const f32x4 gg = *(const f32x4*)(gnext + 4 * F.lane + 256 * q); u32x2 w; w.x = pk2(xv[q].x * r2 * gg.x, xv[q].y * r2 * gg.y); w.y = pk2(xv[q].z * r2 * gg.z, xv[q].w * r2 * gg.w);
                *(u32x2*)(xn + 4 * F.lane + 256 * q) = w; } }
    }
}
__device__ __forceinline__ f32x2 pool_h(ArgsRef A, const Frame& F, int grp, int b, int t, int col, int p) {
    const bf16* XN = (const bf16*)(F.ws + WS_XN);
    if (t >= 0) { const int row = grp == 0 ? b * 8192 + t : grp == 1 ? ROW_S + b * 64 + t : ROW_M + t; const unsigned w = *(const unsigned*)(XN + (size_t)row * D + col); return (f32x2){bflo(w), bfhi(w)}; }
    if (grp == 0) { const unsigned w = *(const unsigned*)(XN + (size_t)(ROW_M + 16 + t) * D + col); return (f32x2){bflo(w), bfhi(w)}; }
    if (grp == 1) return *(const f32x2*)(A.in[4] + ((size_t)(p * 8 + b) * 15 + 15 + t) * D + col);
    return (f32x2){0.f, 0.f};
}
__device__ __forceinline__ void pool_phase(ArgsRef A, Frame& F, int p) {
    { const int t_ = mk_tid(F.wave); F.tid = t_; F.lane = t_ & 63; }
    bf16* DB = (bf16*)(F.ws + WS_QB);
    const int col = 2 * F.tid, w = 2 << (col >> 8);
    for (int it = F.vcu; it < 2065; it += F.G) {
        int grp, b, t0, nr;
        if (it < 2048) { grp = 0; b = it >> 8; t0 = (it & 255) * 32; nr = 32; } else if (it < 2064) { const int s = it - 2048; grp = 1; b = s >> 1; t0 = (s & 1) * 32; nr = 32; } else { grp = 2; b = 0; t0 = 0; nr = 16; }
        f32x2 sum = {0.f, 0.f};
        for (int j = 1; j < w; ++j) sum += pool_h(A, F, grp, b, t0 - j, col, p);
        for (int t = t0; t < t0 + nr; ++t) {
            const f32x2 cur = pool_h(A, F, grp, b, t, col, p); sum += cur;
            const float inv = 1.0f / (float)(grp == 2 ? min(t + 1, w) : w);
            const int row = grp == 0 ? b * 8192 + t : grp == 1 ? ROW_S + b * 64 + t : ROW_M + t;
            *(unsigned*)(DB + (size_t)row * D + col) = pk2(sum.x * inv - cur.x, sum.y * inv - cur.y);
            sum -= pool_h(A, F, grp, b, t - w + 1, col, p);
            if (grp == 0 && t >= 8177) *(f32x2*)(F.out + OFF_PP + ((size_t)(p * 8 + b) * 15 + (t - 8177)) * D + col) = cur;
            if (grp == 1 && t >= 49) *(f32x2*)(F.out + OFF_PS + ((size_t)(p * 8 + b) * 15 + (t - 49)) * D + col) = cur;
        }
    }
}

namespace att {
constexpr int KSTR = 272;
constexpr int TB = 16384;
constexpr int OFF_K0 = 0, OFF_K1 = TB, OFF_V0 = 2 * TB, OFF_V1 = 3 * TB, OFF_BT = 4 * TB, OFF_GT = OFF_BT + 2048, OFF_Q = 5 * TB, XB = 16384;
static_assert(OFF_BT >= 4 * XB && OFF_GT + 512 <= OFF_Q && OFF_Q + 2 * TB <= 131072, "attention LDS map");
constexpr float THR = 48.0f;
constexpr float NEG = -1e30f;
struct AUnit { const bf16* K; const bf16* V; const bf16* KM; const bf16* VM; const bf16* Q; bf16* O; int P, L, x, h; };
__device__ __forceinline__ float max3f(float a, float b, float c) { float r; asm("v_max3_f32 %0, %1, %2, %3" : "=v"(r) : "v"(a), "v"(b), "v"(c)); return r; }
__device__ __forceinline__ float swapmax(float v) { auto rr = __builtin_amdgcn_permlane32_swap(__float_as_uint(v), __float_as_uint(v), false, false); return fmaxf(__uint_as_float(rr[0]), __uint_as_float(rr[1])); }
__device__ __forceinline__ float swapsum(float v) { auto rr = __builtin_amdgcn_permlane32_swap(__float_as_uint(v), __float_as_uint(v), false, false); return __uint_as_float(rr[0]) + __uint_as_float(rr[1]); }
typedef __bf16 bf16x2_t __attribute__((ext_vector_type(2)));
__device__ __forceinline__ unsigned cvtpk(float lo, float hi) { f32x2 v = {lo, hi}; bf16x2_t b = __builtin_convertvector(v, bf16x2_t); return __builtin_bit_cast(unsigned, b); }
__device__ __forceinline__ s16x4 vtr(const LAS unsigned char* p) { return __builtin_bit_cast(s16x4, __builtin_amdgcn_ds_read_tr16_b64_v4i16((LAS s16x4*)p)); }
__device__ __forceinline__ void glds16(const void* gsrc, unsigned lds_dst) { unsigned keep;
    asm volatile("s_mov_b32 %0, m0\n\ts_mov_b32 m0, %2\n\ts_nop 0\n\tglobal_load_lds_dwordx4 %1, off\n\ts_mov_b32 m0, %0" : "=&s"(keep) : "v"(gsrc), "s"(lds_dst) : "memory"); }
__device__ __forceinline__ bf16x8 pack8(const f32x16& S, int o) {
    u32x4 w; w.x = cvtpk(S[o], S[o + 1]); w.y = cvtpk(S[o + 2], S[o + 3]); w.z = cvtpk(S[o + 4], S[o + 5]); w.w = cvtpk(S[o + 6], S[o + 7]); return __builtin_bit_cast(bf16x8, w);
}

__device__ __forceinline__ void attn_unit(const int wv, LAS unsigned char* lds, const AUnit& u, const float* lq1, const float* lk1, const float* lq2, const float* lk2, const int layer_a, const float* relb, const float* subg) {
    const int tid = mk_tid(wv), lane = tid & 63, wid = wv, mp = wid >> 2, rg = wid & 3, q32 = lane & 31, hi = lane >> 5;
    LAS float* BT = (LAS float*)(lds + OFF_BT); LAS float* GT = (LAS float*)(lds + OFF_GT);
    {
        const float b15 = relb[15 * 8 + u.h];
        if (tid < 448) { const int rel = tid - 192, n = rel < 0 ? -rel : rel;
            int bk = n < 8 ? n : n < 12 ? 8 : n < 16 ? 9 : n < 23 ? 10 : n < 32 ? 11 : n < 46 ? 12 : n < 64 ? 13 : n < 91 ? 14 : 15; if (rel > 0) bk += 16;
            BT[tid] = (relb[bk * 8 + u.h] - b15) * LOG2E; }
        if (tid >= 384) GT[tid - 384] = subg[tid - 384] * (layer_a == 0 ? 0.8f : 0.52928698f);
    }
    const int vrows = min(128, u.L - 128 * u.x);
    const bool active = rg * 32 < vrows;
    const int ch = rg >> 1;
    const int NTw = active ? (u.P + min((2 * u.x + ch + 1) * 64, u.L) + 48) >> 6 : 0;
    const int NT = (u.P + min((2 * u.x + 2) * 64, u.L) + 48) >> 6;
    const int eq0 = u.P + 128 * u.x + rg * 32, eq = eq0 + q32;
    unsigned goff[2];
#pragma unroll
    for (int j = 0; j < 2; ++j) { const int row = wid * 8 + 4 * j + (lane >> 4), x = ((row & 3) << 2) | ((row >> 2) & 3), c = (lane & 15) ^ x; goff[j] = (unsigned)(row * 1024 + u.h * 128 + c * 8); }
    const unsigned ldst = (unsigned)wid * 2048u; const unsigned lds0 = (unsigned)(size_t)lds;
#define ATT_DMA(base, bufoff) do { _Pragma("unroll") for (int j_ = 0; j_ < 2; ++j_) \
        glds16((base) + goff[j_], (unsigned)__builtin_amdgcn_readfirstlane((int)(lds0 + (unsigned)(bufoff) + ldst + j_ * 1024))); } while (0)
#define ATT_ISSUE_K(t, bufoff) do { const bf16* b_ = ((t) == 0 && wid < 2) ? u.KM : u.K + (size_t)(t) * 65536; ATT_DMA(b_, bufoff); } while (0)
#define ATT_ISSUE_V(t, bufoff) do { const bf16* b_ = ((t) == 0 && wid < 2) ? u.VM : u.V + (size_t)(t) * 65536; ATT_DMA(b_, bufoff); } while (0)
#define ATT_WAITBAR() do { asm volatile("s_waitcnt vmcnt(0) lgkmcnt(0)" ::: "memory"); __builtin_amdgcn_s_barrier(); asm volatile("" ::: "memory"); } while (0)
    int koff[4];
    { const int x = ((q32 & 3) << 2) | ((q32 >> 2) & 3);
#pragma unroll
      for (int d0 = 0; d0 < 4; ++d0) koff[d0] = q32 * 256 + (((mp * 8 + 2 * d0 + hi) ^ x) << 4); }
    int vofs[4][2];
    { const int qq = (lane & 15) >> 2, cl = 2 * ((lane >> 4) & 1) + ((lane & 3) >> 1), sub = 8 * (lane & 1);
#pragma unroll
      for (int dvb = 0; dvb < 4; ++dvb)
#pragma unroll
          for (int hf = 0; hf < 2; ++hf) vofs[dvb][hf] = (8 * hf + 4 * hi + qq) * 256 + ((((dvb ^ qq) << 2) | (cl ^ (2 * hf + hi))) << 4) + sub; }
    {
        const bf16* qb_ = u.Q + (size_t)(128 * u.x + wid * 16) * 1024;
#pragma unroll
        for (int j = 0; j < 4; ++j) { const int row = 4 * j + (lane >> 4), x = ((row & 3) << 2) | ((row >> 2) & 3), c = (lane & 15) ^ x;
            glds16(qb_ + row * 1024 + u.h * 128 + c * 8, (unsigned)__builtin_amdgcn_readfirstlane((int)(lds0 + OFF_Q + wid * 4096 + j * 1024))); }
    }
    ATT_ISSUE_K(0, OFF_K0); ATT_ISSUE_V(0, OFF_V0); if (NT > 1) ATT_ISSUE_K(1, OFF_K1);
    ATT_WAITBAR();
    f32x16 O[4];
#pragma unroll
    for (int i = 0; i < 4; ++i)
#pragma unroll
        for (int r = 0; r < 16; ++r) O[i][r] = 0.f;
    float m = 0.f, l = 0.f;
    f32x16 SA0, SA1, SB0, SB1;
    const f32x16 zero16 = {0.f, 0.f, 0.f, 0.f, 0.f, 0.f, 0.f, 0.f, 0.f, 0.f, 0.f, 0.f, 0.f, 0.f, 0.f, 0.f};
#define ATT_SB() __builtin_amdgcn_sched_barrier(0)
#define ATT_QK(S0_, S1_, kbufoff) do { const LAS unsigned char* kb_ = lds + (kbufoff); const LAS unsigned char* qb2_ = lds + OFF_Q + rg * 8192; \
        bf16x8 kfa[4], kfb[4], qfr[4]; \
        _Pragma("unroll") for (int d0 = 0; d0 < 4; ++d0) { kfa[d0] = *(const LAS bf16x8*)(kb_ + koff[d0]); kfb[d0] = *(const LAS bf16x8*)(kb_ + koff[d0] + 8192); qfr[d0] = *(const LAS bf16x8*)(qb2_ + koff[d0]); } \
        ATT_SB(); \
        S0_ = __builtin_amdgcn_mfma_f32_32x32x16_bf16(kfa[0], qfr[0], zero16, 0, 0, 0); S1_ = __builtin_amdgcn_mfma_f32_32x32x16_bf16(kfb[0], qfr[0], zero16, 0, 0, 0); \
        _Pragma("unroll") for (int d0 = 1; d0 < 4; ++d0) { S0_ = __builtin_amdgcn_mfma_f32_32x32x16_bf16(kfa[d0], qfr[d0], S0_, 0, 0, 0); S1_ = __builtin_amdgcn_mfma_f32_32x32x16_bf16(kfb[d0], qfr[d0], S1_, 0, 0, 0); } } while (0)
#define ATT_VLD(bank, ks) do { _Pragma("unroll") for (int dvb = 0; dvb < 4; ++dvb) { bank[dvb][0] = vtr(vb_ + (ks) * 4096 + vofs[dvb][0]); bank[dvb][1] = vtr(vb_ + (ks) * 4096 + vofs[dvb][1]); } } while (0)
#define ATT_PV(bank, ks, C0, C1) do { const bf16x8 pb = pack8(((ks) < 2) ? C0 : C1, 8 * ((ks) & 1)); \
        _Pragma("unroll") for (int dvb = 0; dvb < 4; ++dvb) { const bf16x8 vf = (bf16x8){bank[dvb][0][0], bank[dvb][0][1], bank[dvb][0][2], bank[dvb][0][3], bank[dvb][1][0], bank[dvb][1][1], bank[dvb][1][2], bank[dvb][1][3]}; \
            O[dvb] = __builtin_amdgcn_mfma_f32_32x32x16_bf16(vf, pb, O[dvb], 0, 0, 0); } } while (0)
#define ATT_STEP(C0, C1, N0, N1, t_) do { const int t = (t_); const int cur = t & 1; \
        if (t + 2 < NT) ATT_ISSUE_K(t + 2, cur ? OFF_K1 : OFF_K0); \
        if (t + 1 < NT) ATT_ISSUE_V(t + 1, cur ? OFF_V0 : OFF_V1); \
        { \
            const int k0 = t * 64; \
            if (k0 + 154 > eq0) { const LAS float* bt_ = BT + (k0 - eq + 192 + 4 * hi); \
                _Pragma("unroll") for (int r = 0; r < 16; ++r) { C0[r] += bt_[(r & 3) + 8 * (r >> 2)]; } \
                ATT_SB(); \
                _Pragma("unroll") for (int r = 0; r < 16; ++r) { C1[r] += bt_[32 + (r & 3) + 8 * (r >> 2)]; } } \
            if (t >= NTw - 1) { const bool all_ = t >= NTw; _Pragma("unroll") for (int r = 0; r < 16; ++r) { if (r >= 8 || all_) C0[r] = NEG; C1[r] = NEG; } } \
            if (__any(m != 0.f)) { _Pragma("unroll") for (int r = 0; r < 16; ++r) { C0[r] -= m; C1[r] -= m; } } \
            float mx = max3f(C0[0], C1[0], C0[1]), mx2 = max3f(C1[1], C0[2], C1[2]); \
            _Pragma("unroll") for (int r = 3; r < 15; r += 2) { mx = max3f(mx, C0[r], C1[r]); mx2 = max3f(mx2, C0[r + 1], C1[r + 1]); } \
            mx = max3f(mx, mx2, C0[15]); mx = fmaxf(mx, C1[15]); \
            mx = swapmax(mx); \
            if (__any(mx > THR || (t == 0 && mx < -THR))) { const float dl = (t == 0) ? mx : fmaxf(mx, 0.f); m += dl; const float f = (t == 0) ? 1.f : __builtin_amdgcn_exp2f(-dl); l *= f; \
                _Pragma("unroll") for (int r = 0; r < 16; ++r) { C0[r] -= dl; C1[r] -= dl; } \
                _Pragma("unroll") for (int i = 0; i < 4; ++i) _Pragma("unroll") for (int r = 0; r < 16; ++r) O[i][r] *= f; } \
        } \
        ATT_SB(); \
        if (t + 1 < NT) ATT_QK(N0, N1, cur ? OFF_K0 : OFF_K1); \
        ATT_SB(); \
        { \
            const LAS unsigned char* vb_ = lds + (cur ? OFF_V1 : OFF_V0); \
            s16x4 vA[4][2], vB[4][2]; \
            ATT_VLD(vA, 0); \
            ATT_SB(); \
            float ls = 0.f; \
            _Pragma("unroll") for (int r = 0; r < 16; ++r) { C0[r] = __builtin_amdgcn_exp2f(C0[r]); C1[r] = __builtin_amdgcn_exp2f(C1[r]); ls += C0[r] + C1[r]; } \
            l += ls; \
            ATT_SB(); \
            ATT_VLD(vB, 1); ATT_SB(); ATT_PV(vA, 0, C0, C1); ATT_SB(); \
            ATT_VLD(vA, 2); ATT_SB(); ATT_PV(vB, 1, C0, C1); ATT_SB(); \
            ATT_VLD(vB, 3); ATT_SB(); ATT_PV(vA, 2, C0, C1); ATT_SB(); \
            ATT_PV(vB, 3, C0, C1); \
        } \
        ATT_WAITBAR(); } while (0)
    ATT_QK(SA0, SA1, OFF_K0);
    ATT_WAITBAR();
    for (int tt = 0; tt < NT; tt += 2) { ATT_STEP(SA0, SA1, SB0, SB1, tt); if (tt + 1 < NT) ATT_STEP(SB0, SB1, SA0, SA1, tt + 1); }
#undef ATT_STEP
#undef ATT_QK
#undef ATT_VLD
#undef ATT_PV
#undef ATT_SB
#undef ATT_WAITBAR
#undef ATT_ISSUE_K
#undef ATT_ISSUE_V
#undef ATT_DMA
    const int tid2_ = mk_tid(wv);
    const int lane2 = tid2_ & 63, q32b = lane2 & 31, hib = lane2 >> 5;
    float lam;
    { float s1 = lq1[lane2] * lk1[lane2], s2 = lq2[lane2] * lk2[lane2]; s1 = wave_sum(s1); s2 = wave_sum(s2); lam = expf(s1) - expf(s2) + (layer_a == 0 ? 0.2f : 0.47071302f); }
    l = swapsum(l); const float inv = active ? 1.0f / l : 0.f;
    LAS float* xb = (LAS float*)(lds + rg * XB);
    if (mp == 1) { const float f = inv * lam;
#pragma unroll
        for (int i = 0; i < 4; ++i)
#pragma unroll
            for (int r = 0; r < 16; ++r) xb[(i * 16 + r) * 64 + lane2] = O[i][r] * f; }
    __syncthreads();
    if (mp == 0 && active) {
        float ss = 0.f;
#pragma unroll
        for (int i = 0; i < 4; ++i)
#pragma unroll
            for (int r = 0; r < 16; ++r) { const float o = O[i][r] * inv - xb[(i * 16 + r) * 64 + lane2]; O[i][r] = o; ss += o * o; }
        ss = swapsum(ss); const float rs = 1.0f / sqrtf(ss * (1.f / 128.f) + SUBLN_EPS);
        asm volatile("s_waitcnt lgkmcnt(0)" ::: "memory");
        LAS unsigned char* stg = (LAS unsigned char*)xb;
#pragma unroll
        for (int i = 0; i < 4; ++i)
#pragma unroll
            for (int r4 = 0; r4 < 4; ++r4) { const int dv0 = 32 * i + 8 * r4 + 4 * hib; const f32x4 gg = *(const LAS f32x4*)(GT + dv0);
                u32x2 w; w.x = cvtpk(O[i][4 * r4] * rs * gg.x, O[i][4 * r4 + 1] * rs * gg.y); w.y = cvtpk(O[i][4 * r4 + 2] * rs * gg.z, O[i][4 * r4 + 3] * rs * gg.w);
                *(LAS u32x2*)(stg + q32b * KSTR + dv0 * 2) = w; }
        asm volatile("s_waitcnt lgkmcnt(0)" ::: "memory");
        bf16* og = u.O + (size_t)(128 * u.x + rg * 32) * 1024 + u.h * 128;
#pragma unroll
        for (int i = 0; i < 8; ++i) { const int row = i * 4 + (lane2 >> 4), c16 = lane2 & 15; const u32x4 v = *(const LAS u32x4*)(stg + row * KSTR + c16 * 16);
            if (rg * 32 + row < vrows) *(u32x4*)(og + (size_t)row * 1024 + c16 * 8) = v; }
    }
    __syncthreads();
}
__device__ __forceinline__ void attn_phase(ArgsRef A, Frame& F, int a) {
    const bf16* QB = (const bf16*)(F.ws + WS_QB); bf16* OB = (bf16*)(F.ws + WS_XN); const bf16* KX = (const bf16*)(F.ws + WS_KX); const bf16* VX = (const bf16*)(F.ws + WS_VX);
    const bf16* KXS = (const bf16*)(F.ws + WS_KXS) + (size_t)a * KXS_LAYER; const bf16* VXS = (const bf16*)(F.ws + WS_VXS) + (size_t)a * KXS_LAYER;
    { const int gt = blockIdx.x * 512 + mk_tid(F.wave);
      for (int i = gt; i < 65536; i += F.G * 512) { const int c4 = i & 255, r = (i >> 8) & 15, b = (i >> 12) & 7, kv = i >> 15;
          const f32x4 v = *(const f32x4*)((const float*)(F.ws + (kv ? WS_MFV : WS_MFK)) + r * 1024 + c4 * 4);
          *(f32x4*)(F.out + (kv ? OFF_VP : OFF_KP) + (size_t)a * 8 * EXT_P * 1024 + (size_t)(b * EXT_P + r) * 1024 + c4 * 4) = v; } }
    for (int n = F.vcu; n < 4168; n += F.G) {
        AUnit u; u.KM = (const bf16*)(F.ws + WS_KXM); u.VM = (const bf16*)(F.ws + WS_VXM);
        if (n < 4096) { const int i = n >> 8, v = n & 255, c = v & 31, bh = (v >> 5) * 8 + (i >> 1); const int x = (i & 1) ? 63 - c : c; const int b = bh >> 3;
            u.K = KX + (size_t)b * EXT_P * 1024; u.V = VX + (size_t)b * EXT_P * 1024; u.Q = QB + (size_t)b * 8192 * 1024; u.O = OB + (size_t)b * 8192 * 1024; u.P = 16; u.L = 8192; u.x = x; u.h = bh & 7; }
        else if (n < 4160) { const int j = n - 4096, b = j >> 3; u.K = KXS + (size_t)b * EXT_S * 1024; u.V = VXS + (size_t)b * EXT_S * 1024; u.Q = QB + (size_t)(ROW_S + b * 64) * 1024; u.O = OB + (size_t)(ROW_S + b * 64) * 1024; u.P = 1040; u.L = 64; u.x = 0; u.h = j & 7; }
        else { u.K = (const bf16*)(F.ws + WS_KXM); u.V = (const bf16*)(F.ws + WS_VXM); u.Q = QB + (size_t)ROW_M * 1024; u.O = OB + (size_t)ROW_M * 1024; u.P = 0; u.L = 16; u.x = 0; u.h = n - 4160; }
        attn_unit(F.wave, F.lds, u, A.in[12] + a * 64, A.in[13] + a * 64, A.in[14] + a * 64, A.in[15] + a * 64, a, A.in[6], A.in[16] + a * 128);
    }
}
}

#define XB_TMO      128
#define XB_XCNT(j)  (256  + 64 * (j))
#define XB_XSUB(j)  (1280 + 64 * (j))
#define XB_XGEN(j)  (2304 + 64 * (j))
#define XB_TOP      3328
#define XB_TOPGEN   3392
#define XCD_BAR_WORDS 3456
#define XB_SPIN_CAP (1u << 18)

__device__ __forceinline__ unsigned xb_ld(unsigned* p)              { return __hip_atomic_load(p, __ATOMIC_RELAXED, __HIP_MEMORY_SCOPE_AGENT); }
__device__ __forceinline__ unsigned xb_add(unsigned* p, unsigned v) { return __hip_atomic_fetch_add(p, v, __ATOMIC_RELAXED, __HIP_MEMORY_SCOPE_AGENT); }
__device__ __forceinline__ unsigned xb_xcc_id() { return (unsigned)__builtin_amdgcn_s_getreg((3 << 11) | 20) & 0xFu; }
#define XB_SPIN(cond, bar) do { unsigned _sp = 0; while (cond) { __builtin_amdgcn_s_sleep(1); \
    if ((++_sp & 255u) == 0u) { if (xb_ld(&(bar)[XB_TMO])) break; if (_sp > XB_SPIN_CAP) { atomicAdd(&(bar)[XB_TMO], 1u); break; } } } } while (0)

struct XcdBarrier {
    bool leader; unsigned* bar; unsigned x;
    volatile LAS unsigned* st;
};

__device__ __forceinline__ XcdBarrier xcd_barrier_post(unsigned* bar, volatile LAS unsigned* st) {
    XcdBarrier b; b.bar = bar; b.x = xb_xcc_id(); b.st = st;
    b.leader = (threadIdx.x == 0);
    if (b.leader) (void)xb_add(&bar[XB_XCNT(b.x)], 1u);
    return b;
}
__device__ __forceinline__ void xcd_barrier_complete(unsigned* bar, unsigned x, unsigned& nloc, unsigned& nx) {
    const unsigned G = gridDim.x * gridDim.y * gridDim.z;
    unsigned sum, cnt, mine, sp = 0u;
    for (;;) {
        sum = 0u; cnt = 0u; mine = 0u;
#pragma unroll
        for (unsigned j = 0; j < 16; ++j) { const unsigned c = xb_ld(&bar[XB_XCNT(j)]); sum += c; cnt += (c > 0u) ? 1u : 0u; mine = (j == x) ? c : mine; }
        if (sum == G) break;
        __builtin_amdgcn_s_sleep(1);
        if ((++sp & 255u) == 0u) { if (xb_ld(&bar[XB_TMO])) break; if (sp > XB_SPIN_CAP) { atomicAdd(&bar[XB_TMO], 1u); break; } }
    }
    nloc = mine > 0u ? mine : 1u; nx = cnt > 0u ? cnt : 1u;
}

__device__ __forceinline__ void xcd_barrier(const XcdBarrier& b) {
    asm volatile("s_waitcnt vmcnt(0)" ::: "memory");
    __syncthreads();
    if (b.leader) {
        unsigned* bar = b.bar;
        __builtin_amdgcn_s_waitcnt(0);
        unsigned nloc = b.st[0], nx = b.st[1];
        if (nloc == 0u) { xcd_barrier_complete(bar, b.x, nloc, nx); b.st[0] = nloc; b.st[1] = nx; }
        const unsigned old = xb_add(&bar[XB_XSUB(b.x)], 1u);
        const unsigned gen = old / nloc;
        if (old + 1u == (gen + 1u) * nloc) {
            __builtin_amdgcn_fence(__ATOMIC_RELEASE, "agent");
            asm volatile("s_waitcnt vmcnt(0)" ::: "memory");
            const unsigned og = xb_add(&bar[XB_TOP], 1u);
            const unsigned tg = og / nx;
            if (og + 1u == (tg + 1u) * nx) xb_add(&bar[XB_TOPGEN], 1u);
            else XB_SPIN(xb_ld(&bar[XB_TOPGEN]) == tg, bar);
            __builtin_amdgcn_fence(__ATOMIC_ACQUIRE, "agent");
            xb_add(&bar[XB_XGEN(b.x)], 1u);
            asm volatile("s_waitcnt vmcnt(0)" ::: "memory");
        } else {
            XB_SPIN(xb_ld(&bar[XB_XGEN(b.x)]) == gen, bar);
            __builtin_amdgcn_fence(__ATOMIC_ACQUIRE, "agent");
            asm volatile("s_waitcnt vmcnt(0)" ::: "memory");
        }
    }
    __syncthreads();
}

__device__ __forceinline__ void run_step(ArgsRef args, const int step, const int wv) {
    extern __shared__ __attribute__((aligned(16))) unsigned char lds_raw[];
    Frame F;
    F.lds = (LAS unsigned char*)lds_raw; F.tid = 0; F.lane = 0; F.wave = wv;
    F.G = gridDim.x; { const int bx = blockIdx.x; F.vcu = (F.G % 8 == 0) ? (bx % 8) * (F.G / 8) + bx / 8 : bx; }
    F.out = args.out; F.ws = args.ws;
    bf16* XN = (bf16*)(F.ws + WS_XN); bf16* QB = (bf16*)(F.ws + WS_QB); bf16* YB = (bf16*)(F.ws + WS_YB); bf16* U = (bf16*)(F.ws + WS_U);
    int layer = 0, k = -1;
    if (step > 0) { const int s = step - 1; if (s < 7) { layer = 0; k = s; } else if (s < 13) { layer = 1; k = s - 7; } else if (s < 20) { layer = 2; k = s - 13; } else { layer = 3; k = s - 20; } }
    const bool attn = (layer & 1) == 0; const int a = layer >> 1;
    int type;
    if (step == 0) type = 0; else if (attn) type = k == 0 ? 1 : k == 1 ? 2 : k == 2 ? 4 : k == 3 ? 5 : k == 4 ? 6 : k == 5 ? 7 : 8;
    else type = k == 0 ? 3 : k == 1 ? 4 : k == 2 ? 5 : k == 3 ? 6 : k == 4 ? 7 : 8;
    if (type == 0) prologue(args, F);
    else if (type == 1) {
        pg8::Gemm g{XN, (const bf16*)(F.ws + WS_WQKV) + (size_t)a * 3072 * D, MPAD, 3072, D, D, D, 0}; pg8::StaticOrder S; S.init(MPAD, 3072, F.G, (int)blockIdx.x);
        pg8::EpiQKV E{F.ws, F.out, a};
        pg8::gemm_phase<pg8::EpiQKV, pg8::StaticOrder, true, true>(F.lds, g, S, E, mk_tid(F.wave));
    } else if (type == 2) { att::attn_phase(args, F, a); }
    else if (type == 3) { pool_phase(args, F, a); }
    else if (type == 4 || type == 7) {
        pg8::Gemm g;
        if (type == 7) g = pg8::Gemm{U, (const bf16*)(F.ws + WS_WDN) + (size_t)layer * D * FF, MPAD, D, FF, FF, FF, 0};
        else if (attn) g = pg8::Gemm{XN, (const bf16*)(F.ws + WS_WO) + (size_t)a * D * D, MPAD, D, D, D, D, 0};
        else g = pg8::Gemm{QB, (const bf16*)(F.ws + WS_WPOOL) + (size_t)a * 4 * 65536, MPAD, D, 256, D, 256, 512};
        pg8::StaticOrder S; S.init(MPAD, D, F.G, (int)blockIdx.x);
        pg8::EpiBf16<0> E{YB, D};
        pg8::gemm_phase<pg8::EpiBf16<0>, pg8::StaticOrder, true, true>(F.lds, g, S, E, mk_tid(F.wave));
    } else if (type == 5) { fin_phase(args, F, layer == 0, args.in[8] + layer * D, args.in[9] + layer * D); }
    else if (type == 6) {
        pg8::Gemm g{XN, (const bf16*)(F.ws + WS_WUP) + (size_t)layer * D * FF, MPAD, FF, D, D, D, 0}; pg8::StaticOrder S; S.init(MPAD, FF, F.G, (int)blockIdx.x);
        pg8::EpiBf16<2> E{U, FF};
        pg8::gemm_phase<pg8::EpiBf16<2>, pg8::StaticOrder, true, true>(F.lds, g, S, E, mk_tid(F.wave));
    } else { fin_phase(args, F, false, args.in[10] + layer * D, layer < 3 ? args.in[7] + (layer + 1) * D : nullptr); }
}
__global__ void __launch_bounds__(512, 2) fwd_kernel(Args args_) {
    const int lo = args_.lo, hi = args_.hi;
    const int wv = __builtin_amdgcn_readfirstlane((int)threadIdx.x >> 6);
    extern __shared__ __attribute__((aligned(16))) unsigned char lds_raw[];
    volatile LAS unsigned* bst = (volatile LAS unsigned*)((LAS unsigned char*)lds_raw + 131072);
    if (threadIdx.x < 2) bst[threadIdx.x] = 0u;
    __syncthreads();
    XcdBarrier bar = xcd_barrier_post((unsigned*)args_.ws + 4096, bst);
    int probe_rep = 0; (void)probe_rep;
    for (int step = lo; step < hi; ++step) {
        const __attribute__((address_space(4))) Args* ap = (const __attribute__((address_space(4))) Args*)__builtin_amdgcn_kernarg_segment_ptr();
        asm volatile("" : "+s"(ap));
        run_step(*ap, step, wv);
#if defined(PROBE_MASK)
        {
            int ty = 0; if (step > 0) { const int s = step - 1; const int k = s < 7 ? s : s < 13 ? s - 7 : s < 20 ? s - 13 : s - 20; const bool at = (s < 7) || (s >= 13 && s < 20);
                ty = at ? (k == 0 ? 1 : k == 1 ? 2 : k == 2 ? 4 : k == 3 ? 5 : k == 4 ? 6 : k == 5 ? 7 : 8) : (k == 0 ? 3 : k == 1 ? 4 : k == 2 ? 5 : k == 3 ? 6 : k == 4 ? 7 : 8); }
            if (((PROBE_MASK >> ty) & 1) && !probe_rep) { probe_rep = 1; --step; __syncthreads(); continue; }
            probe_rep = 0; }
#endif
        if (step + 1 < hi) { if (step == lo) { __threadfence(); cg::this_grid().sync(); } else xcd_barrier(bar); }
    }
}

extern "C" void kernel_launch(void* const* d_in, const int* in_sizes, int n_in, void* d_out, int out_size, void* d_ws, size_t ws_size, hipStream_t stream) {
    static int grid = 0;
    if (grid == 0) {
        if (n_in != 22 || (size_t)out_size != OUT_TOTAL || ws_size < WS_END) { fprintf(stderr, "kernel_launch: unexpected shapes n_in %d out %d ws %zu\n", n_in, out_size, ws_size); grid = -1; return; }
        int dev = 0, cus = 0, per_cu = 0;
        hipGetDevice(&dev); hipDeviceGetAttribute(&cus, hipDeviceAttributeMultiprocessorCount, dev);
        hipFuncSetAttribute((const void*)fwd_kernel, hipFuncAttributeMaxDynamicSharedMemorySize, LDS_BYTES);
        hipOccupancyMaxActiveBlocksPerMultiprocessor(&per_cu, (const void*)fwd_kernel, 512, LDS_BYTES);
        if (per_cu < 1) { fprintf(stderr, "kernel_launch: occupancy query says %d blocks/CU\n", per_cu); per_cu = 1; }
        (void)hipGetLastError();
        grid = cus;
    }
    if (grid < 0) return;
    if (hipMemsetAsync(d_ws, 0, 65536, stream) != hipSuccess) { fprintf(stderr, "kernel_launch: memset failed\n"); return; }
    Args a{};
    for (int i = 0; i < 22; ++i) a.in[i] = (const float*)d_in[i];
    a.out = (float*)d_out; a.ws = (unsigned char*)d_ws;
#if ONE_LAUNCH
    a.lo = 0; a.hi = NSTEPS;
    void* kargs[] = {&a};
    hipError_t e = hipLaunchCooperativeKernel((const void*)fwd_kernel, dim3(grid), dim3(512), kargs, LDS_BYTES, stream);
    if (e != hipSuccess) fprintf(stderr, "cooperative launch failed: %s (grid %d)\n", hipGetErrorString(e), grid);
#else
    for (int s = 0; s < NSTEPS; ++s) { a.lo = s; a.hi = s + 1; hipLaunchKernelGGL(fwd_kernel, dim3(grid), dim3(512), LDS_BYTES, stream, a); }
#endif
}
static_assert(WS_QB == 213 * MiB && WS_KX == 473 * MiB && WS_VX == 602 * MiB && WS_KXS == 731 * MiB && WS_VXS == 767 * MiB && WS_KXM == 803 * MiB && WS_VXM == 804 * MiB && KXS_LAYER == 9 * MiB && WS_MFK == 1323 * MiB && WS_MFV == 1324 * MiB, "EpiQKV hard-coded map");
static_assert(OFF_KP == 67633152 && OFF_VP == 202113024 && OFF_KS == 336838656 && OFF_VS == 337887232, "EpiQKV hard-coded output offsets");
```

```cpp
#include <hip/hip_runtime.h>
#include <hip/hip_cooperative_groups.h>
#include <hip/hip_bf16.h>
#include <cstdio>
#include <cstdint>
namespace cg = cooperative_groups;
namespace pg8 {
#define PG8_LAS __attribute__((address_space(3)))
typedef unsigned short bf16_t;
typedef short bf16x8 __attribute__((ext_vector_type(8)));
typedef float f32x4 __attribute__((ext_vector_type(4)));
typedef unsigned u32x4 __attribute__((ext_vector_type(4)));
constexpr int BM = 256, BK = 64, HALF = 128, HTB = HALF * BK * 2  , STAGE_BYTES = 8 * HTB, NXCD = 8, WGM = 8;

__host__ __device__ __forceinline__ int lds_byte(int r, int c) { const int st = (r >> 4) * 2 + (c >> 5), rr = r & 15, cc = c & 31, ob = rr * 64 + cc * 2; return st * 1024 + (ob ^ (((ob >> 9) & 1) << 5)); }
__host__ __device__ __forceinline__ void stage_rc(int b, int& R, int& C) { const int st = b / 1024, sb = b % 1024, swz = sb ^ (((sb >> 9) & 1) << 5); R = (st >> 1) * 16 + swz / 64; C = (st & 1) * 32 + (swz % 64) / 2; }
__host__ __device__ __forceinline__ int perm32(int rho) { const int n = rho >> 4, i = rho & 15; return 8 * (i >> 2) + 4 * n + (i & 3); }

struct Unit { int pm, pn; };
struct Gemm { const bf16_t* A; const bf16_t* Bt; int M, N, K, lda, ldb, acs; };

struct StaticOrder {
    int nM, nN, nwg, G, c;
    __host__ __device__ void init(int M, int N, int G_, int c_) { nM = M / BM; nN = N / BM; nwg = nM * nN; G = G_; c = c_; }
    __host__ __device__ bool next(int i, Unit& u) const {
        const long L = (long)i * G + c; if (L >= nwg) return false;
        int wgid = (int)L; { const int q = nwg / NXCD, r = nwg % NXCD, xcd = wgid % NXCD, off = wgid / NXCD; wgid = (xcd < r ? xcd * (q + 1) : r * (q + 1) + (xcd - r) * q) + off; }
        const int nig = WGM * nN, gid = wgid / nig, fm = gid * WGM, gsz = (nM - fm) < WGM ? (nM - fm) : WGM;
        u.pm = fm + ((wgid % nig) % gsz); u.pn = (wgid % nig) / gsz; return true;
    }
    __device__ __forceinline__ void a_ready(const Unit&) const {}
    __device__ __forceinline__ void done(const Unit&) const {}
};

__device__ __forceinline__ unsigned cvt_pk_bf16(float lo, float hi) { unsigned r; asm volatile("v_cvt_pk_bf16_f32 %0, %1, %2" : "=v"(r) : "v"(lo), "v"(hi)); return r; }
template <int ACT  > struct EpiBf16 {
    static constexpr bool PERM = true, AFTER_DRAIN = false;
    bf16_t* O; int ldc;
    __device__ __forceinline__ void operator()(const f32x4 (&acc)[2][2][4][2], const Unit& u, int wr, int wc, int fr, int fq) const {
        asm volatile("" : "+v"(fr), "+v"(fq));
        const int row0 = u.pm * BM + wr * 64 + fr; const int col0 = u.pn * BM + wc * 32 + 8 * fq;
#pragma unroll
        for (int ai = 0; ai < 2; ++ai)
#pragma unroll
            for (int m = 0; m < 4; ++m) { bf16_t* rowp = O + (size_t)(row0 + ai * HALF + m * 16) * ldc + col0;
#pragma unroll
                for (int bj = 0; bj < 2; ++bj) { f32x4 v0 = acc[ai][bj][m][0], v1 = acc[ai][bj][m][1];
                    if (ACT == 2) {
#pragma unroll
                        for (int e = 0; e < 4; ++e) { float a = fmaxf(v0[e], 0.f), b = fmaxf(v1[e], 0.f); v0[e] = a * a; v1[e] = b * b; } }
                    u32x4 w; w.x = cvt_pk_bf16(v0[0], v0[1]); w.y = cvt_pk_bf16(v0[2], v0[3]); w.z = cvt_pk_bf16(v1[0], v1[1]); w.w = cvt_pk_bf16(v1[2], v1[3]);
                    *(u32x4*)(rowp + bj * HALF) = w; } }
    }
};
struct EpiQKV {
    static constexpr bool PERM = true, AFTER_DRAIN = false;
    unsigned char* ws; float* out; int a;
    __device__ __forceinline__ void operator()(const f32x4 (&acc)[2][2][4][2], const Unit& u, int wr, int wc, int fr, int fq) const {
        const size_t MiB_ = 1u << 20;
        asm volatile("" : "+v"(fr), "+v"(fq));
        const int t3 = u.pn >> 2; const int colb = (u.pn & 3) * 256 + wc * 32 + 8 * fq;
        bf16_t* X; float* Fp = nullptr; int rbase, jump = 0, s0 = 0; float sc = 1.f;
        if (t3 == 0) { X = (bf16_t*)(ws + 213 * MiB_); rbase = u.pm * BM; sc = 0.125f * 1.4426950408889634f; }
        else if (u.pm < 256) { const int b = u.pm >> 5; rbase = b * 8208 + 16 + (u.pm & 31) * 256; X = (bf16_t*)(ws + (t3 == 1 ? 473 : 602) * MiB_);
            Fp = out + (t3 == 1 ? (size_t)67633152 : (size_t)202113024) + (size_t)a * 8 * 8208 * 1024 + (size_t)rbase * 1024; }
        else if (u.pm < 258) { s0 = (u.pm - 256) * 256; rbase = 1040 + s0; jump = 1040; X = (bf16_t*)(ws + (t3 == 1 ? 731 : 767) * MiB_) + (size_t)a * (9 * MiB_);
            Fp = out + (t3 == 1 ? (size_t)336838656 : (size_t)337887232) + (size_t)a * 512 * 1024 + (size_t)s0 * 1024; }
        else { rbase = 0; X = (bf16_t*)(ws + (t3 == 1 ? 803 : 804) * MiB_); Fp = (float*)(ws + (t3 == 1 ? 1323 : 1324) * MiB_); }
#pragma unroll
        for (int ai = 0; ai < 2; ++ai)
#pragma unroll
            for (int m = 0; m < 4; ++m) { const int rit = ai * HALF + wr * 64 + m * 16 + fr;
                bf16_t* xr = X + (unsigned)((rbase + rit + ((s0 + rit) >> 6) * jump) * 1024 + colb); float* fr_ = Fp + (unsigned)(rit * 1024 + colb);
#pragma unroll
                for (int bj = 0; bj < 2; ++bj) { const f32x4 v0 = acc[ai][bj][m][0], v1 = acc[ai][bj][m][1]; const f32x4 s0v = v0 * sc, s1v = v1 * sc;
                    u32x4 w; w.x = cvt_pk_bf16(s0v[0], s0v[1]); w.y = cvt_pk_bf16(s0v[2], s0v[3]); w.z = cvt_pk_bf16(s1v[0], s1v[1]); w.w = cvt_pk_bf16(s1v[2], s1v[3]);
                    *(u32x4*)(xr + bj * HALF) = w;
                    if (t3 != 0) { *(f32x4*)(fr_ + bj * HALF) = v0; *(f32x4*)(fr_ + bj * HALF + 4) = v1; } } }
    }
};
template <class Epi, class Sched, bool ALIGN_EPI = false, bool SP2 = false>
__device__ __forceinline__ void gemm_phase(PG8_LAS unsigned char* lds, const Gemm g, const Sched& S, const Epi& E, const int tid_in) {
    int tid_ = tid_in; asm volatile("" : "+v"(tid_));
    const int tid = tid_, wid = __builtin_amdgcn_readfirstlane(tid >> 6), lane = tid & 63, wr = wid >> 2, wc = wid & 3, fr = lane & 15, fq = lane >> 4;
    const int K = g.K, nt = K / BK;
    unsigned voffA[2], voffB[2];
#pragma unroll
    for (int i = 0; i < 2; ++i) { int R, C; stage_rc(tid * 16 + i * 8192, R, C); const int Rb = Epi::PERM ? ((R & ~31) + perm32(R & 31)) : R;
        voffA[i] = (unsigned)(R * g.lda + C) * 2u; voffB[i] = (unsigned)(Rb * g.ldb + C) * 2u; }
    const size_t kstep = (size_t)(BK * 2);
    const size_t hstepA = (size_t)HALF * g.lda * 2, hstepB = (size_t)HALF * g.ldb * 2;
    const size_t tstepA = 2 * hstepA, tstepB = 2 * hstepB;
    const unsigned ldsw = (unsigned)wid * 1024u;
    const int aoff = lds_byte(wr * 64 + fr, fq * 8), boff = lds_byte(wc * 32 + fr, fq * 8);
#define PG8_SA(b, h) (((b) * 2 + (h)) * HTB)
#define PG8_SB(b, h) ((4 + (b) * 2 + (h)) * HTB)
#define PG8_STAGE(bufoff, gbase, voff) do { _Pragma("unroll") for (int _i = 0; _i < 2; ++_i) \
        __builtin_amdgcn_global_load_lds((const unsigned*)((const char*)(gbase) + (voff)[_i]), (PG8_LAS unsigned*)(lds + (bufoff) + ldsw + _i * 8192), 16, 0, 0); } while (0)
#define PG8_LDA(dst, b, h) do { _Pragma("unroll") for (int m = 0; m < 4; ++m) _Pragma("unroll") for (int k = 0; k < 2; ++k) dst[m][k] = *(const PG8_LAS bf16x8*)(lds + PG8_SA(b, h) + aoff + m * 2048 + k * 1024); } while (0)
#define PG8_LDB(dst, b, h) do { _Pragma("unroll") for (int n = 0; n < 2; ++n) _Pragma("unroll") for (int k = 0; k < 2; ++k) dst[n][k] = *(const PG8_LAS bf16x8*)(lds + PG8_SB(b, h) + boff + n * 2048 + k * 1024); } while (0)
#define PG8_MMA(ai, bj, At, Bt) do { __builtin_amdgcn_s_setprio(1); _Pragma("unroll") for (int m = 0; m < 4; ++m) _Pragma("unroll") for (int n = 0; n < 2; ++n) _Pragma("unroll") for (int k = 0; k < 2; ++k) \
        acc[ai][bj][m][n] = __builtin_amdgcn_mfma_f32_16x16x32_bf16(Bt[n][k], At[m][k], acc[ai][bj][m][n], 0, 0, 0); __builtin_amdgcn_s_setprio(0); } while (0)
#define PG8_WAIT_V(n) asm volatile("s_waitcnt vmcnt(" #n ")" ::: "memory")
#define PG8_WAIT_L(n) asm volatile("s_waitcnt lgkmcnt(" #n ")" ::: "memory")
#define PG8_BAR __builtin_amdgcn_s_barrier()
#define PG8_SCHED __builtin_amdgcn_sched_barrier(0)
    Unit cur, nxt; int ui = 0;
    if (!S.next(0, cur)) return;
    f32x4 acc[2][2][4][2];
#pragma unroll
    for (int a = 0; a < 2; ++a)
#pragma unroll
        for (int b = 0; b < 2; ++b)
#pragma unroll
            for (int m = 0; m < 4; ++m)
#pragma unroll
                for (int n = 0; n < 2; ++n) acc[a][b][m][n] = (f32x4){0.f, 0.f, 0.f, 0.f};
    bf16x8 At[4][2], B0[2][2], B1[2][2];
    const char* cA = (const char*)g.A + (size_t)cur.pm * tstepA + (size_t)cur.pn * g.acs; const char* cB = (const char*)g.Bt + (size_t)cur.pn * tstepB;
    S.a_ready(cur);
    if constexpr (SP2) {
        PG8_STAGE(PG8_SB(0, 0), cB, voffB); PG8_STAGE(PG8_SB(0, 1), cB + hstepB, voffB); PG8_STAGE(PG8_SA(0, 0), cA, voffA); PG8_STAGE(PG8_SA(0, 1), cA + hstepA, voffA);
        if (wr == 1) PG8_BAR;
        PG8_WAIT_V(2); PG8_BAR;
        PG8_STAGE(PG8_SB(1, 0), cB + kstep, voffB); PG8_STAGE(PG8_SA(1, 0), cA + kstep, voffA); PG8_STAGE(PG8_SB(1, 1), cB + hstepB + kstep, voffB);
        PG8_WAIT_V(6); PG8_BAR;
    } else {
        PG8_STAGE(PG8_SB(0, 0), cB, voffB); PG8_STAGE(PG8_SA(0, 0), cA, voffA); PG8_STAGE(PG8_SB(0, 1), cB + hstepB, voffB); PG8_STAGE(PG8_SA(0, 1), cA + hstepA, voffA);
        if (wr == 1) PG8_BAR;
        PG8_WAIT_V(4); PG8_BAR;
        PG8_STAGE(PG8_SB(1, 0), cB + kstep, voffB); PG8_STAGE(PG8_SA(1, 0), cA + kstep, voffA); PG8_STAGE(PG8_SB(1, 1), cB + hstepB + kstep, voffB);
        PG8_WAIT_V(6); PG8_BAR;
    }
    for (;;) {
        const bool has_next = S.next(ui + 1, nxt);
        const char* nA = has_next ? (const char*)g.A + (size_t)nxt.pm * tstepA + (size_t)nxt.pn * g.acs : cA; const char* nB = has_next ? (const char*)g.Bt + (size_t)nxt.pn * tstepB : cB;
        for (int t = 0; t < nt; t += 2) {
            const bool last = (t == nt - 2);
            const char* a1 = cA + (size_t)(t + 1) * kstep;
            const char* a2 = last ? nA : cA + (size_t)(t + 2) * kstep; const char* b2 = last ? nB : cB + (size_t)(t + 2) * kstep;
            const char* a3 = a2 + kstep; const char* b3 = b2 + kstep;
            if (last && has_next) S.a_ready(nxt);
            if constexpr (SP2) {
            PG8_LDB(B0, 0, 0); PG8_LDB(B1, 0, 1); PG8_SCHED; PG8_LDA(At, 0, 0); PG8_STAGE(PG8_SA(1, 1), a1 + hstepA, voffA);
            PG8_WAIT_V(8); PG8_WAIT_L(0); PG8_BAR; PG8_MMA(0, 0, At, B0); PG8_MMA(0, 1, At, B1); PG8_BAR; PG8_SCHED;
            PG8_LDA(At, 0, 1); PG8_STAGE(PG8_SB(0, 0), b2, voffB); PG8_STAGE(PG8_SB(0, 1), b2 + hstepB, voffB); PG8_STAGE(PG8_SA(0, 0), a2, voffA);
            PG8_WAIT_V(8); PG8_WAIT_L(0); PG8_BAR; PG8_MMA(1, 0, At, B0); PG8_MMA(1, 1, At, B1); PG8_BAR; PG8_SCHED;
            PG8_LDB(B0, 1, 0); PG8_LDB(B1, 1, 1); PG8_SCHED; PG8_LDA(At, 1, 0); PG8_STAGE(PG8_SA(0, 1), a2 + hstepA, voffA);
            PG8_WAIT_V(8); PG8_WAIT_L(0); PG8_BAR; PG8_MMA(0, 0, At, B0); PG8_MMA(0, 1, At, B1); PG8_BAR; PG8_SCHED;
            PG8_LDA(At, 1, 1); PG8_STAGE(PG8_SB(1, 0), b3, voffB); PG8_STAGE(PG8_SB(1, 1), b3 + hstepB, voffB); PG8_STAGE(PG8_SA(1, 0), a3, voffA);
            PG8_WAIT_V(8); PG8_WAIT_L(0); PG8_BAR; PG8_MMA(1, 0, At, B0); PG8_MMA(1, 1, At, B1); PG8_BAR; PG8_SCHED;
            } else {
            PG8_LDB(B0, 0, 0); PG8_SCHED; PG8_LDA(At, 0, 0); PG8_STAGE(PG8_SA(1, 1), a1 + hstepA, voffA);
            PG8_WAIT_L(8); PG8_BAR; PG8_WAIT_L(0); PG8_MMA(0, 0, At, B0); PG8_BAR; PG8_SCHED;
            PG8_LDB(B1, 0, 1); PG8_STAGE(PG8_SB(0, 0), b2, voffB);
            PG8_BAR; PG8_WAIT_L(0); PG8_MMA(0, 1, At, B1); PG8_BAR;
            PG8_LDA(At, 0, 1); PG8_STAGE(PG8_SA(0, 0), a2, voffA);
            PG8_BAR; PG8_WAIT_L(0); PG8_MMA(1, 0, At, B0); PG8_BAR; PG8_SCHED;
            PG8_STAGE(PG8_SB(0, 1), b2 + hstepB, voffB);
            PG8_WAIT_V(6); PG8_BAR; PG8_MMA(1, 1, At, B1); PG8_BAR;
            PG8_LDB(B0, 1, 0); PG8_SCHED; PG8_LDA(At, 1, 0); PG8_STAGE(PG8_SA(0, 1), a2 + hstepA, voffA);
            PG8_WAIT_L(8); PG8_BAR; PG8_WAIT_L(0); PG8_MMA(0, 0, At, B0); PG8_BAR; PG8_SCHED;
            PG8_LDB(B1, 1, 1); PG8_STAGE(PG8_SB(1, 0), b3, voffB);
            PG8_BAR; PG8_WAIT_L(0); PG8_MMA(0, 1, At, B1); PG8_BAR;
            PG8_LDA(At, 1, 1); PG8_STAGE(PG8_SA(1, 0), a3, voffA);
            PG8_BAR; PG8_WAIT_L(0); PG8_MMA(1, 0, At, B0); PG8_BAR; PG8_SCHED;
            PG8_STAGE(PG8_SB(1, 1), b3 + hstepB, voffB);
            PG8_WAIT_V(6); PG8_BAR; PG8_MMA(1, 1, At, B1); PG8_BAR;
            }
        }
        if constexpr (ALIGN_EPI) { if (wr == 0) PG8_BAR; }
        if constexpr (!Epi::AFTER_DRAIN) { E(acc, cur, wr, wc, fr, fq); S.done(cur); }
        if (!has_next) break;
#pragma unroll
        for (int a = 0; a < 2; ++a)
#pragma unroll
            for (int b = 0; b < 2; ++b)
#pragma unroll
                for (int m = 0; m < 4; ++m)
#pragma unroll
                    for (int n = 0; n < 2; ++n) acc[a][b][m][n] = (f32x4){0.f, 0.f, 0.f, 0.f};
        cur = nxt; cA = nA; cB = nB; ++ui;
        if constexpr (ALIGN_EPI) { if (wr == 1) PG8_BAR; }
    }
    PG8_WAIT_V(0);
    if constexpr (!ALIGN_EPI) { if (wr == 0) PG8_BAR; }
    PG8_BAR;
    if constexpr (Epi::AFTER_DRAIN) { E.fused(acc, cur, wr, wc, fr, fq, lds, wid, lane); S.done(cur); }
#undef PG8_SA
#undef PG8_SB
#undef PG8_STAGE
#undef PG8_LDA
#undef PG8_LDB
#undef PG8_MMA
#undef PG8_WAIT_V
#undef PG8_WAIT_L
#undef PG8_BAR
#undef PG8_SCHED
}
}
#define LAS __attribute__((address_space(3)))
#define GAS __attribute__((address_space(1)))
typedef unsigned short bf16;
typedef unsigned u32x4 __attribute__((ext_vector_type(4)));
typedef unsigned u32x2 __attribute__((ext_vector_type(2)));
typedef float f32x4 __attribute__((ext_vector_type(4)));
typedef float f32x2 __attribute__((ext_vector_type(2)));
typedef float f32x16 __attribute__((ext_vector_type(16)));
typedef short bf16x8 __attribute__((ext_vector_type(8)));
typedef short s16x4 __attribute__((ext_vector_type(4)));
constexpr int D = 1024, FF = 4096, NH = 8;
constexpr int ROW_S = 65536, ROW_M = 66048, ROWS_VALID = 66064, MPAD = 66304;
constexpr int EXT_P = 8208, EXT_S = 1104;
constexpr float LOG2E = 1.4426950408889634f;
constexpr float QSCALE = 0.125f * LOG2E;
constexpr float EPS = 1e-6f, SUBLN_EPS = 1e-5f;
constexpr size_t OFF_YP = 0, OFF_YS = 67108864, OFF_KP = OFF_YS + 524288, OFF_VP = OFF_KP + 134479872, OFF_PP = OFF_VP + 134479872,
                 OFF_KS = OFF_PP + 245760, OFF_VS = OFF_KS + 1048576, OFF_PS = OFF_VS + 1048576, OUT_TOTAL = OFF_PS + 245760;
constexpr size_t MiB = 1u << 20;
constexpr size_t WS_WQKV = 1 * MiB, WS_WO = 13 * MiB, WS_WPOOL = 17 * MiB, WS_WUP = 18 * MiB, WS_WDN = 50 * MiB, WS_XM = 82 * MiB,
                 WS_XN = 83 * MiB, WS_QB = 213 * MiB, WS_YB = 343 * MiB, WS_KX = 473 * MiB, WS_VX = 602 * MiB, WS_KXS = 731 * MiB, WS_VXS = 767 * MiB,
                 WS_KXM = 803 * MiB, WS_VXM = 804 * MiB, WS_U = 805 * MiB, WS_MFK = 1323 * MiB, WS_MFV = 1324 * MiB, WS_END = 1325 * MiB;
constexpr size_t KXS_LAYER = 18 * MiB / 2;
constexpr int LDS_BYTES = 147456;
constexpr int NSTEPS = 27;
#ifndef ONE_LAUNCH
#define ONE_LAUNCH 1
#endif

__device__ __forceinline__ unsigned f2bf(float f) { unsigned u = __builtin_bit_cast(unsigned, f); return (u + 0x7fffu + ((u >> 16) & 1u)) >> 16; }
__device__ __forceinline__ unsigned pk2(float lo, float hi) { return f2bf(lo) | (f2bf(hi) << 16); }
__device__ __forceinline__ float bflo(unsigned w) { return __builtin_bit_cast(float, w << 16); }
__device__ __forceinline__ float bfhi(unsigned w) { return __builtin_bit_cast(float, w & 0xffff0000u); }
__device__ __forceinline__ float wave_sum(float v) {
#pragma unroll
    for (int o = 1; o < 64; o <<= 1) v += __shfl_xor(v, o);
    return v;
}

struct Args { const float* in[22]; float* out; unsigned char* ws; int lo, hi; };
typedef const __attribute__((address_space(4))) Args& ArgsRef;
__device__ __forceinline__ int mk_tid(int wv) { int t; asm volatile("v_mbcnt_lo_u32_b32 %0, -1, 0\n\tv_mbcnt_hi_u32_b32 %0, -1, %0" : "=v"(t)); return wv * 64 + t; }
struct Frame {
    LAS unsigned char* lds; int tid, lane, wave, vcu, G;
    float* out; unsigned char* ws;
};

__device__ __forceinline__ void transpose_item(const float* W, int K, int N, bf16* WT, LAS float* scr, int item, int lane, const float* nscale) {
    const int nblk = N / 32, kb = item / nblk, nb = item % nblk, k0 = 64 * kb, n0 = 32 * nb;
#pragma unroll 8
    for (int i = 0; i < 32; ++i) { const int kk = 2 * i + (lane >> 5); scr[kk * 33 + (lane & 31)] = W[(size_t)(k0 + kk) * N + n0 + (lane & 31)]; }
    asm volatile("s_waitcnt lgkmcnt(0)" ::: "memory");
    const int c = lane & 7;
#pragma unroll
    for (int j = 0; j < 4; ++j) { const int n = (lane >> 3) + 8 * j; const LAS float* s = scr + (8 * c) * 33 + n; const float sc = nscale ? nscale[n0 + n] : 1.f;
        u32x4 o; o.x = pk2(s[0 * 33] * sc, s[1 * 33] * sc); o.y = pk2(s[2 * 33] * sc, s[3 * 33] * sc); o.z = pk2(s[4 * 33] * sc, s[5 * 33] * sc); o.w = pk2(s[6 * 33] * sc, s[7 * 33] * sc);
        *(u32x4*)(WT + (size_t)(n0 + n) * K + k0 + 8 * c) = o; }
    asm volatile("s_waitcnt lgkmcnt(0)" ::: "memory");
}
__device__ __forceinline__ const float* xin_row(ArgsRef A, int row) {
    return row < ROW_S ? A.in[0] + (size_t)row * D : row < ROW_M ? A.in[1] + (size_t)(row - ROW_S) * D : A.in[5] + (size_t)(row - ROW_M) * D;
}
__device__ __forceinline__ float* xres_row(const Frame& F, int row) {
    return row < ROW_S ? F.out + OFF_YP + (size_t)row * D : row < ROW_M ? F.out + OFF_YS + (size_t)(row - ROW_S) * D : (float*)(F.ws + WS_XM) + (size_t)(row - ROW_M) * D;
}
__device__ __forceinline__ void prologue(ArgsRef A, Frame& F) {
    { const int t_ = mk_tid(F.wave); F.tid = t_; F.lane = t_ & 63; }
    LAS float* scr = (LAS float*)(F.lds + F.wave * 16384);
    const int gw = F.vcu * 8 + F.wave, NGW = F.G * 8;
    constexpr int I_QKV = 16 * 96, I_O = 16 * 32, I_UP = 16 * 128, I_DN = 64 * 32, I_PL = 4 * 8;
    constexpr int NITEMS = 2 * I_QKV + 2 * I_O + 4 * I_UP + 4 * I_DN + 8 * I_PL;
    for (int it = gw; it < NITEMS; it += NGW) {
        int r = it;
        if (r < 2 * I_QKV) { const int a = r / I_QKV; transpose_item(A.in[11] + (size_t)a * D * 3072, D, 3072, (bf16*)(F.ws + WS_WQKV) + (size_t)a * 3072 * D, scr, r % I_QKV, F.lane, nullptr); continue; } r -= 2 * I_QKV;
        if (r < 2 * I_O) { const int a = r / I_O; transpose_item(A.in[17] + (size_t)a * D * D, D, D, (bf16*)(F.ws + WS_WO) + (size_t)a * D * D, scr, r % I_O, F.lane, nullptr); continue; } r -= 2 * I_O;
        if (r < 4 * I_UP) { const int i = r / I_UP; transpose_item(A.in[20] + (size_t)i * D * FF, D, FF, (bf16*)(F.ws + WS_WUP) + (size_t)i * D * FF, scr, r % I_UP, F.lane, nullptr); continue; } r -= 4 * I_UP;
        if (r < 4 * I_DN) { const int i = r / I_DN; transpose_item(A.in[21] + (size_t)i * D * FF, FF, D, (bf16*)(F.ws + WS_WDN) + (size_t)i * D * FF, scr, r % I_DN, F.lane, nullptr); continue; } r -= 4 * I_DN;
        { const int pg = r / I_PL; transpose_item(A.in[18] + (size_t)pg * 65536, 256, 256, (bf16*)(F.ws + WS_WPOOL) + (size_t)pg * 65536, scr, r % I_PL, F.lane, A.in[19] + pg * 256); }
    }
    for (int it0 = gw; it0 < 32768; it0 += 4 * NGW) {
        f32x4 v[4][4];
#pragma unroll
        for (int r4 = 0; r4 < 4; ++r4) { const int it = min(it0 + r4 * NGW, 32767); const int j = it & 1023, b = (it >> 10) & 7, kv = (it >> 13) & 1, a = it >> 14;
            const float* src = (kv ? A.in[3] : A.in[2]) + ((size_t)(a * 8 + b) * 1024 + j) * D;
#pragma unroll
            for (int q = 0; q < 4; ++q) v[r4][q] = *(const f32x4*)(src + 4 * F.lane + 256 * q); }
#pragma unroll
        for (int r4 = 0; r4 < 4; ++r4) { const int it = it0 + r4 * NGW; if (it < 32768) { const int j = it & 1023, b = (it >> 10) & 7, kv = (it >> 13) & 1, a = it >> 14;
            bf16* dst = (bf16*)(F.ws + (kv ? WS_VXS : WS_KXS)) + (size_t)a * KXS_LAYER + (size_t)(b * EXT_S + 16 + j) * D;
#pragma unroll
            for (int q = 0; q < 4; ++q) { u32x2 w; w.x = pk2(v[r4][q].x, v[r4][q].y); w.y = pk2(v[r4][q].z, v[r4][q].w); *(u32x2*)(dst + 4 * F.lane + 256 * q) = w; } } }
    }
    const float* g = A.in[7];
    for (int row = ROWS_VALID + gw; row < MPAD; row += NGW) { bf16* xn = (bf16*)(F.ws + WS_XN) + (size_t)row * D;
#pragma unroll
        for (int q = 0; q < 4; ++q) *(u32x2*)(xn + 4 * F.lane + 256 * q) = (u32x2){0u, 0u}; }
    for (int row0 = gw; row0 < ROWS_VALID; row0 += 4 * NGW) {
        f32x4 v[4][4]; float ss[4];
#pragma unroll
        for (int j = 0; j < 4; ++j) { const float* x = xin_row(A, min(row0 + j * NGW, ROWS_VALID - 1)); ss[j] = 0.f;
#pragma unroll
            for (int q = 0; q < 4; ++q) v[j][q] = *(const f32x4*)(x + 4 * F.lane + 256 * q); }
#pragma unroll
        for (int j = 0; j < 4; ++j) {
#pragma unroll
            for (int q = 0; q < 4; ++q) ss[j] += v[j][q].x * v[j][q].x + v[j][q].y * v[j][q].y + v[j][q].z * v[j][q].z + v[j][q].w * v[j][q].w; }
#pragma unroll
        for (int o = 1; o < 64; o <<= 1) {
#pragma unroll
            for (int j = 0; j < 4; ++j) ss[j] += __shfl_xor(ss[j], o); }
#pragma unroll
        for (int j = 0; j < 4; ++j) { const int row = row0 + j * NGW; const float r = 1.0f / sqrtf(ss[j] * (1.f / D) + EPS); bf16* xn = (bf16*)(F.ws + WS_XN) + (size_t)row * D;
#pragma unroll
            for (int q = 0; q < 4; ++q) { const f32x4 gg = *(const f32x4*)(g + 4 * F.lane + 256 * q); u32x2 w; w.x = pk2(v[j][q].x * r * gg.x, v[j][q].y * r * gg.y); w.y = pk2(v[j][q].z * r * gg.z, v[j][q].w * r * gg.w);
                if (row < ROWS_VALID) *(u32x2*)(xn + 4 * F.lane + 256 * q) = w; } }
    }
}
__device__ __forceinline__ void fin_phase(ArgsRef A, Frame& F, bool from_inputs, const float* gpost, const float* gnext) {
    { const int t_ = mk_tid(F.wave); F.tid = t_; F.lane = t_ & 63; }
    constexpr int FR = 4;
    const int gw = F.vcu * 8 + F.wave, NGW = F.G * 8;
    const bf16* YB = (const bf16*)(F.ws + WS_YB);
    const int lo4 = 4 * F.lane;
    for (int row0 = gw; row0 < ROWS_VALID; row0 += NGW * FR) {
        f32x4 yv[FR][4], xv[FR][4]; float ss[FR];
#pragma unroll
        for (int j = 0; j < FR; ++j) { const int row = min(row0 + j * NGW, ROWS_VALID - 1); const bf16* y = YB + (size_t)row * D; const float* xi = from_inputs ? xin_row(A, row) : xres_row(F, row); ss[j] = 0.f;
#pragma unroll
            for (int q = 0; q < 4; ++q) { const u32x2 w = *(const u32x2*)(y + lo4 + 256 * q); yv[j][q] = (f32x4){bflo(w.x), bfhi(w.x), bflo(w.y), bfhi(w.y)}; xv[j][q] = *(const f32x4*)(xi + lo4 + 256 * q); } }
#pragma unroll
        for (int j = 0; j < FR; ++j) {
#pragma unroll
            for (int q = 0; q < 4; ++q) ss[j] += yv[j][q].x * yv[j][q].x + yv[j][q].y * yv[j][q].y + yv[j][q].z * yv[j][q].z + yv[j][q].w * yv[j][q].w; }
#pragma unroll
        for (int o = 1; o < 64; o <<= 1) {
#pragma unroll
            for (int j = 0; j < FR; ++j) ss[j] += __shfl_xor(ss[j], o); }
        float s2[FR];
#pragma unroll
        for (int j = 0; j < FR; ++j) { const int row = row0 + j * NGW; const float r = 1.0f / sqrtf(ss[j] * (1.f / D) + EPS); s2[j] = 0.f;
#pragma unroll
            for (int q = 0; q < 4; ++q) { const f32x4 gg = *(const f32x4*)(gpost + lo4 + 256 * q); xv[j][q] = xv[j][q] + yv[j][q] * r * gg;
                if (row < ROWS_VALID) *(f32x4*)(xres_row(F, row) + lo4 + 256 * q) = xv[j][q];
                s2[j] += xv[j][q].x * xv[j][q].x + xv[j][q].y * xv[j][q].y + xv[j][q].z * xv[j][q].z + xv[j][q].w * xv[j][q].w; } }
        if (gnext) {
#pragma unroll
            for (int o = 1; o < 64; o <<= 1) {
#pragma unroll
                for (int j = 0; j < FR; ++j) s2[j] += __shfl_xor(s2[j], o); }
#pragma unroll
            for (int j = 0; j < FR; ++j) { const int row = row0 + j * NGW; const float r2 = 1.0f / sqrtf(s2[j] * (1.f / D) + EPS); bf16* xn = (bf16*)(F.ws + WS_XN) + (size_t)row * D;
#pragma unroll
                for (int q = 0; q < 4; ++q) { const f32x4 gg = *(const f32x4*)(gnext + lo4 + 256 * q); u32x2 w; w.x = pk2(xv[j][q].x * r2 * gg.x, xv[j][q].y * r2 * gg.y); w.y = pk2(xv[j][q].z * r2 * gg.z, xv[j][q].w * r2 * gg.w);
                    if (row < ROWS_VALID) *(u32x2*)(xn + lo4 + 256 * q) = w; } }
        }
    }
}
__device__ __forceinline__ f32x2 pool_h(ArgsRef A, const Frame& F, int grp, int b, int t, int col, int p) {
    const bf16* XN = (const bf16*)(F.ws + WS_XN);
    if (t >= 0) { const int row = grp == 0 ? b * 8192 + t : grp == 1 ? ROW_S + b * 64 + t : ROW_M + t; const unsigned w = *(const unsigned*)(XN + (size_t)row * D + col); return (f32x2){bflo(w), bfhi(w)}; }
    if (grp == 0) { const unsigned w = *(const unsigned*)(XN + (size_t)(ROW_M + 16 + t) * D + col); return (f32x2){bflo(w), bfhi(w)}; }
    if (grp == 1) return *(const f32x2*)(A.in[4] + ((size_t)(p * 8 + b) * 15 + 15 + t) * D + col);
    return (f32x2){0.f, 0.f};
}
__device__ __forceinline__ void pool_phase(ArgsRef A, Frame& F, int p) {
    { const int t_ = mk_tid(F.wave); F.tid = t_; F.lane = t_ & 63; }
    bf16* DB = (bf16*)(F.ws + WS_QB);
    const int col = 2 * F.tid, w = 2 << (col >> 8);
    for (int it = F.vcu; it < 2065; it += F.G) {
        int grp, b, t0, nr;
        if (it < 2048) { grp = 0; b = it >> 8; t0 = (it & 255) * 32; nr = 32; } else if (it < 2064) { const int s = it - 2048; grp = 1; b = s >> 1; t0 = (s & 1) * 32; nr = 32; } else { grp = 2; b = 0; t0 = 0; nr = 16; }
        f32x2 h[47];
#pragma unroll
        for (int i = 0; i < 47; ++i) h[i] = (i - 15 < nr) ? pool_h(A, F, grp, b, t0 - 15 + i, col, p) : (f32x2){0.f, 0.f};
        f32x2 sum = {0.f, 0.f};
#pragma unroll
        for (int j = 1; j < 16; ++j) if (j < w) sum += h[15 - j];
#pragma unroll
        for (int i = 0; i < 32; ++i) { const int t = t0 + i;
            if (i < nr) {
                const f32x2 cur = h[15 + i]; sum += cur;
                const float inv = 1.0f / (float)(grp == 2 ? min(t + 1, w) : w);
                const int row = grp == 0 ? b * 8192 + t : grp == 1 ? ROW_S + b * 64 + t : ROW_M + t;
                *(unsigned*)(DB + (size_t)row * D + col) = pk2(sum.x * inv - cur.x, sum.y * inv - cur.y);
                const f32x2 old = (w == 2) ? h[15 + i - 1] : (w == 4) ? h[15 + i - 3] : (w == 8) ? h[15 + i - 7] : h[15 + i - 15];
                sum -= old;
                if (grp == 0 && t >= 8177) *(f32x2*)(F.out + OFF_PP + ((size_t)(p * 8 + b) * 15 + (t - 8177)) * D + col) = cur;
                if (grp == 1 && t >= 49) *(f32x2*)(F.out + OFF_PS + ((size_t)(p * 8 + b) * 15 + (t - 49)) * D + col) = cur;
            }
        }
    }
}

namespace att {
constexpr int KSTR = 272;
constexpr int TB = 16384;
constexpr int OFF_K0 = 0, OFF_K1 = TB, OFF_V0 = 2 * TB, OFF_V1 = 3 * TB, OFF_BT = 4 * TB, OFF_GT = OFF_BT + 2048, OFF_Q = 5 * TB, XB = 16384;
static_assert(OFF_BT >= 4 * XB && OFF_GT + 512 <= OFF_Q && OFF_Q + 2 * TB <= 131072, "attention LDS map");
constexpr float THR = 48.0f;
constexpr float NEG = -1e30f;
struct AUnit { const bf16* K; const bf16* V; const bf16* KM; const bf16* VM; const bf16* Q; bf16* O; int P, L, x, h; };
__device__ __forceinline__ float max3f(float a, float b, float c) { float r; asm("v_max3_f32 %0, %1, %2, %3" : "=v"(r) : "v"(a), "v"(b), "v"(c)); return r; }
__device__ __forceinline__ float swapmax(float v) { auto rr = __builtin_amdgcn_permlane32_swap(__float_as_uint(v), __float_as_uint(v), false, false); return fmaxf(__uint_as_float(rr[0]), __uint_as_float(rr[1])); }
__device__ __forceinline__ float swapsum(float v) { auto rr = __builtin_amdgcn_permlane32_swap(__float_as_uint(v), __float_as_uint(v), false, false); return __uint_as_float(rr[0]) + __uint_as_float(rr[1]); }
typedef __bf16 bf16x2_t __attribute__((ext_vector_type(2)));
__device__ __forceinline__ unsigned cvtpk(float lo, float hi) { f32x2 v = {lo, hi}; bf16x2_t b = __builtin_convertvector(v, bf16x2_t); return __builtin_bit_cast(unsigned, b); }
__device__ __forceinline__ s16x4 vtr(const LAS unsigned char* p) { return __builtin_bit_cast(s16x4, __builtin_amdgcn_ds_read_tr16_b64_v4i16((LAS s16x4*)p)); }
__device__ __forceinline__ void glds16(const void* gsrc, unsigned lds_dst) { unsigned keep;
    asm volatile("s_mov_b32 %0, m0\n\ts_mov_b32 m0, %2\n\ts_nop 0\n\tglobal_load_lds_dwordx4 %1, off\n\ts_mov_b32 m0, %0" : "=&s"(keep) : "v"(gsrc), "s"(lds_dst) : "memory"); }
__device__ __forceinline__ bf16x8 pack8(const f32x16& S, int o) {
    u32x4 w; w.x = cvtpk(S[o], S[o + 1]); w.y = cvtpk(S[o + 2], S[o + 3]); w.z = cvtpk(S[o + 4], S[o + 5]); w.w = cvtpk(S[o + 6], S[o + 7]); return __builtin_bit_cast(bf16x8, w);
}

__device__ __forceinline__ void attn_unit(const int wv, LAS unsigned char* lds, const AUnit& u, const float* lq1, const float* lk1, const float* lq2, const float* lk2, const int layer_a, const float* relb, const float* subg) {
    const int tid = mk_tid(wv), lane = tid & 63, wid = wv, mp = wid >> 2, rg = wid & 3, q32 = lane & 31, hi = lane >> 5;
    LAS float* BT = (LAS float*)(lds + OFF_BT); LAS float* GT = (LAS float*)(lds + OFF_GT);
    {
        const float b15 = relb[15 * 8 + u.h];
        if (tid < 448) { const int rel = tid - 192, n = rel < 0 ? -rel : rel;
            int bk = n < 8 ? n : n < 12 ? 8 : n < 16 ? 9 : n < 23 ? 10 : n < 32 ? 11 : n < 46 ? 12 : n < 64 ? 13 : n < 91 ? 14 : 15; if (rel > 0) bk += 16;
            BT[tid] = (relb[bk * 8 + u.h] - b15) * LOG2E; }
        if (tid >= 384) GT[tid - 384] = subg[tid - 384] * (layer_a == 0 ? 0.8f : 0.52928698f);
    }
    const int vrows = min(128, u.L - 128 * u.x);
    const bool active = rg * 32 < vrows;
    const int ch = rg >> 1;
    const int NTw = active ? (u.P + min((2 * u.x + ch + 1) * 64, u.L) + 48) >> 6 : 0;
    const int NT = (u.P + min((2 * u.x + 2) * 64, u.L) + 48) >> 6;
    const int eq0 = u.P + 128 * u.x + rg * 32, eq = eq0 + q32;
    const unsigned lds0 = (unsigned)(size_t)lds;
    unsigned goff[2];
#pragma unroll
    for (int j = 0; j < 2; ++j) { const int row = wid * 8 + 4 * j + (lane >> 4), x = ((row & 3) << 2) | ((row >> 2) & 3), c = (lane & 15) ^ x; goff[j] = (unsigned)(row * 1024 + u.h * 128 + c * 8); }
    const unsigned ldst = (unsigned)wid * 2048u;
#define ATT_DMA(base, bufoff) do { _Pragma("unroll") for (int j_ = 0; j_ < 2; ++j_) \
        glds16((base) + goff[j_], (unsigned)__builtin_amdgcn_readfirstlane((int)(lds0 + (unsigned)(bufoff) + ldst + j_ * 1024))); } while (0)
#define ATT_ISSUE_K(t, bufoff) do { const bf16* b_ = ((t) == 0 && wid < 2) ? u.KM : u.K + (size_t)(t) * 65536; ATT_DMA(b_, bufoff); } while (0)
#define ATT_ISSUE_V(t, bufoff) do { const bf16* b_ = ((t) == 0 && wid < 2) ? u.VM : u.V + (size_t)(t) * 65536; ATT_DMA(b_, bufoff); } while (0)
#define ATT_WAITBAR() do { asm volatile("s_waitcnt vmcnt(0) lgkmcnt(0)" ::: "memory"); __builtin_amdgcn_s_barrier(); asm volatile("" ::: "memory"); } while (0)
    unsigned koff[4];
    { const int x = ((q32 & 3) << 2) | ((q32 >> 2) & 3);
#pragma unroll
      for (int d0 = 0; d0 < 4; ++d0) koff[d0] = lds0 + (unsigned)(q32 * 256 + (((mp * 8 + 2 * d0 + hi) ^ x) << 4)); }
    unsigned vofs[4][2];
    { const int qq = (lane & 15) >> 2, cl = 2 * ((lane >> 4) & 1) + ((lane & 3) >> 1), sub = 8 * (lane & 1);
#pragma unroll
      for (int dvb = 0; dvb < 4; ++dvb)
#pragma unroll
          for (int hf = 0; hf < 2; ++hf) vofs[dvb][hf] = lds0 + (unsigned)((8 * hf + 4 * hi + qq) * 256 + ((((dvb ^ qq) << 2) | (cl ^ (2 * hf + hi))) << 4) + sub); }
    {
        const bf16* qb_ = u.Q + (size_t)(128 * u.x + wid * 16) * 1024;
#pragma unroll
        for (int j = 0; j < 4; ++j) { const int row = 4 * j + (lane >> 4), x = ((row & 3) << 2) | ((row >> 2) & 3), c = (lane & 15) ^ x;
            glds16(qb_ + row * 1024 + u.h * 128 + c * 8, (unsigned)__builtin_amdgcn_readfirstlane((int)(lds0 + OFF_Q + wid * 4096 + j * 1024))); }
    }
    ATT_ISSUE_K(0, OFF_K0); ATT_ISSUE_V(0, OFF_V0); if (NT > 1) ATT_ISSUE_K(1, OFF_K1);
    ATT_WAITBAR();
    f32x16 O[4];
#pragma unroll
    for (int i = 0; i < 4; ++i)
#pragma unroll
        for (int r = 0; r < 16; ++r) O[i][r] = 0.f;
    float m = 0.f, l = 0.f;
    f32x16 SA0, SA1, SB0, SB1;
    const f32x16 zero16 = {0.f, 0.f, 0.f, 0.f, 0.f, 0.f, 0.f, 0.f, 0.f, 0.f, 0.f, 0.f, 0.f, 0.f, 0.f, 0.f};
#define ATT_SB() __builtin_amdgcn_sched_barrier(0)
#define ATT_QK(S0_, S1_, kbufoff) do { unsigned qsh_ = (unsigned)(OFF_Q + rg * 8192); asm volatile("" : "+s"(qsh_));     \
        bf16x8 kfa[4], kfb[4], qfr[4]; \
        _Pragma("unroll") for (int d0 = 0; d0 < 4; ++d0) { kfa[d0] = *(const LAS bf16x8*)(size_t)(koff[d0] + (unsigned)(kbufoff)); kfb[d0] = *(const LAS bf16x8*)(size_t)(koff[d0] + (unsigned)(kbufoff) + 8192u); qfr[d0] = *(const LAS bf16x8*)(size_t)(koff[d0] + qsh_); } \
        ATT_SB(); \
        S0_ = __builtin_amdgcn_mfma_f32_32x32x16_bf16(kfa[0], qfr[0], zero16, 0, 0, 0); S1_ = __builtin_amdgcn_mfma_f32_32x32x16_bf16(kfb[0], qfr[0], zero16, 0, 0, 0); \
        _Pragma("unroll") for (int d0 = 1; d0 < 4; ++d0) { S0_ = __builtin_amdgcn_mfma_f32_32x32x16_bf16(kfa[d0], qfr[d0], S0_, 0, 0, 0); S1_ = __builtin_amdgcn_mfma_f32_32x32x16_bf16(kfb[d0], qfr[d0], S1_, 0, 0, 0); } } while (0)
#define ATT_VLD(bank, ks) do { _Pragma("unroll") for (int dvb = 0; dvb < 4; ++dvb) { bank[dvb][0] = vtr((const LAS unsigned char*)(size_t)(vofs[dvb][0] + vb_ + (unsigned)((ks) * 4096))); bank[dvb][1] = vtr((const LAS unsigned char*)(size_t)(vofs[dvb][1] + vb_ + (unsigned)((ks) * 4096))); } } while (0)
#define ATT_PV(bank, ks, C0, C1) do { const bf16x8 pb = pack8(((ks) < 2) ? C0 : C1, 8 * ((ks) & 1)); \
        _Pragma("unroll") for (int dvb = 0; dvb < 4; ++dvb) { const bf16x8 vf = (bf16x8){bank[dvb][0][0], bank[dvb][0][1], bank[dvb][0][2], bank[dvb][0][3], bank[dvb][1][0], bank[dvb][1][1], bank[dvb][1][2], bank[dvb][1][3]}; \
            O[dvb] = __builtin_amdgcn_mfma_f32_32x32x16_bf16(vf, pb, O[dvb], 0, 0, 0); } } while (0)
#define ATT_STEP(C0, C1, N0, N1, t_, PAR) do { const int t = (t_); constexpr int cur = (PAR); \
        if (t + 2 < NT) ATT_ISSUE_K(t + 2, cur ? OFF_K1 : OFF_K0); \
        if (t + 1 < NT) ATT_ISSUE_V(t + 1, cur ? OFF_V0 : OFF_V1); \
        { \
            const int k0 = t * 64; \
            if (k0 + 154 > eq0) { const LAS float* bt_ = BT + (k0 - eq + 192 + 4 * hi); \
                _Pragma("unroll") for (int r = 0; r < 16; ++r) { C0[r] += bt_[(r & 3) + 8 * (r >> 2)]; } \
                ATT_SB(); \
                _Pragma("unroll") for (int r = 0; r < 16; ++r) { C1[r] += bt_[32 + (r & 3) + 8 * (r >> 2)]; } } \
            if (t >= NTw - 1) { const bool all_ = t >= NTw; _Pragma("unroll") for (int r = 0; r < 16; ++r) { if (r >= 8 || all_) C0[r] = NEG; C1[r] = NEG; } } \
            if (__any(m != 0.f)) { _Pragma("unroll") for (int r = 0; r < 16; ++r) { C0[r] -= m; C1[r] -= m; } } \
            float mx = max3f(C0[0], C1[0], C0[1]), mx2 = max3f(C1[1], C0[2], C1[2]); \
            _Pragma("unroll") for (int r = 3; r < 15; r += 2) { mx = max3f(mx, C0[r], C1[r]); mx2 = max3f(mx2, C0[r + 1], C1[r + 1]); } \
            mx = max3f(mx, mx2, C0[15]); mx = fmaxf(mx, C1[15]); \
            mx = swapmax(mx); \
            if (__any(mx > THR || (t == 0 && mx < -THR))) { const float dl = (t == 0) ? mx : fmaxf(mx, 0.f); m += dl; const float f = (t == 0) ? 1.f : __builtin_amdgcn_exp2f(-dl); l *= f; \
                _Pragma("unroll") for (int r = 0; r < 16; ++r) { C0[r] -= dl; C1[r] -= dl; } \
                _Pragma("unroll") for (int i = 0; i < 4; ++i) _Pragma("unroll") for (int r = 0; r < 16; ++r) O[i][r] *= f; } \
        } \
        ATT_SB(); \
        if (t + 1 < NT) ATT_QK(N0, N1, cur ? OFF_K0 : OFF_K1); \
        ATT_SB(); \
        { \
            constexpr unsigned vb_ = (unsigned)(cur ? OFF_V1 : OFF_V0); \
            s16x4 vA[4][2], vB[4][2]; \
            ATT_VLD(vA, 0); \
            ATT_SB(); \
            float ls = 0.f; \
            _Pragma("unroll") for (int r = 0; r < 16; ++r) { C0[r] = __builtin_amdgcn_exp2f(C0[r]); C1[r] = __builtin_amdgcn_exp2f(C1[r]); ls += C0[r] + C1[r]; } \
            l += ls; \
            ATT_SB(); \
            ATT_VLD(vB, 1); ATT_SB(); ATT_PV(vA, 0, C0, C1); ATT_SB(); \
            ATT_VLD(vA, 2); ATT_SB(); ATT_PV(vB, 1, C0, C1); ATT_SB(); \
            ATT_VLD(vB, 3); ATT_SB(); ATT_PV(vA, 2, C0, C1); ATT_SB(); \
            ATT_PV(vB, 3, C0, C1); \
        } \
        ATT_WAITBAR(); } while (0)
    ATT_QK(SA0, SA1, OFF_K0);
    ATT_WAITBAR();
    for (int tt = 0; tt < NT; tt += 2) { ATT_STEP(SA0, SA1, SB0, SB1, tt, 0); if (tt + 1 < NT) ATT_STEP(SB0, SB1, SA0, SA1, tt + 1, 1); }
#undef ATT_STEP
#undef ATT_QK
#undef ATT_VLD
#undef ATT_PV
#undef ATT_SB
#undef ATT_WAITBAR
#undef ATT_ISSUE_K
#undef ATT_ISSUE_V
#undef ATT_DMA
    const int tid2_ = mk_tid(wv);
    const int lane2 = tid2_ & 63, q32b = lane2 & 31, hib = lane2 >> 5;
    float lam;
    { float s1 = lq1[lane2] * lk1[lane2], s2 = lq2[lane2] * lk2[lane2]; s1 = wave_sum(s1); s2 = wave_sum(s2); lam = expf(s1) - expf(s2) + (layer_a == 0 ? 0.2f : 0.47071302f); }
    l = swapsum(l); const float inv = active ? 1.0f / l : 0.f;
    LAS float* xb = (LAS float*)(lds + rg * XB);
    if (mp == 1) { const float f = inv * lam;
#pragma unroll
        for (int i = 0; i < 4; ++i)
#pragma unroll
            for (int r = 0; r < 16; ++r) xb[(i * 16 + r) * 64 + lane2] = O[i][r] * f; }
    __syncthreads();
    if (mp == 0 && active) {
        float ss = 0.f;
#pragma unroll
        for (int i = 0; i < 4; ++i)
#pragma unroll
            for (int r = 0; r < 16; ++r) { const float o = O[i][r] * inv - xb[(i * 16 + r) * 64 + lane2]; O[i][r] = o; ss += o * o; }
        ss = swapsum(ss); const float rs = 1.0f / sqrtf(ss * (1.f / 128.f) + SUBLN_EPS);
        asm volatile("s_waitcnt lgkmcnt(0)" ::: "memory");
        LAS unsigned char* stg = (LAS unsigned char*)xb;
#pragma unroll
        for (int i = 0; i < 4; ++i)
#pragma unroll
            for (int r4 = 0; r4 < 4; ++r4) { const int dv0 = 32 * i + 8 * r4 + 4 * hib; const f32x4 gg = *(const LAS f32x4*)(GT + dv0);
                u32x2 w; w.x = cvtpk(O[i][4 * r4] * rs * gg.x, O[i][4 * r4 + 1] * rs * gg.y); w.y = cvtpk(O[i][4 * r4 + 2] * rs * gg.z, O[i][4 * r4 + 3] * rs * gg.w);
                *(LAS u32x2*)(stg + q32b * KSTR + dv0 * 2) = w; }
        asm volatile("s_waitcnt lgkmcnt(0)" ::: "memory");
        bf16* og = u.O + (size_t)(128 * u.x + rg * 32) * 1024 + u.h * 128;
#pragma unroll
        for (int i = 0; i < 8; ++i) { const int row = i * 4 + (lane2 >> 4), c16 = lane2 & 15; const u32x4 v = *(const LAS u32x4*)(stg + row * KSTR + c16 * 16);
            if (rg * 32 + row < vrows) *(u32x4*)(og + (size_t)row * 1024 + c16 * 8) = v; }
    }
    __syncthreads();
}
__device__ __forceinline__ void attn_phase(ArgsRef A, Frame& F, int a) {
    const bf16* QB = (const bf16*)(F.ws + WS_QB); bf16* OB = (bf16*)(F.ws + WS_XN); const bf16* KX = (const bf16*)(F.ws + WS_KX); const bf16* VX = (const bf16*)(F.ws + WS_VX);
    const bf16* KXS = (const bf16*)(F.ws + WS_KXS) + (size_t)a * KXS_LAYER; const bf16* VXS = (const bf16*)(F.ws + WS_VXS) + (size_t)a * KXS_LAYER;
    { const int gt = blockIdx.x * 512 + mk_tid(F.wave);
      for (int i = gt; i < 65536; i += F.G * 512) { const int c4 = i & 255, r = (i >> 8) & 15, b = (i >> 12) & 7, kv = i >> 15;
          const f32x4 v = *(const f32x4*)((const float*)(F.ws + (kv ? WS_MFV : WS_MFK)) + r * 1024 + c4 * 4);
          *(f32x4*)(F.out + (kv ? OFF_VP : OFF_KP) + (size_t)a * 8 * EXT_P * 1024 + (size_t)(b * EXT_P + r) * 1024 + c4 * 4) = v; } }
    for (int n = F.vcu; n < 4168; n += F.G) {
        AUnit u; u.KM = (const bf16*)(F.ws + WS_KXM); u.VM = (const bf16*)(F.ws + WS_VXM);
        if (n < 4096) { const int i = n >> 8, v = n & 255, c = v & 31, bh = (v >> 5) * 8 + (i >> 1); const int x = (i & 1) ? 63 - c : c; const int b = bh >> 3;
            u.K = KX + (size_t)b * EXT_P * 1024; u.V = VX + (size_t)b * EXT_P * 1024; u.Q = QB + (size_t)b * 8192 * 1024; u.O = OB + (size_t)b * 8192 * 1024; u.P = 16; u.L = 8192; u.x = x; u.h = bh & 7; }
        else if (n < 4160) { const int j = n - 4096, b = j >> 3; u.K = KXS + (size_t)b * EXT_S * 1024; u.V = VXS + (size_t)b * EXT_S * 1024; u.Q = QB + (size_t)(ROW_S + b * 64) * 1024; u.O = OB + (size_t)(ROW_S + b * 64) * 1024; u.P = 1040; u.L = 64; u.x = 0; u.h = j & 7; }
        else { u.K = (const bf16*)(F.ws + WS_KXM); u.V = (const bf16*)(F.ws + WS_VXM); u.Q = QB + (size_t)ROW_M * 1024; u.O = OB + (size_t)ROW_M * 1024; u.P = 0; u.L = 16; u.x = 0; u.h = n - 4160; }
        attn_unit(F.wave, F.lds, u, A.in[12] + a * 64, A.in[13] + a * 64, A.in[14] + a * 64, A.in[15] + a * 64, a, A.in[6], A.in[16] + a * 128);
    }
}
}

#define XB_TMO      128
#define XB_XCNT(j)  (256  + 64 * (j))
#define XB_XSUB(j)  (1280 + 64 * (j))
#define XB_XGEN(j)  (2304 + 64 * (j))
#define XB_TOP      3328
#define XB_TOPGEN   3392
#define XCD_BAR_WORDS 3456
#define XB_SPIN_CAP (1u << 18)

__device__ __forceinline__ unsigned xb_ld(unsigned* p)              { return __hip_atomic_load(p, __ATOMIC_RELAXED, __HIP_MEMORY_SCOPE_AGENT); }
__device__ __forceinline__ unsigned xb_add(unsigned* p, unsigned v) { return __hip_atomic_fetch_add(p, v, __ATOMIC_RELAXED, __HIP_MEMORY_SCOPE_AGENT); }
__device__ __forceinline__ unsigned xb_xcc_id() { return (unsigned)__builtin_amdgcn_s_getreg((3 << 11) | 20) & 0xFu; }
#define XB_SPIN(cond, bar) do { unsigned _sp = 0; while (cond) { __builtin_amdgcn_s_sleep(1); \
    if ((++_sp & 255u) == 0u) { if (xb_ld(&(bar)[XB_TMO])) break; if (_sp > XB_SPIN_CAP) { atomicAdd(&(bar)[XB_TMO], 1u); break; } } } } while (0)

struct XcdBarrier {
    bool leader; unsigned* bar; unsigned x;
    volatile LAS unsigned* st;
};

__device__ __forceinline__ XcdBarrier xcd_barrier_post(unsigned* bar, volatile LAS unsigned* st) {
    XcdBarrier b; b.bar = bar; b.x = xb_xcc_id(); b.st = st;
    b.leader = (threadIdx.x == 0);
    if (b.leader) (void)xb_add(&bar[XB_XCNT(b.x)], 1u);
    return b;
}
__device__ __forceinline__ void xcd_barrier_complete(unsigned* bar, unsigned x, unsigned& nloc, unsigned& nx) {
    const unsigned G = gridDim.x * gridDim.y * gridDim.z;
    unsigned sum, cnt, mine, sp = 0u;
    for (;;) {
        sum = 0u; cnt = 0u; mine = 0u;
#pragma unroll
        for (unsigned j = 0; j < 16; ++j) { const unsigned c = xb_ld(&bar[XB_XCNT(j)]); sum += c; cnt += (c > 0u) ? 1u : 0u; mine = (j == x) ? c : mine; }
        if (sum == G) break;
        __builtin_amdgcn_s_sleep(1);
        if ((++sp & 255u) == 0u) { if (xb_ld(&bar[XB_TMO])) break; if (sp > XB_SPIN_CAP) { atomicAdd(&bar[XB_TMO], 1u); break; } }
    }
    nloc = mine > 0u ? mine : 1u; nx = cnt > 0u ? cnt : 1u;
}

__device__ __forceinline__ void xcd_barrier(const XcdBarrier& b) {
    asm volatile("s_waitcnt vmcnt(0)" ::: "memory");
    __syncthreads();
    if (b.leader) {
        unsigned* bar = b.bar;
        __builtin_amdgcn_s_waitcnt(0);
        unsigned nloc = b.st[0], nx = b.st[1];
        if (nloc == 0u) { xcd_barrier_complete(bar, b.x, nloc, nx); b.st[0] = nloc; b.st[1] = nx; }
        const unsigned old = xb_add(&bar[XB_XSUB(b.x)], 1u);
        const unsigned gen = old / nloc;
        if (old + 1u == (gen + 1u) * nloc) {
            __builtin_amdgcn_fence(__ATOMIC_RELEASE, "agent");
            asm volatile("s_waitcnt vmcnt(0)" ::: "memory");
            const unsigned og = xb_add(&bar[XB_TOP], 1u);
            const unsigned tg = og / nx;
            if (og + 1u == (tg + 1u) * nx) xb_add(&bar[XB_TOPGEN], 1u);
            else XB_SPIN(xb_ld(&bar[XB_TOPGEN]) == tg, bar);
            __builtin_amdgcn_fence(__ATOMIC_ACQUIRE, "agent");
            xb_add(&bar[XB_XGEN(b.x)], 1u);
            asm volatile("s_waitcnt vmcnt(0)" ::: "memory");
        } else {
            XB_SPIN(xb_ld(&bar[XB_XGEN(b.x)]) == gen, bar);
            __builtin_amdgcn_fence(__ATOMIC_ACQUIRE, "agent");
            asm volatile("s_waitcnt vmcnt(0)" ::: "memory");
        }
    }
    __syncthreads();
}

__device__ __forceinline__ void run_step(ArgsRef args, const int step, const int wv) {
    extern __shared__ __attribute__((aligned(16))) unsigned char lds_raw[];
    Frame F;
    F.lds = (LAS unsigned char*)lds_raw; F.tid = 0; F.lane = 0; F.wave = wv;
    F.G = gridDim.x; { const int bx = blockIdx.x; F.vcu = (F.G % 8 == 0) ? (bx % 8) * (F.G / 8) + bx / 8 : bx; }
    F.out = args.out; F.ws = args.ws;
    bf16* XN = (bf16*)(F.ws + WS_XN); bf16* QB = (bf16*)(F.ws + WS_QB); bf16* YB = (bf16*)(F.ws + WS_YB); bf16* U = (bf16*)(F.ws + WS_U);
    int layer = 0, k = -1;
    if (step > 0) { const int s = step - 1; if (s < 7) { layer = 0; k = s; } else if (s < 13) { layer = 1; k = s - 7; } else if (s < 20) { layer = 2; k = s - 13; } else { layer = 3; k = s - 20; } }
    const bool attn = (layer & 1) == 0; const int a = layer >> 1;
    int type;
    if (step == 0) type = 0; else if (attn) type = k == 0 ? 1 : k == 1 ? 2 : k == 2 ? 4 : k == 3 ? 5 : k == 4 ? 6 : k == 5 ? 7 : 8;
    else type = k == 0 ? 3 : k == 1 ? 4 : k == 2 ? 5 : k == 3 ? 6 : k == 4 ? 7 : 8;
    if (type == 0) prologue(args, F);
    else if (type == 1) {
        pg8::Gemm g{XN, (const bf16*)(F.ws + WS_WQKV) + (size_t)a * 3072 * D, MPAD, 3072, D, D, D, 0}; pg8::StaticOrder S; S.init(MPAD, 3072, F.G, (int)blockIdx.x);
        pg8::EpiQKV E{F.ws, F.out, a};
        pg8::gemm_phase<pg8::EpiQKV, pg8::StaticOrder, true, true>(F.lds, g, S, E, mk_tid(F.wave));
    } else if (type == 2) { att::attn_phase(args, F, a); }
    else if (type == 3) { pool_phase(args, F, a); }
    else if (type == 4 || type == 7) {
        pg8::Gemm g;
        if (type == 7) g = pg8::Gemm{U, (const bf16*)(F.ws + WS_WDN) + (size_t)layer * D * FF, MPAD, D, FF, FF, FF, 0};
        else if (attn) g = pg8::Gemm{XN, (const bf16*)(F.ws + WS_WO) + (size_t)a * D * D, MPAD, D, D, D, D, 0};
        else g = pg8::Gemm{QB, (const bf16*)(F.ws + WS_WPOOL) + (size_t)a * 4 * 65536, MPAD, D, 256, D, 256, 512};
        pg8::StaticOrder S; S.init(MPAD, D, F.G, (int)blockIdx.x);
        pg8::EpiBf16<0> E{YB, D};
        pg8::gemm_phase<pg8::EpiBf16<0>, pg8::StaticOrder, true, true>(F.lds, g, S, E, mk_tid(F.wave));
    } else if (type == 5) { fin_phase(args, F, layer == 0, args.in[8] + layer * D, args.in[9] + layer * D); }
    else if (type == 6) {
        pg8::Gemm g{XN, (const bf16*)(F.ws + WS_WUP) + (size_t)layer * D * FF, MPAD, FF, D, D, D, 0}; pg8::StaticOrder S; S.init(MPAD, FF, F.G, (int)blockIdx.x);
        pg8::EpiBf16<2> E{U, FF};
        pg8::gemm_phase<pg8::EpiBf16<2>, pg8::StaticOrder, true, true>(F.lds, g, S, E, mk_tid(F.wave));
    } else { fin_phase(args, F, false, args.in[10] + layer * D, layer < 3 ? args.in[7] + (layer + 1) * D : nullptr); }
}
__global__ void __launch_bounds__(512, 2) fwd_kernel(Args args_) {
    const int lo = args_.lo, hi = args_.hi;
    const int wv = __builtin_amdgcn_readfirstlane((int)threadIdx.x >> 6);
    extern __shared__ __attribute__((aligned(16))) unsigned char lds_raw[];
    volatile LAS unsigned* bst = (volatile LAS unsigned*)((LAS unsigned char*)lds_raw + 131072);
    if (threadIdx.x < 2) bst[threadIdx.x] = 0u;
    __syncthreads();
    XcdBarrier bar = xcd_barrier_post((unsigned*)args_.ws + 4096, bst);
    int probe_rep = 0; (void)probe_rep;
    for (int step = lo; step < hi; ++step) {
        const __attribute__((address_space(4))) Args* ap = (const __attribute__((address_space(4))) Args*)__builtin_amdgcn_kernarg_segment_ptr();
        asm volatile("" : "+s"(ap));
        run_step(*ap, step, wv);
#if defined(PROBE_MASK)
        {
            int ty = 0; if (step > 0) { const int s = step - 1; const int k = s < 7 ? s : s < 13 ? s - 7 : s < 20 ? s - 13 : s - 20; const bool at = (s < 7) || (s >= 13 && s < 20);
                ty = at ? (k == 0 ? 1 : k == 1 ? 2 : k == 2 ? 4 : k == 3 ? 5 : k == 4 ? 6 : k == 5 ? 7 : 8) : (k == 0 ? 3 : k == 1 ? 4 : k == 2 ? 5 : k == 3 ? 6 : k == 4 ? 7 : 8); }
            if (((PROBE_MASK >> ty) & 1) && !probe_rep) { probe_rep = 1; --step; __syncthreads(); continue; }
            probe_rep = 0; }
#endif
        if (step + 1 < hi) { if (step == lo) { __threadfence(); cg::this_grid().sync(); } else xcd_barrier(bar); }
    }
}

extern "C" void kernel_launch(void* const* d_in, const int* in_sizes, int n_in, void* d_out, int out_size, void* d_ws, size_t ws_size, hipStream_t stream) {
    static int grid = 0;
    if (grid == 0) {
        if (n_in != 22 || (size_t)out_size != OUT_TOTAL || ws_size < WS_END) { fprintf(stderr, "kernel_launch: unexpected shapes n_in %d out %d ws %zu\n", n_in, out_size, ws_size); grid = -1; return; }
        int dev = 0, cus = 0, per_cu = 0;
        hipGetDevice(&dev); hipDeviceGetAttribute(&cus, hipDeviceAttributeMultiprocessorCount, dev);
        hipFuncSetAttribute((const void*)fwd_kernel, hipFuncAttributeMaxDynamicSharedMemorySize, LDS_BYTES);
        hipOccupancyMaxActiveBlocksPerMultiprocessor(&per_cu, (const void*)fwd_kernel, 512, LDS_BYTES);
        if (per_cu < 1) { fprintf(stderr, "kernel_launch: occupancy query says %d blocks/CU\n", per_cu); per_cu = 1; }
        (void)hipGetLastError();
        grid = cus;
    }
    if (grid < 0) return;
    if (hipMemsetAsync(d_ws, 0, 65536, stream) != hipSuccess) { fprintf(stderr, "kernel_launch: memset failed\n"); return; }
    Args a{};
    for (int i = 0; i < 22; ++i) a.in[i] = (const float*)d_in[i];
    a.out = (float*)d_out; a.ws = (unsigned char*)d_ws;
#if ONE_LAUNCH
    a.lo = 0; a.hi = NSTEPS;
    void* kargs[] = {&a};
    hipError_t e = hipLaunchCooperativeKernel((const void*)fwd_kernel, dim3(grid), dim3(512), kargs, LDS_BYTES, stream);
    if (e != hipSuccess) fprintf(stderr, "cooperative launch failed: %s (grid %d)\n", hipGetErrorString(e), grid);
#else
    for (int s = 0; s < NSTEPS; ++s) { a.lo = s; a.hi = s + 1; hipLaunchKernelGGL(fwd_kernel, dim3(grid), dim3(512), LDS_BYTES, stream, a); }
#endif
}
static_assert(WS_QB == 213 * MiB && WS_KX == 473 * MiB && WS_VX == 602 * MiB && WS_KXS == 731 * MiB && WS_VXS == 767 * MiB && WS_KXM == 803 * MiB && WS_VXM == 804 * MiB && KXS_LAYER == 9 * MiB && WS_MFK == 1323 * MiB && WS_MFV == 1324 * MiB, "EpiQKV hard-coded map");
static_assert(OFF_KP == 67633152 && OFF_VP == 202113024 && OFF_KS == 336838656 && OFF_VS == 337887232, "EpiQKV hard-coded output offsets");
```

```cpp
#include <hip/hip_runtime.h>
#include <hip/hip_cooperative_groups.h>
#include <hip/hip_bf16.h>
#include <cstdio>
#include <cstdint>
namespace cg = cooperative_groups;
namespace pg8 {
#define PG8_LAS __attribute__((address_space(3)))
typedef unsigned short bf16_t;
typedef short bf16x8 __attribute__((ext_vector_type(8)));
typedef float f32x4 __attribute__((ext_vector_type(4)));
typedef unsigned u32x4 __attribute__((ext_vector_type(4)));
constexpr int BM = 256, BK = 64, HALF = 128, HTB = HALF * BK * 2  , STAGE_BYTES = 8 * HTB, NXCD = 8, WGM = 8;

__host__ __device__ __forceinline__ int lds_byte(int r, int c) { const int st = (r >> 4) * 2 + (c >> 5), rr = r & 15, cc = c & 31, ob = rr * 64 + cc * 2; return st * 1024 + (ob ^ (((ob >> 9) & 1) << 5)); }
__host__ __device__ __forceinline__ void stage_rc(int b, int& R, int& C) { const int st = b / 1024, sb = b % 1024, swz = sb ^ (((sb >> 9) & 1) << 5); R = (st >> 1) * 16 + swz / 64; C = (st & 1) * 32 + (swz % 64) / 2; }
__host__ __device__ __forceinline__ int perm32(int rho) { const int n = rho >> 4, i = rho & 15; return 8 * (i >> 2) + 4 * n + (i & 3); }

struct Unit { int pm, pn, ko, nt, sp; };
struct Gemm { const bf16_t* A; const bf16_t* Bt; int M, N, K, lda, ldb, acs; };

struct StaticOrder {
    int nM, nN, nwg, G, c, ntf;
    __host__ __device__ void init(int M, int N, int G_, int c_, int K) { nM = M / BM; nN = N / BM; nwg = nM * nN; G = G_; c = c_; ntf = K / BK; }
    __host__ __device__ bool next(int i, Unit& u) const {
        const long L = (long)i * G + c; if (L >= nwg) return false;
        int wgid = (int)L; { const int q = nwg / NXCD, r = nwg % NXCD, xcd = wgid % NXCD, off = wgid / NXCD; wgid = (xcd < r ? xcd * (q + 1) : r * (q + 1) + (xcd - r) * q) + off; }
        const int nig = WGM * nN, gid = wgid / nig, fm = gid * WGM, gsz = (nM - fm) < WGM ? (nM - fm) : WGM;
        u.pm = fm + ((wgid % nig) % gsz); u.pn = (wgid % nig) / gsz; u.ko = 0; u.nt = ntf; u.sp = 0; return true;
    }
    __device__ __forceinline__ void a_ready(const Unit&) const {}
    __device__ __forceinline__ void done(const Unit&) const {}
};
struct TailOrder {
    StaticOrder mn; int KS, kc;
    __host__ __device__ void init(int N, int G_, int c_, int K, int KS_) { mn.init(65536, N, G_, c_, K); KS = KS_; kc = K / KS_; }
    __host__ __device__ bool next(int i, Unit& u) const {
        const long L = (long)i * mn.G + mn.c; if (L < mn.nwg) return mn.next(i, u);
        const int Lt = (int)(L - mn.nwg); if (Lt >= 3 * mn.nN * KS) return false;
        const int tile = Lt / KS, ks = Lt - tile * KS; u.pm = 256 + tile / mn.nN; u.pn = tile % mn.nN; u.ko = ks * kc; u.nt = kc / BK; u.sp = KS > 1 ? ks + 1 : 0; return true;
    }
    __device__ __forceinline__ void a_ready(const Unit&) const {}
    __device__ __forceinline__ void done(const Unit&) const {}
};

__device__ __forceinline__ unsigned cvt_pk_bf16(float lo, float hi) { unsigned r; asm volatile("v_cvt_pk_bf16_f32 %0, %1, %2" : "=v"(r) : "v"(lo), "v"(hi)); return r; }
template <int ACT  > struct EpiBf16 {
    static constexpr bool PERM = true, AFTER_DRAIN = false;
    bf16_t* O; int ldc; float* yf;
    __device__ __forceinline__ void operator()(const f32x4 (&acc)[2][2][4][2], const Unit& u, int wr, int wc, int fr, int fq) const {
        asm volatile("" : "+v"(fr), "+v"(fq));
        const int row0 = u.pm * BM + wr * 64 + fr; const int col0 = u.pn * BM + wc * 32 + 8 * fq;
#pragma unroll
        for (int ai = 0; ai < 2; ++ai)
#pragma unroll
            for (int m = 0; m < 4; ++m) { bf16_t* rowp = O + (size_t)(row0 + ai * HALF + m * 16) * ldc + col0;
#pragma unroll
                for (int bj = 0; bj < 2; ++bj) { f32x4 v0 = acc[ai][bj][m][0], v1 = acc[ai][bj][m][1];
                    if (ACT == 2) {
#pragma unroll
                        for (int e = 0; e < 4; ++e) { float a = fmaxf(v0[e], 0.f), b = fmaxf(v1[e], 0.f); v0[e] = a * a; v1[e] = b * b; } }
                    if (u.sp) { float* yr = yf + ((size_t)(u.sp - 1) * 768 + (size_t)(row0 + ai * HALF + m * 16 - 65536)) * 1024 + col0 + bj * HALF;
                        *(f32x4*)yr = v0; *(f32x4*)(yr + 4) = v1; }
                    else { u32x4 w; w.x = cvt_pk_bf16(v0[0], v0[1]); w.y = cvt_pk_bf16(v0[2], v0[3]); w.z = cvt_pk_bf16(v1[0], v1[1]); w.w = cvt_pk_bf16(v1[2], v1[3]);
                    *(u32x4*)(rowp + bj * HALF) = w; } } }
    }
};
struct EpiQKV {
    static constexpr bool PERM = true, AFTER_DRAIN = false;
    unsigned char* ws; float* out; int a;
    __device__ __forceinline__ void operator()(const f32x4 (&acc)[2][2][4][2], const Unit& u, int wr, int wc, int fr, int fq) const {
        const size_t MiB_ = 1u << 20;
        asm volatile("" : "+v"(fr), "+v"(fq));
        const int t3 = u.pn >> 2; const int colb = (u.pn & 3) * 256 + wc * 32 + 8 * fq;
        bf16_t* X; float* Fp = nullptr; int rbase, jump = 0, s0 = 0; float sc = 1.f;
        if (t3 == 0) { X = (bf16_t*)(ws + 213 * MiB_); rbase = u.pm * BM; sc = 0.125f * 1.4426950408889634f; }
        else if (u.pm < 256) { const int b = u.pm >> 5; rbase = b * 8208 + 16 + (u.pm & 31) * 256; X = (bf16_t*)(ws + (t3 == 1 ? 473 : 602) * MiB_);
            Fp = out + (t3 == 1 ? (size_t)67633152 : (size_t)202113024) + (size_t)a * 8 * 8208 * 1024 + (size_t)rbase * 1024; }
        else if (u.pm < 258) { s0 = (u.pm - 256) * 256; rbase = 1040 + s0; jump = 1040; X = (bf16_t*)(ws + (t3 == 1 ? 731 : 767) * MiB_) + (size_t)a * (9 * MiB_);
            Fp = out + (t3 == 1 ? (size_t)336838656 : (size_t)337887232) + (size_t)a * 512 * 1024 + (size_t)s0 * 1024; }
        else { rbase = 0; X = (bf16_t*)(ws + (t3 == 1 ? 803 : 804) * MiB_); Fp = (float*)(ws + (t3 == 1 ? 1323 : 1324) * MiB_); }
#pragma unroll
        for (int ai = 0; ai < 2; ++ai)
#pragma unroll
            for (int m = 0; m < 4; ++m) { const int rit = ai * HALF + wr * 64 + m * 16 + fr;
                bf16_t* xr = X + (unsigned)((rbase + rit + ((s0 + rit) >> 6) * jump) * 1024 + colb); float* fr_ = Fp + (unsigned)(rit * 1024 + colb);
#pragma unroll
                for (int bj = 0; bj < 2; ++bj) { const f32x4 v0 = acc[ai][bj][m][0], v1 = acc[ai][bj][m][1]; const f32x4 s0v = v0 * sc, s1v = v1 * sc;
                    u32x4 w; w.x = cvt_pk_bf16(s0v[0], s0v[1]); w.y = cvt_pk_bf16(s0v[2], s0v[3]); w.z = cvt_pk_bf16(s1v[0], s1v[1]); w.w = cvt_pk_bf16(s1v[2], s1v[3]);
                    *(u32x4*)(xr + bj * HALF) = w;
                    if (t3 != 0) { *(f32x4*)(fr_ + bj * HALF) = v0; *(f32x4*)(fr_ + bj * HALF + 4) = v1; } } }
    }
};
template <class Epi, class Sched, bool ALIGN_EPI = false, bool SP2 = false>
__device__ __forceinline__ void gemm_phase(PG8_LAS unsigned char* lds, const Gemm g, const Sched& S, const Epi& E, const int tid_in) {
    int tid_ = tid_in; asm volatile("" : "+v"(tid_));
    const int tid = tid_, wid = __builtin_amdgcn_readfirstlane(tid >> 6), lane = tid & 63, wr = wid >> 2, wc = wid & 3, fr = lane & 15, fq = lane >> 4;
    const int K = g.K; (void)K;
    unsigned voffA[2], voffB[2];
#pragma unroll
    for (int i = 0; i < 2; ++i) { int R, C; stage_rc(tid * 16 + i * 8192, R, C); const int Rb = Epi::PERM ? ((R & ~31) + perm32(R & 31)) : R;
        voffA[i] = (unsigned)(R * g.lda + C) * 2u; voffB[i] = (unsigned)(Rb * g.ldb + C) * 2u; }
    const size_t kstep = (size_t)(BK * 2);
    const size_t hstepA = (size_t)HALF * g.lda * 2, hstepB = (size_t)HALF * g.ldb * 2;
    const size_t tstepA = 2 * hstepA, tstepB = 2 * hstepB;
    const unsigned ldsw = (unsigned)wid * 1024u;
    const int aoff = lds_byte(wr * 64 + fr, fq * 8), boff = lds_byte(wc * 32 + fr, fq * 8);
#define PG8_SA(b, h) (((b) * 2 + (h)) * HTB)
#define PG8_SB(b, h) ((4 + (b) * 2 + (h)) * HTB)
#define PG8_STAGE(bufoff, gbase, voff) do { _Pragma("unroll") for (int _i = 0; _i < 2; ++_i) \
        __builtin_amdgcn_global_load_lds((const unsigned*)((const char*)(gbase) + (voff)[_i]), (PG8_LAS unsigned*)(lds + (bufoff) + ldsw + _i * 8192), 16, 0, 0); } while (0)
#define PG8_LDA(dst, b, h) do { _Pragma("unroll") for (int m = 0; m < 4; ++m) _Pragma("unroll") for (int k = 0; k < 2; ++k) dst[m][k] = *(const PG8_LAS bf16x8*)(lds + PG8_SA(b, h) + aoff + m * 2048 + k * 1024); } while (0)
#define PG8_LDB(dst, b, h) do { _Pragma("unroll") for (int n = 0; n < 2; ++n) _Pragma("unroll") for (int k = 0; k < 2; ++k) dst[n][k] = *(const PG8_LAS bf16x8*)(lds + PG8_SB(b, h) + boff + n * 2048 + k * 1024); } while (0)
#define PG8_MMA(ai, bj, At, Bt) do { __builtin_amdgcn_s_setprio(1); _Pragma("unroll") for (int m = 0; m < 4; ++m) _Pragma("unroll") for (int n = 0; n < 2; ++n) _Pragma("unroll") for (int k = 0; k < 2; ++k) \
        acc[ai][bj][m][n] = __builtin_amdgcn_mfma_f32_16x16x32_bf16(Bt[n][k], At[m][k], acc[ai][bj][m][n], 0, 0, 0); __builtin_amdgcn_s_setprio(0); } while (0)
#define PG8_WAIT_V(n) asm volatile("s_waitcnt vmcnt(" #n ")" ::: "memory")
#define PG8_WAIT_L(n) asm volatile("s_waitcnt lgkmcnt(" #n ")" ::: "memory")
#define PG8_BAR __builtin_amdgcn_s_barrier()
#define PG8_SCHED __builtin_amdgcn_sched_barrier(0)
    Unit cur, nxt; int ui = 0;
    if (!S.next(0, cur)) return;
    f32x4 acc[2][2][4][2];
#pragma unroll
    for (int a = 0; a < 2; ++a)
#pragma unroll
        for (int b = 0; b < 2; ++b)
#pragma unroll
            for (int m = 0; m < 4; ++m)
#pragma unroll
                for (int n = 0; n < 2; ++n) acc[a][b][m][n] = (f32x4){0.f, 0.f, 0.f, 0.f};
    bf16x8 At[4][2], B0[2][2], B1[2][2];
    const char* cA = (const char*)g.A + (size_t)cur.pm * tstepA + (size_t)cur.pn * g.acs + (size_t)cur.ko * 2; const char* cB = (const char*)g.Bt + (size_t)cur.pn * tstepB + (size_t)cur.ko * 2;
    S.a_ready(cur);
    if constexpr (SP2) {
        PG8_STAGE(PG8_SB(0, 0), cB, voffB); PG8_STAGE(PG8_SB(0, 1), cB + hstepB, voffB); PG8_STAGE(PG8_SA(0, 0), cA, voffA); PG8_STAGE(PG8_SA(0, 1), cA + hstepA, voffA);
        if (wr == 1) PG8_BAR;
        PG8_WAIT_V(2); PG8_BAR;
        PG8_STAGE(PG8_SB(1, 0), cB + kstep, voffB); PG8_STAGE(PG8_SA(1, 0), cA + kstep, voffA); PG8_STAGE(PG8_SB(1, 1), cB + hstepB + kstep, voffB);
        PG8_WAIT_V(6); PG8_BAR;
    } else {
        PG8_STAGE(PG8_SB(0, 0), cB, voffB); PG8_STAGE(PG8_SA(0, 0), cA, voffA); PG8_STAGE(PG8_SB(0, 1), cB + hstepB, voffB); PG8_STAGE(PG8_SA(0, 1), cA + hstepA, voffA);
        if (wr == 1) PG8_BAR;
        PG8_WAIT_V(4); PG8_BAR;
        PG8_STAGE(PG8_SB(1, 0), cB + kstep, voffB); PG8_STAGE(PG8_SA(1, 0), cA + kstep, voffA); PG8_STAGE(PG8_SB(1, 1), cB + hstepB + kstep, voffB);
        PG8_WAIT_V(6); PG8_BAR;
    }
    for (;;) {
        const bool has_next = S.next(ui + 1, nxt);
        const char* nA = has_next ? (const char*)g.A + (size_t)nxt.pm * tstepA + (size_t)nxt.pn * g.acs + (size_t)nxt.ko * 2 : cA; const char* nB = has_next ? (const char*)g.Bt + (size_t)nxt.pn * tstepB + (size_t)nxt.ko * 2 : cB;
        const int nt = cur.nt;
        for (int t = 0; t < nt; t += 2) {
            const bool last = (t == nt - 2);
            const char* a1 = cA + (size_t)(t + 1) * kstep;
            const char* a2 = last ? nA : cA + (size_t)(t + 2) * kstep; const char* b2 = last ? nB : cB + (size_t)(t + 2) * kstep;
            const char* a3 = a2 + kstep; const char* b3 = b2 + kstep;
            if (last && has_next) S.a_ready(nxt);
            if constexpr (SP2) {
            PG8_LDB(B0, 0, 0); PG8_LDB(B1, 0, 1); PG8_SCHED; PG8_LDA(At, 0, 0); PG8_STAGE(PG8_SA(1, 1), a1 + hstepA, voffA);
            PG8_WAIT_V(8); PG8_WAIT_L(0); PG8_BAR; PG8_MMA(0, 0, At, B0); PG8_MMA(0, 1, At, B1); PG8_BAR; PG8_SCHED;
            PG8_LDA(At, 0, 1); PG8_STAGE(PG8_SB(0, 0), b2, voffB); PG8_STAGE(PG8_SB(0, 1), b2 + hstepB, voffB); PG8_STAGE(PG8_SA(0, 0), a2, voffA);
            PG8_WAIT_V(8); PG8_WAIT_L(0); PG8_BAR; PG8_MMA(1, 0, At, B0); PG8_MMA(1, 1, At, B1); PG8_BAR; PG8_SCHED;
            PG8_LDB(B0, 1, 0); PG8_LDB(B1, 1, 1); PG8_SCHED; PG8_LDA(At, 1, 0); PG8_STAGE(PG8_SA(0, 1), a2 + hstepA, voffA);
            PG8_WAIT_V(8); PG8_WAIT_L(0); PG8_BAR; PG8_MMA(0, 0, At, B0); PG8_MMA(0, 1, At, B1); PG8_BAR; PG8_SCHED;
            PG8_LDA(At, 1, 1); PG8_STAGE(PG8_SB(1, 0), b3, voffB); PG8_STAGE(PG8_SB(1, 1), b3 + hstepB, voffB); PG8_STAGE(PG8_SA(1, 0), a3, voffA);
            PG8_WAIT_V(8); PG8_WAIT_L(0); PG8_BAR; PG8_MMA(1, 0, At, B0); PG8_MMA(1, 1, At, B1); PG8_BAR; PG8_SCHED;
            } else {
            PG8_LDB(B0, 0, 0); PG8_SCHED; PG8_LDA(At, 0, 0); PG8_STAGE(PG8_SA(1, 1), a1 + hstepA, voffA);
            PG8_WAIT_L(8); PG8_BAR; PG8_WAIT_L(0); PG8_MMA(0, 0, At, B0); PG8_BAR; PG8_SCHED;
            PG8_LDB(B1, 0, 1); PG8_STAGE(PG8_SB(0, 0), b2, voffB);
            PG8_BAR; PG8_WAIT_L(0); PG8_MMA(0, 1, At, B1); PG8_BAR;
            PG8_LDA(At, 0, 1); PG8_STAGE(PG8_SA(0, 0), a2, voffA);
            PG8_BAR; PG8_WAIT_L(0); PG8_MMA(1, 0, At, B0); PG8_BAR; PG8_SCHED;
            PG8_STAGE(PG8_SB(0, 1), b2 + hstepB, voffB);
            PG8_WAIT_V(6); PG8_BAR; PG8_MMA(1, 1, At, B1); PG8_BAR;
            PG8_LDB(B0, 1, 0); PG8_SCHED; PG8_LDA(At, 1, 0); PG8_STAGE(PG8_SA(0, 1), a2 + hstepA, voffA);
            PG8_WAIT_L(8); PG8_BAR; PG8_WAIT_L(0); PG8_MMA(0, 0, At, B0); PG8_BAR; PG8_SCHED;
            PG8_LDB(B1, 1, 1); PG8_STAGE(PG8_SB(1, 0), b3, voffB);
            PG8_BAR; PG8_WAIT_L(0); PG8_MMA(0, 1, At, B1); PG8_BAR;
            PG8_LDA(At, 1, 1); PG8_STAGE(PG8_SA(1, 0), a3, voffA);
            PG8_BAR; PG8_WAIT_L(0); PG8_MMA(1, 0, At, B0); PG8_BAR; PG8_SCHED;
            PG8_STAGE(PG8_SB(1, 1), b3 + hstepB, voffB);
            PG8_WAIT_V(6); PG8_BAR; PG8_MMA(1, 1, At, B1); PG8_BAR;
            }
        }
        if constexpr (ALIGN_EPI) { if (wr == 0) PG8_BAR; }
        if constexpr (!Epi::AFTER_DRAIN) { E(acc, cur, wr, wc, fr, fq); S.done(cur); }
        if (!has_next) break;
#pragma unroll
        for (int a = 0; a < 2; ++a)
#pragma unroll
            for (int b = 0; b < 2; ++b)
#pragma unroll
                for (int m = 0; m < 4; ++m)
#pragma unroll
                    for (int n = 0; n < 2; ++n) acc[a][b][m][n] = (f32x4){0.f, 0.f, 0.f, 0.f};
        cur = nxt; cA = nA; cB = nB; ++ui;
        if constexpr (ALIGN_EPI) { if (wr == 1) PG8_BAR; }
    }
    PG8_WAIT_V(0);
    if constexpr (!ALIGN_EPI) { if (wr == 0) PG8_BAR; }
    PG8_BAR;
    if constexpr (Epi::AFTER_DRAIN) { E.fused(acc, cur, wr, wc, fr, fq, lds, wid, lane); S.done(cur); }
#undef PG8_SA
#undef PG8_SB
#undef PG8_STAGE
#undef PG8_LDA
#undef PG8_LDB
#undef PG8_MMA
#undef PG8_WAIT_V
#undef PG8_WAIT_L
#undef PG8_BAR
#undef PG8_SCHED
}
}
#define LAS __attribute__((address_space(3)))
#define GAS __attribute__((address_space(1)))
typedef unsigned short bf16;
typedef unsigned u32x4 __attribute__((ext_vector_type(4)));
typedef unsigned u32x2 __attribute__((ext_vector_type(2)));
typedef float f32x4 __attribute__((ext_vector_type(4)));
typedef float f32x2 __attribute__((ext_vector_type(2)));
typedef float f32x16 __attribute__((ext_vector_type(16)));
typedef short bf16x8 __attribute__((ext_vector_type(8)));
typedef short s16x4 __attribute__((ext_vector_type(4)));
constexpr int D = 1024, FF = 4096, NH = 8;
constexpr int ROW_S = 65536, ROW_M = 66048, ROWS_VALID = 66064, MPAD = 66304;
constexpr int EXT_P = 8208, EXT_S = 1104;
constexpr float LOG2E = 1.4426950408889634f;
constexpr float QSCALE = 0.125f * LOG2E;
constexpr float EPS = 1e-6f, SUBLN_EPS = 1e-5f;
constexpr size_t OFF_YP = 0, OFF_YS = 67108864, OFF_KP = OFF_YS + 524288, OFF_VP = OFF_KP + 134479872, OFF_PP = OFF_VP + 134479872,
                 OFF_KS = OFF_PP + 245760, OFF_VS = OFF_KS + 1048576, OFF_PS = OFF_VS + 1048576, OUT_TOTAL = OFF_PS + 245760;
constexpr size_t MiB = 1u << 20;
constexpr size_t WS_WQKV = 1 * MiB, WS_WO = 13 * MiB, WS_WPOOL = 17 * MiB, WS_WUP = 18 * MiB, WS_WDN = 50 * MiB, WS_XM = 82 * MiB,
                 WS_XN = 83 * MiB, WS_QB = 213 * MiB, WS_YB = 343 * MiB, WS_KX = 473 * MiB, WS_VX = 602 * MiB, WS_KXS = 731 * MiB, WS_VXS = 767 * MiB,
                 WS_KXM = 803 * MiB, WS_VXM = 804 * MiB, WS_U = 805 * MiB, WS_MFK = 1323 * MiB, WS_MFV = 1324 * MiB, WS_YF = 1325 * MiB, WS_END = 1373 * MiB;
constexpr size_t KXS_LAYER = 18 * MiB / 2;
constexpr int LDS_BYTES = 147456;
constexpr int NSTEPS = 27;
#ifndef ONE_LAUNCH
#define ONE_LAUNCH 1
#endif

__device__ __forceinline__ unsigned f2bf(float f) { unsigned u = __builtin_bit_cast(unsigned, f); return (u + 0x7fffu + ((u >> 16) & 1u)) >> 16; }
__device__ __forceinline__ unsigned pk2(float lo, float hi) { return f2bf(lo) | (f2bf(hi) << 16); }
__device__ __forceinline__ float bflo(unsigned w) { return __builtin_bit_cast(float, w << 16); }
__device__ __forceinline__ float bfhi(unsigned w) { return __builtin_bit_cast(float, w & 0xffff0000u); }
__device__ __forceinline__ float wave_sum(float v) {
#pragma unroll
    for (int o = 1; o < 64; o <<= 1) v += __shfl_xor(v, o);
    return v;
}

struct Args { const float* in[22]; float* out; unsigned char* ws; int lo, hi; };
typedef const __attribute__((address_space(4))) Args& ArgsRef;
__device__ __forceinline__ int mk_tid(int wv) { int t; asm volatile("v_mbcnt_lo_u32_b32 %0, -1, 0\n\tv_mbcnt_hi_u32_b32 %0, -1, %0" : "=v"(t)); return wv * 64 + t; }
struct Frame {
    LAS unsigned char* lds; int tid, lane, wave, vcu, G;
    float* out; unsigned char* ws;
};

__device__ __forceinline__ void transpose_item(const float* W, int K, int N, bf16* WT, LAS float* scr, int item, int lane, const float* nscale) {
    const int nblk = N / 32, kb = item / nblk, nb = item % nblk, k0 = 64 * kb, n0 = 32 * nb;
#pragma unroll 8
    for (int i = 0; i < 32; ++i) { const int kk = 2 * i + (lane >> 5); scr[kk * 33 + (lane & 31)] = W[(size_t)(k0 + kk) * N + n0 + (lane & 31)]; }
    asm volatile("s_waitcnt lgkmcnt(0)" ::: "memory");
    const int c = lane & 7;
#pragma unroll
    for (int j = 0; j < 4; ++j) { const int n = (lane >> 3) + 8 * j; const LAS float* s = scr + (8 * c) * 33 + n; const float sc = nscale ? nscale[n0 + n] : 1.f;
        u32x4 o; o.x = pk2(s[0 * 33] * sc, s[1 * 33] * sc); o.y = pk2(s[2 * 33] * sc, s[3 * 33] * sc); o.z = pk2(s[4 * 33] * sc, s[5 * 33] * sc); o.w = pk2(s[6 * 33] * sc, s[7 * 33] * sc);
        *(u32x4*)(WT + (size_t)(n0 + n) * K + k0 + 8 * c) = o; }
    asm volatile("s_waitcnt lgkmcnt(0)" ::: "memory");
}
__device__ __forceinline__ const float* xin_row(ArgsRef A, int row) {
    return row < ROW_S ? A.in[0] + (size_t)row * D : row < ROW_M ? A.in[1] + (size_t)(row - ROW_S) * D : A.in[5] + (size_t)(row - ROW_M) * D;
}
__device__ __forceinline__ float* xres_row(const Frame& F, int row) {
    return row < ROW_S ? F.out + OFF_YP + (size_t)row * D : row < ROW_M ? F.out + OFF_YS + (size_t)(row - ROW_S) * D : (float*)(F.ws + WS_XM) + (size_t)(row - ROW_M) * D;
}
__device__ __forceinline__ void prologue(ArgsRef A, Frame& F) {
    { const int t_ = mk_tid(F.wave); F.tid = t_; F.lane = t_ & 63; }
    LAS float* scr = (LAS float*)(F.lds + F.wave * 16384);
    const int gw = F.vcu * 8 + F.wave, NGW = F.G * 8;
    constexpr int I_QKV = 16 * 96, I_O = 16 * 32, I_UP = 16 * 128, I_DN = 64 * 32, I_PL = 4 * 8;
    constexpr int NITEMS = 2 * I_QKV + 2 * I_O + 4 * I_UP + 4 * I_DN + 8 * I_PL;
    for (int it = gw; it < NITEMS; it += NGW) {
        int r = it;
        if (r < 2 * I_QKV) { const int a = r / I_QKV; transpose_item(A.in[11] + (size_t)a * D * 3072, D, 3072, (bf16*)(F.ws + WS_WQKV) + (size_t)a * 3072 * D, scr, r % I_QKV, F.lane, nullptr); continue; } r -= 2 * I_QKV;
        if (r < 2 * I_O) { const int a = r / I_O; transpose_item(A.in[17] + (size_t)a * D * D, D, D, (bf16*)(F.ws + WS_WO) + (size_t)a * D * D, scr, r % I_O, F.lane, nullptr); continue; } r -= 2 * I_O;
        if (r < 4 * I_UP) { const int i = r / I_UP; transpose_item(A.in[20] + (size_t)i * D * FF, D, FF, (bf16*)(F.ws + WS_WUP) + (size_t)i * D * FF, scr, r % I_UP, F.lane, nullptr); continue; } r -= 4 * I_UP;
        if (r < 4 * I_DN) { const int i = r / I_DN; transpose_item(A.in[21] + (size_t)i * D * FF, FF, D, (bf16*)(F.ws + WS_WDN) + (size_t)i * D * FF, scr, r % I_DN, F.lane, nullptr); continue; } r -= 4 * I_DN;
        { const int pg = r / I_PL; transpose_item(A.in[18] + (size_t)pg * 65536, 256, 256, (bf16*)(F.ws + WS_WPOOL) + (size_t)pg * 65536, scr, r % I_PL, F.lane, A.in[19] + pg * 256); }
    }
    for (int it0 = gw; it0 < 32768; it0 += 4 * NGW) {
        f32x4 v[4][4];
#pragma unroll
        for (int r4 = 0; r4 < 4; ++r4) { const int it = min(it0 + r4 * NGW, 32767); const int j = it & 1023, b = (it >> 10) & 7, kv = (it >> 13) & 1, a = it >> 14;
            const float* src = (kv ? A.in[3] : A.in[2]) + ((size_t)(a * 8 + b) * 1024 + j) * D;
#pragma unroll
            for (int q = 0; q < 4; ++q) v[r4][q] = *(const f32x4*)(src + 4 * F.lane + 256 * q); }
#pragma unroll
        for (int r4 = 0; r4 < 4; ++r4) { const int it = it0 + r4 * NGW; if (it < 32768) { const int j = it & 1023, b = (it >> 10) & 7, kv = (it >> 13) & 1, a = it >> 14;
            bf16* dst = (bf16*)(F.ws + (kv ? WS_VXS : WS_KXS)) + (size_t)a * KXS_LAYER + (size_t)(b * EXT_S + 16 + j) * D;
#pragma unroll
            for (int q = 0; q < 4; ++q) { u32x2 w; w.x = pk2(v[r4][q].x, v[r4][q].y); w.y = pk2(v[r4][q].z, v[r4][q].w); *(u32x2*)(dst + 4 * F.lane + 256 * q) = w; } } }
    }
    const float* g = A.in[7];
    for (int row = ROWS_VALID + gw; row < MPAD; row += NGW) { bf16* xn = (bf16*)(F.ws + WS_XN) + (size_t)row * D;
#pragma unroll
        for (int q = 0; q < 4; ++q) *(u32x2*)(xn + 4 * F.lane + 256 * q) = (u32x2){0u, 0u}; }
    const int RPC = (ROWS_VALID + F.G - 1) / F.G, rbeg = F.vcu * RPC, rend = min(rbeg + RPC, ROWS_VALID);
    for (int row0 = rbeg + F.wave; row0 < rend; row0 += 32) {
        f32x4 v[4][4]; float ss[4];
#pragma unroll
        for (int j = 0; j < 4; ++j) { const float* x = xin_row(A, min(row0 + j * 8, ROWS_VALID - 1)); ss[j] = 0.f;
#pragma unroll
            for (int q = 0; q < 4; ++q) v[j][q] = *(const f32x4*)(x + 4 * F.lane + 256 * q); }
#pragma unroll
        for (int j = 0; j < 4; ++j) {
#pragma unroll
            for (int q = 0; q < 4; ++q) ss[j] += v[j][q].x * v[j][q].x + v[j][q].y * v[j][q].y + v[j][q].z * v[j][q].z + v[j][q].w * v[j][q].w; }
#pragma unroll
        for (int o = 1; o < 64; o <<= 1) {
#pragma unroll
            for (int j = 0; j < 4; ++j) ss[j] += __shfl_xor(ss[j], o); }
#pragma unroll
        for (int j = 0; j < 4; ++j) { const int row = row0 + j * 8; const float r = 1.0f / sqrtf(ss[j] * (1.f / D) + EPS); bf16* xn = (bf16*)(F.ws + WS_XN) + (size_t)row * D;
#pragma unroll
            for (int q = 0; q < 4; ++q) { const f32x4 gg = *(const f32x4*)(g + 4 * F.lane + 256 * q); u32x2 w; w.x = pk2(v[j][q].x * r * gg.x, v[j][q].y * r * gg.y); w.y = pk2(v[j][q].z * r * gg.z, v[j][q].w * r * gg.w);
                if (row < rend) *(u32x2*)(xn + 4 * F.lane + 256 * q) = w; } }
    }
}
__device__ __forceinline__ void fin_phase(ArgsRef A, Frame& F, bool from_inputs, const int nks  , const float* gpost, const float* gnext) {
    { const int t_ = mk_tid(F.wave); F.tid = t_; F.lane = t_ & 63; }
    constexpr int FR = 4;
    const int gw = F.vcu * 8 + F.wave, NGW = F.G * 8;
    const bf16* YB = (const bf16*)(F.ws + WS_YB);
    const int lo4 = 4 * F.lane;
    const int RPC = (ROW_S + F.G - 1) / F.G, rbeg = F.vcu * RPC, rend = min(rbeg + RPC, ROW_S);
    for (int row0 = rbeg + F.wave; row0 < rend; row0 += 8 * FR) {
        f32x4 yv[FR][4], xv[FR][4]; float ss[FR];
#pragma unroll
        for (int j = 0; j < FR; ++j) { const int row = min(row0 + j * 8, ROWS_VALID - 1); const bf16* y = YB + (size_t)row * D; const float* xi = from_inputs ? xin_row(A, row) : xres_row(F, row); ss[j] = 0.f;
#pragma unroll
            for (int q = 0; q < 4; ++q) {
                { const u32x2 w = *(const u32x2*)(y + lo4 + 256 * q); yv[j][q] = (f32x4){bflo(w.x), bfhi(w.x), bflo(w.y), bfhi(w.y)}; }
                xv[j][q] = *(const f32x4*)(xi + lo4 + 256 * q); } }
#pragma unroll
        for (int j = 0; j < FR; ++j) {
#pragma unroll
            for (int q = 0; q < 4; ++q) ss[j] += yv[j][q].x * yv[j][q].x + yv[j][q].y * yv[j][q].y + yv[j][q].z * yv[j][q].z + yv[j][q].w * yv[j][q].w; }
#pragma unroll
        for (int o = 1; o < 64; o <<= 1) {
#pragma unroll
            for (int j = 0; j < FR; ++j) ss[j] += __shfl_xor(ss[j], o); }
        float s2[FR];
#pragma unroll
        for (int j = 0; j < FR; ++j) { const int row = row0 + j * 8; const float r = 1.0f / sqrtf(ss[j] * (1.f / D) + EPS); s2[j] = 0.f;
#pragma unroll
            for (int q = 0; q < 4; ++q) { const f32x4 gg = *(const f32x4*)(gpost + lo4 + 256 * q); xv[j][q] = xv[j][q] + yv[j][q] * r * gg;
                if (row < rend) *(f32x4*)(xres_row(F, row) + lo4 + 256 * q) = xv[j][q];
                s2[j] += xv[j][q].x * xv[j][q].x + xv[j][q].y * xv[j][q].y + xv[j][q].z * xv[j][q].z + xv[j][q].w * xv[j][q].w; } }
        if (gnext) {
#pragma unroll
            for (int o = 1; o < 64; o <<= 1) {
#pragma unroll
                for (int j = 0; j < FR; ++j) s2[j] += __shfl_xor(s2[j], o); }
#pragma unroll
            for (int j = 0; j < FR; ++j) { const int row = row0 + j * 8; const float r2 = 1.0f / sqrtf(s2[j] * (1.f / D) + EPS); bf16* xn = (bf16*)(F.ws + WS_XN) + (size_t)row * D;
#pragma unroll
                for (int q = 0; q < 4; ++q) { const f32x4 gg = *(const f32x4*)(gnext + lo4 + 256 * q); u32x2 w; w.x = pk2(xv[j][q].x * r2 * gg.x, xv[j][q].y * r2 * gg.y); w.y = pk2(xv[j][q].z * r2 * gg.z, xv[j][q].w * r2 * gg.w);
                    if (row < rend) *(u32x2*)(xn + lo4 + 256 * q) = w; } }
        }
    }
    for (int row = ROW_S + gw; row < ROWS_VALID; row += NGW) {
        const float* xi = from_inputs ? xin_row(A, row) : xres_row(F, row); float* xo = xres_row(F, row);
        f32x4 yv[4], xv[4]; float ss = 0.f;
#pragma unroll
        for (int q = 0; q < 4; ++q) {
            if (nks == 0) { const u32x2 w = *(const u32x2*)(YB + (size_t)row * D + lo4 + 256 * q); yv[q] = (f32x4){bflo(w.x), bfhi(w.x), bflo(w.y), bfhi(w.y)}; }
            else { const float* yf = (const float*)(F.ws + WS_YF) + (size_t)(row - ROW_S) * D + lo4 + 256 * q; yv[q] = *(const f32x4*)yf; for (int k = 1; k < nks; ++k) yv[q] += *(const f32x4*)(yf + (size_t)k * 768 * D); }
            xv[q] = *(const f32x4*)(xi + lo4 + 256 * q); ss += yv[q].x * yv[q].x + yv[q].y * yv[q].y + yv[q].z * yv[q].z + yv[q].w * yv[q].w; }
        const float r = 1.0f / sqrtf(wave_sum(ss) * (1.f / D) + EPS); float s2 = 0.f;
#pragma unroll
        for (int q = 0; q < 4; ++q) { const f32x4 gg = *(const f32x4*)(gpost + lo4 + 256 * q); xv[q] = xv[q] + yv[q] * r * gg; *(f32x4*)(xo + lo4 + 256 * q) = xv[q];
            s2 += xv[q].x * xv[q].x + xv[q].y * xv[q].y + xv[q].z * xv[q].z + xv[q].w * xv[q].w; }
        if (gnext) { const float r2 = 1.0f / sqrtf(wave_sum(s2) * (1.f / D) + EPS); bf16* xn = (bf16*)(F.ws + WS_XN) + (size_t)row * D;
#pragma unroll
            for (int q = 0; q < 4; ++q) { const f32x4 gg = *(const f32x4*)(gnext + lo4 + 256 * q); u32x2 w; w.x = pk2(xv[q].x * r2 * gg.x, xv[q].y * r2 * gg.y); w.y = pk2(xv[q].z * r2 * gg.z, xv[q].w * r2 * gg.w);
                *(u32x2*)(xn + lo4 + 256 * q) = w; } }
    }
}
__device__ __forceinline__ f32x2 pool_h(ArgsRef A, const Frame& F, int grp, int b, int t, int col, int p) {
    const bf16* XN = (const bf16*)(F.ws + WS_XN);
    if (t >= 0) { const int row = grp == 0 ? b * 8192 + t : grp == 1 ? ROW_S + b * 64 + t : ROW_M + t; const unsigned w = *(const unsigned*)(XN + (size_t)row * D + col); return (f32x2){bflo(w), bfhi(w)}; }
    if (grp == 0) { const unsigned w = *(const unsigned*)(XN + (size_t)(ROW_M + 16 + t) * D + col); return (f32x2){bflo(w), bfhi(w)}; }
    if (grp == 1) return *(const f32x2*)(A.in[4] + ((size_t)(p * 8 + b) * 15 + 15 + t) * D + col);
    return (f32x2){0.f, 0.f};
}
__device__ __forceinline__ void pool_phase(ArgsRef A, Frame& F, int p) {
    { const int t_ = mk_tid(F.wave); F.tid = t_; F.lane = t_ & 63; }
    bf16* DB = (bf16*)(F.ws + WS_QB);
    const int col = 2 * F.tid, w = 2 << (col >> 8);
    for (int it = F.vcu; it < 2065; it += F.G) {
        int grp, b, t0, nr;
        if (it < 2048) { grp = 0; b = it >> 8; t0 = (it & 255) * 32; nr = 32; } else if (it < 2064) { const int s = it - 2048; grp = 1; b = s >> 1; t0 = (s & 1) * 32; nr = 32; } else { grp = 2; b = 0; t0 = 0; nr = 16; }
        f32x2 h[47];
#pragma unroll
        for (int i = 0; i < 47; ++i) h[i] = (i - 15 < nr) ? pool_h(A, F, grp, b, t0 - 15 + i, col, p) : (f32x2){0.f, 0.f};
        f32x2 sum = {0.f, 0.f};
#pragma unroll
        for (int j = 1; j < 16; ++j) if (j < w) sum += h[15 - j];
#pragma unroll
        for (int i = 0; i < 32; ++i) { const int t = t0 + i;
            if (i < nr) {
                const f32x2 cur = h[15 + i]; sum += cur;
                const float inv = 1.0f / (float)(grp == 2 ? min(t + 1, w) : w);
                const int row = grp == 0 ? b * 8192 + t : grp == 1 ? ROW_S + b * 64 + t : ROW_M + t;
                *(unsigned*)(DB + (size_t)row * D + col) = pk2(sum.x * inv - cur.x, sum.y * inv - cur.y);
                const f32x2 old = (w == 2) ? h[15 + i - 1] : (w == 4) ? h[15 + i - 3] : (w == 8) ? h[15 + i - 7] : h[15 + i - 15];
                sum -= old;
                if (grp == 0 && t >= 8177) *(f32x2*)(F.out + OFF_PP + ((size_t)(p * 8 + b) * 15 + (t - 8177)) * D + col) = cur;
                if (grp == 1 && t >= 49) *(f32x2*)(F.out + OFF_PS + ((size_t)(p * 8 + b) * 15 + (t - 49)) * D + col) = cur;
            }
        }
    }
}

namespace att {
constexpr int KSTR = 272;
constexpr int TB = 16384;
constexpr int OFF_K0 = 0, OFF_K1 = TB, OFF_V0 = 2 * TB, OFF_V1 = 3 * TB, OFF_BT = 4 * TB, OFF_GT = OFF_BT + 2048, OFF_Q = 5 * TB, XB = 16384;
static_assert(OFF_BT >= 4 * XB && OFF_GT + 512 <= OFF_Q && OFF_Q + 2 * TB <= 131072, "attention LDS map");
constexpr float THR = 48.0f;
constexpr float NEG = -1e30f;
struct AUnit { const bf16* K; const bf16* V; const bf16* KM; const bf16* VM; const bf16* Q; bf16* O; int P, L, x, h; };
__device__ __forceinline__ float max3f(float a, float b, float c) { float r; asm("v_max3_f32 %0, %1, %2, %3" : "=v"(r) : "v"(a), "v"(b), "v"(c)); return r; }
__device__ __forceinline__ float swapmax(float v) { auto rr = __builtin_amdgcn_permlane32_swap(__float_as_uint(v), __float_as_uint(v), false, false); return fmaxf(__uint_as_float(rr[0]), __uint_as_float(rr[1])); }
__device__ __forceinline__ float swapsum(float v) { auto rr = __builtin_amdgcn_permlane32_swap(__float_as_uint(v), __float_as_uint(v), false, false); return __uint_as_float(rr[0]) + __uint_as_float(rr[1]); }
typedef __bf16 bf16x2_t __attribute__((ext_vector_type(2)));
__device__ __forceinline__ unsigned cvtpk(float lo, float hi) { f32x2 v = {lo, hi}; bf16x2_t b = __builtin_convertvector(v, bf16x2_t); return __builtin_bit_cast(unsigned, b); }
__device__ __forceinline__ s16x4 vtr(const LAS unsigned char* p) { return __builtin_bit_cast(s16x4, __builtin_amdgcn_ds_read_tr16_b64_v4i16((LAS s16x4*)p)); }
__device__ __forceinline__ void glds16(const void* gsrc, unsigned lds_dst) { unsigned keep;
    asm volatile("s_mov_b32 %0, m0\n\ts_mov_b32 m0, %2\n\ts_nop 0\n\tglobal_load_lds_dwordx4 %1, off\n\ts_mov_b32 m0, %0" : "=&s"(keep) : "v"(gsrc), "s"(lds_dst) : "memory"); }
__device__ __forceinline__ bf16x8 pack8(const f32x16& S, int o) {
    u32x4 w; w.x = cvtpk(S[o], S[o + 1]); w.y = cvtpk(S[o + 2], S[o + 3]); w.z = cvtpk(S[o + 4], S[o + 5]); w.w = cvtpk(S[o + 6], S[o + 7]); return __builtin_bit_cast(bf16x8, w);
}

__device__ __forceinline__ void attn_unit(const int wv, LAS unsigned char* lds, const AUnit& u, const float* lq1, const float* lk1, const float* lq2, const float* lk2, const int layer_a, const float* relb, const float* subg) {
    const int tid = mk_tid(wv), lane = tid & 63, wid = wv, mp = wid >> 2, rg = wid & 3, q32 = lane & 31, hi = lane >> 5;
    LAS float* BT = (LAS float*)(lds + OFF_BT); LAS float* GT = (LAS float*)(lds + OFF_GT);
    {
        const float b15 = relb[15 * 8 + u.h];
        if (tid < 448) { const int rel = tid - 192, n = rel < 0 ? -rel : rel;
            int bk = n < 8 ? n : n < 12 ? 8 : n < 16 ? 9 : n < 23 ? 10 : n < 32 ? 11 : n < 46 ? 12 : n < 64 ? 13 : n < 91 ? 14 : 15; if (rel > 0) bk += 16;
            BT[tid] = (relb[bk * 8 + u.h] - b15) * LOG2E; }
        if (tid >= 384) GT[tid - 384] = subg[tid - 384] * (layer_a == 0 ? 0.8f : 0.52928698f);
    }
    const int vrows = min(128, u.L - 128 * u.x);
    const bool active = rg * 32 < vrows;
    const int ch = rg >> 1;
    const int NTw = active ? (u.P + min((2 * u.x + ch + 1) * 64, u.L) + 48) >> 6 : 0;
    const int NT = (u.P + min((2 * u.x + 2) * 64, u.L) + 48) >> 6;
    const int eq0 = u.P + 128 * u.x + rg * 32, eq = eq0 + q32;
    const unsigned lds0 = (unsigned)(size_t)lds;
    unsigned goff[2];
#pragma unroll
    for (int j = 0; j < 2; ++j) { const int row = wid * 8 + 4 * j + (lane >> 4), x = ((row & 3) << 2) | ((row >> 2) & 3), c = (lane & 15) ^ x; goff[j] = (unsigned)(row * 1024 + u.h * 128 + c * 8); }
    const unsigned ldst = (unsigned)wid * 2048u;
#define ATT_DMA(base, bufoff) do { _Pragma("unroll") for (int j_ = 0; j_ < 2; ++j_) \
        glds16((base) + goff[j_], (unsigned)__builtin_amdgcn_readfirstlane((int)(lds0 + (unsigned)(bufoff) + ldst + j_ * 1024))); } while (0)
#define ATT_ISSUE_K(t, bufoff) do { const bf16* b_ = ((t) == 0 && wid < 2) ? u.KM : u.K + (size_t)(t) * 65536; ATT_DMA(b_, bufoff); } while (0)
#define ATT_ISSUE_V(t, bufoff) do { const bf16* b_ = ((t) == 0 && wid < 2) ? u.VM : u.V + (size_t)(t) * 65536; ATT_DMA(b_, bufoff); } while (0)
#define ATT_WAITBAR() do { asm volatile("s_waitcnt vmcnt(0) lgkmcnt(0)" ::: "memory"); __builtin_amdgcn_s_barrier(); asm volatile("" ::: "memory"); } while (0)
    unsigned koff[4];
    { const int x = ((q32 & 3) << 2) | ((q32 >> 2) & 3);
#pragma unroll
      for (int d0 = 0; d0 < 4; ++d0) koff[d0] = lds0 + (unsigned)(q32 * 256 + (((mp * 8 + 2 * d0 + hi) ^ x) << 4)); }
    unsigned vofs[4][2];
    { const int qq = (lane & 15) >> 2, cl = 2 * ((lane >> 4) & 1) + ((lane & 3) >> 1), sub = 8 * (lane & 1);
#pragma unroll
      for (int dvb = 0; dvb < 4; ++dvb)
#pragma unroll
          for (int hf = 0; hf < 2; ++hf) vofs[dvb][hf] = lds0 + (unsigned)((8 * hf + 4 * hi + qq) * 256 + ((((dvb ^ qq) << 2) | (cl ^ (2 * hf + hi))) << 4) + sub); }
    {
        const bf16* qb_ = u.Q + (size_t)(128 * u.x + wid * 16) * 1024;
#pragma unroll
        for (int j = 0; j < 4; ++j) { const int row = 4 * j + (lane >> 4), x = ((row & 3) << 2) | ((row >> 2) & 3), c = (lane & 15) ^ x;
            glds16(qb_ + row * 1024 + u.h * 128 + c * 8, (unsigned)__builtin_amdgcn_readfirstlane((int)(lds0 + OFF_Q + wid * 4096 + j * 1024))); }
    }
    ATT_ISSUE_K(0, OFF_K0); ATT_ISSUE_V(0, OFF_V0); if (NT > 1) ATT_ISSUE_K(1, OFF_K1);
    ATT_WAITBAR();
    f32x16 O[4];
#pragma unroll
    for (int i = 0; i < 4; ++i)
#pragma unroll
        for (int r = 0; r < 16; ++r) O[i][r] = 0.f;
    float m = 0.f, l = 0.f;
    f32x16 SA0, SA1, SB0, SB1;
    const f32x16 zero16 = {0.f, 0.f, 0.f, 0.f, 0.f, 0.f, 0.f, 0.f, 0.f, 0.f, 0.f, 0.f, 0.f, 0.f, 0.f, 0.f};
#define ATT_SB() __builtin_amdgcn_sched_barrier(0)
#define ATT_QK(S0_, S1_, kbufoff) do { unsigned qsh_ = (unsigned)(OFF_Q + rg * 8192); asm volatile("" : "+s"(qsh_));     \
        bf16x8 kfa[4], kfb[4], qfr[4]; \
        _Pragma("unroll") for (int d0 = 0; d0 < 4; ++d0) { kfa[d0] = *(const LAS bf16x8*)(size_t)(koff[d0] + (unsigned)(kbufoff)); kfb[d0] = *(const LAS bf16x8*)(size_t)(koff[d0] + (unsigned)(kbufoff) + 8192u); qfr[d0] = *(const LAS bf16x8*)(size_t)(koff[d0] + qsh_); } \
        ATT_SB(); \
        S0_ = __builtin_amdgcn_mfma_f32_32x32x16_bf16(kfa[0], qfr[0], zero16, 0, 0, 0); S1_ = __builtin_amdgcn_mfma_f32_32x32x16_bf16(kfb[0], qfr[0], zero16, 0, 0, 0); \
        _Pragma("unroll") for (int d0 = 1; d0 < 4; ++d0) { S0_ = __builtin_amdgcn_mfma_f32_32x32x16_bf16(kfa[d0], qfr[d0], S0_, 0, 0, 0); S1_ = __builtin_amdgcn_mfma_f32_32x32x16_bf16(kfb[d0], qfr[d0], S1_, 0, 0, 0); } } while (0)
#define ATT_VLD(bank, ks) do { _Pragma("unroll") for (int dvb = 0; dvb < 4; ++dvb) { bank[dvb][0] = vtr((const LAS unsigned char*)(size_t)(vofs[dvb][0] + vb_ + (unsigned)((ks) * 4096))); bank[dvb][1] = vtr((const LAS unsigned char*)(size_t)(vofs[dvb][1] + vb_ + (unsigned)((ks) * 4096))); } } while (0)
#define ATT_PV(bank, ks, C0, C1) do { const bf16x8 pb = pack8(((ks) < 2) ? C0 : C1, 8 * ((ks) & 1)); \
        _Pragma("unroll") for (int dvb = 0; dvb < 4; ++dvb) { const bf16x8 vf = (bf16x8){bank[dvb][0][0], bank[dvb][0][1], bank[dvb][0][2], bank[dvb][0][3], bank[dvb][1][0], bank[dvb][1][1], bank[dvb][1][2], bank[dvb][1][3]}; \
            O[dvb] = __builtin_amdgcn_mfma_f32_32x32x16_bf16(vf, pb, O[dvb], 0, 0, 0); } } while (0)
#define ATT_STEP(C0, C1, N0, N1, t_, PAR) do { const int t = (t_); constexpr int cur = (PAR); \
        if (t + 2 < NT) ATT_ISSUE_K(t + 2, cur ? OFF_K1 : OFF_K0); \
        if (t + 1 < NT) ATT_ISSUE_V(t + 1, cur ? OFF_V0 : OFF_V1); \
        { \
            const int k0 = t * 64; \
            if (k0 + 154 > eq0) { const LAS float* bt_ = BT + (k0 - eq + 192 + 4 * hi); \
                _Pragma("unroll") for (int r = 0; r < 16; ++r) { C0[r] += bt_[(r & 3) + 8 * (r >> 2)]; } \
                ATT_SB(); \
                _Pragma("unroll") for (int r = 0; r < 16; ++r) { C1[r] += bt_[32 + (r & 3) + 8 * (r >> 2)]; } } \
            if (t >= NTw - 1) { const bool all_ = t >= NTw; _Pragma("unroll") for (int r = 0; r < 16; ++r) { if (r >= 8 || all_) C0[r] = NEG; C1[r] = NEG; } } \
            if (__any(m != 0.f)) { _Pragma("unroll") for (int r = 0; r < 16; ++r) { C0[r] -= m; C1[r] -= m; } } \
            float mx = max3f(C0[0], C1[0], C0[1]), mx2 = max3f(C1[1], C0[2], C1[2]); \
            _Pragma("unroll") for (int r = 3; r < 15; r += 2) { mx = max3f(mx, C0[r], C1[r]); mx2 = max3f(mx2, C0[r + 1], C1[r + 1]); } \
            mx = max3f(mx, mx2, C0[15]); mx = fmaxf(mx, C1[15]); \
            mx = swapmax(mx); \
            if (__any(mx > THR || (t == 0 && mx < -THR))) { const float dl = (t == 0) ? mx : fmaxf(mx, 0.f); m += dl; const float f = (t == 0) ? 1.f : __builtin_amdgcn_exp2f(-dl); l *= f; \
                _Pragma("unroll") for (int r = 0; r < 16; ++r) { C0[r] -= dl; C1[r] -= dl; } \
                _Pragma("unroll") for (int i = 0; i < 4; ++i) _Pragma("unroll") for (int r = 0; r < 16; ++r) O[i][r] *= f; } \
        } \
        ATT_SB(); \
        if (t + 1 < NT) ATT_QK(N0, N1, cur ? OFF_K0 : OFF_K1); \
        ATT_SB(); \
        { \
            constexpr unsigned vb_ = (unsigned)(cur ? OFF_V1 : OFF_V0); \
            s16x4 vA[4][2], vB[4][2]; \
            ATT_VLD(vA, 0); \
            ATT_SB(); \
            float ls = 0.f; \
            _Pragma("unroll") for (int r = 0; r < 16; ++r) { C0[r] = __builtin_amdgcn_exp2f(C0[r]); C1[r] = __builtin_amdgcn_exp2f(C1[r]); ls += C0[r]; ls += C1[r]; } \
            l += ls; \
            ATT_SB(); \
            ATT_VLD(vB, 1); ATT_SB(); ATT_PV(vA, 0, C0, C1); ATT_SB(); \
            ATT_VLD(vA, 2); ATT_SB(); ATT_PV(vB, 1, C0, C1); ATT_SB(); \
            ATT_VLD(vB, 3); ATT_SB(); ATT_PV(vA, 2, C0, C1); ATT_SB(); \
            ATT_PV(vB, 3, C0, C1); \
        } \
        ATT_WAITBAR(); } while (0)
    ATT_QK(SA0, SA1, OFF_K0);
    ATT_WAITBAR();
    for (int tt = 0; tt < NT; tt += 2) { ATT_STEP(SA0, SA1, SB0, SB1, tt, 0); if (tt + 1 < NT) ATT_STEP(SB0, SB1, SA0, SA1, tt + 1, 1); }
#undef ATT_STEP
#undef ATT_QK
#undef ATT_VLD
#undef ATT_PV
#undef ATT_SB
#undef ATT_WAITBAR
#undef ATT_ISSUE_K
#undef ATT_ISSUE_V
#undef ATT_DMA
    const int tid2_ = mk_tid(wv);
    const int lane2 = tid2_ & 63, q32b = lane2 & 31, hib = lane2 >> 5;
    float lam;
    { float s1 = lq1[lane2] * lk1[lane2], s2 = lq2[lane2] * lk2[lane2]; s1 = wave_sum(s1); s2 = wave_sum(s2); lam = expf(s1) - expf(s2) + (layer_a == 0 ? 0.2f : 0.47071302f); }
    l = swapsum(l); const float inv = active ? 1.0f / l : 0.f;
    LAS float* xb = (LAS float*)(lds + rg * XB);
    if (mp == 1) { const float f = inv * lam;
#pragma unroll
        for (int i = 0; i < 4; ++i)
#pragma unroll
            for (int r = 0; r < 16; ++r) xb[(i * 16 + r) * 64 + lane2] = O[i][r] * f; }
    __syncthreads();
    if (mp == 0 && active) {
        float ss = 0.f;
#pragma unroll
        for (int i = 0; i < 4; ++i)
#pragma unroll
            for (int r = 0; r < 16; ++r) { const float o = O[i][r] * inv - xb[(i * 16 + r) * 64 + lane2]; O[i][r] = o; ss += o * o; }
        ss = swapsum(ss); const float rs = 1.0f / sqrtf(ss * (1.f / 128.f) + SUBLN_EPS);
        asm volatile("s_waitcnt lgkmcnt(0)" ::: "memory");
        LAS unsigned char* stg = (LAS unsigned char*)xb;
#pragma unroll
        for (int i = 0; i < 4; ++i)
#pragma unroll
            for (int r4 = 0; r4 < 4; ++r4) { const int dv0 = 32 * i + 8 * r4 + 4 * hib; const f32x4 gg = *(const LAS f32x4*)(GT + dv0);
                u32x2 w; w.x = cvtpk(O[i][4 * r4] * rs * gg.x, O[i][4 * r4 + 1] * rs * gg.y); w.y = cvtpk(O[i][4 * r4 + 2] * rs * gg.z, O[i][4 * r4 + 3] * rs * gg.w);
                *(LAS u32x2*)(stg + q32b * KSTR + dv0 * 2) = w; }
        asm volatile("s_waitcnt lgkmcnt(0)" ::: "memory");
        bf16* og = u.O + (size_t)(128 * u.x + rg * 32) * 1024 + u.h * 128;
#pragma unroll
        for (int i = 0; i < 8; ++i) { const int row = i * 4 + (lane2 >> 4), c16 = lane2 & 15; const u32x4 v = *(const LAS u32x4*)(stg + row * KSTR + c16 * 16);
            if (rg * 32 + row < vrows) *(u32x4*)(og + (size_t)row * 1024 + c16 * 8) = v; }
    }
    __syncthreads();
}
__device__ __forceinline__ void attn_phase(ArgsRef A, Frame& F, int a) {
    const bf16* QB = (const bf16*)(F.ws + WS_QB); bf16* OB = (bf16*)(F.ws + WS_XN); const bf16* KX = (const bf16*)(F.ws + WS_KX); const bf16* VX = (const bf16*)(F.ws + WS_VX);
    const bf16* KXS = (const bf16*)(F.ws + WS_KXS) + (size_t)a * KXS_LAYER; const bf16* VXS = (const bf16*)(F.ws + WS_VXS) + (size_t)a * KXS_LAYER;
    { const int gt = blockIdx.x * 512 + mk_tid(F.wave);
      for (int i = gt; i < 65536; i += F.G * 512) { const int c4 = i & 255, r = (i >> 8) & 15, b = (i >> 12) & 7, kv = i >> 15;
          const f32x4 v = *(const f32x4*)((const float*)(F.ws + (kv ? WS_MFV : WS_MFK)) + r * 1024 + c4 * 4);
          *(f32x4*)(F.out + (kv ? OFF_VP : OFF_KP) + (size_t)a * 8 * EXT_P * 1024 + (size_t)(b * EXT_P + r) * 1024 + c4 * 4) = v; } }
    for (int n = F.vcu; n < 4168; n += F.G) {
        AUnit u; u.KM = (const bf16*)(F.ws + WS_KXM); u.VM = (const bf16*)(F.ws + WS_VXM);
        if (n < 4096) { const int i = n >> 8, v = n & 255, c = v & 31, bh = (v >> 5) * 8 + (i >> 1); const int x = (i & 1) ? 63 - c : c; const int b = bh >> 3;
            u.K = KX + (size_t)b * EXT_P * 1024; u.V = VX + (size_t)b * EXT_P * 1024; u.Q = QB + (size_t)b * 8192 * 1024; u.O = OB + (size_t)b * 8192 * 1024; u.P = 16; u.L = 8192; u.x = x; u.h = bh & 7; }
        else if (n < 4160) { const int j = n - 4096, b = j >> 3; u.K = KXS + (size_t)b * EXT_S * 1024; u.V = VXS + (size_t)b * EXT_S * 1024; u.Q = QB + (size_t)(ROW_S + b * 64) * 1024; u.O = OB + (size_t)(ROW_S + b * 64) * 1024; u.P = 1040; u.L = 64; u.x = 0; u.h = j & 7; }
        else { u.K = (const bf16*)(F.ws + WS_KXM); u.V = (const bf16*)(F.ws + WS_VXM); u.Q = QB + (size_t)ROW_M * 1024; u.O = OB + (size_t)ROW_M * 1024; u.P = 0; u.L = 16; u.x = 0; u.h = n - 4160; }
        attn_unit(F.wave, F.lds, u, A.in[12] + a * 64, A.in[13] + a * 64, A.in[14] + a * 64, A.in[15] + a * 64, a, A.in[6], A.in[16] + a * 128);
    }
}
}

#define XB_TMO      128
#define XB_XCNT(j)  (256  + 64 * (j))
#define XB_XSUB(j)  (1280 + 64 * (j))
#define XB_XGEN(j)  (2304 + 64 * (j))
#define XB_TOP      3328
#define XB_TOPGEN   3392
#define XCD_BAR_WORDS 3456
#define XB_SPIN_CAP (1u << 18)

__device__ __forceinline__ unsigned xb_ld(unsigned* p)              { return __hip_atomic_load(p, __ATOMIC_RELAXED, __HIP_MEMORY_SCOPE_AGENT); }
__device__ __forceinline__ unsigned xb_add(unsigned* p, unsigned v) { return __hip_atomic_fetch_add(p, v, __ATOMIC_RELAXED, __HIP_MEMORY_SCOPE_AGENT); }
__device__ __forceinline__ unsigned xb_xcc_id() { return (unsigned)__builtin_amdgcn_s_getreg((3 << 11) | 20) & 0xFu; }
#define XB_SPIN(cond, bar) do { unsigned _sp = 0; while (cond) { __builtin_amdgcn_s_sleep(1); \
    if ((++_sp & 255u) == 0u) { if (xb_ld(&(bar)[XB_TMO])) break; if (_sp > XB_SPIN_CAP) { atomicAdd(&(bar)[XB_TMO], 1u); break; } } } } while (0)

struct XcdBarrier {
    bool leader; unsigned* bar; unsigned x;
    volatile LAS unsigned* st;
};

__device__ __forceinline__ XcdBarrier xcd_barrier_post(unsigned* bar, volatile LAS unsigned* st) {
    XcdBarrier b; b.bar = bar; b.x = xb_xcc_id(); b.st = st;
    b.leader = (threadIdx.x == 0);
    if (b.leader) (void)xb_add(&bar[XB_XCNT(b.x)], 1u);
    return b;
}
__device__ __forceinline__ void xcd_barrier_complete(unsigned* bar, unsigned x, unsigned& nloc, unsigned& nx) {
    const unsigned G = gridDim.x * gridDim.y * gridDim.z;
    unsigned sum, cnt, mine, sp = 0u;
    for (;;) {
        sum = 0u; cnt = 0u; mine = 0u;
#pragma unroll
        for (unsigned j = 0; j < 16; ++j) { const unsigned c = xb_ld(&bar[XB_XCNT(j)]); sum += c; cnt += (c > 0u) ? 1u : 0u; mine = (j == x) ? c : mine; }
        if (sum == G) break;
        __builtin_amdgcn_s_sleep(1);
        if ((++sp & 255u) == 0u) { if (xb_ld(&bar[XB_TMO])) break; if (sp > XB_SPIN_CAP) { atomicAdd(&bar[XB_TMO], 1u); break; } }
    }
    nloc = mine > 0u ? mine : 1u; nx = cnt > 0u ? cnt : 1u;
}

__device__ __forceinline__ void xcd_barrier(const XcdBarrier& b) {
    asm volatile("s_waitcnt vmcnt(0)" ::: "memory");
    __syncthreads();
    if (b.leader) {
        unsigned* bar = b.bar;
        __builtin_amdgcn_s_waitcnt(0);
        unsigned nloc = b.st[0], nx = b.st[1];
        if (nloc == 0u) { xcd_barrier_complete(bar, b.x, nloc, nx); b.st[0] = nloc; b.st[1] = nx; }
        const unsigned old = xb_add(&bar[XB_XSUB(b.x)], 1u);
        const unsigned gen = old / nloc;
        if (old + 1u == (gen + 1u) * nloc) {
            __builtin_amdgcn_fence(__ATOMIC_RELEASE, "agent");
            asm volatile("s_waitcnt vmcnt(0)" ::: "memory");
            const unsigned og = xb_add(&bar[XB_TOP], 1u);
            const unsigned tg = og / nx;
            if (og + 1u == (tg + 1u) * nx) xb_add(&bar[XB_TOPGEN], 1u);
            else XB_SPIN(xb_ld(&bar[XB_TOPGEN]) == tg, bar);
            __builtin_amdgcn_fence(__ATOMIC_ACQUIRE, "agent");
            xb_add(&bar[XB_XGEN(b.x)], 1u);
            asm volatile("s_waitcnt vmcnt(0)" ::: "memory");
        } else {
            XB_SPIN(xb_ld(&bar[XB_XGEN(b.x)]) == gen, bar);
            __builtin_amdgcn_fence(__ATOMIC_ACQUIRE, "agent");
            asm volatile("s_waitcnt vmcnt(0)" ::: "memory");
        }
    }
    __syncthreads();
}

__device__ __forceinline__ void run_step(ArgsRef args, const int step, const int wv) {
    extern __shared__ __attribute__((aligned(16))) unsigned char lds_raw[];
    Frame F;
    F.lds = (LAS unsigned char*)lds_raw; F.tid = 0; F.lane = 0; F.wave = wv;
    F.G = gridDim.x; { const int bx = blockIdx.x; F.vcu = (F.G % 8 == 0) ? (bx % 8) * (F.G / 8) + bx / 8 : bx; }
    F.out = args.out; F.ws = args.ws;
    bf16* XN = (bf16*)(F.ws + WS_XN); bf16* QB = (bf16*)(F.ws + WS_QB); bf16* YB = (bf16*)(F.ws + WS_YB); bf16* U = (bf16*)(F.ws + WS_U);
    int layer = 0, k = -1;
    if (step > 0) { const int s = step - 1; if (s < 7) { layer = 0; k = s; } else if (s < 13) { layer = 1; k = s - 7; } else if (s < 20) { layer = 2; k = s - 13; } else { layer = 3; k = s - 20; } }
    const bool attn = (layer & 1) == 0; const int a = layer >> 1;
    int type;
    if (step == 0) type = 0; else if (attn) type = k == 0 ? 1 : k == 1 ? 2 : k == 2 ? 4 : k == 3 ? 5 : k == 4 ? 6 : k == 5 ? 7 : 8;
    else type = k == 0 ? 3 : k == 1 ? 4 : k == 2 ? 5 : k == 3 ? 6 : k == 4 ? 7 : 8;
    if (type == 0) prologue(args, F);
    else if (type == 1) {
        pg8::Gemm g{XN, (const bf16*)(F.ws + WS_WQKV) + (size_t)a * 3072 * D, MPAD, 3072, D, D, D, 0}; pg8::StaticOrder S; S.init(MPAD, 3072, F.G, (int)blockIdx.x, D);
        pg8::EpiQKV E{F.ws, F.out, a};
        pg8::gemm_phase<pg8::EpiQKV, pg8::StaticOrder, true, true>(F.lds, g, S, E, mk_tid(F.wave));
    } else if (type == 2) { att::attn_phase(args, F, a); }
    else if (type == 3) { pool_phase(args, F, a); }
    else if (type == 4 || type == 7) {
        pg8::Gemm g;
        if (type == 7) g = pg8::Gemm{U, (const bf16*)(F.ws + WS_WDN) + (size_t)layer * D * FF, MPAD, D, FF, FF, FF, 0};
        else if (attn) g = pg8::Gemm{XN, (const bf16*)(F.ws + WS_WO) + (size_t)a * D * D, MPAD, D, D, D, D, 0};
        else g = pg8::Gemm{QB, (const bf16*)(F.ws + WS_WPOOL) + (size_t)a * 4 * 65536, MPAD, D, 256, D, 256, 512};
        pg8::TailOrder S; S.init(D, F.G, (int)blockIdx.x, g.K, type == 7 ? 16 : (attn ? 4 : 1));
        pg8::EpiBf16<0> E{YB, D, (float*)(F.ws + WS_YF)};
        pg8::gemm_phase<pg8::EpiBf16<0>, pg8::TailOrder, true, true>(F.lds, g, S, E, mk_tid(F.wave));
    } else if (type == 5) { fin_phase(args, F, layer == 0, attn ? 4 : 0, args.in[8] + layer * D, args.in[9] + layer * D); }
    else if (type == 6) {
        pg8::Gemm g{XN, (const bf16*)(F.ws + WS_WUP) + (size_t)layer * D * FF, MPAD, FF, D, D, D, 0}; pg8::StaticOrder S; S.init(MPAD, FF, F.G, (int)blockIdx.x, D);
        pg8::EpiBf16<2> E{U, FF, nullptr};
        pg8::gemm_phase<pg8::EpiBf16<2>, pg8::StaticOrder, true, true>(F.lds, g, S, E, mk_tid(F.wave));
    } else { fin_phase(args, F, false, 16, args.in[10] + layer * D, layer < 3 ? args.in[7] + (layer + 1) * D : nullptr); }
}
__global__ void __launch_bounds__(512, 2) fwd_kernel(Args args_) {
    const int lo = args_.lo, hi = args_.hi;
    const int wv = __builtin_amdgcn_readfirstlane((int)threadIdx.x >> 6);
    extern __shared__ __attribute__((aligned(16))) unsigned char lds_raw[];
    volatile LAS unsigned* bst = (volatile LAS unsigned*)((LAS unsigned char*)lds_raw + 131072);
    if (threadIdx.x < 2) bst[threadIdx.x] = 0u;
    __syncthreads();
    XcdBarrier bar = xcd_barrier_post((unsigned*)args_.ws + 4096, bst);
    int probe_rep = 0; (void)probe_rep;
    for (int step = lo; step < hi; ++step) {
        const __attribute__((address_space(4))) Args* ap = (const __attribute__((address_space(4))) Args*)__builtin_amdgcn_kernarg_segment_ptr();
        asm volatile("" : "+s"(ap));
        run_step(*ap, step, wv);
#if defined(PROBE_MASK)
        {
            int ty = 0; if (step > 0) { const int s = step - 1; const int k = s < 7 ? s : s < 13 ? s - 7 : s < 20 ? s - 13 : s - 20; const bool at = (s < 7) || (s >= 13 && s < 20);
                ty = at ? (k == 0 ? 1 : k == 1 ? 2 : k == 2 ? 4 : k == 3 ? 5 : k == 4 ? 6 : k == 5 ? 7 : 8) : (k == 0 ? 3 : k == 1 ? 4 : k == 2 ? 5 : k == 3 ? 6 : k == 4 ? 7 : 8); }
            if (((PROBE_MASK >> ty) & 1) && !probe_rep) { probe_rep = 1; --step; __syncthreads(); continue; }
            probe_rep = 0; }
#endif
        if (step + 1 < hi) { if (step == lo) { __threadfence(); cg::this_grid().sync(); } else { xcd_barrier(bar);
#if defined(PROBE_BAR2)
 xcd_barrier(bar);
#endif
 } }
    }
}

extern "C" void kernel_launch(void* const* d_in, const int* in_sizes, int n_in, void* d_out, int out_size, void* d_ws, size_t ws_size, hipStream_t stream) {
    static int grid = 0;
    if (grid == 0) {
        if (n_in != 22 || (size_t)out_size != OUT_TOTAL || ws_size < WS_END) { fprintf(stderr, "kernel_launch: unexpected shapes n_in %d out %d ws %zu\n", n_in, out_size, ws_size); grid = -1; return; }
        int dev = 0, cus = 0, per_cu = 0;
        hipGetDevice(&dev); hipDeviceGetAttribute(&cus, hipDeviceAttributeMultiprocessorCount, dev);
        hipFuncSetAttribute((const void*)fwd_kernel, hipFuncAttributeMaxDynamicSharedMemorySize, LDS_BYTES);
        hipOccupancyMaxActiveBlocksPerMultiprocessor(&per_cu, (const void*)fwd_kernel, 512, LDS_BYTES);
        if (per_cu < 1) { fprintf(stderr, "kernel_launch: occupancy query says %d blocks/CU\n", per_cu); per_cu = 1; }
        (void)hipGetLastError();
        grid = cus;
    }
    if (grid < 0) return;
    if (hipMemsetAsync(d_ws, 0, 65536, stream) != hipSuccess) { fprintf(stderr, "kernel_launch: memset failed\n"); return; }
    Args a{};
    for (int i = 0; i < 22; ++i) a.in[i] = (const float*)d_in[i];
    a.out = (float*)d_out; a.ws = (unsigned char*)d_ws;
#if ONE_LAUNCH
    a.lo = 0; a.hi = NSTEPS;
    void* kargs[] = {&a};
    hipError_t e = hipLaunchCooperativeKernel((const void*)fwd_kernel, dim3(grid), dim3(512), kargs, LDS_BYTES, stream);
    if (e != hipSuccess) fprintf(stderr, "cooperative launch failed: %s (grid %d)\n", hipGetErrorString(e), grid);
#else
    for (int s = 0; s < NSTEPS; ++s) { a.lo = s; a.hi = s + 1; hipLaunchKernelGGL(fwd_kernel, dim3(grid), dim3(512), LDS_BYTES, stream, a); }
#endif
}
static_assert(WS_QB == 213 * MiB && WS_KX == 473 * MiB && WS_VX == 602 * MiB && WS_KXS == 731 * MiB && WS_VXS == 767 * MiB && WS_KXM == 803 * MiB && WS_VXM == 804 * MiB && KXS_LAYER == 9 * MiB && WS_MFK == 1323 * MiB && WS_MFV == 1324 * MiB, "EpiQKV hard-coded map");
static_assert(OFF_KP == 67633152 && OFF_VP == 202113024 && OFF_KS == 336838656 && OFF_VS == 337887232, "EpiQKV hard-coded output offsets");
```

```cpp
#include <hip/hip_runtime.h>
#include <hip/hip_cooperative_groups.h>
#include <hip/hip_bf16.h>
#include <cstdio>
#include <cstdint>
namespace cg = cooperative_groups;
namespace pg8 {
#define PG8_LAS __attribute__((address_space(3)))
typedef unsigned short bf16_t;
typedef short bf16x8 __attribute__((ext_vector_type(8)));
typedef float f32x4 __attribute__((ext_vector_type(4)));
typedef unsigned u32x4 __attribute__((ext_vector_type(4)));
constexpr int BM = 256, BK = 64, HALF = 128, HTB = HALF * BK * 2  , STAGE_BYTES = 8 * HTB, NXCD = 8, WGM = 8;

__host__ __device__ __forceinline__ int lds_byte(int r, int c) { const int st = (r >> 4) * 2 + (c >> 5), rr = r & 15, cc = c & 31, ob = rr * 64 + cc * 2; return st * 1024 + (ob ^ (((ob >> 9) & 1) << 5)); }
__host__ __device__ __forceinline__ void stage_rc(int b, int& R, int& C) { const int st = b / 1024, sb = b % 1024, swz = sb ^ (((sb >> 9) & 1) << 5); R = (st >> 1) * 16 + swz / 64; C = (st & 1) * 32 + (swz % 64) / 2; }
__host__ __device__ __forceinline__ int perm32(int rho) { const int n = rho >> 4, i = rho & 15; return 8 * (i >> 2) + 4 * n + (i & 3); }

struct Unit { int pm, pn, ko, nt, sp; };
struct Gemm { const bf16_t* A; const bf16_t* Bt; int M, N, K, lda, ldb, acs; };

struct StaticOrder {
    int nM, nN, nwg, G, c, ntf;
    __host__ __device__ void init(int M, int N, int G_, int c_, int K) { nM = M / BM; nN = N / BM; nwg = nM * nN; G = G_; c = c_; ntf = K / BK; }
    __host__ __device__ bool next(int i, Unit& u) const {
        const long L = (long)i * G + c; if (L >= nwg) return false;
        int wgid = (int)L; { const int q = nwg / NXCD, r = nwg % NXCD, xcd = wgid % NXCD, off = wgid / NXCD; wgid = (xcd < r ? xcd * (q + 1) : r * (q + 1) + (xcd - r) * q) + off; }
        const int nig = WGM * nN, gid = wgid / nig, fm = gid * WGM, gsz = (nM - fm) < WGM ? (nM - fm) : WGM;
        u.pm = fm + ((wgid % nig) % gsz); u.pn = (wgid % nig) / gsz; u.ko = 0; u.nt = ntf; u.sp = 0; return true;
    }
    __device__ __forceinline__ void a_ready(const Unit&) const {}
    __device__ __forceinline__ void done(const Unit&) const {}
};
struct TailOrder {
    StaticOrder mn; int KS, kc;
    __host__ __device__ void init(int N, int G_, int c_, int K, int KS_) { mn.init(65536, N, G_, c_, K); KS = KS_; kc = K / KS_; }
    __host__ __device__ bool next(int i, Unit& u) const {
        const long L = (long)i * mn.G + mn.c; if (L < mn.nwg) return mn.next(i, u);
        const int Lt = (int)(L - mn.nwg); if (Lt >= 3 * mn.nN * KS) return false;
        const int tile = Lt / KS, ks = Lt - tile * KS; u.pm = 256 + tile / mn.nN; u.pn = tile % mn.nN; u.ko = ks * kc; u.nt = kc / BK; u.sp = KS > 1 ? ks + 1 : 0; return true;
    }
    __device__ __forceinline__ void a_ready(const Unit&) const {}
    __device__ __forceinline__ void done(const Unit&) const {}
};

__device__ __forceinline__ unsigned cvt_pk_bf16(float lo, float hi) { unsigned r; asm volatile("v_cvt_pk_bf16_f32 %0, %1, %2" : "=v"(r) : "v"(lo), "v"(hi)); return r; }
template <int ACT  > struct EpiBf16 {
    static constexpr bool PERM = true, AFTER_DRAIN = false;
    bf16_t* O; int ldc; float* yf;
    __device__ __forceinline__ void operator()(const f32x4 (&acc)[2][2][4][2], const Unit& u, int wr, int wc, int fr, int fq) const {
        asm volatile("" : "+v"(fr), "+v"(fq));
        const int row0 = u.pm * BM + wr * 64 + fr; const int col0 = u.pn * BM + wc * 32 + 8 * fq;
#pragma unroll
        for (int ai = 0; ai < 2; ++ai)
#pragma unroll
            for (int m = 0; m < 4; ++m) { bf16_t* rowp = O + (size_t)(row0 + ai * HALF + m * 16) * ldc + col0;
#pragma unroll
                for (int bj = 0; bj < 2; ++bj) { f32x4 v0 = acc[ai][bj][m][0], v1 = acc[ai][bj][m][1];
                    if (ACT == 2) {
#pragma unroll
                        for (int e = 0; e < 4; ++e) { float a = fmaxf(v0[e], 0.f), b = fmaxf(v1[e], 0.f); v0[e] = a * a; v1[e] = b * b; } }
                    if (u.sp) { float* yr = yf + ((size_t)(u.sp - 1) * 768 + (size_t)(row0 + ai * HALF + m * 16 - 65536)) * 1024 + col0 + bj * HALF;
                        *(f32x4*)yr = v0; *(f32x4*)(yr + 4) = v1; }
                    else { u32x4 w; w.x = cvt_pk_bf16(v0[0], v0[1]); w.y = cvt_pk_bf16(v0[2], v0[3]); w.z = cvt_pk_bf16(v1[0], v1[1]); w.w = cvt_pk_bf16(v1[2], v1[3]);
                    *(u32x4*)(rowp + bj * HALF) = w; } } }
    }
};
struct EpiQKV {
    static constexpr bool PERM = true, AFTER_DRAIN = false;
    unsigned char* ws; float* out; int a;
    __device__ __forceinline__ void operator()(const f32x4 (&acc)[2][2][4][2], const Unit& u, int wr, int wc, int fr, int fq) const {
        const size_t MiB_ = 1u << 20;
        asm volatile("" : "+v"(fr), "+v"(fq));
        const int t3 = u.pn >> 2; const int colb = (u.pn & 3) * 256 + wc * 32 + 8 * fq;
        bf16_t* X; float* Fp = nullptr; int rbase, jump = 0, s0 = 0; float sc = 1.f;
        if (t3 == 0) { X = (bf16_t*)(ws + 213 * MiB_); rbase = u.pm * BM; sc = 0.125f * 1.4426950408889634f; }
        else if (u.pm < 256) { const int b = u.pm >> 5; rbase = b * 8208 + 16 + (u.pm & 31) * 256; X = (bf16_t*)(ws + (t3 == 1 ? 473 : 602) * MiB_);
            Fp = out + (t3 == 1 ? (size_t)67633152 : (size_t)202113024) + (size_t)a * 8 * 8208 * 1024 + (size_t)rbase * 1024; }
        else if (u.pm < 258) { s0 = (u.pm - 256) * 256; rbase = 1040 + s0; jump = 1040; X = (bf16_t*)(ws + (t3 == 1 ? 731 : 767) * MiB_) + (size_t)a * (9 * MiB_);
            Fp = out + (t3 == 1 ? (size_t)336838656 : (size_t)337887232) + (size_t)a * 512 * 1024 + (size_t)s0 * 1024; }
        else { rbase = 0; X = (bf16_t*)(ws + (t3 == 1 ? 803 : 804) * MiB_); Fp = (float*)(ws + (t3 == 1 ? 1323 : 1324) * MiB_); }
#pragma unroll
        for (int ai = 0; ai < 2; ++ai)
#pragma unroll
            for (int m = 0; m < 4; ++m) { const int rit = ai * HALF + wr * 64 + m * 16 + fr;
                bf16_t* xr = X + (unsigned)((rbase + rit + ((s0 + rit) >> 6) * jump) * 1024 + colb); float* fr_ = Fp + (unsigned)(rit * 1024 + colb);
#pragma unroll
                for (int bj = 0; bj < 2; ++bj) { const f32x4 v0 = acc[ai][bj][m][0], v1 = acc[ai][bj][m][1]; const f32x4 s0v = v0 * sc, s1v = v1 * sc;
                    u32x4 w; w.x = cvt_pk_bf16(s0v[0], s0v[1]); w.y = cvt_pk_bf16(s0v[2], s0v[3]); w.z = cvt_pk_bf16(s1v[0], s1v[1]); w.w = cvt_pk_bf16(s1v[2], s1v[3]);
                    *(u32x4*)(xr + bj * HALF) = w;
                    if (t3 != 0) { *(f32x4*)(fr_ + bj * HALF) = v0; *(f32x4*)(fr_ + bj * HALF + 4) = v1; } } }
    }
};
template <class Epi, class Sched, bool ALIGN_EPI = false, bool SP2 = false>
__device__ __forceinline__ void gemm_phase(PG8_LAS unsigned char* lds, const Gemm g, const Sched& S, const Epi& E, const int tid_in) {
    int tid_ = tid_in; asm volatile("" : "+v"(tid_));
    const int tid = tid_, wid = __builtin_amdgcn_readfirstlane(tid >> 6), lane = tid & 63, wr = wid >> 2, wc = wid & 3, fr = lane & 15, fq = lane >> 4;
    const int K = g.K; (void)K;
    unsigned voffA[2], voffB[2];
#pragma unroll
    for (int i = 0; i < 2; ++i) { int R, C; stage_rc(tid * 16 + i * 8192, R, C); const int Rb = Epi::PERM ? ((R & ~31) + perm32(R & 31)) : R;
        voffA[i] = (unsigned)(R * g.lda + C) * 2u; voffB[i] = (unsigned)(Rb * g.ldb + C) * 2u; }
    const size_t kstep = (size_t)(BK * 2);
    const size_t hstepA = (size_t)HALF * g.lda * 2, hstepB = (size_t)HALF * g.ldb * 2;
    const size_t tstepA = 2 * hstepA, tstepB = 2 * hstepB;
    const unsigned ldsw = (unsigned)wid * 1024u;
    const int aoff = lds_byte(wr * 64 + fr, fq * 8), boff = lds_byte(wc * 32 + fr, fq * 8);
#define PG8_SA(b, h) (((b) * 2 + (h)) * HTB)
#define PG8_SB(b, h) ((4 + (b) * 2 + (h)) * HTB)
#define PG8_STAGE(bufoff, gbase, voff) do { _Pragma("unroll") for (int _i = 0; _i < 2; ++_i) \
        __builtin_amdgcn_global_load_lds((const unsigned*)((const char*)(gbase) + (voff)[_i]), (PG8_LAS unsigned*)(lds + (bufoff) + ldsw + _i * 8192), 16, 0, 0); } while (0)
#define PG8_LDA(dst, b, h) do { _Pragma("unroll") for (int m = 0; m < 4; ++m) _Pragma("unroll") for (int k = 0; k < 2; ++k) dst[m][k] = *(const PG8_LAS bf16x8*)(lds + PG8_SA(b, h) + aoff + m * 2048 + k * 1024); } while (0)
#define PG8_LDB(dst, b, h) do { _Pragma("unroll") for (int n = 0; n < 2; ++n) _Pragma("unroll") for (int k = 0; k < 2; ++k) dst[n][k] = *(const PG8_LAS bf16x8*)(lds + PG8_SB(b, h) + boff + n * 2048 + k * 1024); } while (0)
#define PG8_MMA(ai, bj, At, Bt) do { __builtin_amdgcn_s_setprio(1); _Pragma("unroll") for (int m = 0; m < 4; ++m) _Pragma("unroll") for (int n = 0; n < 2; ++n) _Pragma("unroll") for (int k = 0; k < 2; ++k) \
        acc[ai][bj][m][n] = __builtin_amdgcn_mfma_f32_16x16x32_bf16(Bt[n][k], At[m][k], acc[ai][bj][m][n], 0, 0, 0); __builtin_amdgcn_s_setprio(0); } while (0)
#define PG8_WAIT_V(n) asm volatile("s_waitcnt vmcnt(" #n ")" ::: "memory")
#define PG8_WAIT_L(n) asm volatile("s_waitcnt lgkmcnt(" #n ")" ::: "memory")
#define PG8_BAR __builtin_amdgcn_s_barrier()
#define PG8_SCHED __builtin_amdgcn_sched_barrier(0)
    Unit cur, nxt; int ui = 0;
    if (!S.next(0, cur)) return;
    f32x4 acc[2][2][4][2];
#pragma unroll
    for (int a = 0; a < 2; ++a)
#pragma unroll
        for (int b = 0; b < 2; ++b)
#pragma unroll
            for (int m = 0; m < 4; ++m)
#pragma unroll
                for (int n = 0; n < 2; ++n) acc[a][b][m][n] = (f32x4){0.f, 0.f, 0.f, 0.f};
    bf16x8 At[4][2], B0[2][2], B1[2][2];
    const char* cA = (const char*)g.A + (size_t)cur.pm * tstepA + (size_t)cur.pn * g.acs + (size_t)cur.ko * 2; const char* cB = (const char*)g.Bt + (size_t)cur.pn * tstepB + (size_t)cur.ko * 2;
    S.a_ready(cur);
    if constexpr (SP2) {
        PG8_STAGE(PG8_SB(0, 0), cB, voffB); PG8_STAGE(PG8_SB(0, 1), cB + hstepB, voffB); PG8_STAGE(PG8_SA(0, 0), cA, voffA); PG8_STAGE(PG8_SA(0, 1), cA + hstepA, voffA);
        if (wr == 1) PG8_BAR;
        PG8_WAIT_V(2); PG8_BAR;
        PG8_STAGE(PG8_SB(1, 0), cB + kstep, voffB); PG8_STAGE(PG8_SA(1, 0), cA + kstep, voffA); PG8_STAGE(PG8_SB(1, 1), cB + hstepB + kstep, voffB);
        PG8_WAIT_V(6); PG8_BAR;
    } else {
        PG8_STAGE(PG8_SB(0, 0), cB, voffB); PG8_STAGE(PG8_SA(0, 0), cA, voffA); PG8_STAGE(PG8_SB(0, 1), cB + hstepB, voffB); PG8_STAGE(PG8_SA(0, 1), cA + hstepA, voffA);
        if (wr == 1) PG8_BAR;
        PG8_WAIT_V(4); PG8_BAR;
        PG8_STAGE(PG8_SB(1, 0), cB + kstep, voffB); PG8_STAGE(PG8_SA(1, 0), cA + kstep, voffA); PG8_STAGE(PG8_SB(1, 1), cB + hstepB + kstep, voffB);
        PG8_WAIT_V(6); PG8_BAR;
    }
    for (;;) {
        const bool has_next = S.next(ui + 1, nxt);
        const char* nA = has_next ? (const char*)g.A + (size_t)nxt.pm * tstepA + (size_t)nxt.pn * g.acs + (size_t)nxt.ko * 2 : cA; const char* nB = has_next ? (const char*)g.Bt + (size_t)nxt.pn * tstepB + (size_t)nxt.ko * 2 : cB;
        const int nt = cur.nt;
        for (int t = 0; t < nt; t += 2) {
            const bool last = (t == nt - 2);
            const char* a1 = cA + (size_t)(t + 1) * kstep;
            const char* a2 = last ? nA : cA + (size_t)(t + 2) * kstep; const char* b2 = last ? nB : cB + (size_t)(t + 2) * kstep;
            const char* a3 = a2 + kstep; const char* b3 = b2 + kstep;
            if (last && has_next) S.a_ready(nxt);
            if constexpr (SP2) {
            PG8_LDB(B0, 0, 0); PG8_LDB(B1, 0, 1); PG8_SCHED; PG8_LDA(At, 0, 0); PG8_STAGE(PG8_SA(1, 1), a1 + hstepA, voffA);
            PG8_WAIT_V(8); PG8_WAIT_L(0); PG8_BAR; PG8_MMA(0, 0, At, B0); PG8_MMA(0, 1, At, B1); PG8_BAR; PG8_SCHED;
            PG8_LDA(At, 0, 1); PG8_STAGE(PG8_SB(0, 0), b2, voffB); PG8_STAGE(PG8_SB(0, 1), b2 + hstepB, voffB); PG8_STAGE(PG8_SA(0, 0), a2, voffA);
            PG8_WAIT_V(8); PG8_WAIT_L(0); PG8_BAR; PG8_MMA(1, 0, At, B0); PG8_MMA(1, 1, At, B1); PG8_BAR; PG8_SCHED;
            PG8_LDB(B0, 1, 0); PG8_LDB(B1, 1, 1); PG8_SCHED; PG8_LDA(At, 1, 0); PG8_STAGE(PG8_SA(0, 1), a2 + hstepA, voffA);
            PG8_WAIT_V(8); PG8_WAIT_L(0); PG8_BAR; PG8_MMA(0, 0, At, B0); PG8_MMA(0, 1, At, B1); PG8_BAR; PG8_SCHED;
            PG8_LDA(At, 1, 1); PG8_STAGE(PG8_SB(1, 0), b3, voffB); PG8_STAGE(PG8_SB(1, 1), b3 + hstepB, voffB); PG8_STAGE(PG8_SA(1, 0), a3, voffA);
            PG8_WAIT_V(8); PG8_WAIT_L(0); PG8_BAR; PG8_MMA(1, 0, At, B0); PG8_MMA(1, 1, At, B1); PG8_BAR; PG8_SCHED;
            } else {
            PG8_LDB(B0, 0, 0); PG8_SCHED; PG8_LDA(At, 0, 0); PG8_STAGE(PG8_SA(1, 1), a1 + hstepA, voffA);
            PG8_WAIT_L(8); PG8_BAR; PG8_WAIT_L(0); PG8_MMA(0, 0, At, B0); PG8_BAR; PG8_SCHED;
            PG8_LDB(B1, 0, 1); PG8_STAGE(PG8_SB(0, 0), b2, voffB);
            PG8_BAR; PG8_WAIT_L(0); PG8_MMA(0, 1, At, B1); PG8_BAR;
            PG8_LDA(At, 0, 1); PG8_STAGE(PG8_SA(0, 0), a2, voffA);
            PG8_BAR; PG8_WAIT_L(0); PG8_MMA(1, 0, At, B0); PG8_BAR; PG8_SCHED;
            PG8_STAGE(PG8_SB(0, 1), b2 + hstepB, voffB);
            PG8_WAIT_V(6); PG8_BAR; PG8_MMA(1, 1, At, B1); PG8_BAR;
            PG8_LDB(B0, 1, 0); PG8_SCHED; PG8_LDA(At, 1, 0); PG8_STAGE(PG8_SA(0, 1), a2 + hstepA, voffA);
            PG8_WAIT_L(8); PG8_BAR; PG8_WAIT_L(0); PG8_MMA(0, 0, At, B0); PG8_BAR; PG8_SCHED;
            PG8_LDB(B1, 1, 1); PG8_STAGE(PG8_SB(1, 0), b3, voffB);
            PG8_BAR; PG8_WAIT_L(0); PG8_MMA(0, 1, At, B1); PG8_BAR;
            PG8_LDA(At, 1, 1); PG8_STAGE(PG8_SA(1, 0), a3, voffA);
            PG8_BAR; PG8_WAIT_L(0); PG8_MMA(1, 0, At, B0); PG8_BAR; PG8_SCHED;
            PG8_STAGE(PG8_SB(1, 1), b3 + hstepB, voffB);
            PG8_WAIT_V(6); PG8_BAR; PG8_MMA(1, 1, At, B1); PG8_BAR;
            }
        }
        if constexpr (ALIGN_EPI) { if (wr == 0) PG8_BAR; }
        if constexpr (!Epi::AFTER_DRAIN) { E(acc, cur, wr, wc, fr, fq); S.done(cur); }
        if (!has_next) break;
#pragma unroll
        for (int a = 0; a < 2; ++a)
#pragma unroll
            for (int b = 0; b < 2; ++b)
#pragma unroll
                for (int m = 0; m < 4; ++m)
#pragma unroll
                    for (int n = 0; n < 2; ++n) acc[a][b][m][n] = (f32x4){0.f, 0.f, 0.f, 0.f};
        cur = nxt; cA = nA; cB = nB; ++ui;
        if constexpr (ALIGN_EPI) { if (wr == 1) PG8_BAR; }
    }
    PG8_WAIT_V(0);
    if constexpr (!ALIGN_EPI) { if (wr == 0) PG8_BAR; }
    PG8_BAR;
    if constexpr (Epi::AFTER_DRAIN) { E.fused(acc, cur, wr, wc, fr, fq, lds, wid, lane); S.done(cur); }
#undef PG8_SA
#undef PG8_SB
#undef PG8_STAGE
#undef PG8_LDA
#undef PG8_LDB
#undef PG8_MMA
#undef PG8_WAIT_V
#undef PG8_WAIT_L
#undef PG8_BAR
#undef PG8_SCHED
}
}
#define LAS __attribute__((address_space(3)))
#define GAS __attribute__((address_space(1)))
typedef unsigned short bf16;
typedef unsigned u32x4 __attribute__((ext_vector_type(4)));
typedef unsigned u32x2 __attribute__((ext_vector_type(2)));
typedef float f32x4 __attribute__((ext_vector_type(4)));
typedef float f32x2 __attribute__((ext_vector_type(2)));
typedef float f32x16 __attribute__((ext_vector_type(16)));
typedef short bf16x8 __attribute__((ext_vector_type(8)));
typedef short s16x4 __attribute__((ext_vector_type(4)));
constexpr int D = 1024, FF = 4096, NH = 8;
constexpr int ROW_S = 65536, ROW_M = 66048, ROWS_VALID = 66064, MPAD = 66304;
constexpr int EXT_P = 8208, EXT_S = 1104;
constexpr float LOG2E = 1.4426950408889634f;
constexpr float QSCALE = 0.125f * LOG2E;
constexpr float EPS = 1e-6f, SUBLN_EPS = 1e-5f;
constexpr size_t OFF_YP = 0, OFF_YS = 67108864, OFF_KP = OFF_YS + 524288, OFF_VP = OFF_KP + 134479872, OFF_PP = OFF_VP + 134479872,
                 OFF_KS = OFF_PP + 245760, OFF_VS = OFF_KS + 1048576, OFF_PS = OFF_VS + 1048576, OUT_TOTAL = OFF_PS + 245760;
constexpr size_t MiB = 1u << 20;
constexpr size_t WS_WQKV = 1 * MiB, WS_WO = 13 * MiB, WS_WPOOL = 17 * MiB, WS_WUP = 18 * MiB, WS_WDN = 50 * MiB, WS_XM = 82 * MiB,
                 WS_XN = 83 * MiB, WS_QB = 213 * MiB, WS_YB = 343 * MiB, WS_KX = 473 * MiB, WS_VX = 602 * MiB, WS_KXS = 731 * MiB, WS_VXS = 767 * MiB,
                 WS_KXM = 803 * MiB, WS_VXM = 804 * MiB, WS_U = 805 * MiB, WS_MFK = 1323 * MiB, WS_MFV = 1324 * MiB, WS_YF = 1325 * MiB, WS_END = 1373 * MiB;
constexpr size_t KXS_LAYER = 18 * MiB / 2;
constexpr int LDS_BYTES = 147456;
constexpr int NSTEPS = 27;
#ifndef ONE_LAUNCH
#define ONE_LAUNCH 1
#endif

__device__ __forceinline__ unsigned f2bf(float f) { unsigned u = __builtin_bit_cast(unsigned, f); return (u + 0x7fffu + ((u >> 16) & 1u)) >> 16; }
__device__ __forceinline__ unsigned pk2(float lo, float hi) { return f2bf(lo) | (f2bf(hi) << 16); }
__device__ __forceinline__ float bflo(unsigned w) { return __builtin_bit_cast(float, w << 16); }
__device__ __forceinline__ float bfhi(unsigned w) { return __builtin_bit_cast(float, w & 0xffff0000u); }
__device__ __forceinline__ float wave_sum(float v) {
#pragma unroll
    for (int o = 1; o < 64; o <<= 1) v += __shfl_xor(v, o);
    return v;
}

struct Args { const float* in[22]; float* out; unsigned char* ws; int lo, hi; };
typedef const __attribute__((address_space(4))) Args& ArgsRef;
__device__ __forceinline__ int mk_tid(int wv) { int t; asm volatile("v_mbcnt_lo_u32_b32 %0, -1, 0\n\tv_mbcnt_hi_u32_b32 %0, -1, %0" : "=v"(t)); return wv * 64 + t; }
struct Frame {
    LAS unsigned char* lds; int tid, lane, wave, vcu, G;
    float* out; unsigned char* ws;
};

__device__ __forceinline__ void transpose_item(const float* W, int K, int N, bf16* WT, LAS float* scr, int item, int lane, const float* nscale) {
    const int nblk = N / 32, kb = item / nblk, nb = item % nblk, k0 = 64 * kb, n0 = 32 * nb;
#pragma unroll
    for (int i = 0; i < 32; ++i) { const int kk = 2 * i + (lane >> 5); scr[kk * 33 + (lane & 31)] = W[(size_t)(k0 + kk) * N + n0 + (lane & 31)]; }
    asm volatile("s_waitcnt lgkmcnt(0)" ::: "memory");
    const int c = lane & 7;
#pragma unroll
    for (int j = 0; j < 4; ++j) { const int n = (lane >> 3) + 8 * j; const LAS float* s = scr + (8 * c) * 33 + n; const float sc = nscale ? nscale[n0 + n] : 1.f;
        u32x4 o; o.x = pk2(s[0 * 33] * sc, s[1 * 33] * sc); o.y = pk2(s[2 * 33] * sc, s[3 * 33] * sc); o.z = pk2(s[4 * 33] * sc, s[5 * 33] * sc); o.w = pk2(s[6 * 33] * sc, s[7 * 33] * sc);
        *(u32x4*)(WT + (size_t)(n0 + n) * K + k0 + 8 * c) = o; }
    asm volatile("s_waitcnt lgkmcnt(0)" ::: "memory");
}
__device__ __forceinline__ const float* xin_row(ArgsRef A, int row) {
    return row < ROW_S ? A.in[0] + (size_t)row * D : row < ROW_M ? A.in[1] + (size_t)(row - ROW_S) * D : A.in[5] + (size_t)(row - ROW_M) * D;
}
__device__ __forceinline__ float* xres_row(const Frame& F, int row) {
    return row < ROW_S ? F.out + OFF_YP + (size_t)row * D : row < ROW_M ? F.out + OFF_YS + (size_t)(row - ROW_S) * D : (float*)(F.ws + WS_XM) + (size_t)(row - ROW_M) * D;
}
__device__ __forceinline__ void prologue(ArgsRef A, Frame& F) {
    { const int t_ = mk_tid(F.wave); F.tid = t_; F.lane = t_ & 63; }
    LAS float* scr = (LAS float*)(F.lds + F.wave * 16384);
    const int gw = F.vcu * 8 + F.wave, NGW = F.G * 8;
    constexpr int I_QKV = 16 * 96, I_O = 16 * 32, I_UP = 16 * 128, I_DN = 64 * 32, I_PL = 4 * 8;
    constexpr int NITEMS = 2 * I_QKV + 2 * I_O + 4 * I_UP + 4 * I_DN + 8 * I_PL;
    for (int it = gw; it < NITEMS; it += NGW) {
        int r = it;
        if (r < 2 * I_QKV) { const int a = r / I_QKV; transpose_item(A.in[11] + (size_t)a * D * 3072, D, 3072, (bf16*)(F.ws + WS_WQKV) + (size_t)a * 3072 * D, scr, r % I_QKV, F.lane, nullptr); continue; } r -= 2 * I_QKV;
        if (r < 2 * I_O) { const int a = r / I_O; transpose_item(A.in[17] + (size_t)a * D * D, D, D, (bf16*)(F.ws + WS_WO) + (size_t)a * D * D, scr, r % I_O, F.lane, nullptr); continue; } r -= 2 * I_O;
        if (r < 4 * I_UP) { const int i = r / I_UP; transpose_item(A.in[20] + (size_t)i * D * FF, D, FF, (bf16*)(F.ws + WS_WUP) + (size_t)i * D * FF, scr, r % I_UP, F.lane, nullptr); continue; } r -= 4 * I_UP;
        if (r < 4 * I_DN) { const int i = r / I_DN; transpose_item(A.in[21] + (size_t)i * D * FF, FF, D, (bf16*)(F.ws + WS_WDN) + (size_t)i * D * FF, scr, r % I_DN, F.lane, nullptr); continue; } r -= 4 * I_DN;
        { const int pg = r / I_PL; transpose_item(A.in[18] + (size_t)pg * 65536, 256, 256, (bf16*)(F.ws + WS_WPOOL) + (size_t)pg * 65536, scr, r % I_PL, F.lane, A.in[19] + pg * 256); }
    }
    for (int it0 = gw; it0 < 32768; it0 += 4 * NGW) {
        f32x4 v[4][4];
#pragma unroll
        for (int r4 = 0; r4 < 4; ++r4) { const int it = min(it0 + r4 * NGW, 32767); const int j = it & 1023, b = (it >> 10) & 7, kv = (it >> 13) & 1, a = it >> 14;
            const float* src = (kv ? A.in[3] : A.in[2]) + ((size_t)(a * 8 + b) * 1024 + j) * D;
#pragma unroll
            for (int q = 0; q < 4; ++q) v[r4][q] = *(const f32x4*)(src + 4 * F.lane + 256 * q); }
#pragma unroll
        for (int r4 = 0; r4 < 4; ++r4) { const int it = it0 + r4 * NGW; if (it < 32768) { const int j = it & 1023, b = (it >> 10) & 7, kv = (it >> 13) & 1, a = it >> 14;
            bf16* dst = (bf16*)(F.ws + (kv ? WS_VXS : WS_KXS)) + (size_t)a * KXS_LAYER + (size_t)(b * EXT_S + 16 + j) * D;
#pragma unroll
            for (int q = 0; q < 4; ++q) { u32x2 w; w.x = pk2(v[r4][q].x, v[r4][q].y); w.y = pk2(v[r4][q].z, v[r4][q].w); *(u32x2*)(dst + 4 * F.lane + 256 * q) = w; } } }
    }
    const float* g = A.in[7];
    for (int row = ROWS_VALID + gw; row < MPAD; row += NGW) { bf16* xn = (bf16*)(F.ws + WS_XN) + (size_t)row * D;
#pragma unroll
        for (int q = 0; q < 4; ++q) *(u32x2*)(xn + 4 * F.lane + 256 * q) = (u32x2){0u, 0u}; }
    const int RPC = (ROWS_VALID + F.G - 1) / F.G, rbeg = F.vcu * RPC, rend = min(rbeg + RPC, ROWS_VALID);
    for (int row0 = rbeg + F.wave; row0 < rend; row0 += 32) {
        f32x4 v[4][4]; float ss[4];
#pragma unroll
        for (int j = 0; j < 4; ++j) { const float* x = xin_row(A, min(row0 + j * 8, ROWS_VALID - 1)); ss[j] = 0.f;
#pragma unroll
            for (int q = 0; q < 4; ++q) v[j][q] = *(const f32x4*)(x + 4 * F.lane + 256 * q); }
#pragma unroll
        for (int j = 0; j < 4; ++j) {
#pragma unroll
            for (int q = 0; q < 4; ++q) ss[j] += v[j][q].x * v[j][q].x + v[j][q].y * v[j][q].y + v[j][q].z * v[j][q].z + v[j][q].w * v[j][q].w; }
#pragma unroll
        for (int o = 1; o < 64; o <<= 1) {
#pragma unroll
            for (int j = 0; j < 4; ++j) ss[j] += __shfl_xor(ss[j], o); }
#pragma unroll
        for (int j = 0; j < 4; ++j) { const int row = row0 + j * 8; const float r = 1.0f / sqrtf(ss[j] * (1.f / D) + EPS); bf16* xn = (bf16*)(F.ws + WS_XN) + (size_t)row * D;
#pragma unroll
            for (int q = 0; q < 4; ++q) { const f32x4 gg = *(const f32x4*)(g + 4 * F.lane + 256 * q); u32x2 w; w.x = pk2(v[j][q].x * r * gg.x, v[j][q].y * r * gg.y); w.y = pk2(v[j][q].z * r * gg.z, v[j][q].w * r * gg.w);
                if (row < rend) *(u32x2*)(xn + 4 * F.lane + 256 * q) = w; } }
    }
}
__device__ __forceinline__ void fin_phase(ArgsRef A, Frame& F, bool from_inputs, const int nks  , const float* gpost, const float* gnext) {
    { const int t_ = mk_tid(F.wave); F.tid = t_; F.lane = t_ & 63; }
    constexpr int FR = 4;
    const int gw = F.vcu * 8 + F.wave, NGW = F.G * 8;
    const bf16* YB = (const bf16*)(F.ws + WS_YB);
    const int lo4 = 4 * F.lane;
    const int RPC = (ROW_S + F.G - 1) / F.G, rbeg = F.vcu * RPC, rend = min(rbeg + RPC, ROW_S);
    for (int row0 = rbeg + F.wave; row0 < rend; row0 += 8 * FR) {
        f32x4 yv[FR][4], xv[FR][4]; float ss[FR];
#pragma unroll
        for (int j = 0; j < FR; ++j) { const int row = min(row0 + j * 8, ROWS_VALID - 1); const bf16* y = YB + (size_t)row * D; const float* xi = from_inputs ? xin_row(A, row) : xres_row(F, row); ss[j] = 0.f;
#pragma unroll
            for (int q = 0; q < 4; ++q) {
                { const u32x2 w = *(const u32x2*)(y + lo4 + 256 * q); yv[j][q] = (f32x4){bflo(w.x), bfhi(w.x), bflo(w.y), bfhi(w.y)}; }
                xv[j][q] = *(const f32x4*)(xi + lo4 + 256 * q); } }
#pragma unroll
        for (int j = 0; j < FR; ++j) {
#pragma unroll
            for (int q = 0; q < 4; ++q) ss[j] += yv[j][q].x * yv[j][q].x + yv[j][q].y * yv[j][q].y + yv[j][q].z * yv[j][q].z + yv[j][q].w * yv[j][q].w; }
#pragma unroll
        for (int o = 1; o < 64; o <<= 1) {
#pragma unroll
            for (int j = 0; j < FR; ++j) ss[j] += __shfl_xor(ss[j], o); }
        float s2[FR];
#pragma unroll
        for (int j = 0; j < FR; ++j) { const int row = row0 + j * 8; const float r = 1.0f / sqrtf(ss[j] * (1.f / D) + EPS); s2[j] = 0.f;
#pragma unroll
            for (int q = 0; q < 4; ++q) { const f32x4 gg = *(const f32x4*)(gpost + lo4 + 256 * q); xv[j][q] = xv[j][q] + yv[j][q] * r * gg;
                if (row < rend) *(f32x4*)(xres_row(F, row) + lo4 + 256 * q) = xv[j][q];
                s2[j] += xv[j][q].x * xv[j][q].x + xv[j][q].y * xv[j][q].y + xv[j][q].z * xv[j][q].z + xv[j][q].w * xv[j][q].w; } }
        if (gnext) {
#pragma unroll
            for (int o = 1; o < 64; o <<= 1) {
#pragma unroll
                for (int j = 0; j < FR; ++j) s2[j] += __shfl_xor(s2[j], o); }
#pragma unroll
            for (int j = 0; j < FR; ++j) { const int row = row0 + j * 8; const float r2 = 1.0f / sqrtf(s2[j] * (1.f / D) + EPS); bf16* xn = (bf16*)(F.ws + WS_XN) + (size_t)row * D;
#pragma unroll
                for (int q = 0; q < 4; ++q) { const f32x4 gg = *(const f32x4*)(gnext + lo4 + 256 * q); u32x2 w; w.x = pk2(xv[j][q].x * r2 * gg.x, xv[j][q].y * r2 * gg.y); w.y = pk2(xv[j][q].z * r2 * gg.z, xv[j][q].w * r2 * gg.w);
                    if (row < rend) *(u32x2*)(xn + lo4 + 256 * q) = w; } }
        }
    }
    for (int row = ROW_S + gw; row < ROWS_VALID; row += NGW) {
        const float* xi = from_inputs ? xin_row(A, row) : xres_row(F, row); float* xo = xres_row(F, row);
        f32x4 yv[4], xv[4]; float ss = 0.f;
#pragma unroll
        for (int q = 0; q < 4; ++q) {
            if (nks == 0) { const u32x2 w = *(const u32x2*)(YB + (size_t)row * D + lo4 + 256 * q); yv[q] = (f32x4){bflo(w.x), bfhi(w.x), bflo(w.y), bfhi(w.y)}; }
            else { const float* yf = (const float*)(F.ws + WS_YF) + (size_t)(row - ROW_S) * D + lo4 + 256 * q; yv[q] = *(const f32x4*)yf; for (int k = 1; k < nks; ++k) yv[q] += *(const f32x4*)(yf + (size_t)k * 768 * D); }
            xv[q] = *(const f32x4*)(xi + lo4 + 256 * q); ss += yv[q].x * yv[q].x + yv[q].y * yv[q].y + yv[q].z * yv[q].z + yv[q].w * yv[q].w; }
        const float r = 1.0f / sqrtf(wave_sum(ss) * (1.f / D) + EPS); float s2 = 0.f;
#pragma unroll
        for (int q = 0; q < 4; ++q) { const f32x4 gg = *(const f32x4*)(gpost + lo4 + 256 * q); xv[q] = xv[q] + yv[q] * r * gg; *(f32x4*)(xo + lo4 + 256 * q) = xv[q];
            s2 += xv[q].x * xv[q].x + xv[q].y * xv[q].y + xv[q].z * xv[q].z + xv[q].w * xv[q].w; }
        if (gnext) { const float r2 = 1.0f / sqrtf(wave_sum(s2) * (1.f / D) + EPS); bf16* xn = (bf16*)(F.ws + WS_XN) + (size_t)row * D;
#pragma unroll
            for (int q = 0; q < 4; ++q) { const f32x4 gg = *(const f32x4*)(gnext + lo4 + 256 * q); u32x2 w; w.x = pk2(xv[q].x * r2 * gg.x, xv[q].y * r2 * gg.y); w.y = pk2(xv[q].z * r2 * gg.z, xv[q].w * r2 * gg.w);
                *(u32x2*)(xn + lo4 + 256 * q) = w; } }
    }
}
__device__ __forceinline__ f32x2 pool_h(ArgsRef A, const Frame& F, int grp, int b, int t, int col, int p) {
    const bf16* XN = (const bf16*)(F.ws + WS_XN);
    if (t >= 0) { const int row = grp == 0 ? b * 8192 + t : grp == 1 ? ROW_S + b * 64 + t : ROW_M + t; const unsigned w = *(const unsigned*)(XN + (size_t)row * D + col); return (f32x2){bflo(w), bfhi(w)}; }
    if (grp == 0) { const unsigned w = *(const unsigned*)(XN + (size_t)(ROW_M + 16 + t) * D + col); return (f32x2){bflo(w), bfhi(w)}; }
    if (grp == 1) return *(const f32x2*)(A.in[4] + ((size_t)(p * 8 + b) * 15 + 15 + t) * D + col);
    return (f32x2){0.f, 0.f};
}
__device__ __forceinline__ void pool_phase(ArgsRef A, Frame& F, int p) {
    { const int t_ = mk_tid(F.wave); F.tid = t_; F.lane = t_ & 63; }
    bf16* DB = (bf16*)(F.ws + WS_QB);
    const int col = 2 * F.tid, w = 2 << (col >> 8);
    for (int it = F.vcu; it < 2065; it += F.G) {
        int grp, b, t0, nr;
        if (it < 2048) { grp = 0; b = it >> 8; t0 = (it & 255) * 32; nr = 32; } else if (it < 2064) { const int s = it - 2048; grp = 1; b = s >> 1; t0 = (s & 1) * 32; nr = 32; } else { grp = 2; b = 0; t0 = 0; nr = 16; }
        f32x2 h[47];
#pragma unroll
        for (int i = 0; i < 47; ++i) h[i] = (i - 15 < nr) ? pool_h(A, F, grp, b, t0 - 15 + i, col, p) : (f32x2){0.f, 0.f};
        f32x2 sum = {0.f, 0.f};
#pragma unroll
        for (int j = 1; j < 16; ++j) if (j < w) sum += h[15 - j];
#pragma unroll
        for (int i = 0; i < 32; ++i) { const int t = t0 + i;
            if (i < nr) {
                const f32x2 cur = h[15 + i]; sum += cur;
                const float inv = 1.0f / (float)(grp == 2 ? min(t + 1, w) : w);
                const int row = grp == 0 ? b * 8192 + t : grp == 1 ? ROW_S + b * 64 + t : ROW_M + t;
                *(unsigned*)(DB + (size_t)row * D + col) = pk2(sum.x * inv - cur.x, sum.y * inv - cur.y);
                const f32x2 old = (w == 2) ? h[15 + i - 1] : (w == 4) ? h[15 + i - 3] : (w == 8) ? h[15 + i - 7] : h[15 + i - 15];
                sum -= old;
                if (grp == 0 && t >= 8177) *(f32x2*)(F.out + OFF_PP + ((size_t)(p * 8 + b) * 15 + (t - 8177)) * D + col) = cur;
                if (grp == 1 && t >= 49) *(f32x2*)(F.out + OFF_PS + ((size_t)(p * 8 + b) * 15 + (t - 49)) * D + col) = cur;
            }
        }
    }
}

namespace att {
constexpr int KSTR = 272;
constexpr int TB = 16384;
constexpr int OFF_K0 = 0, OFF_K1 = TB, OFF_V0 = 2 * TB, OFF_V1 = 3 * TB, OFF_BT = 4 * TB, OFF_GT = OFF_BT + 2048, OFF_Q = 5 * TB, XB = 16384;
static_assert(OFF_BT >= 4 * XB && OFF_GT + 512 <= OFF_Q && OFF_Q + 2 * TB <= 131072, "attention LDS map");
constexpr float THR = 48.0f;
constexpr float NEG = -1e30f;
struct AUnit { const bf16* K; const bf16* V; const bf16* KM; const bf16* VM; const bf16* Q; bf16* O; int P, L, x, h; };
__device__ __forceinline__ float max3f(float a, float b, float c) { float r; asm("v_max3_f32 %0, %1, %2, %3" : "=v"(r) : "v"(a), "v"(b), "v"(c)); return r; }
__device__ __forceinline__ float swapmax(float v) { auto rr = __builtin_amdgcn_permlane32_swap(__float_as_uint(v), __float_as_uint(v), false, false); return fmaxf(__uint_as_float(rr[0]), __uint_as_float(rr[1])); }
__device__ __forceinline__ float swapsum(float v) { auto rr = __builtin_amdgcn_permlane32_swap(__float_as_uint(v), __float_as_uint(v), false, false); return __uint_as_float(rr[0]) + __uint_as_float(rr[1]); }
typedef __bf16 bf16x2_t __attribute__((ext_vector_type(2)));
__device__ __forceinline__ unsigned cvtpk(float lo, float hi) { f32x2 v = {lo, hi}; bf16x2_t b = __builtin_convertvector(v, bf16x2_t); return __builtin_bit_cast(unsigned, b); }
__device__ __forceinline__ s16x4 vtr(const LAS unsigned char* p) { return __builtin_bit_cast(s16x4, __builtin_amdgcn_ds_read_tr16_b64_v4i16((LAS s16x4*)p)); }
__device__ __forceinline__ void glds16(const void* gsrc, unsigned lds_dst) { unsigned keep;
    asm volatile("s_mov_b32 %0, m0\n\ts_mov_b32 m0, %2\n\ts_nop 0\n\tglobal_load_lds_dwordx4 %1, off\n\ts_mov_b32 m0, %0" : "=&s"(keep) : "v"(gsrc), "s"(lds_dst) : "memory"); }
__device__ __forceinline__ bf16x8 pack8(const f32x16& S, int o) {
    u32x4 w; w.x = cvtpk(S[o], S[o + 1]); w.y = cvtpk(S[o + 2], S[o + 3]); w.z = cvtpk(S[o + 4], S[o + 5]); w.w = cvtpk(S[o + 6], S[o + 7]); return __builtin_bit_cast(bf16x8, w);
}

__device__ __forceinline__ void attn_unit(const int wv, LAS unsigned char* lds, const AUnit& u, const float* lq1, const float* lk1, const float* lq2, const float* lk2, const int layer_a, const float* relb, const float* subg) {
    const int tid = mk_tid(wv), lane = tid & 63, wid = wv, mp = wid >> 2, rg = wid & 3, q32 = lane & 31, hi = lane >> 5;
    LAS float* BT = (LAS float*)(lds + OFF_BT); LAS float* GT = (LAS float*)(lds + OFF_GT);
    {
        const float b15 = relb[15 * 8 + u.h];
        if (tid < 448) { const int rel = tid - 192, n = rel < 0 ? -rel : rel;
            int bk = n < 8 ? n : n < 12 ? 8 : n < 16 ? 9 : n < 23 ? 10 : n < 32 ? 11 : n < 46 ? 12 : n < 64 ? 13 : n < 91 ? 14 : 15; if (rel > 0) bk += 16;
            BT[tid] = (relb[bk * 8 + u.h] - b15) * LOG2E; }
        if (tid >= 384) GT[tid - 384] = subg[tid - 384] * (layer_a == 0 ? 0.8f : 0.52928698f);
    }
    const int vrows = min(128, u.L - 128 * u.x);
    const bool active = rg * 32 < vrows;
    const int ch = rg >> 1;
    const int NTw = active ? (u.P + min((2 * u.x + ch + 1) * 64, u.L) + 48) >> 6 : 0;
    const int NT = (u.P + min((2 * u.x + 2) * 64, u.L) + 48) >> 6;
    const int eq0 = u.P + 128 * u.x + rg * 32, eq = eq0 + q32;
    const unsigned lds0 = (unsigned)(size_t)lds;
    unsigned goff[2];
#pragma unroll
    for (int j = 0; j < 2; ++j) { const int row = wid * 8 + 4 * j + (lane >> 4), x = ((row & 3) << 2) | ((row >> 2) & 3), c = (lane & 15) ^ x; goff[j] = (unsigned)(row * 1024 + u.h * 128 + c * 8); }
    const unsigned ldst = (unsigned)wid * 2048u;
#define ATT_DMA(base, bufoff) do { _Pragma("unroll") for (int j_ = 0; j_ < 2; ++j_) \
        glds16((base) + goff[j_], (unsigned)__builtin_amdgcn_readfirstlane((int)(lds0 + (unsigned)(bufoff) + ldst + j_ * 1024))); } while (0)
#define ATT_ISSUE_K(t, bufoff) do { const bf16* b_ = ((t) == 0 && wid < 2) ? u.KM : u.K + (size_t)(t) * 65536; ATT_DMA(b_, bufoff); } while (0)
#define ATT_ISSUE_V(t, bufoff) do { const bf16* b_ = ((t) == 0 && wid < 2) ? u.VM : u.V + (size_t)(t) * 65536; ATT_DMA(b_, bufoff); } while (0)
#define ATT_WAITBAR() do { asm volatile("s_waitcnt vmcnt(0) lgkmcnt(0)" ::: "memory"); __builtin_amdgcn_s_barrier(); asm volatile("" ::: "memory"); } while (0)
    unsigned koff[4];
    { const int x = ((q32 & 3) << 2) | ((q32 >> 2) & 3);
#pragma unroll
      for (int d0 = 0; d0 < 4; ++d0) koff[d0] = lds0 + (unsigned)(q32 * 256 + (((mp * 8 + 2 * d0 + hi) ^ x) << 4)); }
    unsigned vofs[4][2];
    { const int qq = (lane & 15) >> 2, cl = 2 * ((lane >> 4) & 1) + ((lane & 3) >> 1), sub = 8 * (lane & 1);
#pragma unroll
      for (int dvb = 0; dvb < 4; ++dvb)
#pragma unroll
          for (int hf = 0; hf < 2; ++hf) vofs[dvb][hf] = lds0 + (unsigned)((8 * hf + 4 * hi + qq) * 256 + ((((dvb ^ qq) << 2) | (cl ^ (2 * hf + hi))) << 4) + sub); }
    {
        const bf16* qb_ = u.Q + (size_t)(128 * u.x + wid * 16) * 1024;
#pragma unroll
        for (int j = 0; j < 4; ++j) { const int row = 4 * j + (lane >> 4), x = ((row & 3) << 2) | ((row >> 2) & 3), c = (lane & 15) ^ x;
            glds16(qb_ + row * 1024 + u.h * 128 + c * 8, (unsigned)__builtin_amdgcn_readfirstlane((int)(lds0 + OFF_Q + wid * 4096 + j * 1024))); }
    }
    ATT_ISSUE_K(0, OFF_K0); ATT_ISSUE_V(0, OFF_V0); if (NT > 1) ATT_ISSUE_K(1, OFF_K1);
    ATT_WAITBAR();
    f32x16 O[4];
#pragma unroll
    for (int i = 0; i < 4; ++i)
#pragma unroll
        for (int r = 0; r < 16; ++r) O[i][r] = 0.f;
    float m = 0.f, l = 0.f;
    f32x16 SA0, SA1, SB0, SB1;
    const f32x16 zero16 = {0.f, 0.f, 0.f, 0.f, 0.f, 0.f, 0.f, 0.f, 0.f, 0.f, 0.f, 0.f, 0.f, 0.f, 0.f, 0.f};
#define ATT_SB() __builtin_amdgcn_sched_barrier(0)
#define ATT_QK(S0_, S1_, kbufoff) do { unsigned qsh_ = (unsigned)(OFF_Q + rg * 8192); asm volatile("" : "+s"(qsh_));     \
        bf16x8 kfa[4], kfb[4], qfr[4]; \
        _Pragma("unroll") for (int d0 = 0; d0 < 4; ++d0) { kfa[d0] = *(const LAS bf16x8*)(size_t)(koff[d0] + (unsigned)(kbufoff)); kfb[d0] = *(const LAS bf16x8*)(size_t)(koff[d0] + (unsigned)(kbufoff) + 8192u); qfr[d0] = *(const LAS bf16x8*)(size_t)(koff[d0] + qsh_); } \
        ATT_SB(); \
        S0_ = __builtin_amdgcn_mfma_f32_32x32x16_bf16(kfa[0], qfr[0], zero16, 0, 0, 0); S1_ = __builtin_amdgcn_mfma_f32_32x32x16_bf16(kfb[0], qfr[0], zero16, 0, 0, 0); \
        _Pragma("unroll") for (int d0 = 1; d0 < 4; ++d0) { S0_ = __builtin_amdgcn_mfma_f32_32x32x16_bf16(kfa[d0], qfr[d0], S0_, 0, 0, 0); S1_ = __builtin_amdgcn_mfma_f32_32x32x16_bf16(kfb[d0], qfr[d0], S1_, 0, 0, 0); } } while (0)
#define ATT_VLD(bank, ks) do { _Pragma("unroll") for (int dvb = 0; dvb < 4; ++dvb) { bank[dvb][0] = vtr((const LAS unsigned char*)(size_t)(vofs[dvb][0] + vb_ + (unsigned)((ks) * 4096))); bank[dvb][1] = vtr((const LAS unsigned char*)(size_t)(vofs[dvb][1] + vb_ + (unsigned)((ks) * 4096))); } } while (0)
#define ATT_PV(bank, ks, C0, C1) do { const bf16x8 pb = pack8(((ks) < 2) ? C0 : C1, 8 * ((ks) & 1)); \
        _Pragma("unroll") for (int dvb = 0; dvb < 4; ++dvb) { const bf16x8 vf = (bf16x8){bank[dvb][0][0], bank[dvb][0][1], bank[dvb][0][2], bank[dvb][0][3], bank[dvb][1][0], bank[dvb][1][1], bank[dvb][1][2], bank[dvb][1][3]}; \
            O[dvb] = __builtin_amdgcn_mfma_f32_32x32x16_bf16(vf, pb, O[dvb], 0, 0, 0); } } while (0)
#define ATT_STEP(C0, C1, N0, N1, t_, PAR) do { const int t = (t_); constexpr int cur = (PAR); \
        if (t + 2 < NT) ATT_ISSUE_K(t + 2, cur ? OFF_K1 : OFF_K0); \
        if (t + 1 < NT) ATT_ISSUE_V(t + 1, cur ? OFF_V0 : OFF_V1); \
        { \
            const int k0 = t * 64; \
            if (k0 + 154 > eq0) { const LAS float* bt_ = BT + (k0 - eq + 192 + 4 * hi); \
                _Pragma("unroll") for (int r = 0; r < 16; ++r) { C0[r] += bt_[(r & 3) + 8 * (r >> 2)]; } \
                ATT_SB(); \
                _Pragma("unroll") for (int r = 0; r < 16; ++r) { C1[r] += bt_[32 + (r & 3) + 8 * (r >> 2)]; } } \
            if (t >= NTw - 1) { const bool all_ = t >= NTw; _Pragma("unroll") for (int r = 0; r < 16; ++r) { if (r >= 8 || all_) C0[r] = NEG; C1[r] = NEG; } } \
            if (__any(m != 0.f)) { _Pragma("unroll") for (int r = 0; r < 16; ++r) { C0[r] -= m; C1[r] -= m; } } \
            float mx = max3f(C0[0], C1[0], C0[1]), mx2 = max3f(C1[1], C0[2], C1[2]); \
            _Pragma("unroll") for (int r = 3; r < 15; r += 2) { mx = max3f(mx, C0[r], C1[r]); mx2 = max3f(mx2, C0[r + 1], C1[r + 1]); } \
            mx = max3f(mx, mx2, C0[15]); mx = fmaxf(mx, C1[15]); \
            mx = swapmax(mx); \
            if (__any(mx > THR || (t == 0 && mx < -THR))) { const float dl = (t == 0) ? mx : fmaxf(mx, 0.f); m += dl; const float f = (t == 0) ? 1.f : __builtin_amdgcn_exp2f(-dl); l *= f; \
                _Pragma("unroll") for (int r = 0; r < 16; ++r) { C0[r] -= dl; C1[r] -= dl; } \
                _Pragma("unroll") for (int i = 0; i < 4; ++i) _Pragma("unroll") for (int r = 0; r < 16; ++r) O[i][r] *= f; } \
        } \
        ATT_SB(); \
        if (t + 1 < NT) ATT_QK(N0, N1, cur ? OFF_K0 : OFF_K1); \
        ATT_SB(); \
        { \
            constexpr unsigned vb_ = (unsigned)(cur ? OFF_V1 : OFF_V0); \
            s16x4 vA[4][2], vB[4][2]; \
            ATT_VLD(vA, 0); \
            ATT_SB(); \
            float ls = 0.f; \
            _Pragma("unroll") for (int r = 0; r < 16; ++r) { C0[r] = __builtin_amdgcn_exp2f(C0[r]); C1[r] = __builtin_amdgcn_exp2f(C1[r]); ls += C0[r]; ls += C1[r]; } \
            l += ls; \
            ATT_SB(); \
            ATT_VLD(vB, 1); ATT_SB(); ATT_PV(vA, 0, C0, C1); ATT_SB(); \
            ATT_VLD(vA, 2); ATT_SB(); ATT_PV(vB, 1, C0, C1); ATT_SB(); \
            ATT_VLD(vB, 3); ATT_SB(); ATT_PV(vA, 2, C0, C1); ATT_SB(); \
            ATT_PV(vB, 3, C0, C1); \
        } \
        ATT_WAITBAR(); } while (0)
    ATT_QK(SA0, SA1, OFF_K0);
    ATT_WAITBAR();
    for (int tt = 0; tt < NT; tt += 2) { ATT_STEP(SA0, SA1, SB0, SB1, tt, 0); if (tt + 1 < NT) ATT_STEP(SB0, SB1, SA0, SA1, tt + 1, 1); }
#undef ATT_STEP
#undef ATT_QK
#undef ATT_VLD
#undef ATT_PV
#undef ATT_SB
#undef ATT_WAITBAR
#undef ATT_ISSUE_K
#undef ATT_ISSUE_V
#undef ATT_DMA
    const int tid2_ = mk_tid(wv);
    const int lane2 = tid2_ & 63, q32b = lane2 & 31, hib = lane2 >> 5;
    float lam;
    { float s1 = lq1[lane2] * lk1[lane2], s2 = lq2[lane2] * lk2[lane2]; s1 = wave_sum(s1); s2 = wave_sum(s2); lam = expf(s1) - expf(s2) + (layer_a == 0 ? 0.2f : 0.47071302f); }
    l = swapsum(l); const float inv = active ? 1.0f / l : 0.f;
    LAS float* xb = (LAS float*)(lds + rg * XB);
    if (mp == 1) { const float f = inv * lam;
#pragma unroll
        for (int i = 0; i < 4; ++i)
#pragma unroll
            for (int r = 0; r < 16; ++r) xb[(i * 16 + r) * 64 + lane2] = O[i][r] * f; }
    __syncthreads();
    if (mp == 0 && active) {
        float ss = 0.f;
#pragma unroll
        for (int i = 0; i < 4; ++i)
#pragma unroll
            for (int r = 0; r < 16; ++r) { const float o = O[i][r] * inv - xb[(i * 16 + r) * 64 + lane2]; O[i][r] = o; ss += o * o; }
        ss = swapsum(ss); const float rs = 1.0f / sqrtf(ss * (1.f / 128.f) + SUBLN_EPS);
        asm volatile("s_waitcnt lgkmcnt(0)" ::: "memory");
        LAS unsigned char* stg = (LAS unsigned char*)xb;
#pragma unroll
        for (int i = 0; i < 4; ++i)
#pragma unroll
            for (int r4 = 0; r4 < 4; ++r4) { const int dv0 = 32 * i + 8 * r4 + 4 * hib; const f32x4 gg = *(const LAS f32x4*)(GT + dv0);
                u32x2 w; w.x = cvtpk(O[i][4 * r4] * rs * gg.x, O[i][4 * r4 + 1] * rs * gg.y); w.y = cvtpk(O[i][4 * r4 + 2] * rs * gg.z, O[i][4 * r4 + 3] * rs * gg.w);
                *(LAS u32x2*)(stg + q32b * KSTR + dv0 * 2) = w; }
        asm volatile("s_waitcnt lgkmcnt(0)" ::: "memory");
        bf16* og = u.O + (size_t)(128 * u.x + rg * 32) * 1024 + u.h * 128;
#pragma unroll
        for (int i = 0; i < 8; ++i) { const int row = i * 4 + (lane2 >> 4), c16 = lane2 & 15; const u32x4 v = *(const LAS u32x4*)(stg + row * KSTR + c16 * 16);
            if (rg * 32 + row < vrows) *(u32x4*)(og + (size_t)row * 1024 + c16 * 8) = v; }
    }
    __syncthreads();
}
__device__ __forceinline__ void attn_phase(ArgsRef A, Frame& F, int a) {
    const bf16* QB = (const bf16*)(F.ws + WS_QB); bf16* OB = (bf16*)(F.ws + WS_XN); const bf16* KX = (const bf16*)(F.ws + WS_KX); const bf16* VX = (const bf16*)(F.ws + WS_VX);
    const bf16* KXS = (const bf16*)(F.ws + WS_KXS) + (size_t)a * KXS_LAYER; const bf16* VXS = (const bf16*)(F.ws + WS_VXS) + (size_t)a * KXS_LAYER;
    { const int gt = blockIdx.x * 512 + mk_tid(F.wave);
      for (int i = gt; i < 65536; i += F.G * 512) { const int c4 = i & 255, r = (i >> 8) & 15, b = (i >> 12) & 7, kv = i >> 15;
          const f32x4 v = *(const f32x4*)((const float*)(F.ws + (kv ? WS_MFV : WS_MFK)) + r * 1024 + c4 * 4);
          *(f32x4*)(F.out + (kv ? OFF_VP : OFF_KP) + (size_t)a * 8 * EXT_P * 1024 + (size_t)(b * EXT_P + r) * 1024 + c4 * 4) = v; } }
    for (int n = F.vcu; n < 4168; n += F.G) {
        AUnit u; u.KM = (const bf16*)(F.ws + WS_KXM); u.VM = (const bf16*)(F.ws + WS_VXM);
        if (n < 4096) { const int i = n >> 8, v = n & 255, c = v & 31, bh = (v >> 5) * 8 + (i >> 1); const int x = (i & 1) ? 63 - c : c; const int b = bh >> 3;
            u.K = KX + (size_t)b * EXT_P * 1024; u.V = VX + (size_t)b * EXT_P * 1024; u.Q = QB + (size_t)b * 8192 * 1024; u.O = OB + (size_t)b * 8192 * 1024; u.P = 16; u.L = 8192; u.x = x; u.h = bh & 7; }
        else if (n < 4160) { const int j = n - 4096, b = j >> 3; u.K = KXS + (size_t)b * EXT_S * 1024; u.V = VXS + (size_t)b * EXT_S * 1024; u.Q = QB + (size_t)(ROW_S + b * 64) * 1024; u.O = OB + (size_t)(ROW_S + b * 64) * 1024; u.P = 1040; u.L = 64; u.x = 0; u.h = j & 7; }
        else { u.K = (const bf16*)(F.ws + WS_KXM); u.V = (const bf16*)(F.ws + WS_VXM); u.Q = QB + (size_t)ROW_M * 1024; u.O = OB + (size_t)ROW_M * 1024; u.P = 0; u.L = 16; u.x = 0; u.h = n - 4160; }
        attn_unit(F.wave, F.lds, u, A.in[12] + a * 64, A.in[13] + a * 64, A.in[14] + a * 64, A.in[15] + a * 64, a, A.in[6], A.in[16] + a * 128);
    }
}
}

#define XB_TMO      128
#define XB_XCNT(j)  (256  + 64 * (j))
#define XB_XSUB(j)  (1280 + 64 * (j))
#define XB_XGEN(j)  (2304 + 64 * (j))
#define XB_TOP      3328
#define XB_TOPGEN   3392
#define XCD_BAR_WORDS 3456
#define XB_SPIN_CAP (1u << 18)

__device__ __forceinline__ unsigned xb_ld(unsigned* p)              { return __hip_atomic_load(p, __ATOMIC_RELAXED, __HIP_MEMORY_SCOPE_AGENT); }
__device__ __forceinline__ unsigned xb_add(unsigned* p, unsigned v) { return __hip_atomic_fetch_add(p, v, __ATOMIC_RELAXED, __HIP_MEMORY_SCOPE_AGENT); }
__device__ __forceinline__ unsigned xb_xcc_id() { return (unsigned)__builtin_amdgcn_s_getreg((3 << 11) | 20) & 0xFu; }
#define XB_SPIN(cond, bar) do { unsigned _sp = 0; while (cond) { __builtin_amdgcn_s_sleep(1); \
    if ((++_sp & 255u) == 0u) { if (xb_ld(&(bar)[XB_TMO])) break; if (_sp > XB_SPIN_CAP) { atomicAdd(&(bar)[XB_TMO], 1u); break; } } } } while (0)

struct XcdBarrier {
    bool leader; unsigned* bar; unsigned x;
    volatile LAS unsigned* st;
};

__device__ __forceinline__ XcdBarrier xcd_barrier_post(unsigned* bar, volatile LAS unsigned* st) {
    XcdBarrier b; b.bar = bar; b.x = xb_xcc_id(); b.st = st;
    b.leader = (threadIdx.x == 0);
    if (b.leader) (void)xb_add(&bar[XB_XCNT(b.x)], 1u);
    return b;
}
__device__ __forceinline__ void xcd_barrier_complete(unsigned* bar, unsigned x, unsigned& nloc, unsigned& nx) {
    const unsigned G = gridDim.x * gridDim.y * gridDim.z;
    unsigned sum, cnt, mine, sp = 0u;
    for (;;) {
        sum = 0u; cnt = 0u; mine = 0u;
#pragma unroll
        for (unsigned j = 0; j < 16; ++j) { const unsigned c = xb_ld(&bar[XB_XCNT(j)]); sum += c; cnt += (c > 0u) ? 1u : 0u; mine = (j == x) ? c : mine; }
        if (sum == G) break;
        __builtin_amdgcn_s_sleep(1);
        if ((++sp & 255u) == 0u) { if (xb_ld(&bar[XB_TMO])) break; if (sp > XB_SPIN_CAP) { atomicAdd(&bar[XB_TMO], 1u); break; } }
    }
    nloc = mine > 0u ? mine : 1u; nx = cnt > 0u ? cnt : 1u;
}

__device__ __forceinline__ void xcd_barrier(const XcdBarrier& b) {
    asm volatile("s_waitcnt vmcnt(0)" ::: "memory");
    __syncthreads();
    if (b.leader) {
        unsigned* bar = b.bar;
        __builtin_amdgcn_s_waitcnt(0);
        unsigned nloc = b.st[0], nx = b.st[1];
        if (nloc == 0u) { xcd_barrier_complete(bar, b.x, nloc, nx); b.st[0] = nloc; b.st[1] = nx; }
        const unsigned old = xb_add(&bar[XB_XSUB(b.x)], 1u);
        const unsigned gen = old / nloc;
        if (old + 1u == (gen + 1u) * nloc) {
            __builtin_amdgcn_fence(__ATOMIC_RELEASE, "agent");
            asm volatile("s_waitcnt vmcnt(0)" ::: "memory");
            const unsigned og = xb_add(&bar[XB_TOP], 1u);
            const unsigned tg = og / nx;
            if (og + 1u == (tg + 1u) * nx) xb_add(&bar[XB_TOPGEN], 1u);
            else XB_SPIN(xb_ld(&bar[XB_TOPGEN]) == tg, bar);
            __builtin_amdgcn_fence(__ATOMIC_ACQUIRE, "agent");
            xb_add(&bar[XB_XGEN(b.x)], 1u);
            asm volatile("s_waitcnt vmcnt(0)" ::: "memory");
        } else {
            XB_SPIN(xb_ld(&bar[XB_XGEN(b.x)]) == gen, bar);
            __builtin_amdgcn_fence(__ATOMIC_ACQUIRE, "agent");
            asm volatile("s_waitcnt vmcnt(0)" ::: "memory");
        }
    }
    __syncthreads();
}

__device__ __forceinline__ void run_step(ArgsRef args, const int step, const int wv) {
    extern __shared__ __attribute__((aligned(16))) unsigned char lds_raw[];
    Frame F;
    F.lds = (LAS unsigned char*)lds_raw; F.tid = 0; F.lane = 0; F.wave = wv;
    F.G = gridDim.x; { const int bx = blockIdx.x; F.vcu = (F.G % 8 == 0) ? (bx % 8) * (F.G / 8) + bx / 8 : bx; }
    F.out = args.out; F.ws = args.ws;
    bf16* XN = (bf16*)(F.ws + WS_XN); bf16* QB = (bf16*)(F.ws + WS_QB); bf16* YB = (bf16*)(F.ws + WS_YB); bf16* U = (bf16*)(F.ws + WS_U);
    int layer = 0, k = -1;
    if (step > 0) { const int s = step - 1; if (s < 7) { layer = 0; k = s; } else if (s < 13) { layer = 1; k = s - 7; } else if (s < 20) { layer = 2; k = s - 13; } else { layer = 3; k = s - 20; } }
    const bool attn = (layer & 1) == 0; const int a = layer >> 1;
    int type;
    if (step == 0) type = 0; else if (attn) type = k == 0 ? 1 : k == 1 ? 2 : k == 2 ? 4 : k == 3 ? 5 : k == 4 ? 6 : k == 5 ? 7 : 8;
    else type = k == 0 ? 3 : k == 1 ? 4 : k == 2 ? 5 : k == 3 ? 6 : k == 4 ? 7 : 8;
    if (type == 0) prologue(args, F);
    else if (type == 1) {
        pg8::Gemm g{XN, (const bf16*)(F.ws + WS_WQKV) + (size_t)a * 3072 * D, MPAD, 3072, D, D, D, 0}; pg8::StaticOrder S; S.init(MPAD, 3072, F.G, (int)blockIdx.x, D);
        pg8::EpiQKV E{F.ws, F.out, a};
        pg8::gemm_phase<pg8::EpiQKV, pg8::StaticOrder, true, true>(F.lds, g, S, E, mk_tid(F.wave));
    } else if (type == 2) { att::attn_phase(args, F, a); }
    else if (type == 3) { pool_phase(args, F, a); }
    else if (type == 4 || type == 7) {
        pg8::Gemm g;
        if (type == 7) g = pg8::Gemm{U, (const bf16*)(F.ws + WS_WDN) + (size_t)layer * D * FF, MPAD, D, FF, FF, FF, 0};
        else if (attn) g = pg8::Gemm{XN, (const bf16*)(F.ws + WS_WO) + (size_t)a * D * D, MPAD, D, D, D, D, 0};
        else g = pg8::Gemm{QB, (const bf16*)(F.ws + WS_WPOOL) + (size_t)a * 4 * 65536, MPAD, D, 256, D, 256, 512};
        pg8::TailOrder S; S.init(D, F.G, (int)blockIdx.x, g.K, type == 7 ? 16 : (attn ? 4 : 1));
        pg8::EpiBf16<0> E{YB, D, (float*)(F.ws + WS_YF)};
        pg8::gemm_phase<pg8::EpiBf16<0>, pg8::TailOrder, true, true>(F.lds, g, S, E, mk_tid(F.wave));
    } else if (type == 5) { fin_phase(args, F, layer == 0, attn ? 4 : 0, args.in[8] + layer * D, args.in[9] + layer * D); }
    else if (type == 6) {
        pg8::Gemm g{XN, (const bf16*)(F.ws + WS_WUP) + (size_t)layer * D * FF, MPAD, FF, D, D, D, 0}; pg8::StaticOrder S; S.init(MPAD, FF, F.G, (int)blockIdx.x, D);
        pg8::EpiBf16<2> E{U, FF, nullptr};
        pg8::gemm_phase<pg8::EpiBf16<2>, pg8::StaticOrder, true, true>(F.lds, g, S, E, mk_tid(F.wave));
    } else { fin_phase(args, F, false, 16, args.in[10] + layer * D, layer < 3 ? args.in[7] + (layer + 1) * D : nullptr); }
}
__global__ void __launch_bounds__(512, 2) fwd_kernel(Args args_) {
    const int lo = args_.lo, hi = args_.hi;
    const int wv = __builtin_amdgcn_readfirstlane((int)threadIdx.x >> 6);
    extern __shared__ __attribute__((aligned(16))) unsigned char lds_raw[];
    volatile LAS unsigned* bst = (volatile LAS unsigned*)((LAS unsigned char*)lds_raw + 131072);
    if (threadIdx.x < 2) bst[threadIdx.x] = 0u;
    __syncthreads();
    XcdBarrier bar = xcd_barrier_post((unsigned*)args_.ws + 4096, bst);
    int probe_rep = 0; (void)probe_rep;
    for (int step = lo; step < hi; ++step) {
        const __attribute__((address_space(4))) Args* ap = (const __attribute__((address_space(4))) Args*)__builtin_amdgcn_kernarg_segment_ptr();
        asm volatile("" : "+s"(ap));
        run_step(*ap, step, wv);
#if defined(PROBE_MASK)
        {
            int ty = 0; if (step > 0) { const int s = step - 1; const int k = s < 7 ? s : s < 13 ? s - 7 : s < 20 ? s - 13 : s - 20; const bool at = (s < 7) || (s >= 13 && s < 20);
                ty = at ? (k == 0 ? 1 : k == 1 ? 2 : k == 2 ? 4 : k == 3 ? 5 : k == 4 ? 6 : k == 5 ? 7 : 8) : (k == 0 ? 3 : k == 1 ? 4 : k == 2 ? 5 : k == 3 ? 6 : k == 4 ? 7 : 8); }
            if (((PROBE_MASK >> ty) & 1) && !probe_rep) { probe_rep = 1; --step; __syncthreads(); continue; }
            probe_rep = 0; }
#endif
        if (step + 1 < hi) { if (lo < 0) { __threadfence(); cg::this_grid().sync(); }
            else { xcd_barrier(bar);
#if defined(PROBE_BAR2)
 xcd_barrier(bar);
#endif
 } }
    }
}

extern "C" void kernel_launch(void* const* d_in, const int* in_sizes, int n_in, void* d_out, int out_size, void* d_ws, size_t ws_size, hipStream_t stream) {
    static int grid = 0;
    if (grid == 0) {
        if (n_in != 22 || (size_t)out_size != OUT_TOTAL || ws_size < WS_END) { fprintf(stderr, "kernel_launch: unexpected shapes n_in %d out %d ws %zu\n", n_in, out_size, ws_size); grid = -1; return; }
        int dev = 0, cus = 0, per_cu = 0;
        hipGetDevice(&dev); hipDeviceGetAttribute(&cus, hipDeviceAttributeMultiprocessorCount, dev);
        hipFuncSetAttribute((const void*)fwd_kernel, hipFuncAttributeMaxDynamicSharedMemorySize, LDS_BYTES);
        hipOccupancyMaxActiveBlocksPerMultiprocessor(&per_cu, (const void*)fwd_kernel, 512, LDS_BYTES);
        if (per_cu < 1) { fprintf(stderr, "kernel_launch: occupancy query says %d blocks/CU\n", per_cu); per_cu = 1; }
        (void)hipGetLastError();
        grid = cus;
    }
    if (grid < 0) return;
    if (hipMemsetAsync(d_ws, 0, 65536, stream) != hipSuccess) { fprintf(stderr, "kernel_launch: memset failed\n"); return; }
    Args a{};
    for (int i = 0; i < 22; ++i) a.in[i] = (const float*)d_in[i];
    a.out = (float*)d_out; a.ws = (unsigned char*)d_ws;
#if ONE_LAUNCH
    a.lo = 0; a.hi = NSTEPS;
    void* kargs[] = {&a};
    hipError_t e = hipLaunchCooperativeKernel((const void*)fwd_kernel, dim3(grid), dim3(512), kargs, LDS_BYTES, stream);
    if (e != hipSuccess) fprintf(stderr, "cooperative launch failed: %s (grid %d)\n", hipGetErrorString(e), grid);
#else
    for (int s = 0; s < NSTEPS; ++s) { a.lo = s; a.hi = s + 1; hipLaunchKernelGGL(fwd_kernel, dim3(grid), dim3(512), LDS_BYTES, stream, a); }
#endif
}
static_assert(WS_QB == 213 * MiB && WS_KX == 473 * MiB && WS_VX == 602 * MiB && WS_KXS == 731 * MiB && WS_VXS == 767 * MiB && WS_KXM == 803 * MiB && WS_VXM == 804 * MiB && KXS_LAYER == 9 * MiB && WS_MFK == 1323 * MiB && WS_MFV == 1324 * MiB, "EpiQKV hard-coded map");
static_assert(OFF_KP == 67633152 && OFF_VP == 202113024 && OFF_KS == 336838656 && OFF_VS == 337887232, "EpiQKV hard-coded output offsets");
```

```cpp
#include <hip/hip_runtime.h>
#include <hip/hip_cooperative_groups.h>
#include <hip/hip_bf16.h>
#include <cstdio>
#include <cstdint>
namespace cg = cooperative_groups;
namespace pg8 {
#define PG8_LAS __attribute__((address_space(3)))
typedef unsigned short bf16_t;
typedef short bf16x8 __attribute__((ext_vector_type(8)));
typedef float f32x4 __attribute__((ext_vector_type(4)));
typedef unsigned u32x4 __attribute__((ext_vector_type(4)));
constexpr int BM = 256, BK = 64, HALF = 128, HTB = HALF * BK * 2  , STAGE_BYTES = 8 * HTB, NXCD = 8, WGM = 8;

__host__ __device__ __forceinline__ int lds_byte(int r, int c) { const int st = (r >> 4) * 2 + (c >> 5), rr = r & 15, cc = c & 31, ob = rr * 64 + cc * 2; return st * 1024 + (ob ^ (((ob >> 9) & 1) << 5)); }
__host__ __device__ __forceinline__ void stage_rc(int b, int& R, int& C) { const int st = b / 1024, sb = b % 1024, swz = sb ^ (((sb >> 9) & 1) << 5); R = (st >> 1) * 16 + swz / 64; C = (st & 1) * 32 + (swz % 64) / 2; }
__host__ __device__ __forceinline__ int perm32(int rho) { const int n = rho >> 4, i = rho & 15; return 8 * (i >> 2) + 4 * n + (i & 3); }

struct Unit { int pm, pn, ko, nt, sp; };
struct Gemm { const bf16_t* A; const bf16_t* Bt; int M, N, K, lda, ldb, acs; };

struct StaticOrder {
    int nM, nN, nwg, G, c, ntf;
    __host__ __device__ void init(int M, int N, int G_, int c_, int K) { nM = M / BM; nN = N / BM; nwg = nM * nN; G = G_; c = c_; ntf = K / BK; }
    __host__ __device__ bool next(int i, Unit& u) const {
        const long L = (long)i * G + c; if (L >= nwg) return false;
        int wgid = (int)L; { const int q = nwg / NXCD, r = nwg % NXCD, xcd = wgid % NXCD, off = wgid / NXCD; wgid = (xcd < r ? xcd * (q + 1) : r * (q + 1) + (xcd - r) * q) + off; }
        const int nig = WGM * nN, gid = wgid / nig, fm = gid * WGM, gsz = (nM - fm) < WGM ? (nM - fm) : WGM;
        u.pm = fm + ((wgid % nig) % gsz); u.pn = (wgid % nig) / gsz; u.ko = 0; u.nt = ntf; u.sp = 0; return true;
    }
    __device__ __forceinline__ void a_ready(const Unit&) const {}
    __device__ __forceinline__ void done(const Unit&) const {}
};
struct TailOrder {
    StaticOrder mn; int KS, kc;
    __host__ __device__ void init(int N, int G_, int c_, int K, int KS_) { mn.init(65536, N, G_, c_, K); KS = KS_; kc = K / KS_; }
    __host__ __device__ bool next(int i, Unit& u) const {
        const long L = (long)i * mn.G + mn.c; if (L < mn.nwg) return mn.next(i, u);
        const int Lt = (int)(L - mn.nwg); if (Lt >= 3 * mn.nN * KS) return false;
        const int tile = Lt / KS, ks = Lt - tile * KS; u.pm = 256 + tile / mn.nN; u.pn = tile % mn.nN; u.ko = ks * kc; u.nt = kc / BK; u.sp = KS > 1 ? ks + 1 : 0; return true;
    }
    __device__ __forceinline__ void a_ready(const Unit&) const {}
    __device__ __forceinline__ void done(const Unit&) const {}
};

__device__ __forceinline__ unsigned cvt_pk_bf16(float lo, float hi) { unsigned r; asm volatile("v_cvt_pk_bf16_f32 %0, %1, %2" : "=v"(r) : "v"(lo), "v"(hi)); return r; }
template <int ACT  > struct EpiBf16 {
    static constexpr bool PERM = true, AFTER_DRAIN = false;
    bf16_t* O; int ldc; float* yf;
    __device__ __forceinline__ void operator()(const f32x4 (&acc)[2][2][4][2], const Unit& u, int wr, int wc, int fr, int fq) const {
        asm volatile("" : "+v"(fr), "+v"(fq));
        const int row0 = u.pm * BM + wr * 64 + fr; const int col0 = u.pn * BM + wc * 32 + 8 * fq;
#pragma unroll
        for (int ai = 0; ai < 2; ++ai)
#pragma unroll
            for (int m = 0; m < 4; ++m) { bf16_t* rowp = O + (size_t)(row0 + ai * HALF + m * 16) * ldc + col0;
#pragma unroll
                for (int bj = 0; bj < 2; ++bj) { f32x4 v0 = acc[ai][bj][m][0], v1 = acc[ai][bj][m][1];
                    if (ACT == 2) {
#pragma unroll
                        for (int e = 0; e < 4; ++e) { float a = fmaxf(v0[e], 0.f), b = fmaxf(v1[e], 0.f); v0[e] = a * a; v1[e] = b * b; } }
                    if (u.sp) { float* yr = yf + ((size_t)(u.sp - 1) * 768 + (size_t)(row0 + ai * HALF + m * 16 - 65536)) * 1024 + col0 + bj * HALF;
                        *(f32x4*)yr = v0; *(f32x4*)(yr + 4) = v1; }
                    else { u32x4 w; w.x = cvt_pk_bf16(v0[0], v0[1]); w.y = cvt_pk_bf16(v0[2], v0[3]); w.z = cvt_pk_bf16(v1[0], v1[1]); w.w = cvt_pk_bf16(v1[2], v1[3]);
                    *(u32x4*)(rowp + bj * HALF) = w; } } }
    }
};
struct EpiQKV {
    static constexpr bool PERM = true, AFTER_DRAIN = false;
    unsigned char* ws; float* out; int a;
    __device__ __forceinline__ void operator()(const f32x4 (&acc)[2][2][4][2], const Unit& u, int wr, int wc, int fr, int fq) const {
        const size_t MiB_ = 1u << 20;
        asm volatile("" : "+v"(fr), "+v"(fq));
        const int t3 = u.pn >> 2; const int colb = (u.pn & 3) * 256 + wc * 32 + 8 * fq;
        bf16_t* X; float* Fp = nullptr; int rbase, jump = 0, s0 = 0; float sc = 1.f;
        if (t3 == 0) { X = (bf16_t*)(ws + 213 * MiB_); rbase = u.pm * BM; sc = 0.125f * 1.4426950408889634f; }
        else if (u.pm < 256) { const int b = u.pm >> 5; rbase = b * 8208 + 16 + (u.pm & 31) * 256; X = (bf16_t*)(ws + (t3 == 1 ? 473 : 602) * MiB_);
            Fp = out + (t3 == 1 ? (size_t)67633152 : (size_t)202113024) + (size_t)a * 8 * 8208 * 1024 + (size_t)rbase * 1024; }
        else if (u.pm < 258) { s0 = (u.pm - 256) * 256; rbase = 1040 + s0; jump = 1040; X = (bf16_t*)(ws + (t3 == 1 ? 731 : 767) * MiB_) + (size_t)a * (9 * MiB_);
            Fp = out + (t3 == 1 ? (size_t)336838656 : (size_t)337887232) + (size_t)a * 512 * 1024 + (size_t)s0 * 1024; }
        else { rbase = 0; X = (bf16_t*)(ws + (t3 == 1 ? 803 : 804) * MiB_); Fp = (float*)(ws + (t3 == 1 ? 1323 : 1324) * MiB_); }
#pragma unroll
        for (int ai = 0; ai < 2; ++ai)
#pragma unroll
            for (int m = 0; m < 4; ++m) { const int rit = ai * HALF + wr * 64 + m * 16 + fr;
                bf16_t* xr = X + (unsigned)((rbase + rit + ((s0 + rit) >> 6) * jump) * 1024 + colb); float* fr_ = Fp + (unsigned)(rit * 1024 + colb);
#pragma unroll
                for (int bj = 0; bj < 2; ++bj) { const f32x4 v0 = acc[ai][bj][m][0], v1 = acc[ai][bj][m][1]; const f32x4 s0v = v0 * sc, s1v = v1 * sc;
                    u32x4 w; w.x = cvt_pk_bf16(s0v[0], s0v[1]); w.y = cvt_pk_bf16(s0v[2], s0v[3]); w.z = cvt_pk_bf16(s1v[0], s1v[1]); w.w = cvt_pk_bf16(s1v[2], s1v[3]);
                    *(u32x4*)(xr + bj * HALF) = w;
                    if (t3 != 0) { *(f32x4*)(fr_ + bj * HALF) = v0; *(f32x4*)(fr_ + bj * HALF + 4) = v1; } } }
    }
};
template <class Epi, class Sched, bool ALIGN_EPI = false, bool SP2 = false>
__device__ __forceinline__ void gemm_phase(PG8_LAS unsigned char* lds, const Gemm g, const Sched& S, const Epi& E, const int tid_in) {
    int tid_ = tid_in; asm volatile("" : "+v"(tid_));
    const int tid = tid_, wid = __builtin_amdgcn_readfirstlane(tid >> 6), lane = tid & 63, wr = wid >> 2, wc = wid & 3, fr = lane & 15, fq = lane >> 4;
    const int K = g.K; (void)K;
    unsigned voffA[2], voffB[2];
#pragma unroll
    for (int i = 0; i < 2; ++i) { int R, C; stage_rc(tid * 16 + i * 8192, R, C); const int Rb = Epi::PERM ? ((R & ~31) + perm32(R & 31)) : R;
        voffA[i] = (unsigned)(R * g.lda + C) * 2u; voffB[i] = (unsigned)(Rb * g.ldb + C) * 2u; }
    const size_t kstep = (size_t)(BK * 2);
    const size_t hstepA = (size_t)HALF * g.lda * 2, hstepB = (size_t)HALF * g.ldb * 2;
    const size_t tstepA = 2 * hstepA, tstepB = 2 * hstepB;
    const unsigned ldsw = (unsigned)wid * 1024u;
    const int aoff = lds_byte(wr * 64 + fr, fq * 8), boff = lds_byte(wc * 32 + fr, fq * 8);
#define PG8_SA(b, h) (((b) * 2 + (h)) * HTB)
#define PG8_SB(b, h) ((4 + (b) * 2 + (h)) * HTB)
#define PG8_STAGE(bufoff, gbase, voff) do { _Pragma("unroll") for (int _i = 0; _i < 2; ++_i) \
        __builtin_amdgcn_global_load_lds((const unsigned*)((const char*)(gbase) + (voff)[_i]), (PG8_LAS unsigned*)(lds + (bufoff) + ldsw + _i * 8192), 16, 0, 0); } while (0)
#define PG8_LDA(dst, b, h) do { _Pragma("unroll") for (int m = 0; m < 4; ++m) _Pragma("unroll") for (int k = 0; k < 2; ++k) dst[m][k] = *(const PG8_LAS bf16x8*)(lds + PG8_SA(b, h) + aoff + m * 2048 + k * 1024); } while (0)
#define PG8_LDB(dst, b, h) do { _Pragma("unroll") for (int n = 0; n < 2; ++n) _Pragma("unroll") for (int k = 0; k < 2; ++k) dst[n][k] = *(const PG8_LAS bf16x8*)(lds + PG8_SB(b, h) + boff + n * 2048 + k * 1024); } while (0)
#define PG8_MMA(ai, bj, At, Bt) do { __builtin_amdgcn_s_setprio(1); _Pragma("unroll") for (int m = 0; m < 4; ++m) _Pragma("unroll") for (int n = 0; n < 2; ++n) _Pragma("unroll") for (int k = 0; k < 2; ++k) \
        acc[ai][bj][m][n] = __builtin_amdgcn_mfma_f32_16x16x32_bf16(Bt[n][k], At[m][k], acc[ai][bj][m][n], 0, 0, 0); __builtin_amdgcn_s_setprio(0); } while (0)
#define PG8_WAIT_V(n) asm volatile("s_waitcnt vmcnt(" #n ")" ::: "memory")
#define PG8_WAIT_L(n) asm volatile("s_waitcnt lgkmcnt(" #n ")" ::: "memory")
#define PG8_BAR __builtin_amdgcn_s_barrier()
#define PG8_SCHED __builtin_amdgcn_sched_barrier(0)
    Unit cur, nxt; int ui = 0;
    if (!S.next(0, cur)) return;
    f32x4 acc[2][2][4][2];
#pragma unroll
    for (int a = 0; a < 2; ++a)
#pragma unroll
        for (int b = 0; b < 2; ++b)
#pragma unroll
            for (int m = 0; m < 4; ++m)
#pragma unroll
                for (int n = 0; n < 2; ++n) acc[a][b][m][n] = (f32x4){0.f, 0.f, 0.f, 0.f};
    bf16x8 At[4][2], B0[2][2], B1[2][2];
    const char* cA = (const char*)g.A + (size_t)cur.pm * tstepA + (size_t)cur.pn * g.acs + (size_t)cur.ko * 2; const char* cB = (const char*)g.Bt + (size_t)cur.pn * tstepB + (size_t)cur.ko * 2;
    S.a_ready(cur);
    if constexpr (SP2) {
        PG8_STAGE(PG8_SB(0, 0), cB, voffB); PG8_STAGE(PG8_SB(0, 1), cB + hstepB, voffB); PG8_STAGE(PG8_SA(0, 0), cA, voffA); PG8_STAGE(PG8_SA(0, 1), cA + hstepA, voffA);
        if (wr == 1) PG8_BAR;
        PG8_WAIT_V(2); PG8_BAR;
        PG8_STAGE(PG8_SB(1, 0), cB + kstep, voffB); PG8_STAGE(PG8_SA(1, 0), cA + kstep, voffA); PG8_STAGE(PG8_SB(1, 1), cB + hstepB + kstep, voffB);
        PG8_WAIT_V(6); PG8_BAR;
    } else {
        PG8_STAGE(PG8_SB(0, 0), cB, voffB); PG8_STAGE(PG8_SA(0, 0), cA, voffA); PG8_STAGE(PG8_SB(0, 1), cB + hstepB, voffB); PG8_STAGE(PG8_SA(0, 1), cA + hstepA, voffA);
        if (wr == 1) PG8_BAR;
        PG8_WAIT_V(4); PG8_BAR;
        PG8_STAGE(PG8_SB(1, 0), cB + kstep, voffB); PG8_STAGE(PG8_SA(1, 0), cA + kstep, voffA); PG8_STAGE(PG8_SB(1, 1), cB + hstepB + kstep, voffB);
        PG8_WAIT_V(6); PG8_BAR;
    }
    for (;;) {
        const bool has_next = S.next(ui + 1, nxt);
        const char* nA = has_next ? (const char*)g.A + (size_t)nxt.pm * tstepA + (size_t)nxt.pn * g.acs + (size_t)nxt.ko * 2 : cA; const char* nB = has_next ? (const char*)g.Bt + (size_t)nxt.pn * tstepB + (size_t)nxt.ko * 2 : cB;
        const int nt = cur.nt;
        for (int t = 0; t < nt; t += 2) {
            const bool last = (t == nt - 2);
            const char* a1 = cA + (size_t)(t + 1) * kstep;
            const char* a2 = last ? nA : cA + (size_t)(t + 2) * kstep; const char* b2 = last ? nB : cB + (size_t)(t + 2) * kstep;
            const char* a3 = a2 + kstep; const char* b3 = b2 + kstep;
            if (last && has_next) S.a_ready(nxt);
            if constexpr (SP2) {
            PG8_LDB(B0, 0, 0); PG8_LDB(B1, 0, 1); PG8_SCHED; PG8_LDA(At, 0, 0); PG8_STAGE(PG8_SA(1, 1), a1 + hstepA, voffA);
            PG8_WAIT_V(8); PG8_WAIT_L(0); PG8_BAR; PG8_MMA(0, 0, At, B0); PG8_MMA(0, 1, At, B1); PG8_BAR; PG8_SCHED;
            PG8_LDA(At, 0, 1); PG8_STAGE(PG8_SB(0, 0), b2, voffB); PG8_STAGE(PG8_SB(0, 1), b2 + hstepB, voffB); PG8_STAGE(PG8_SA(0, 0), a2, voffA);
            PG8_WAIT_V(8); PG8_WAIT_L(0); PG8_BAR; PG8_MMA(1, 0, At, B0); PG8_MMA(1, 1, At, B1); PG8_BAR; PG8_SCHED;
            PG8_LDB(B0, 1, 0); PG8_LDB(B1, 1, 1); PG8_SCHED; PG8_LDA(At, 1, 0); PG8_STAGE(PG8_SA(0, 1), a2 + hstepA, voffA);
            PG8_WAIT_V(8); PG8_WAIT_L(0); PG8_BAR; PG8_MMA(0, 0, At, B0); PG8_MMA(0, 1, At, B1); PG8_BAR; PG8_SCHED;
            PG8_LDA(At, 1, 1); PG8_STAGE(PG8_SB(1, 0), b3, voffB); PG8_STAGE(PG8_SB(1, 1), b3 + hstepB, voffB); PG8_STAGE(PG8_SA(1, 0), a3, voffA);
            PG8_WAIT_V(8); PG8_WAIT_L(0); PG8_BAR; PG8_MMA(1, 0, At, B0); PG8_MMA(1, 1, At, B1); PG8_BAR; PG8_SCHED;
            } else {
            PG8_LDB(B0, 0, 0); PG8_SCHED; PG8_LDA(At, 0, 0); PG8_STAGE(PG8_SA(1, 1), a1 + hstepA, voffA);
            PG8_WAIT_L(8); PG8_BAR; PG8_WAIT_L(0); PG8_MMA(0, 0, At, B0); PG8_BAR; PG8_SCHED;
            PG8_LDB(B1, 0, 1); PG8_STAGE(PG8_SB(0, 0), b2, voffB);
            PG8_BAR; PG8_WAIT_L(0); PG8_MMA(0, 1, At, B1); PG8_BAR;
            PG8_LDA(At, 0, 1); PG8_STAGE(PG8_SA(0, 0), a2, voffA);
            PG8_BAR; PG8_WAIT_L(0); PG8_MMA(1, 0, At, B0); PG8_BAR; PG8_SCHED;
            PG8_STAGE(PG8_SB(0, 1), b2 + hstepB, voffB);
            PG8_WAIT_V(6); PG8_BAR; PG8_MMA(1, 1, At, B1); PG8_BAR;
            PG8_LDB(B0, 1, 0); PG8_SCHED; PG8_LDA(At, 1, 0); PG8_STAGE(PG8_SA(0, 1), a2 + hstepA, voffA);
            PG8_WAIT_L(8); PG8_BAR; PG8_WAIT_L(0); PG8_MMA(0, 0, At, B0); PG8_BAR; PG8_SCHED;
            PG8_LDB(B1, 1, 1); PG8_STAGE(PG8_SB(1, 0), b3, voffB);
            PG8_BAR; PG8_WAIT_L(0); PG8_MMA(0, 1, At, B1); PG8_BAR;
            PG8_LDA(At, 1, 1); PG8_STAGE(PG8_SA(1, 0), a3, voffA);
            PG8_BAR; PG8_WAIT_L(0); PG8_MMA(1, 0, At, B0); PG8_BAR; PG8_SCHED;
            PG8_STAGE(PG8_SB(1, 1), b3 + hstepB, voffB);
            PG8_WAIT_V(6); PG8_BAR; PG8_MMA(1, 1, At, B1); PG8_BAR;
            }
        }
        if constexpr (ALIGN_EPI) { if (wr == 0) PG8_BAR; }
        if constexpr (!Epi::AFTER_DRAIN) { E(acc, cur, wr, wc, fr, fq); S.done(cur); }
        if (!has_next) break;
#pragma unroll
        for (int a = 0; a < 2; ++a)
#pragma unroll
            for (int b = 0; b < 2; ++b)
#pragma unroll
                for (int m = 0; m < 4; ++m)
#pragma unroll
                    for (int n = 0; n < 2; ++n) acc[a][b][m][n] = (f32x4){0.f, 0.f, 0.f, 0.f};
        cur = nxt; cA = nA; cB = nB; ++ui;
        if constexpr (ALIGN_EPI) { if (wr == 1) PG8_BAR; }
    }
    PG8_WAIT_V(0);
    if constexpr (!ALIGN_EPI) { if (wr == 0) PG8_BAR; }
    PG8_BAR;
    if constexpr (Epi::AFTER_DRAIN) { E.fused(acc, cur, wr, wc, fr, fq, lds, wid, lane); S.done(cur); }
#undef PG8_SA
#undef PG8_SB
#undef PG8_STAGE
#undef PG8_LDA
#undef PG8_LDB
#undef PG8_MMA
#undef PG8_WAIT_V
#undef PG8_WAIT_L
#undef PG8_BAR
#undef PG8_SCHED
}
}
#define LAS __attribute__((address_space(3)))
#define GAS __attribute__((address_space(1)))
typedef unsigned short bf16;
typedef unsigned u32x4 __attribute__((ext_vector_type(4)));
typedef unsigned u32x2 __attribute__((ext_vector_type(2)));
typedef float f32x4 __attribute__((ext_vector_type(4)));
typedef float f32x2 __attribute__((ext_vector_type(2)));
typedef float f32x16 __attribute__((ext_vector_type(16)));
typedef short bf16x8 __attribute__((ext_vector_type(8)));
typedef short s16x4 __attribute__((ext_vector_type(4)));
constexpr int D = 1024, FF = 4096, NH = 8;
constexpr int ROW_S = 65536, ROW_M = 66048, ROWS_VALID = 66064, MPAD = 66304;
constexpr int EXT_P = 8208, EXT_S = 1104;
constexpr float LOG2E = 1.4426950408889634f;
constexpr float QSCALE = 0.125f * LOG2E;
constexpr float EPS = 1e-6f, SUBLN_EPS = 1e-5f;
constexpr size_t OFF_YP = 0, OFF_YS = 67108864, OFF_KP = OFF_YS + 524288, OFF_VP = OFF_KP + 134479872, OFF_PP = OFF_VP + 134479872,
                 OFF_KS = OFF_PP + 245760, OFF_VS = OFF_KS + 1048576, OFF_PS = OFF_VS + 1048576, OUT_TOTAL = OFF_PS + 245760;
constexpr size_t MiB = 1u << 20;
constexpr size_t WS_WQKV = 1 * MiB, WS_WO = 13 * MiB, WS_WPOOL = 17 * MiB, WS_WUP = 18 * MiB, WS_WDN = 50 * MiB, WS_XM = 82 * MiB,
                 WS_XN = 83 * MiB, WS_QB = 213 * MiB, WS_YB = 343 * MiB, WS_KX = 473 * MiB, WS_VX = 602 * MiB, WS_KXS = 731 * MiB, WS_VXS = 767 * MiB,
                 WS_KXM = 803 * MiB, WS_VXM = 804 * MiB, WS_U = 805 * MiB, WS_MFK = 1323 * MiB, WS_MFV = 1324 * MiB, WS_YF = 1325 * MiB, WS_END = 1373 * MiB;
constexpr size_t KXS_LAYER = 18 * MiB / 2;
constexpr int LDS_BYTES = 147456;
constexpr int NSTEPS = 27;
#ifndef ONE_LAUNCH
#define ONE_LAUNCH 1
#endif

__device__ __forceinline__ unsigned f2bf(float f) { unsigned u = __builtin_bit_cast(unsigned, f); return (u + 0x7fffu + ((u >> 16) & 1u)) >> 16; }
__device__ __forceinline__ unsigned pk2(float lo, float hi) { return f2bf(lo) | (f2bf(hi) << 16); }
__device__ __forceinline__ float bflo(unsigned w) { return __builtin_bit_cast(float, w << 16); }
__device__ __forceinline__ float bfhi(unsigned w) { return __builtin_bit_cast(float, w & 0xffff0000u); }
__device__ __forceinline__ float wave_sum(float v) {
#pragma unroll
    for (int o = 1; o < 64; o <<= 1) v += __shfl_xor(v, o);
    return v;
}

struct Args { const float* in[22]; float* out; unsigned char* ws; int lo, hi; };
typedef const __attribute__((address_space(4))) Args& ArgsRef;
__device__ __forceinline__ int mk_tid(int wv) { int t; asm volatile("v_mbcnt_lo_u32_b32 %0, -1, 0\n\tv_mbcnt_hi_u32_b32 %0, -1, %0" : "=v"(t)); return wv * 64 + t; }
struct Frame {
    LAS unsigned char* lds; int tid, lane, wave, vcu, G;
    float* out; unsigned char* ws;
};

__device__ __forceinline__ void transpose_item(const float* W, int K, int N, bf16* WT, LAS float* scr, int item, int lane, const float* nscale) {
    const int nblk = N / 64, kb = item / nblk, nb = item % nblk, k0 = 64 * kb, n0 = 64 * nb;
    f32x4 v[16];
#pragma unroll
    for (int i = 0; i < 16; ++i) v[i] = *(const f32x4*)(W + (size_t)(k0 + 4 * i + (lane >> 4)) * N + n0 + 4 * (lane & 15));
#pragma unroll
    for (int i = 0; i < 16; ++i) { LAS float* d = scr + (4 * i + (lane >> 4)) * 65 + 4 * (lane & 15); d[0] = v[i].x; d[1] = v[i].y; d[2] = v[i].z; d[3] = v[i].w; }
    asm volatile("s_waitcnt lgkmcnt(0)" ::: "memory");
    const int c = lane & 7;
#pragma unroll
    for (int j = 0; j < 8; ++j) { const int n = (lane >> 3) + 8 * j; const LAS float* s = scr + (8 * c) * 65 + n; const float sc = nscale ? nscale[n0 + n] : 1.f;
        u32x4 o; o.x = pk2(s[0 * 65] * sc, s[1 * 65] * sc); o.y = pk2(s[2 * 65] * sc, s[3 * 65] * sc); o.z = pk2(s[4 * 65] * sc, s[5 * 65] * sc); o.w = pk2(s[6 * 65] * sc, s[7 * 65] * sc);
        *(u32x4*)(WT + (size_t)(n0 + n) * K + k0 + 8 * c) = o; }
    asm volatile("s_waitcnt lgkmcnt(0)" ::: "memory");
}
__device__ __forceinline__ const float* xin_row(ArgsRef A, int row) {
    return row < ROW_S ? A.in[0] + (size_t)row * D : row < ROW_M ? A.in[1] + (size_t)(row - ROW_S) * D : A.in[5] + (size_t)(row - ROW_M) * D;
}
__device__ __forceinline__ float* xres_row(const Frame& F, int row) {
    return row < ROW_S ? F.out + OFF_YP + (size_t)row * D : row < ROW_M ? F.out + OFF_YS + (size_t)(row - ROW_S) * D : (float*)(F.ws + WS_XM) + (size_t)(row - ROW_M) * D;
}
__device__ __forceinline__ void prologue(ArgsRef A, Frame& F) {
    { const int t_ = mk_tid(F.wave); F.tid = t_; F.lane = t_ & 63; }
    LAS float* scr = (LAS float*)(F.lds + F.wave * 16640);
    const int gw = F.vcu * 8 + F.wave, NGW = F.G * 8;
    constexpr int I_QKV = 16 * 48, I_O = 16 * 16, I_UP = 16 * 64, I_DN = 64 * 16, I_PL = 4 * 4;
    constexpr int NITEMS = 2 * I_QKV + 2 * I_O + 4 * I_UP + 4 * I_DN + 8 * I_PL;
    for (int it = gw; it < NITEMS; it += NGW) {
        int r = it;
        if (r < 2 * I_QKV) { const int a = r / I_QKV; transpose_item(A.in[11] + (size_t)a * D * 3072, D, 3072, (bf16*)(F.ws + WS_WQKV) + (size_t)a * 3072 * D, scr, r % I_QKV, F.lane, nullptr); continue; } r -= 2 * I_QKV;
        if (r < 2 * I_O) { const int a = r / I_O; transpose_item(A.in[17] + (size_t)a * D * D, D, D, (bf16*)(F.ws + WS_WO) + (size_t)a * D * D, scr, r % I_O, F.lane, nullptr); continue; } r -= 2 * I_O;
        if (r < 4 * I_UP) { const int i = r / I_UP; transpose_item(A.in[20] + (size_t)i * D * FF, D, FF, (bf16*)(F.ws + WS_WUP) + (size_t)i * D * FF, scr, r % I_UP, F.lane, nullptr); continue; } r -= 4 * I_UP;
        if (r < 4 * I_DN) { const int i = r / I_DN; transpose_item(A.in[21] + (size_t)i * D * FF, FF, D, (bf16*)(F.ws + WS_WDN) + (size_t)i * D * FF, scr, r % I_DN, F.lane, nullptr); continue; } r -= 4 * I_DN;
        { const int pg = r / I_PL; transpose_item(A.in[18] + (size_t)pg * 65536, 256, 256, (bf16*)(F.ws + WS_WPOOL) + (size_t)pg * 65536, scr, r % I_PL, F.lane, A.in[19] + pg * 256); }
    }
    for (int it0 = gw; it0 < 32768; it0 += 4 * NGW) {
        f32x4 v[4][4];
#pragma unroll
        for (int r4 = 0; r4 < 4; ++r4) { const int it = min(it0 + r4 * NGW, 32767); const int j = it & 1023, b = (it >> 10) & 7, kv = (it >> 13) & 1, a = it >> 14;
            const float* src = (kv ? A.in[3] : A.in[2]) + ((size_t)(a * 8 + b) * 1024 + j) * D;
#pragma unroll
            for (int q = 0; q < 4; ++q) v[r4][q] = *(const f32x4*)(src + 4 * F.lane + 256 * q); }
#pragma unroll
        for (int r4 = 0; r4 < 4; ++r4) { const int it = it0 + r4 * NGW; if (it < 32768) { const int j = it & 1023, b = (it >> 10) & 7, kv = (it >> 13) & 1, a = it >> 14;
            bf16* dst = (bf16*)(F.ws + (kv ? WS_VXS : WS_KXS)) + (size_t)a * KXS_LAYER + (size_t)(b * EXT_S + 16 + j) * D;
#pragma unroll
            for (int q = 0; q < 4; ++q) { u32x2 w; w.x = pk2(v[r4][q].x, v[r4][q].y); w.y = pk2(v[r4][q].z, v[r4][q].w); *(u32x2*)(dst + 4 * F.lane + 256 * q) = w; } } }
    }
    const float* g = A.in[7];
    for (int row = ROWS_VALID + gw; row < MPAD; row += NGW) { bf16* xn = (bf16*)(F.ws + WS_XN) + (size_t)row * D;
#pragma unroll
        for (int q = 0; q < 4; ++q) *(u32x2*)(xn + 4 * F.lane + 256 * q) = (u32x2){0u, 0u}; }
    const int RPC = (ROWS_VALID + F.G - 1) / F.G, rbeg = F.vcu * RPC, rend = min(rbeg + RPC, ROWS_VALID);
    for (int row0 = rbeg + F.wave; row0 < rend; row0 += 32) {
        f32x4 v[4][4]; float ss[4];
#pragma unroll
        for (int j = 0; j < 4; ++j) { const float* x = xin_row(A, min(row0 + j * 8, ROWS_VALID - 1)); ss[j] = 0.f;
#pragma unroll
            for (int q = 0; q < 4; ++q) v[j][q] = *(const f32x4*)(x + 4 * F.lane + 256 * q); }
#pragma unroll
        for (int j = 0; j < 4; ++j) {
#pragma unroll
            for (int q = 0; q < 4; ++q) ss[j] += v[j][q].x * v[j][q].x + v[j][q].y * v[j][q].y + v[j][q].z * v[j][q].z + v[j][q].w * v[j][q].w; }
#pragma unroll
        for (int o = 1; o < 64; o <<= 1) {
#pragma unroll
            for (int j = 0; j < 4; ++j) ss[j] += __shfl_xor(ss[j], o); }
#pragma unroll
        for (int j = 0; j < 4; ++j) { const int row = row0 + j * 8; const float r = 1.0f / sqrtf(ss[j] * (1.f / D) + EPS); bf16* xn = (bf16*)(F.ws + WS_XN) + (size_t)row * D;
#pragma unroll
            for (int q = 0; q < 4; ++q) { const f32x4 gg = *(const f32x4*)(g + 4 * F.lane + 256 * q); u32x2 w; w.x = pk2(v[j][q].x * r * gg.x, v[j][q].y * r * gg.y); w.y = pk2(v[j][q].z * r * gg.z, v[j][q].w * r * gg.w);
                if (row < rend) *(u32x2*)(xn + 4 * F.lane + 256 * q) = w; } }
    }
}
__device__ __forceinline__ void fin_phase(ArgsRef A, Frame& F, bool from_inputs, const int nks  , const float* gpost, const float* gnext) {
    { const int t_ = mk_tid(F.wave); F.tid = t_; F.lane = t_ & 63; }
    constexpr int FR = 4;
    const int gw = F.vcu * 8 + F.wave, NGW = F.G * 8;
    const bf16* YB = (const bf16*)(F.ws + WS_YB);
    const int lo4 = 4 * F.lane;
    const int RPC = (ROW_S + F.G - 1) / F.G, rbeg = F.vcu * RPC, rend = min(rbeg + RPC, ROW_S);
    for (int row0 = rbeg + F.wave; row0 < rend; row0 += 8 * FR) {
        f32x4 yv[FR][4], xv[FR][4]; float ss[FR];
#pragma unroll
        for (int j = 0; j < FR; ++j) { const int row = min(row0 + j * 8, ROWS_VALID - 1); const bf16* y = YB + (size_t)row * D; const float* xi = from_inputs ? xin_row(A, row) : xres_row(F, row); ss[j] = 0.f;
#pragma unroll
            for (int q = 0; q < 4; ++q) {
                { const u32x2 w = *(const u32x2*)(y + lo4 + 256 * q); yv[j][q] = (f32x4){bflo(w.x), bfhi(w.x), bflo(w.y), bfhi(w.y)}; }
                xv[j][q] = *(const f32x4*)(xi + lo4 + 256 * q); } }
#pragma unroll
        for (int j = 0; j < FR; ++j) {
#pragma unroll
            for (int q = 0; q < 4; ++q) ss[j] += yv[j][q].x * yv[j][q].x + yv[j][q].y * yv[j][q].y + yv[j][q].z * yv[j][q].z + yv[j][q].w * yv[j][q].w; }
#pragma unroll
        for (int o = 1; o < 64; o <<= 1) {
#pragma unroll
            for (int j = 0; j < FR; ++j) ss[j] += __shfl_xor(ss[j], o); }
        float s2[FR];
#pragma unroll
        for (int j = 0; j < FR; ++j) { const int row = row0 + j * 8; const float r = 1.0f / sqrtf(ss[j] * (1.f / D) + EPS); s2[j] = 0.f;
#pragma unroll
            for (int q = 0; q < 4; ++q) { const f32x4 gg = *(const f32x4*)(gpost + lo4 + 256 * q); xv[j][q] = xv[j][q] + yv[j][q] * r * gg;
                if (row < rend) *(f32x4*)(xres_row(F, row) + lo4 + 256 * q) = xv[j][q];
                s2[j] += xv[j][q].x * xv[j][q].x + xv[j][q].y * xv[j][q].y + xv[j][q].z * xv[j][q].z + xv[j][q].w * xv[j][q].w; } }
        if (gnext) {
#pragma unroll
            for (int o = 1; o < 64; o <<= 1) {
#pragma unroll
                for (int j = 0; j < FR; ++j) s2[j] += __shfl_xor(s2[j], o); }
#pragma unroll
            for (int j = 0; j < FR; ++j) { const int row = row0 + j * 8; const float r2 = 1.0f / sqrtf(s2[j] * (1.f / D) + EPS); bf16* xn = (bf16*)(F.ws + WS_XN) + (size_t)row * D;
#pragma unroll
                for (int q = 0; q < 4; ++q) { const f32x4 gg = *(const f32x4*)(gnext + lo4 + 256 * q); u32x2 w; w.x = pk2(xv[j][q].x * r2 * gg.x, xv[j][q].y * r2 * gg.y); w.y = pk2(xv[j][q].z * r2 * gg.z, xv[j][q].w * r2 * gg.w);
                    if (row < rend) *(u32x2*)(xn + lo4 + 256 * q) = w; } }
        }
    }
    for (int row = ROW_S + gw; row < ROWS_VALID; row += NGW) {
        const float* xi = from_inputs ? xin_row(A, row) : xres_row(F, row); float* xo = xres_row(F, row);
        f32x4 yv[4], xv[4]; float ss = 0.f;
#pragma unroll
        for (int q = 0; q < 4; ++q) {
            if (nks == 0) { const u32x2 w = *(const u32x2*)(YB + (size_t)row * D + lo4 + 256 * q); yv[q] = (f32x4){bflo(w.x), bfhi(w.x), bflo(w.y), bfhi(w.y)}; }
            else { const float* yf = (const float*)(F.ws + WS_YF) + (size_t)(row - ROW_S) * D + lo4 + 256 * q; yv[q] = *(const f32x4*)yf; for (int k = 1; k < nks; ++k) yv[q] += *(const f32x4*)(yf + (size_t)k * 768 * D); }
            xv[q] = *(const f32x4*)(xi + lo4 + 256 * q); ss += yv[q].x * yv[q].x + yv[q].y * yv[q].y + yv[q].z * yv[q].z + yv[q].w * yv[q].w; }
        const float r = 1.0f / sqrtf(wave_sum(ss) * (1.f / D) + EPS); float s2 = 0.f;
#pragma unroll
        for (int q = 0; q < 4; ++q) { const f32x4 gg = *(const f32x4*)(gpost + lo4 + 256 * q); xv[q] = xv[q] + yv[q] * r * gg; *(f32x4*)(xo + lo4 + 256 * q) = xv[q];
            s2 += xv[q].x * xv[q].x + xv[q].y * xv[q].y + xv[q].z * xv[q].z + xv[q].w * xv[q].w; }
        if (gnext) { const float r2 = 1.0f / sqrtf(wave_sum(s2) * (1.f / D) + EPS); bf16* xn = (bf16*)(F.ws + WS_XN) + (size_t)row * D;
#pragma unroll
            for (int q = 0; q < 4; ++q) { const f32x4 gg = *(const f32x4*)(gnext + lo4 + 256 * q); u32x2 w; w.x = pk2(xv[q].x * r2 * gg.x, xv[q].y * r2 * gg.y); w.y = pk2(xv[q].z * r2 * gg.z, xv[q].w * r2 * gg.w);
                *(u32x2*)(xn + lo4 + 256 * q) = w; } }
    }
}
__device__ __forceinline__ f32x2 pool_h(ArgsRef A, const Frame& F, int grp, int b, int t, int col, int p) {
    const bf16* XN = (const bf16*)(F.ws + WS_XN);
    if (t >= 0) { const int row = grp == 0 ? b * 8192 + t : grp == 1 ? ROW_S + b * 64 + t : ROW_M + t; const unsigned w = *(const unsigned*)(XN + (size_t)row * D + col); return (f32x2){bflo(w), bfhi(w)}; }
    if (grp == 0) { const unsigned w = *(const unsigned*)(XN + (size_t)(ROW_M + 16 + t) * D + col); return (f32x2){bflo(w), bfhi(w)}; }
    if (grp == 1) return *(const f32x2*)(A.in[4] + ((size_t)(p * 8 + b) * 15 + 15 + t) * D + col);
    return (f32x2){0.f, 0.f};
}
__device__ __forceinline__ void pool_phase(ArgsRef A, Frame& F, int p) {
    { const int t_ = mk_tid(F.wave); F.tid = t_; F.lane = t_ & 63; }
    bf16* DB = (bf16*)(F.ws + WS_QB);
    const int col = 2 * F.tid, w = 2 << (col >> 8);
    for (int it = F.vcu; it < 2065; it += F.G) {
        int grp, b, t0, nr;
        if (it < 2048) { grp = 0; b = it >> 8; t0 = (it & 255) * 32; nr = 32; } else if (it < 2064) { const int s = it - 2048; grp = 1; b = s >> 1; t0 = (s & 1) * 32; nr = 32; } else { grp = 2; b = 0; t0 = 0; nr = 16; }
        f32x2 h[47];
#pragma unroll
        for (int i = 0; i < 47; ++i) h[i] = (i - 15 < nr) ? pool_h(A, F, grp, b, t0 - 15 + i, col, p) : (f32x2){0.f, 0.f};
        f32x2 sum = {0.f, 0.f};
#pragma unroll
        for (int j = 1; j < 16; ++j) if (j < w) sum += h[15 - j];
#pragma unroll
        for (int i = 0; i < 32; ++i) { const int t = t0 + i;
            if (i < nr) {
                const f32x2 cur = h[15 + i]; sum += cur;
                const float inv = 1.0f / (float)(grp == 2 ? min(t + 1, w) : w);
                const int row = grp == 0 ? b * 8192 + t : grp == 1 ? ROW_S + b * 64 + t : ROW_M + t;
                *(unsigned*)(DB + (size_t)row * D + col) = pk2(sum.x * inv - cur.x, sum.y * inv - cur.y);
                const f32x2 old = (w == 2) ? h[15 + i - 1] : (w == 4) ? h[15 + i - 3] : (w == 8) ? h[15 + i - 7] : h[15 + i - 15];
                sum -= old;
                if (grp == 0 && t >= 8177) *(f32x2*)(F.out + OFF_PP + ((size_t)(p * 8 + b) * 15 + (t - 8177)) * D + col) = cur;
                if (grp == 1 && t >= 49) *(f32x2*)(F.out + OFF_PS + ((size_t)(p * 8 + b) * 15 + (t - 49)) * D + col) = cur;
            }
        }
    }
}

namespace att {
constexpr int KSTR = 272;
constexpr int TB = 16384;
constexpr int OFF_K0 = 0, OFF_K1 = TB, OFF_V0 = 2 * TB, OFF_V1 = 3 * TB, OFF_BT = 4 * TB, OFF_GT = OFF_BT + 2048, OFF_Q = 5 * TB, XB = 16384;
static_assert(OFF_BT >= 4 * XB && OFF_GT + 512 <= OFF_Q && OFF_Q + 2 * TB <= 131072, "attention LDS map");
constexpr float THR = 48.0f;
constexpr float NEG = -1e30f;
struct AUnit { const bf16* K; const bf16* V; const bf16* KM; const bf16* VM; const bf16* Q; bf16* O; int P, L, x, h; };
__device__ __forceinline__ float max3f(float a, float b, float c) { float r; asm("v_max3_f32 %0, %1, %2, %3" : "=v"(r) : "v"(a), "v"(b), "v"(c)); return r; }
__device__ __forceinline__ float swapmax(float v) { auto rr = __builtin_amdgcn_permlane32_swap(__float_as_uint(v), __float_as_uint(v), false, false); return fmaxf(__uint_as_float(rr[0]), __uint_as_float(rr[1])); }
__device__ __forceinline__ float swapsum(float v) { auto rr = __builtin_amdgcn_permlane32_swap(__float_as_uint(v), __float_as_uint(v), false, false); return __uint_as_float(rr[0]) + __uint_as_float(rr[1]); }
typedef __bf16 bf16x2_t __attribute__((ext_vector_type(2)));
__device__ __forceinline__ unsigned cvtpk(float lo, float hi) { f32x2 v = {lo, hi}; bf16x2_t b = __builtin_convertvector(v, bf16x2_t); return __builtin_bit_cast(unsigned, b); }
__device__ __forceinline__ s16x4 vtr(const LAS unsigned char* p) { return __builtin_bit_cast(s16x4, __builtin_amdgcn_ds_read_tr16_b64_v4i16((LAS s16x4*)p)); }
__device__ __forceinline__ void glds16(const void* gsrc, unsigned lds_dst) { unsigned keep;
    asm volatile("s_mov_b32 %0, m0\n\ts_mov_b32 m0, %2\n\ts_nop 0\n\tglobal_load_lds_dwordx4 %1, off\n\ts_mov_b32 m0, %0" : "=&s"(keep) : "v"(gsrc), "s"(lds_dst) : "memory"); }
__device__ __forceinline__ bf16x8 pack8(const f32x16& S, int o) {
    u32x4 w; w.x = cvtpk(S[o], S[o + 1]); w.y = cvtpk(S[o + 2], S[o + 3]); w.z = cvtpk(S[o + 4], S[o + 5]); w.w = cvtpk(S[o + 6], S[o + 7]); return __builtin_bit_cast(bf16x8, w);
}

__device__ __forceinline__ void attn_unit(const int wv, LAS unsigned char* lds, const AUnit& u, const float* lq1, const float* lk1, const float* lq2, const float* lk2, const int layer_a, const float* relb, const float* subg) {
    const int tid = mk_tid(wv), lane = tid & 63, wid = wv, mp = wid >> 2, rg = wid & 3, q32 = lane & 31, hi = lane >> 5;
    LAS float* BT = (LAS float*)(lds + OFF_BT); LAS float* GT = (LAS float*)(lds + OFF_GT);
    {
        const float b15 = relb[15 * 8 + u.h];
        if (tid < 448) { const int rel = tid - 192, n = rel < 0 ? -rel : rel;
            int bk = n < 8 ? n : n < 12 ? 8 : n < 16 ? 9 : n < 23 ? 10 : n < 32 ? 11 : n < 46 ? 12 : n < 64 ? 13 : n < 91 ? 14 : 15; if (rel > 0) bk += 16;
            BT[tid] = (relb[bk * 8 + u.h] - b15) * LOG2E; }
        if (tid >= 384) GT[tid - 384] = subg[tid - 384] * (layer_a == 0 ? 0.8f : 0.52928698f);
    }
    const int vrows = min(128, u.L - 128 * u.x);
    const bool active = rg * 32 < vrows;
    const int ch = rg >> 1;
    const int NTw = active ? (u.P + min((2 * u.x + ch + 1) * 64, u.L) + 48) >> 6 : 0;
    const int NT = (u.P + min((2 * u.x + 2) * 64, u.L) + 48) >> 6;
    const int eq0 = u.P + 128 * u.x + rg * 32, eq = eq0 + q32;
    const unsigned lds0 = (unsigned)(size_t)lds;
    unsigned goff[2];
#pragma unroll
    for (int j = 0; j < 2; ++j) { const int row = wid * 8 + 4 * j + (lane >> 4), x = ((row & 3) << 2) | ((row >> 2) & 3), c = (lane & 15) ^ x; goff[j] = (unsigned)(row * 1024 + u.h * 128 + c * 8); }
    const unsigned ldst = (unsigned)wid * 2048u;
#define ATT_DMA(base, bufoff) do { _Pragma("unroll") for (int j_ = 0; j_ < 2; ++j_) \
        glds16((base) + goff[j_], (unsigned)__builtin_amdgcn_readfirstlane((int)(lds0 + (unsigned)(bufoff) + ldst + j_ * 1024))); } while (0)
#define ATT_ISSUE_K(t, bufoff) do { const bf16* b_ = ((t) == 0 && wid < 2) ? u.KM : u.K + (size_t)(t) * 65536; ATT_DMA(b_, bufoff); } while (0)
#define ATT_ISSUE_V(t, bufoff) do { const bf16* b_ = ((t) == 0 && wid < 2) ? u.VM : u.V + (size_t)(t) * 65536; ATT_DMA(b_, bufoff); } while (0)
#define ATT_WAITBAR() do { asm volatile("s_waitcnt vmcnt(0) lgkmcnt(0)" ::: "memory"); __builtin_amdgcn_s_barrier(); asm volatile("" ::: "memory"); } while (0)
    unsigned koff[4];
    { const int x = ((q32 & 3) << 2) | ((q32 >> 2) & 3);
#pragma unroll
      for (int d0 = 0; d0 < 4; ++d0) koff[d0] = lds0 + (unsigned)(q32 * 256 + (((mp * 8 + 2 * d0 + hi) ^ x) << 4)); }
    unsigned vofs[4][2];
    { const int qq = (lane & 15) >> 2, cl = 2 * ((lane >> 4) & 1) + ((lane & 3) >> 1), sub = 8 * (lane & 1);
#pragma unroll
      for (int dvb = 0; dvb < 4; ++dvb)
#pragma unroll
          for (int hf = 0; hf < 2; ++hf) vofs[dvb][hf] = lds0 + (unsigned)((8 * hf + 4 * hi + qq) * 256 + ((((dvb ^ qq) << 2) | (cl ^ (2 * hf + hi))) << 4) + sub); }
    {
        const bf16* qb_ = u.Q + (size_t)(128 * u.x + wid * 16) * 1024;
#pragma unroll
        for (int j = 0; j < 4; ++j) { const int row = 4 * j + (lane >> 4), x = ((row & 3) << 2) | ((row >> 2) & 3), c = (lane & 15) ^ x;
            glds16(qb_ + row * 1024 + u.h * 128 + c * 8, (unsigned)__builtin_amdgcn_readfirstlane((int)(lds0 + OFF_Q + wid * 4096 + j * 1024))); }
    }
    ATT_ISSUE_K(0, OFF_K0); ATT_ISSUE_V(0, OFF_V0); if (NT > 1) ATT_ISSUE_K(1, OFF_K1);
    ATT_WAITBAR();
    f32x16 O[4];
#pragma unroll
    for (int i = 0; i < 4; ++i)
#pragma unroll
        for (int r = 0; r < 16; ++r) O[i][r] = 0.f;
    float m = 0.f, l = 0.f;
    f32x16 SA0, SA1, SB0, SB1;
    const f32x16 zero16 = {0.f, 0.f, 0.f, 0.f, 0.f, 0.f, 0.f, 0.f, 0.f, 0.f, 0.f, 0.f, 0.f, 0.f, 0.f, 0.f};
#define ATT_SB() __builtin_amdgcn_sched_barrier(0)
#define ATT_QK(S0_, S1_, kbufoff) do { unsigned qsh_ = (unsigned)(OFF_Q + rg * 8192); asm volatile("" : "+s"(qsh_));     \
        bf16x8 kfa[4], kfb[4], qfr[4]; \
        _Pragma("unroll") for (int d0 = 0; d0 < 4; ++d0) { kfa[d0] = *(const LAS bf16x8*)(size_t)(koff[d0] + (unsigned)(kbufoff)); kfb[d0] = *(const LAS bf16x8*)(size_t)(koff[d0] + (unsigned)(kbufoff) + 8192u); qfr[d0] = *(const LAS bf16x8*)(size_t)(koff[d0] + qsh_); } \
        ATT_SB(); \
        S0_ = __builtin_amdgcn_mfma_f32_32x32x16_bf16(kfa[0], qfr[0], zero16, 0, 0, 0); S1_ = __builtin_amdgcn_mfma_f32_32x32x16_bf16(kfb[0], qfr[0], zero16, 0, 0, 0); \
        _Pragma("unroll") for (int d0 = 1; d0 < 4; ++d0) { S0_ = __builtin_amdgcn_mfma_f32_32x32x16_bf16(kfa[d0], qfr[d0], S0_, 0, 0, 0); S1_ = __builtin_amdgcn_mfma_f32_32x32x16_bf16(kfb[d0], qfr[d0], S1_, 0, 0, 0); } } while (0)
#define ATT_VLD(bank, ks) do { _Pragma("unroll") for (int dvb = 0; dvb < 4; ++dvb) { bank[dvb][0] = vtr((const LAS unsigned char*)(size_t)(vofs[dvb][0] + vb_ + (unsigned)((ks) * 4096))); bank[dvb][1] = vtr((const LAS unsigned char*)(size_t)(vofs[dvb][1] + vb_ + (unsigned)((ks) * 4096))); } } while (0)
#define ATT_PV(bank, ks, C0, C1) do { const bf16x8 pb = pack8(((ks) < 2) ? C0 : C1, 8 * ((ks) & 1)); \
        _Pragma("unroll") for (int dvb = 0; dvb < 4; ++dvb) { const bf16x8 vf = (bf16x8){bank[dvb][0][0], bank[dvb][0][1], bank[dvb][0][2], bank[dvb][0][3], bank[dvb][1][0], bank[dvb][1][1], bank[dvb][1][2], bank[dvb][1][3]}; \
            O[dvb] = __builtin_amdgcn_mfma_f32_32x32x16_bf16(vf, pb, O[dvb], 0, 0, 0); } } while (0)
#define ATT_STEP(C0, C1, N0, N1, t_, PAR) do { const int t = (t_); constexpr int cur = (PAR); \
        if (t + 2 < NT) ATT_ISSUE_K(t + 2, cur ? OFF_K1 : OFF_K0); \
        if (t + 1 < NT) ATT_ISSUE_V(t + 1, cur ? OFF_V0 : OFF_V1); \
        { \
            const int k0 = t * 64; \
            if (k0 + 154 > eq0) { const LAS float* bt_ = BT + (k0 - eq + 192 + 4 * hi); \
                _Pragma("unroll") for (int r = 0; r < 16; ++r) { C0[r] += bt_[(r & 3) + 8 * (r >> 2)]; } \
                ATT_SB(); \
                _Pragma("unroll") for (int r = 0; r < 16; ++r) { C1[r] += bt_[32 + (r & 3) + 8 * (r >> 2)]; } } \
            if (t >= NTw - 1) { const bool all_ = t >= NTw; _Pragma("unroll") for (int r = 0; r < 16; ++r) { if (r >= 8 || all_) C0[r] = NEG; C1[r] = NEG; } } \
            if (__any(m != 0.f)) { _Pragma("unroll") for (int r = 0; r < 16; ++r) { C0[r] -= m; C1[r] -= m; } } \
            float mx = max3f(C0[0], C1[0], C0[1]), mx2 = max3f(C1[1], C0[2], C1[2]); \
            _Pragma("unroll") for (int r = 3; r < 15; r += 2) { mx = max3f(mx, C0[r], C1[r]); mx2 = max3f(mx2, C0[r + 1], C1[r + 1]); } \
            mx = max3f(mx, mx2, C0[15]); mx = fmaxf(mx, C1[15]); \
            mx = swapmax(mx); \
            if (__any(mx > THR || (t == 0 && mx < -THR))) { const float dl = (t == 0) ? mx : fmaxf(mx, 0.f); m += dl; const float f = (t == 0) ? 1.f : __builtin_amdgcn_exp2f(-dl); l *= f; \
                _Pragma("unroll") for (int r = 0; r < 16; ++r) { C0[r] -= dl; C1[r] -= dl; } \
                _Pragma("unroll") for (int i = 0; i < 4; ++i) _Pragma("unroll") for (int r = 0; r < 16; ++r) O[i][r] *= f; } \
        } \
        ATT_SB(); \
        if (t + 1 < NT) ATT_QK(N0, N1, cur ? OFF_K0 : OFF_K1); \
        ATT_SB(); \
        { \
            constexpr unsigned vb_ = (unsigned)(cur ? OFF_V1 : OFF_V0); \
            s16x4 vA[4][2], vB[4][2]; \
            ATT_VLD(vA, 0); \
            ATT_SB(); \
            float ls = 0.f; \
            _Pragma("unroll") for (int r = 0; r < 16; ++r) { C0[r] = __builtin_amdgcn_exp2f(C0[r]); C1[r] = __builtin_amdgcn_exp2f(C1[r]); ls += C0[r]; ls += C1[r]; } \
            l += ls; \
            ATT_SB(); \
            ATT_VLD(vB, 1); ATT_SB(); ATT_PV(vA, 0, C0, C1); ATT_SB(); \
            ATT_VLD(vA, 2); ATT_SB(); ATT_PV(vB, 1, C0, C1); ATT_SB(); \
            ATT_VLD(vB, 3); ATT_SB(); ATT_PV(vA, 2, C0, C1); ATT_SB(); \
            ATT_PV(vB, 3, C0, C1); \
        } \
        ATT_WAITBAR(); } while (0)
    ATT_QK(SA0, SA1, OFF_K0);
    ATT_WAITBAR();
    for (int tt = 0; tt < NT; tt += 2) { ATT_STEP(SA0, SA1, SB0, SB1, tt, 0); if (tt + 1 < NT) ATT_STEP(SB0, SB1, SA0, SA1, tt + 1, 1); }
#undef ATT_STEP
#undef ATT_QK
#undef ATT_VLD
#undef ATT_PV
#undef ATT_SB
#undef ATT_WAITBAR
#undef ATT_ISSUE_K
#undef ATT_ISSUE_V
#undef ATT_DMA
    const int tid2_ = mk_tid(wv);
    const int lane2 = tid2_ & 63, q32b = lane2 & 31, hib = lane2 >> 5;
    float lam;
    { float s1 = lq1[lane2] * lk1[lane2], s2 = lq2[lane2] * lk2[lane2]; s1 = wave_sum(s1); s2 = wave_sum(s2); lam = expf(s1) - expf(s2) + (layer_a == 0 ? 0.2f : 0.47071302f); }
    l = swapsum(l); const float inv = active ? 1.0f / l : 0.f;
    LAS float* xb = (LAS float*)(lds + rg * XB);
    if (mp == 1) { const float f = inv * lam;
#pragma unroll
        for (int i = 0; i < 4; ++i)
#pragma unroll
            for (int r = 0; r < 16; ++r) xb[(i * 16 + r) * 64 + lane2] = O[i][r] * f; }
    __syncthreads();
    if (mp == 0 && active) {
        float ss = 0.f;
#pragma unroll
        for (int i = 0; i < 4; ++i)
#pragma unroll
            for (int r = 0; r < 16; ++r) { const float o = O[i][r] * inv - xb[(i * 16 + r) * 64 + lane2]; O[i][r] = o; ss += o * o; }
        ss = swapsum(ss); const float rs = 1.0f / sqrtf(ss * (1.f / 128.f) + SUBLN_EPS);
        asm volatile("s_waitcnt lgkmcnt(0)" ::: "memory");
        LAS unsigned char* stg = (LAS unsigned char*)xb;
#pragma unroll
        for (int i = 0; i < 4; ++i)
#pragma unroll
            for (int r4 = 0; r4 < 4; ++r4) { const int dv0 = 32 * i + 8 * r4 + 4 * hib; const f32x4 gg = *(const LAS f32x4*)(GT + dv0);
                u32x2 w; w.x = cvtpk(O[i][4 * r4] * rs * gg.x, O[i][4 * r4 + 1] * rs * gg.y); w.y = cvtpk(O[i][4 * r4 + 2] * rs * gg.z, O[i][4 * r4 + 3] * rs * gg.w);
                *(LAS u32x2*)(stg + q32b * KSTR + dv0 * 2) = w; }
        asm volatile("s_waitcnt lgkmcnt(0)" ::: "memory");
        bf16* og = u.O + (size_t)(128 * u.x + rg * 32) * 1024 + u.h * 128;
#pragma unroll
        for (int i = 0; i < 8; ++i) { const int row = i * 4 + (lane2 >> 4), c16 = lane2 & 15; const u32x4 v = *(const LAS u32x4*)(stg + row * KSTR + c16 * 16);
            if (rg * 32 + row < vrows) *(u32x4*)(og + (size_t)row * 1024 + c16 * 8) = v; }
    }
    __syncthreads();
}
__device__ __forceinline__ void attn_phase(ArgsRef A, Frame& F, int a) {
    const bf16* QB = (const bf16*)(F.ws + WS_QB); bf16* OB = (bf16*)(F.ws + WS_XN); const bf16* KX = (const bf16*)(F.ws + WS_KX); const bf16* VX = (const bf16*)(F.ws + WS_VX);
    const bf16* KXS = (const bf16*)(F.ws + WS_KXS) + (size_t)a * KXS_LAYER; const bf16* VXS = (const bf16*)(F.ws + WS_VXS) + (size_t)a * KXS_LAYER;
    { const int gt = blockIdx.x * 512 + mk_tid(F.wave);
      for (int i = gt; i < 65536; i += F.G * 512) { const int c4 = i & 255, r = (i >> 8) & 15, b = (i >> 12) & 7, kv = i >> 15;
          const f32x4 v = *(const f32x4*)((const float*)(F.ws + (kv ? WS_MFV : WS_MFK)) + r * 1024 + c4 * 4);
          *(f32x4*)(F.out + (kv ? OFF_VP : OFF_KP) + (size_t)a * 8 * EXT_P * 1024 + (size_t)(b * EXT_P + r) * 1024 + c4 * 4) = v; } }
    for (int n = F.vcu; n < 4168; n += F.G) {
        AUnit u; u.KM = (const bf16*)(F.ws + WS_KXM); u.VM = (const bf16*)(F.ws + WS_VXM);
        if (n < 4096) { const int i = n >> 8, v = n & 255, c = v & 31, bh = (v >> 5) * 8 + (i >> 1); const int x = (i & 1) ? 63 - c : c; const int b = bh >> 3;
            u.K = KX + (size_t)b * EXT_P * 1024; u.V = VX + (size_t)b * EXT_P * 1024; u.Q = QB + (size_t)b * 8192 * 1024; u.O = OB + (size_t)b * 8192 * 1024; u.P = 16; u.L = 8192; u.x = x; u.h = bh & 7; }
        else if (n < 4160) { const int j = n - 4096, b = j >> 3; u.K = KXS + (size_t)b * EXT_S * 1024; u.V = VXS + (size_t)b * EXT_S * 1024; u.Q = QB + (size_t)(ROW_S + b * 64) * 1024; u.O = OB + (size_t)(ROW_S + b * 64) * 1024; u.P = 1040; u.L = 64; u.x = 0; u.h = j & 7; }
        else { u.K = (const bf16*)(F.ws + WS_KXM); u.V = (const bf16*)(F.ws + WS_VXM); u.Q = QB + (size_t)ROW_M * 1024; u.O = OB + (size_t)ROW_M * 1024; u.P = 0; u.L = 16; u.x = 0; u.h = n - 4160; }
        attn_unit(F.wave, F.lds, u, A.in[12] + a * 64, A.in[13] + a * 64, A.in[14] + a * 64, A.in[15] + a * 64, a, A.in[6], A.in[16] + a * 128);
    }
}
}

#define XB_TMO      128
#define XB_XCNT(j)  (256  + 64 * (j))
#define XB_XSUB(j)  (1280 + 64 * (j))
#define XB_XGEN(j)  (2304 + 64 * (j))
#define XB_TOP      3328
#define XB_TOPGEN   3392
#define XCD_BAR_WORDS 3456
#define XB_SPIN_CAP (1u << 18)

__device__ __forceinline__ unsigned xb_ld(unsigned* p)              { return __hip_atomic_load(p, __ATOMIC_RELAXED, __HIP_MEMORY_SCOPE_AGENT); }
__device__ __forceinline__ unsigned xb_add(unsigned* p, unsigned v) { return __hip_atomic_fetch_add(p, v, __ATOMIC_RELAXED, __HIP_MEMORY_SCOPE_AGENT); }
__device__ __forceinline__ unsigned xb_xcc_id() { return (unsigned)__builtin_amdgcn_s_getreg((3 << 11) | 20) & 0xFu; }
#define XB_SPIN(cond, bar) do { unsigned _sp = 0; while (cond) { __builtin_amdgcn_s_sleep(1); \
    if ((++_sp & 255u) == 0u) { if (xb_ld(&(bar)[XB_TMO])) break; if (_sp > XB_SPIN_CAP) { atomicAdd(&(bar)[XB_TMO], 1u); break; } } } } while (0)

struct XcdBarrier {
    bool leader; unsigned* bar; unsigned x;
    volatile LAS unsigned* st;
};

__device__ __forceinline__ XcdBarrier xcd_barrier_post(unsigned* bar, volatile LAS unsigned* st) {
    XcdBarrier b; b.bar = bar; b.x = xb_xcc_id(); b.st = st;
    b.leader = (threadIdx.x == 0);
    if (b.leader) (void)xb_add(&bar[XB_XCNT(b.x)], 1u);
    return b;
}
__device__ __forceinline__ void xcd_barrier_complete(unsigned* bar, unsigned x, unsigned& nloc, unsigned& nx) {
    const unsigned G = gridDim.x * gridDim.y * gridDim.z;
    unsigned sum, cnt, mine, sp = 0u;
    for (;;) {
        sum = 0u; cnt = 0u; mine = 0u;
#pragma unroll
        for (unsigned j = 0; j < 16; ++j) { const unsigned c = xb_ld(&bar[XB_XCNT(j)]); sum += c; cnt += (c > 0u) ? 1u : 0u; mine = (j == x) ? c : mine; }
        if (sum == G) break;
        __builtin_amdgcn_s_sleep(1);
        if ((++sp & 255u) == 0u) { if (xb_ld(&bar[XB_TMO])) break; if (sp > XB_SPIN_CAP) { atomicAdd(&bar[XB_TMO], 1u); break; } }
    }
    nloc = mine > 0u ? mine : 1u; nx = cnt > 0u ? cnt : 1u;
}

__device__ __forceinline__ void xcd_barrier(const XcdBarrier& b) {
    asm volatile("s_waitcnt vmcnt(0)" ::: "memory");
    __syncthreads();
    if (b.leader) {
        unsigned* bar = b.bar;
        __builtin_amdgcn_s_waitcnt(0);
        unsigned nloc = b.st[0], nx = b.st[1];
        if (nloc == 0u) { xcd_barrier_complete(bar, b.x, nloc, nx); b.st[0] = nloc; b.st[1] = nx; }
        const unsigned old = xb_add(&bar[XB_XSUB(b.x)], 1u);
        const unsigned gen = old / nloc;
        if (old + 1u == (gen + 1u) * nloc) {
            __builtin_amdgcn_fence(__ATOMIC_RELEASE, "agent");
            asm volatile("s_waitcnt vmcnt(0)" ::: "memory");
            const unsigned og = xb_add(&bar[XB_TOP], 1u);
            const unsigned tg = og / nx;
            if (og + 1u == (tg + 1u) * nx) xb_add(&bar[XB_TOPGEN], 1u);
            else XB_SPIN(xb_ld(&bar[XB_TOPGEN]) == tg, bar);
            __builtin_amdgcn_fence(__ATOMIC_ACQUIRE, "agent");
            xb_add(&bar[XB_XGEN(b.x)], 1u);
            asm volatile("s_waitcnt vmcnt(0)" ::: "memory");
        } else {
            XB_SPIN(xb_ld(&bar[XB_XGEN(b.x)]) == gen, bar);
            __builtin_amdgcn_fence(__ATOMIC_ACQUIRE, "agent");
            asm volatile("s_waitcnt vmcnt(0)" ::: "memory");
        }
    }
    __syncthreads();
}

__device__ __forceinline__ void run_step(ArgsRef args, const int step, const int wv) {
    extern __shared__ __attribute__((aligned(16))) unsigned char lds_raw[];
    Frame F;
    F.lds = (LAS unsigned char*)lds_raw; F.tid = 0; F.lane = 0; F.wave = wv;
    F.G = gridDim.x; { const int bx = blockIdx.x; F.vcu = (F.G % 8 == 0) ? (bx % 8) * (F.G / 8) + bx / 8 : bx; }
    F.out = args.out; F.ws = args.ws;
    bf16* XN = (bf16*)(F.ws + WS_XN); bf16* QB = (bf16*)(F.ws + WS_QB); bf16* YB = (bf16*)(F.ws + WS_YB); bf16* U = (bf16*)(F.ws + WS_U);
    int layer = 0, k = -1;
    if (step > 0) { const int s = step - 1; if (s < 7) { layer = 0; k = s; } else if (s < 13) { layer = 1; k = s - 7; } else if (s < 20) { layer = 2; k = s - 13; } else { layer = 3; k = s - 20; } }
    const bool attn = (layer & 1) == 0; const int a = layer >> 1;
    int type;
    if (step == 0) type = 0; else if (attn) type = k == 0 ? 1 : k == 1 ? 2 : k == 2 ? 4 : k == 3 ? 5 : k == 4 ? 6 : k == 5 ? 7 : 8;
    else type = k == 0 ? 3 : k == 1 ? 4 : k == 2 ? 5 : k == 3 ? 6 : k == 4 ? 7 : 8;
    if (type == 0) prologue(args, F);
    else if (type == 1) {
        pg8::Gemm g{XN, (const bf16*)(F.ws + WS_WQKV) + (size_t)a * 3072 * D, MPAD, 3072, D, D, D, 0}; pg8::StaticOrder S; S.init(MPAD, 3072, F.G, (int)blockIdx.x, D);
        pg8::EpiQKV E{F.ws, F.out, a};
        pg8::gemm_phase<pg8::EpiQKV, pg8::StaticOrder, true, true>(F.lds, g, S, E, mk_tid(F.wave));
    } else if (type == 2) { att::attn_phase(args, F, a); }
    else if (type == 3) { pool_phase(args, F, a); }
    else if (type == 4 || type == 7) {
        pg8::Gemm g;
        if (type == 7) g = pg8::Gemm{U, (const bf16*)(F.ws + WS_WDN) + (size_t)layer * D * FF, MPAD, D, FF, FF, FF, 0};
        else if (attn) g = pg8::Gemm{XN, (const bf16*)(F.ws + WS_WO) + (size_t)a * D * D, MPAD, D, D, D, D, 0};
        else g = pg8::Gemm{QB, (const bf16*)(F.ws + WS_WPOOL) + (size_t)a * 4 * 65536, MPAD, D, 256, D, 256, 512};
        pg8::TailOrder S; S.init(D, F.G, (int)blockIdx.x, g.K, type == 7 ? 16 : (attn ? 4 : 1));
        pg8::EpiBf16<0> E{YB, D, (float*)(F.ws + WS_YF)};
        pg8::gemm_phase<pg8::EpiBf16<0>, pg8::TailOrder, true, true>(F.lds, g, S, E, mk_tid(F.wave));
    } else if (type == 5) { fin_phase(args, F, layer == 0, attn ? 4 : 0, args.in[8] + layer * D, args.in[9] + layer * D); }
    else if (type == 6) {
        pg8::Gemm g{XN, (const bf16*)(F.ws + WS_WUP) + (size_t)layer * D * FF, MPAD, FF, D, D, D, 0}; pg8::StaticOrder S; S.init(MPAD, FF, F.G, (int)blockIdx.x, D);
        pg8::EpiBf16<2> E{U, FF, nullptr};
        pg8::gemm_phase<pg8::EpiBf16<2>, pg8::StaticOrder, true, true>(F.lds, g, S, E, mk_tid(F.wave));
    } else { fin_phase(args, F, false, 16, args.in[10] + layer * D, layer < 3 ? args.in[7] + (layer + 1) * D : nullptr); }
}
__global__ void __launch_bounds__(512, 2) fwd_kernel(Args args_) {
    const int lo = args_.lo, hi = args_.hi;
    const int wv = __builtin_amdgcn_readfirstlane((int)threadIdx.x >> 6);
    extern __shared__ __attribute__((aligned(16))) unsigned char lds_raw[];
    volatile LAS unsigned* bst = (volatile LAS unsigned*)((LAS unsigned char*)lds_raw + 139264);
    if (threadIdx.x < 2) bst[threadIdx.x] = 0u;
    __syncthreads();
    XcdBarrier bar = xcd_barrier_post((unsigned*)args_.ws + 4096, bst);
    int probe_rep = 0; (void)probe_rep;
    for (int step = lo; step < hi; ++step) {
        const __attribute__((address_space(4))) Args* ap = (const __attribute__((address_space(4))) Args*)__builtin_amdgcn_kernarg_segment_ptr();
        asm volatile("" : "+s"(ap));
        run_step(*ap, step, wv);
#if defined(PROBE_MASK)
        {
            int ty = 0; if (step > 0) { const int s = step - 1; const int k = s < 7 ? s : s < 13 ? s - 7 : s < 20 ? s - 13 : s - 20; const bool at = (s < 7) || (s >= 13 && s < 20);
                ty = at ? (k == 0 ? 1 : k == 1 ? 2 : k == 2 ? 4 : k == 3 ? 5 : k == 4 ? 6 : k == 5 ? 7 : 8) : (k == 0 ? 3 : k == 1 ? 4 : k == 2 ? 5 : k == 3 ? 6 : k == 4 ? 7 : 8); }
            if (((PROBE_MASK >> ty) & 1) && !probe_rep) { probe_rep = 1; --step; __syncthreads(); continue; }
            probe_rep = 0; }
#endif
        if (step + 1 < hi) { if (lo < 0) { __threadfence(); cg::this_grid().sync(); }
            else { xcd_barrier(bar);
#if defined(PROBE_BAR2)
 xcd_barrier(bar);
#endif
 } }
    }
}

extern "C" void kernel_launch(void* const* d_in, const int* in_sizes, int n_in, void* d_out, int out_size, void* d_ws, size_t ws_size, hipStream_t stream) {
    static int grid = 0;
    if (grid == 0) {
        if (n_in != 22 || (size_t)out_size != OUT_TOTAL || ws_size < WS_END) { fprintf(stderr, "kernel_launch: unexpected shapes n_in %d out %d ws %zu\n", n_in, out_size, ws_size); grid = -1; return; }
        int dev = 0, cus = 0, per_cu = 0;
        hipGetDevice(&dev); hipDeviceGetAttribute(&cus, hipDeviceAttributeMultiprocessorCount, dev);
        hipFuncSetAttribute((const void*)fwd_kernel, hipFuncAttributeMaxDynamicSharedMemorySize, LDS_BYTES);
        hipOccupancyMaxActiveBlocksPerMultiprocessor(&per_cu, (const void*)fwd_kernel, 512, LDS_BYTES);
        if (per_cu < 1) { fprintf(stderr, "kernel_launch: occupancy query says %d blocks/CU\n", per_cu); per_cu = 1; }
        (void)hipGetLastError();
        grid = cus;
    }
    if (grid < 0) return;
    if (hipMemsetAsync(d_ws, 0, 65536, stream) != hipSuccess) { fprintf(stderr, "kernel_launch: memset failed\n"); return; }
    Args a{};
    for (int i = 0; i < 22; ++i) a.in[i] = (const float*)d_in[i];
    a.out = (float*)d_out; a.ws = (unsigned char*)d_ws;
#if ONE_LAUNCH
    a.lo = 0; a.hi = NSTEPS;
    void* kargs[] = {&a};
    hipError_t e = hipLaunchCooperativeKernel((const void*)fwd_kernel, dim3(grid), dim3(512), kargs, LDS_BYTES, stream);
    if (e != hipSuccess) fprintf(stderr, "cooperative launch failed: %s (grid %d)\n", hipGetErrorString(e), grid);
#else
    for (int s = 0; s < NSTEPS; ++s) { a.lo = s; a.hi = s + 1; hipLaunchKernelGGL(fwd_kernel, dim3(grid), dim3(512), LDS_BYTES, stream, a); }
#endif
}
static_assert(WS_QB == 213 * MiB && WS_KX == 473 * MiB && WS_VX == 602 * MiB && WS_KXS == 731 * MiB && WS_VXS == 767 * MiB && WS_KXM == 803 * MiB && WS_VXM == 804 * MiB && KXS_LAYER == 9 * MiB && WS_MFK == 1323 * MiB && WS_MFV == 1324 * MiB, "EpiQKV hard-coded map");
static_assert(OFF_KP == 67633152 && OFF_VP == 202113024 && OFF_KS == 336838656 && OFF_VS == 337887232, "EpiQKV hard-coded output offsets");
```

```cpp
#include <hip/hip_runtime.h>
#include <hip/hip_cooperative_groups.h>
#include <hip/hip_bf16.h>
#include <cstdio>
#include <cstdint>
namespace cg = cooperative_groups;
namespace pg8 {
#define PG8_LAS __attribute__((address_space(3)))
typedef unsigned short bf16_t;
typedef short bf16x8 __attribute__((ext_vector_type(8)));
typedef float f32x4 __attribute__((ext_vector_type(4)));
typedef unsigned u32x4 __attribute__((ext_vector_type(4)));
constexpr int BM = 256, BK = 64, HALF = 128, HTB = HALF * BK * 2  , STAGE_BYTES = 8 * HTB, NXCD = 8, WGM = 8;

__host__ __device__ __forceinline__ int lds_byte(int r, int c) { const int st = (r >> 4) * 2 + (c >> 5), rr = r & 15, cc = c & 31, ob = rr * 64 + cc * 2; return st * 1024 + (ob ^ (((ob >> 9) & 1) << 5)); }
__host__ __device__ __forceinline__ void stage_rc(int b, int& R, int& C) { const int st = b / 1024, sb = b % 1024, swz = sb ^ (((sb >> 9) & 1) << 5); R = (st >> 1) * 16 + swz / 64; C = (st & 1) * 32 + (swz % 64) / 2; }
__host__ __device__ __forceinline__ int perm32(int rho) { const int n = rho >> 4, i = rho & 15; return 8 * (i >> 2) + 4 * n + (i & 3); }

struct Unit { int pm, pn, ko, nt, sp; };
struct Gemm { const bf16_t* A; const bf16_t* Bt; int M, N, K, lda, ldb, acs; };

struct StaticOrder {
    int nM, nN, nwg, G, c, ntf;
    __host__ __device__ void init(int M, int N, int G_, int c_, int K) { nM = M / BM; nN = N / BM; nwg = nM * nN; G = G_; c = c_; ntf = K / BK; }
    __host__ __device__ bool next(int i, Unit& u) const {
        const long L = (long)i * G + c; if (L >= nwg) return false;
        int wgid = (int)L; { const int q = nwg / NXCD, r = nwg % NXCD, xcd = wgid % NXCD, off = wgid / NXCD; wgid = (xcd < r ? xcd * (q + 1) : r * (q + 1) + (xcd - r) * q) + off; }
        const int nig = WGM * nN, gid = wgid / nig, fm = gid * WGM, gsz = (nM - fm) < WGM ? (nM - fm) : WGM;
        u.pm = fm + ((wgid % nig) % gsz); u.pn = (wgid % nig) / gsz; u.ko = 0; u.nt = ntf; u.sp = 0; return true;
    }
    __device__ __forceinline__ void a_ready(const Unit&) const {}
    __device__ __forceinline__ void done(const Unit&) const {}
};
struct TailOrder {
    StaticOrder mn; int KS, kc;
    __host__ __device__ void init(int N, int G_, int c_, int K, int KS_) { mn.init(65536, N, G_, c_, K); KS = KS_; kc = K / KS_; }
    __host__ __device__ bool next(int i, Unit& u) const {
        const long L = (long)i * mn.G + mn.c; if (L < mn.nwg) return mn.next(i, u);
        const int Lt = (int)(L - mn.nwg); if (Lt >= 3 * mn.nN * KS) return false;
        const int tile = Lt / KS, ks = Lt - tile * KS; u.pm = 256 + tile / mn.nN; u.pn = tile % mn.nN; u.ko = ks * kc; u.nt = kc / BK; u.sp = KS > 1 ? ks + 1 : 0; return true;
    }
    __device__ __forceinline__ void a_ready(const Unit&) const {}
    __device__ __forceinline__ void done(const Unit&) const {}
};

__device__ __forceinline__ unsigned cvt_pk_bf16(float lo, float hi) { unsigned r; asm volatile("v_cvt_pk_bf16_f32 %0, %1, %2" : "=v"(r) : "v"(lo), "v"(hi)); return r; }
template <int ACT  > struct EpiBf16 {
    static constexpr bool PERM = true, AFTER_DRAIN = false;
    bf16_t* O; int ldc; float* yf;
    __device__ __forceinline__ void operator()(const f32x4 (&acc)[2][2][4][2], const Unit& u, int wr, int wc, int fr, int fq) const {
        asm volatile("" : "+v"(fr), "+v"(fq));
        const int row0 = u.pm * BM + wr * 64 + fr; const int col0 = u.pn * BM + wc * 32 + 8 * fq;
#pragma unroll
        for (int ai = 0; ai < 2; ++ai)
#pragma unroll
            for (int m = 0; m < 4; ++m) { bf16_t* rowp = O + (size_t)(row0 + ai * HALF + m * 16) * ldc + col0;
#pragma unroll
                for (int bj = 0; bj < 2; ++bj) { f32x4 v0 = acc[ai][bj][m][0], v1 = acc[ai][bj][m][1];
                    if (ACT == 2) {
#pragma unroll
                        for (int e = 0; e < 4; ++e) { float a = fmaxf(v0[e], 0.f), b = fmaxf(v1[e], 0.f); v0[e] = a * a; v1[e] = b * b; } }
                    if (u.sp) { float* yr = yf + ((size_t)(u.sp - 1) * 768 + (size_t)(row0 + ai * HALF + m * 16 - 65536)) * 1024 + col0 + bj * HALF;
                        *(f32x4*)yr = v0; *(f32x4*)(yr + 4) = v1; }
                    else { u32x4 w; w.x = cvt_pk_bf16(v0[0], v0[1]); w.y = cvt_pk_bf16(v0[2], v0[3]); w.z = cvt_pk_bf16(v1[0], v1[1]); w.w = cvt_pk_bf16(v1[2], v1[3]);
                    *(u32x4*)(rowp + bj * HALF) = w; } } }
    }
};
struct EpiQKV {
    static constexpr bool PERM = true, AFTER_DRAIN = false;
    unsigned char* ws; float* out; int a;
    __device__ __forceinline__ void operator()(const f32x4 (&acc)[2][2][4][2], const Unit& u, int wr, int wc, int fr, int fq) const {
        const size_t MiB_ = 1u << 20;
        asm volatile("" : "+v"(fr), "+v"(fq));
        const int t3 = u.pn >> 2; const int colb = (u.pn & 3) * 256 + wc * 32 + 8 * fq;
        bf16_t* X; float* Fp = nullptr; int rbase, jump = 0, s0 = 0; float sc = 1.f;
        if (t3 == 0) { X = (bf16_t*)(ws + 213 * MiB_); rbase = u.pm * BM; sc = 0.125f * 1.4426950408889634f; }
        else if (u.pm < 256) { const int b = u.pm >> 5; rbase = b * 8208 + 16 + (u.pm & 31) * 256; X = (bf16_t*)(ws + (t3 == 1 ? 473 : 602) * MiB_);
            Fp = out + (t3 == 1 ? (size_t)67633152 : (size_t)202113024) + (size_t)a * 8 * 8208 * 1024 + (size_t)rbase * 1024; }
        else if (u.pm < 258) { s0 = (u.pm - 256) * 256; rbase = 1040 + s0; jump = 1040; X = (bf16_t*)(ws + (t3 == 1 ? 731 : 767) * MiB_) + (size_t)a * (9 * MiB_);
            Fp = out + (t3 == 1 ? (size_t)336838656 : (size_t)337887232) + (size_t)a * 512 * 1024 + (size_t)s0 * 1024; }
        else { rbase = 0; X = (bf16_t*)(ws + (t3 == 1 ? 803 : 804) * MiB_); Fp = (float*)(ws + (t3 == 1 ? 1323 : 1324) * MiB_); }
#pragma unroll
        for (int ai = 0; ai < 2; ++ai)
#pragma unroll
            for (int m = 0; m < 4; ++m) { const int rit = ai * HALF + wr * 64 + m * 16 + fr;
                bf16_t* xr = X + (unsigned)((rbase + rit + ((s0 + rit) >> 6) * jump) * 1024 + colb); float* fr_ = Fp + (unsigned)(rit * 1024 + colb);
#pragma unroll
                for (int bj = 0; bj < 2; ++bj) { const f32x4 v0 = acc[ai][bj][m][0], v1 = acc[ai][bj][m][1]; const f32x4 s0v = v0 * sc, s1v = v1 * sc;
                    u32x4 w; w.x = cvt_pk_bf16(s0v[0], s0v[1]); w.y = cvt_pk_bf16(s0v[2], s0v[3]); w.z = cvt_pk_bf16(s1v[0], s1v[1]); w.w = cvt_pk_bf16(s1v[2], s1v[3]);
                    *(u32x4*)(xr + bj * HALF) = w;
                    if (t3 != 0) { *(f32x4*)(fr_ + bj * HALF) = v0; *(f32x4*)(fr_ + bj * HALF + 4) = v1; } } }
    }
};
template <class Epi, class Sched, bool ALIGN_EPI = false, bool SP2 = false>
__device__ __forceinline__ void gemm_phase(PG8_LAS unsigned char* lds, const Gemm g, const Sched& S, const Epi& E, const int tid_in) {
    int tid_ = tid_in; asm volatile("" : "+v"(tid_));
    const int tid = tid_, wid = __builtin_amdgcn_readfirstlane(tid >> 6), lane = tid & 63, wr = wid >> 2, wc = wid & 3, fr = lane & 15, fq = lane >> 4;
    const int K = g.K; (void)K;
    unsigned voffA[2], voffB[2];
#pragma unroll
    for (int i = 0; i < 2; ++i) { int R, C; stage_rc(tid * 16 + i * 8192, R, C); const int Rb = Epi::PERM ? ((R & ~31) + perm32(R & 31)) : R;
        voffA[i] = (unsigned)(R * g.lda + C) * 2u; voffB[i] = (unsigned)(Rb * g.ldb + C) * 2u; }
    const size_t kstep = (size_t)(BK * 2);
    const size_t hstepA = (size_t)HALF * g.lda * 2, hstepB = (size_t)HALF * g.ldb * 2;
    const size_t tstepA = 2 * hstepA, tstepB = 2 * hstepB;
    const unsigned ldsw = (unsigned)wid * 1024u;
    const int aoff = lds_byte(wr * 64 + fr, fq * 8), boff = lds_byte(wc * 32 + fr, fq * 8);
#define PG8_SA(b, h) (((b) * 2 + (h)) * HTB)
#define PG8_SB(b, h) ((4 + (b) * 2 + (h)) * HTB)
#define PG8_STAGE(bufoff, gbase, voff) do { _Pragma("unroll") for (int _i = 0; _i < 2; ++_i) \
        __builtin_amdgcn_global_load_lds((const unsigned*)((const char*)(gbase) + (voff)[_i]), (PG8_LAS unsigned*)(lds + (bufoff) + ldsw + _i * 8192), 16, 0, 0); } while (0)
#define PG8_LDA(dst, b, h) do { _Pragma("unroll") for (int m = 0; m < 4; ++m) _Pragma("unroll") for (int k = 0; k < 2; ++k) dst[m][k] = *(const PG8_LAS bf16x8*)(lds + PG8_SA(b, h) + aoff + m * 2048 + k * 1024); } while (0)
#define PG8_LDB(dst, b, h) do { _Pragma("unroll") for (int n = 0; n < 2; ++n) _Pragma("unroll") for (int k = 0; k < 2; ++k) dst[n][k] = *(const PG8_LAS bf16x8*)(lds + PG8_SB(b, h) + boff + n * 2048 + k * 1024); } while (0)
#define PG8_MMA(ai, bj, At, Bt) do { __builtin_amdgcn_s_setprio(1); _Pragma("unroll") for (int m = 0; m < 4; ++m) _Pragma("unroll") for (int n = 0; n < 2; ++n) _Pragma("unroll") for (int k = 0; k < 2; ++k) \
        acc[ai][bj][m][n] = __builtin_amdgcn_mfma_f32_16x16x32_bf16(Bt[n][k], At[m][k], acc[ai][bj][m][n], 0, 0, 0); __builtin_amdgcn_s_setprio(0); } while (0)
#define PG8_WAIT_V(n) asm volatile("s_waitcnt vmcnt(" #n ")" ::: "memory")
#define PG8_WAIT_L(n) asm volatile("s_waitcnt lgkmcnt(" #n ")" ::: "memory")
#define PG8_BAR __builtin_amdgcn_s_barrier()
#define PG8_SCHED __builtin_amdgcn_sched_barrier(0)
    Unit cur, nxt; int ui = 0;
    if (!S.next(0, cur)) return;
    f32x4 acc[2][2][4][2];
#pragma unroll
    for (int a = 0; a < 2; ++a)
#pragma unroll
        for (int b = 0; b < 2; ++b)
#pragma unroll
            for (int m = 0; m < 4; ++m)
#pragma unroll
                for (int n = 0; n < 2; ++n) acc[a][b][m][n] = (f32x4){0.f, 0.f, 0.f, 0.f};
    bf16x8 At[4][2], B0[2][2], B1[2][2];
    const char* cA = (const char*)g.A + (size_t)cur.pm * tstepA + (size_t)cur.pn * g.acs + (size_t)cur.ko * 2; const char* cB = (const char*)g.Bt + (size_t)cur.pn * tstepB + (size_t)cur.ko * 2;
    S.a_ready(cur);
    if constexpr (SP2) {
        PG8_STAGE(PG8_SB(0, 0), cB, voffB); PG8_STAGE(PG8_SB(0, 1), cB + hstepB, voffB); PG8_STAGE(PG8_SA(0, 0), cA, voffA); PG8_STAGE(PG8_SA(0, 1), cA + hstepA, voffA);
        if (wr == 1) PG8_BAR;
        PG8_WAIT_V(2); PG8_BAR;
        PG8_STAGE(PG8_SB(1, 0), cB + kstep, voffB); PG8_STAGE(PG8_SA(1, 0), cA + kstep, voffA); PG8_STAGE(PG8_SB(1, 1), cB + hstepB + kstep, voffB);
        PG8_WAIT_V(6); PG8_BAR;
    } else {
        PG8_STAGE(PG8_SB(0, 0), cB, voffB); PG8_STAGE(PG8_SA(0, 0), cA, voffA); PG8_STAGE(PG8_SB(0, 1), cB + hstepB, voffB); PG8_STAGE(PG8_SA(0, 1), cA + hstepA, voffA);
        if (wr == 1) PG8_BAR;
        PG8_WAIT_V(4); PG8_BAR;
        PG8_STAGE(PG8_SB(1, 0), cB + kstep, voffB); PG8_STAGE(PG8_SA(1, 0), cA + kstep, voffA); PG8_STAGE(PG8_SB(1, 1), cB + hstepB + kstep, voffB);
        PG8_WAIT_V(6); PG8_BAR;
    }
    for (;;) {
        const bool has_next = S.next(ui + 1, nxt);
        const char* nA = has_next ? (const char*)g.A + (size_t)nxt.pm * tstepA + (size_t)nxt.pn * g.acs + (size_t)nxt.ko * 2 : cA; const char* nB = has_next ? (const char*)g.Bt + (size_t)nxt.pn * tstepB + (size_t)nxt.ko * 2 : cB;
        const int nt = cur.nt;
        for (int t = 0; t < nt; t += 2) {
            const bool last = (t == nt - 2);
            const char* a1 = cA + (size_t)(t + 1) * kstep;
            const char* a2 = last ? nA : cA + (size_t)(t + 2) * kstep; const char* b2 = last ? nB : cB + (size_t)(t + 2) * kstep;
            const char* a3 = a2 + kstep; const char* b3 = b2 + kstep;
            if (last && has_next) S.a_ready(nxt);
            if constexpr (SP2) {
            PG8_LDB(B0, 0, 0); PG8_LDB(B1, 0, 1); PG8_SCHED; PG8_LDA(At, 0, 0); PG8_STAGE(PG8_SA(1, 1), a1 + hstepA, voffA);
            PG8_WAIT_V(8); PG8_WAIT_L(0); PG8_BAR; PG8_MMA(0, 0, At, B0); PG8_MMA(0, 1, At, B1); PG8_BAR; PG8_SCHED;
            PG8_LDA(At, 0, 1); PG8_STAGE(PG8_SB(0, 0), b2, voffB); PG8_STAGE(PG8_SB(0, 1), b2 + hstepB, voffB); PG8_STAGE(PG8_SA(0, 0), a2, voffA);
            PG8_WAIT_V(8); PG8_WAIT_L(0); PG8_BAR; PG8_MMA(1, 0, At, B0); PG8_MMA(1, 1, At, B1); PG8_BAR; PG8_SCHED;
            PG8_LDB(B0, 1, 0); PG8_LDB(B1, 1, 1); PG8_SCHED; PG8_LDA(At, 1, 0); PG8_STAGE(PG8_SA(0, 1), a2 + hstepA, voffA);
            PG8_WAIT_V(8); PG8_WAIT_L(0); PG8_BAR; PG8_MMA(0, 0, At, B0); PG8_MMA(0, 1, At, B1); PG8_BAR; PG8_SCHED;
            PG8_LDA(At, 1, 1); PG8_STAGE(PG8_SB(1, 0), b3, voffB); PG8_STAGE(PG8_SB(1, 1), b3 + hstepB, voffB); PG8_STAGE(PG8_SA(1, 0), a3, voffA);
            PG8_WAIT_V(8); PG8_WAIT_L(0); PG8_BAR; PG8_MMA(1, 0, At, B0); PG8_MMA(1, 1, At, B1); PG8_BAR; PG8_SCHED;
            } else {
            PG8_LDB(B0, 0, 0); PG8_SCHED; PG8_LDA(At, 0, 0); PG8_STAGE(PG8_SA(1, 1), a1 + hstepA, voffA);
            PG8_WAIT_L(8); PG8_BAR; PG8_WAIT_L(0); PG8_MMA(0, 0, At, B0); PG8_BAR; PG8_SCHED;
            PG8_LDB(B1, 0, 1); PG8_STAGE(PG8_SB(0, 0), b2, voffB);
            PG8_BAR; PG8_WAIT_L(0); PG8_MMA(0, 1, At, B1); PG8_BAR;
            PG8_LDA(At, 0, 1); PG8_STAGE(PG8_SA(0, 0), a2, voffA);
            PG8_BAR; PG8_WAIT_L(0); PG8_MMA(1, 0, At, B0); PG8_BAR; PG8_SCHED;
            PG8_STAGE(PG8_SB(0, 1), b2 + hstepB, voffB);
            PG8_WAIT_V(6); PG8_BAR; PG8_MMA(1, 1, At, B1); PG8_BAR;
            PG8_LDB(B0, 1, 0); PG8_SCHED; PG8_LDA(At, 1, 0); PG8_STAGE(PG8_SA(0, 1), a2 + hstepA, voffA);
            PG8_WAIT_L(8); PG8_BAR; PG8_WAIT_L(0); PG8_MMA(0, 0, At, B0); PG8_BAR; PG8_SCHED;
            PG8_LDB(B1, 1, 1); PG8_STAGE(PG8_SB(1, 0), b3, voffB);
            PG8_BAR; PG8_WAIT_L(0); PG8_MMA(0, 1, At, B1); PG8_BAR;
            PG8_LDA(At, 1, 1); PG8_STAGE(PG8_SA(1, 0), a3, voffA);
            PG8_BAR; PG8_WAIT_L(0); PG8_MMA(1, 0, At, B0); PG8_BAR; PG8_SCHED;
            PG8_STAGE(PG8_SB(1, 1), b3 + hstepB, voffB);
            PG8_WAIT_V(6); PG8_BAR; PG8_MMA(1, 1, At, B1); PG8_BAR;
            }
        }
        if constexpr (ALIGN_EPI) { if (wr == 0) PG8_BAR; }
        if constexpr (!Epi::AFTER_DRAIN) { E(acc, cur, wr, wc, fr, fq); S.done(cur); }
        if (!has_next) break;
#pragma unroll
        for (int a = 0; a < 2; ++a)
#pragma unroll
            for (int b = 0; b < 2; ++b)
#pragma unroll
                for (int m = 0; m < 4; ++m)
#pragma unroll
                    for (int n = 0; n < 2; ++n) acc[a][b][m][n] = (f32x4){0.f, 0.f, 0.f, 0.f};
        cur = nxt; cA = nA; cB = nB; ++ui;
        if constexpr (ALIGN_EPI) { if (wr == 1) PG8_BAR; }
    }
    PG8_WAIT_V(0);
    if constexpr (!ALIGN_EPI) { if (wr == 0) PG8_BAR; }
    PG8_BAR;
    if constexpr (Epi::AFTER_DRAIN) { E.fused(acc, cur, wr, wc, fr, fq, lds, wid, lane); S.done(cur); }
#undef PG8_SA
#undef PG8_SB
#undef PG8_STAGE
#undef PG8_LDA
#undef PG8_LDB
#undef PG8_MMA
#undef PG8_WAIT_V
#undef PG8_WAIT_L
#undef PG8_BAR
#undef PG8_SCHED
}
}
#define LAS __attribute__((address_space(3)))
#define GAS __attribute__((address_space(1)))
typedef unsigned short bf16;
typedef unsigned u32x4 __attribute__((ext_vector_type(4)));
typedef unsigned u32x2 __attribute__((ext_vector_type(2)));
typedef float f32x4 __attribute__((ext_vector_type(4)));
typedef float f32x2 __attribute__((ext_vector_type(2)));
typedef float f32x16 __attribute__((ext_vector_type(16)));
typedef short bf16x8 __attribute__((ext_vector_type(8)));
typedef short s16x4 __attribute__((ext_vector_type(4)));
constexpr int D = 1024, FF = 4096, NH = 8;
constexpr int ROW_S = 65536, ROW_M = 66048, ROWS_VALID = 66064, MPAD = 66304;
constexpr int EXT_P = 8208, EXT_S = 1104;
constexpr float LOG2E = 1.4426950408889634f;
constexpr float QSCALE = 0.125f * LOG2E;
constexpr float EPS = 1e-6f, SUBLN_EPS = 1e-5f;
constexpr size_t OFF_YP = 0, OFF_YS = 67108864, OFF_KP = OFF_YS + 524288, OFF_VP = OFF_KP + 134479872, OFF_PP = OFF_VP + 134479872,
                 OFF_KS = OFF_PP + 245760, OFF_VS = OFF_KS + 1048576, OFF_PS = OFF_VS + 1048576, OUT_TOTAL = OFF_PS + 245760;
constexpr size_t MiB = 1u << 20;
constexpr size_t WS_WQKV = 1 * MiB, WS_WO = 13 * MiB, WS_WPOOL = 17 * MiB, WS_WUP = 18 * MiB, WS_WDN = 50 * MiB, WS_XM = 82 * MiB,
                 WS_XN = 83 * MiB, WS_QB = 213 * MiB, WS_YB = 343 * MiB, WS_KX = 473 * MiB, WS_VX = 602 * MiB, WS_KXS = 731 * MiB, WS_VXS = 767 * MiB,
                 WS_KXM = 803 * MiB, WS_VXM = 804 * MiB, WS_U = 805 * MiB, WS_MFK = 1323 * MiB, WS_MFV = 1324 * MiB, WS_YF = 1325 * MiB, WS_END = 1373 * MiB;
constexpr size_t KXS_LAYER = 18 * MiB / 2;
constexpr int LDS_BYTES = 147456;
constexpr int NSTEPS = 27;
#ifndef ONE_LAUNCH
#define ONE_LAUNCH 1
#endif

__device__ __forceinline__ unsigned f2bf(float f) { unsigned u = __builtin_bit_cast(unsigned, f); return (u + 0x7fffu + ((u >> 16) & 1u)) >> 16; }
__device__ __forceinline__ unsigned pk2(float lo, float hi) { return f2bf(lo) | (f2bf(hi) << 16); }
__device__ __forceinline__ float bflo(unsigned w) { return __builtin_bit_cast(float, w << 16); }
__device__ __forceinline__ float bfhi(unsigned w) { return __builtin_bit_cast(float, w & 0xffff0000u); }
__device__ __forceinline__ float wave_sum(float v) {
#pragma unroll
    for (int o = 1; o < 64; o <<= 1) v += __shfl_xor(v, o);
    return v;
}

struct Args { const float* in[22]; float* out; unsigned char* ws; int lo, hi; };
typedef const __attribute__((address_space(4))) Args& ArgsRef;
__device__ __forceinline__ int mk_tid(int wv) { int t; asm volatile("v_mbcnt_lo_u32_b32 %0, -1, 0\n\tv_mbcnt_hi_u32_b32 %0, -1, %0" : "=v"(t)); return wv * 64 + t; }
struct Frame {
    LAS unsigned char* lds; int tid, lane, wave, vcu, G;
    float* out; unsigned char* ws;
};

__device__ __forceinline__ void transpose_item(const float* W, int K, int N, bf16* WT, LAS float* scr, int item, int lane, const float* nscale) {
    const int nblk = N / 64, kb = item / nblk, nb = item % nblk, k0 = 64 * kb, n0 = 64 * nb;
    f32x4 v[16];
#pragma unroll
    for (int i = 0; i < 16; ++i) v[i] = *(const f32x4*)(W + (size_t)(k0 + 4 * i + (lane >> 4)) * N + n0 + 4 * (lane & 15));
#pragma unroll
    for (int i = 0; i < 16; ++i) { LAS float* d = scr + (4 * i + (lane >> 4)) * 65 + 4 * (lane & 15); d[0] = v[i].x; d[1] = v[i].y; d[2] = v[i].z; d[3] = v[i].w; }
    asm volatile("s_waitcnt lgkmcnt(0)" ::: "memory");
    const int c = lane & 7;
#pragma unroll
    for (int j = 0; j < 8; ++j) { const int n = (lane >> 3) + 8 * j; const LAS float* s = scr + (8 * c) * 65 + n; const float sc = nscale ? nscale[n0 + n] : 1.f;
        u32x4 o; o.x = pk2(s[0 * 65] * sc, s[1 * 65] * sc); o.y = pk2(s[2 * 65] * sc, s[3 * 65] * sc); o.z = pk2(s[4 * 65] * sc, s[5 * 65] * sc); o.w = pk2(s[6 * 65] * sc, s[7 * 65] * sc);
        *(u32x4*)(WT + (size_t)(n0 + n) * K + k0 + 8 * c) = o; }
    asm volatile("s_waitcnt lgkmcnt(0)" ::: "memory");
}
__device__ __forceinline__ const float* xin_row(ArgsRef A, int row) {
    return row < ROW_S ? A.in[0] + (size_t)row * D : row < ROW_M ? A.in[1] + (size_t)(row - ROW_S) * D : A.in[5] + (size_t)(row - ROW_M) * D;
}
__device__ __forceinline__ float* xres_row(const Frame& F, int row) {
    return row < ROW_S ? F.out + OFF_YP + (size_t)row * D : row < ROW_M ? F.out + OFF_YS + (size_t)(row - ROW_S) * D : (float*)(F.ws + WS_XM) + (size_t)(row - ROW_M) * D;
}
__device__ __forceinline__ void prologue(ArgsRef A, Frame& F) {
    { const int t_ = mk_tid(F.wave); F.tid = t_; F.lane = t_ & 63; }
    LAS float* scr = (LAS float*)(F.lds + F.wave * 16640);
    const int gw = F.vcu * 8 + F.wave, NGW = F.G * 8;
    constexpr int I_QKV = 16 * 48, I_O = 16 * 16, I_UP = 16 * 64, I_DN = 64 * 16, I_PL = 4 * 4;
    constexpr int NITEMS = 2 * I_QKV + 2 * I_O + 4 * I_UP + 4 * I_DN + 8 * I_PL;
    for (int it = gw; it < NITEMS; it += NGW) {
        int r = it;
        if (r < 2 * I_QKV) { const int a = r / I_QKV; transpose_item(A.in[11] + (size_t)a * D * 3072, D, 3072, (bf16*)(F.ws + WS_WQKV) + (size_t)a * 3072 * D, scr, r % I_QKV, F.lane, nullptr); continue; } r -= 2 * I_QKV;
        if (r < 2 * I_O) { const int a = r / I_O; transpose_item(A.in[17] + (size_t)a * D * D, D, D, (bf16*)(F.ws + WS_WO) + (size_t)a * D * D, scr, r % I_O, F.lane, nullptr); continue; } r -= 2 * I_O;
        if (r < 4 * I_UP) { const int i = r / I_UP; transpose_item(A.in[20] + (size_t)i * D * FF, D, FF, (bf16*)(F.ws + WS_WUP) + (size_t)i * D * FF, scr, r % I_UP, F.lane, nullptr); continue; } r -= 4 * I_UP;
        if (r < 4 * I_DN) { const int i = r / I_DN; transpose_item(A.in[21] + (size_t)i * D * FF, FF, D, (bf16*)(F.ws + WS_WDN) + (size_t)i * D * FF, scr, r % I_DN, F.lane, nullptr); continue; } r -= 4 * I_DN;
        { const int pg = r / I_PL; transpose_item(A.in[18] + (size_t)pg * 65536, 256, 256, (bf16*)(F.ws + WS_WPOOL) + (size_t)pg * 65536, scr, r % I_PL, F.lane, A.in[19] + pg * 256); }
    }
    for (int it0 = gw; it0 < 32768; it0 += 4 * NGW) {
        f32x4 v[4][4];
#pragma unroll
        for (int r4 = 0; r4 < 4; ++r4) { const int it = min(it0 + r4 * NGW, 32767); const int j = it & 1023, b = (it >> 10) & 7, kv = (it >> 13) & 1, a = it >> 14;
            const float* src = (kv ? A.in[3] : A.in[2]) + ((size_t)(a * 8 + b) * 1024 + j) * D;
#pragma unroll
            for (int q = 0; q < 4; ++q) v[r4][q] = *(const f32x4*)(src + 4 * F.lane + 256 * q); }
#pragma unroll
        for (int r4 = 0; r4 < 4; ++r4) { const int it = it0 + r4 * NGW; if (it < 32768) { const int j = it & 1023, b = (it >> 10) & 7, kv = (it >> 13) & 1, a = it >> 14;
            bf16* dst = (bf16*)(F.ws + (kv ? WS_VXS : WS_KXS)) + (size_t)a * KXS_LAYER + (size_t)(b * EXT_S + 16 + j) * D;
#pragma unroll
            for (int q = 0; q < 4; ++q) { u32x2 w; w.x = pk2(v[r4][q].x, v[r4][q].y); w.y = pk2(v[r4][q].z, v[r4][q].w); *(u32x2*)(dst + 4 * F.lane + 256 * q) = w; } } }
    }
    const float* g = A.in[7];
    for (int row = ROWS_VALID + gw; row < MPAD; row += NGW) { bf16* xn = (bf16*)(F.ws + WS_XN) + (size_t)row * D;
#pragma unroll
        for (int q = 0; q < 4; ++q) *(u32x2*)(xn + 4 * F.lane + 256 * q) = (u32x2){0u, 0u}; }
    const int RPC = (ROWS_VALID + F.G - 1) / F.G, rbeg = F.vcu * RPC, rend = min(rbeg + RPC, ROWS_VALID);
    for (int row0 = rbeg + F.wave; row0 < rend; row0 += 32) {
        f32x4 v[4][4]; float ss[4];
#pragma unroll
        for (int j = 0; j < 4; ++j) { const float* x = xin_row(A, min(row0 + j * 8, ROWS_VALID - 1)); ss[j] = 0.f;
#pragma unroll
            for (int q = 0; q < 4; ++q) v[j][q] = *(const f32x4*)(x + 4 * F.lane + 256 * q); }
#pragma unroll
        for (int j = 0; j < 4; ++j) {
#pragma unroll
            for (int q = 0; q < 4; ++q) ss[j] += v[j][q].x * v[j][q].x + v[j][q].y * v[j][q].y + v[j][q].z * v[j][q].z + v[j][q].w * v[j][q].w; }
#pragma unroll
        for (int o = 1; o < 64; o <<= 1) {
#pragma unroll
            for (int j = 0; j < 4; ++j) ss[j] += __shfl_xor(ss[j], o); }
#pragma unroll
        for (int j = 0; j < 4; ++j) { const int row = row0 + j * 8; const float r = 1.0f / sqrtf(ss[j] * (1.f / D) + EPS); bf16* xn = (bf16*)(F.ws + WS_XN) + (size_t)row * D;
#pragma unroll
            for (int q = 0; q < 4; ++q) { const f32x4 gg = *(const f32x4*)(g + 4 * F.lane + 256 * q); u32x2 w; w.x = pk2(v[j][q].x * r * gg.x, v[j][q].y * r * gg.y); w.y = pk2(v[j][q].z * r * gg.z, v[j][q].w * r * gg.w);
                if (row < rend) *(u32x2*)(xn + 4 * F.lane + 256 * q) = w; } }
    }
}
__device__ __forceinline__ void fin_phase(ArgsRef A, Frame& F, bool from_inputs, const int nks  , const float* gpost, const float* gnext) {
    { const int t_ = mk_tid(F.wave); F.tid = t_; F.lane = t_ & 63; }
    constexpr int FR = 4;
    const int gw = F.vcu * 8 + F.wave, NGW = F.G * 8;
    const bf16* YB = (const bf16*)(F.ws + WS_YB);
    const int lo4 = 4 * F.lane, lo8 = 8 * F.lane;
    const int RPC = (ROW_S + F.G - 1) / F.G, rbeg = F.vcu * RPC, rend = min(rbeg + RPC, ROW_S);
    for (int row0 = rbeg + F.wave; row0 < rend; row0 += 8 * FR) {
        f32x4 yv[FR][4], xv[FR][4]; float ss[FR];
#pragma unroll
        for (int j = 0; j < FR; ++j) { const int row = min(row0 + j * 8, ROWS_VALID - 1); const bf16* y = YB + (size_t)row * D; const float* xi = from_inputs ? xin_row(A, row) : xres_row(F, row); ss[j] = 0.f;
#pragma unroll
            for (int h = 0; h < 2; ++h) { const u32x4 w = *(const u32x4*)(y + lo8 + 512 * h);
                yv[j][2 * h] = (f32x4){bflo(w.x), bfhi(w.x), bflo(w.y), bfhi(w.y)}; yv[j][2 * h + 1] = (f32x4){bflo(w.z), bfhi(w.z), bflo(w.w), bfhi(w.w)}; }
#pragma unroll
            for (int q = 0; q < 4; ++q) xv[j][q] = *(const f32x4*)(xi + lo8 + 4 * (q & 1) + 512 * (q >> 1)); }
#pragma unroll
        for (int j = 0; j < FR; ++j) {
#pragma unroll
            for (int q = 0; q < 4; ++q) ss[j] += yv[j][q].x * yv[j][q].x + yv[j][q].y * yv[j][q].y + yv[j][q].z * yv[j][q].z + yv[j][q].w * yv[j][q].w; }
#pragma unroll
        for (int o = 1; o < 64; o <<= 1) {
#pragma unroll
            for (int j = 0; j < FR; ++j) ss[j] += __shfl_xor(ss[j], o); }
        float s2[FR];
#pragma unroll
        for (int j = 0; j < FR; ++j) { const int row = row0 + j * 8; const float r = 1.0f / sqrtf(ss[j] * (1.f / D) + EPS); s2[j] = 0.f;
#pragma unroll
            for (int q = 0; q < 4; ++q) { const int cq = lo8 + 4 * (q & 1) + 512 * (q >> 1); const f32x4 gg = *(const f32x4*)(gpost + cq); xv[j][q] = xv[j][q] + yv[j][q] * r * gg;
                if (row < rend) *(f32x4*)(xres_row(F, row) + cq) = xv[j][q];
                s2[j] += xv[j][q].x * xv[j][q].x + xv[j][q].y * xv[j][q].y + xv[j][q].z * xv[j][q].z + xv[j][q].w * xv[j][q].w; } }
        if (gnext) {
#pragma unroll
            for (int o = 1; o < 64; o <<= 1) {
#pragma unroll
                for (int j = 0; j < FR; ++j) s2[j] += __shfl_xor(s2[j], o); }
#pragma unroll
            for (int j = 0; j < FR; ++j) { const int row = row0 + j * 8; const float r2 = 1.0f / sqrtf(s2[j] * (1.f / D) + EPS); bf16* xn = (bf16*)(F.ws + WS_XN) + (size_t)row * D;
#pragma unroll
                for (int h = 0; h < 2; ++h) { const f32x4 g0 = *(const f32x4*)(gnext + lo8 + 512 * h), g1 = *(const f32x4*)(gnext + lo8 + 4 + 512 * h); const f32x4 a0 = xv[j][2 * h], a1 = xv[j][2 * h + 1];
                    u32x4 w; w.x = pk2(a0.x * r2 * g0.x, a0.y * r2 * g0.y); w.y = pk2(a0.z * r2 * g0.z, a0.w * r2 * g0.w); w.z = pk2(a1.x * r2 * g1.x, a1.y * r2 * g1.y); w.w = pk2(a1.z * r2 * g1.z, a1.w * r2 * g1.w);
                    if (row < rend) *(u32x4*)(xn + lo8 + 512 * h) = w; } }
        }
    }
    for (int row = ROW_S + gw; row < ROWS_VALID; row += NGW) {
        const float* xi = from_inputs ? xin_row(A, row) : xres_row(F, row); float* xo = xres_row(F, row);
        f32x4 yv[4], xv[4]; float ss = 0.f;
#pragma unroll
        for (int q = 0; q < 4; ++q) {
            if (nks == 0) { const u32x2 w = *(const u32x2*)(YB + (size_t)row * D + lo4 + 256 * q); yv[q] = (f32x4){bflo(w.x), bfhi(w.x), bflo(w.y), bfhi(w.y)}; }
            else { const float* yf = (const float*)(F.ws + WS_YF) + (size_t)(row - ROW_S) * D + lo4 + 256 * q; yv[q] = *(const f32x4*)yf; for (int k = 1; k < nks; ++k) yv[q] += *(const f32x4*)(yf + (size_t)k * 768 * D); }
            xv[q] = *(const f32x4*)(xi + lo4 + 256 * q); ss += yv[q].x * yv[q].x + yv[q].y * yv[q].y + yv[q].z * yv[q].z + yv[q].w * yv[q].w; }
        const float r = 1.0f / sqrtf(wave_sum(ss) * (1.f / D) + EPS); float s2 = 0.f;
#pragma unroll
        for (int q = 0; q < 4; ++q) { const f32x4 gg = *(const f32x4*)(gpost + lo4 + 256 * q); xv[q] = xv[q] + yv[q] * r * gg; *(f32x4*)(xo + lo4 + 256 * q) = xv[q];
            s2 += xv[q].x * xv[q].x + xv[q].y * xv[q].y + xv[q].z * xv[q].z + xv[q].w * xv[q].w; }
        if (gnext) { const float r2 = 1.0f / sqrtf(wave_sum(s2) * (1.f / D) + EPS); bf16* xn = (bf16*)(F.ws + WS_XN) + (size_t)row * D;
#pragma unroll
            for (int q = 0; q < 4; ++q) { const f32x4 gg = *(const f32x4*)(gnext + lo4 + 256 * q); u32x2 w; w.x = pk2(xv[q].x * r2 * gg.x, xv[q].y * r2 * gg.y); w.y = pk2(xv[q].z * r2 * gg.z, xv[q].w * r2 * gg.w);
                *(u32x2*)(xn + lo4 + 256 * q) = w; } }
    }
}
__device__ __forceinline__ f32x2 pool_h(ArgsRef A, const Frame& F, int grp, int b, int t, int col, int p) {
    const bf16* XN = (const bf16*)(F.ws + WS_XN);
    if (t >= 0) { const int row = grp == 0 ? b * 8192 + t : grp == 1 ? ROW_S + b * 64 + t : ROW_M + t; const unsigned w = *(const unsigned*)(XN + (size_t)row * D + col); return (f32x2){bflo(w), bfhi(w)}; }
    if (grp == 0) { const unsigned w = *(const unsigned*)(XN + (size_t)(ROW_M + 16 + t) * D + col); return (f32x2){bflo(w), bfhi(w)}; }
    if (grp == 1) return *(const f32x2*)(A.in[4] + ((size_t)(p * 8 + b) * 15 + 15 + t) * D + col);
    return (f32x2){0.f, 0.f};
}
__device__ __forceinline__ void pool_phase(ArgsRef A, Frame& F, int p) {
    { const int t_ = mk_tid(F.wave); F.tid = t_; F.lane = t_ & 63; }
    bf16* DB = (bf16*)(F.ws + WS_QB);
    const int col = 2 * F.tid, w = 2 << (col >> 8);
    for (int it = F.vcu; it < 2065; it += F.G) {
        int grp, b, t0, nr;
        if (it < 2048) { grp = 0; b = it >> 8; t0 = (it & 255) * 32; nr = 32; } else if (it < 2064) { const int s = it - 2048; grp = 1; b = s >> 1; t0 = (s & 1) * 32; nr = 32; } else { grp = 2; b = 0; t0 = 0; nr = 16; }
        f32x2 h[47];
#pragma unroll
        for (int i = 0; i < 47; ++i) h[i] = (i - 15 < nr) ? pool_h(A, F, grp, b, t0 - 15 + i, col, p) : (f32x2){0.f, 0.f};
        f32x2 sum = {0.f, 0.f};
#pragma unroll
        for (int j = 1; j < 16; ++j) if (j < w) sum += h[15 - j];
#pragma unroll
        for (int i = 0; i < 32; ++i) { const int t = t0 + i;
            if (i < nr) {
                const f32x2 cur = h[15 + i]; sum += cur;
                const float inv = 1.0f / (float)(grp == 2 ? min(t + 1, w) : w);
                const int row = grp == 0 ? b * 8192 + t : grp == 1 ? ROW_S + b * 64 + t : ROW_M + t;
                *(unsigned*)(DB + (size_t)row * D + col) = pk2(sum.x * inv - cur.x, sum.y * inv - cur.y);
                const f32x2 old = (w == 2) ? h[15 + i - 1] : (w == 4) ? h[15 + i - 3] : (w == 8) ? h[15 + i - 7] : h[15 + i - 15];
                sum -= old;
                if (grp == 0 && t >= 8177) *(f32x2*)(F.out + OFF_PP + ((size_t)(p * 8 + b) * 15 + (t - 8177)) * D + col) = cur;
                if (grp == 1 && t >= 49) *(f32x2*)(F.out + OFF_PS + ((size_t)(p * 8 + b) * 15 + (t - 49)) * D + col) = cur;
            }
        }
    }
}

namespace att {
constexpr int KSTR = 272;
constexpr int TB = 16384;
constexpr int OFF_K0 = 0, OFF_K1 = TB, OFF_V0 = 2 * TB, OFF_V1 = 3 * TB, OFF_BT = 4 * TB, OFF_GT = OFF_BT + 2048, OFF_Q = 5 * TB, XB = 16384;
static_assert(OFF_BT >= 4 * XB && OFF_GT + 512 <= OFF_Q && OFF_Q + 2 * TB <= 131072, "attention LDS map");
constexpr float THR = 48.0f;
constexpr float NEG = -1e30f;
struct AUnit { const bf16* K; const bf16* V; const bf16* KM; const bf16* VM; const bf16* Q; bf16* O; int P, L, x, h; };
__device__ __forceinline__ float max3f(float a, float b, float c) { float r; asm("v_max3_f32 %0, %1, %2, %3" : "=v"(r) : "v"(a), "v"(b), "v"(c)); return r; }
__device__ __forceinline__ float swapmax(float v) { auto rr = __builtin_amdgcn_permlane32_swap(__float_as_uint(v), __float_as_uint(v), false, false); return fmaxf(__uint_as_float(rr[0]), __uint_as_float(rr[1])); }
__device__ __forceinline__ float swapsum(float v) { auto rr = __builtin_amdgcn_permlane32_swap(__float_as_uint(v), __float_as_uint(v), false, false); return __uint_as_float(rr[0]) + __uint_as_float(rr[1]); }
typedef __bf16 bf16x2_t __attribute__((ext_vector_type(2)));
__device__ __forceinline__ unsigned cvtpk(float lo, float hi) { f32x2 v = {lo, hi}; bf16x2_t b = __builtin_convertvector(v, bf16x2_t); return __builtin_bit_cast(unsigned, b); }
__device__ __forceinline__ s16x4 vtr(const LAS unsigned char* p) { return __builtin_bit_cast(s16x4, __builtin_amdgcn_ds_read_tr16_b64_v4i16((LAS s16x4*)p)); }
__device__ __forceinline__ void glds16(const void* gsrc, unsigned lds_dst) { unsigned keep;
    asm volatile("s_mov_b32 %0, m0\n\ts_mov_b32 m0, %2\n\ts_nop 0\n\tglobal_load_lds_dwordx4 %1, off\n\ts_mov_b32 m0, %0" : "=&s"(keep) : "v"(gsrc), "s"(lds_dst) : "memory"); }
__device__ __forceinline__ bf16x8 pack8(const f32x16& S, int o) {
    u32x4 w; w.x = cvtpk(S[o], S[o + 1]); w.y = cvtpk(S[o + 2], S[o + 3]); w.z = cvtpk(S[o + 4], S[o + 5]); w.w = cvtpk(S[o + 6], S[o + 7]); return __builtin_bit_cast(bf16x8, w);
}

__device__ __forceinline__ void attn_unit(const int wv, LAS unsigned char* lds, const AUnit& u, const float* lq1, const float* lk1, const float* lq2, const float* lk2, const int layer_a, const float* relb, const float* subg) {
    const int tid = mk_tid(wv), lane = tid & 63, wid = wv, mp = wid >> 2, rg = wid & 3, q32 = lane & 31, hi = lane >> 5;
    LAS float* BT = (LAS float*)(lds + OFF_BT); LAS float* GT = (LAS float*)(lds + OFF_GT);
    {
        const float b15 = relb[15 * 8 + u.h];
        if (tid < 448) { const int rel = tid - 192, n = rel < 0 ? -rel : rel;
            int bk = n < 8 ? n : n < 12 ? 8 : n < 16 ? 9 : n < 23 ? 10 : n < 32 ? 11 : n < 46 ? 12 : n < 64 ? 13 : n < 91 ? 14 : 15; if (rel > 0) bk += 16;
            BT[tid] = (relb[bk * 8 + u.h] - b15) * LOG2E; }
        if (tid >= 384) GT[tid - 384] = subg[tid - 384] * (layer_a == 0 ? 0.8f : 0.52928698f);
    }
    const int vrows = min(128, u.L - 128 * u.x);
    const bool active = rg * 32 < vrows;
    const int ch = rg >> 1;
    const int NTw = active ? (u.P + min((2 * u.x + ch + 1) * 64, u.L) + 48) >> 6 : 0;
    const int NT = (u.P + min((2 * u.x + 2) * 64, u.L) + 48) >> 6;
    const int eq0 = u.P + 128 * u.x + rg * 32, eq = eq0 + q32;
    const unsigned lds0 = (unsigned)(size_t)lds;
    unsigned goff[2];
#pragma unroll
    for (int j = 0; j < 2; ++j) { const int row = wid * 8 + 4 * j + (lane >> 4), x = ((row & 3) << 2) | ((row >> 2) & 3), c = (lane & 15) ^ x; goff[j] = (unsigned)(row * 1024 + u.h * 128 + c * 8); }
    const unsigned ldst = (unsigned)wid * 2048u;
#define ATT_DMA(base, bufoff) do { _Pragma("unroll") for (int j_ = 0; j_ < 2; ++j_) \
        glds16((base) + goff[j_], (unsigned)__builtin_amdgcn_readfirstlane((int)(lds0 + (unsigned)(bufoff) + ldst + j_ * 1024))); } while (0)
#define ATT_ISSUE_K(t, bufoff) do { const bf16* b_ = ((t) == 0 && wid < 2) ? u.KM : u.K + (size_t)(t) * 65536; ATT_DMA(b_, bufoff); } while (0)
#define ATT_ISSUE_V(t, bufoff) do { const bf16* b_ = ((t) == 0 && wid < 2) ? u.VM : u.V + (size_t)(t) * 65536; ATT_DMA(b_, bufoff); } while (0)
#define ATT_WAITBAR() do { asm volatile("s_waitcnt vmcnt(0) lgkmcnt(0)" ::: "memory"); __builtin_amdgcn_s_barrier(); asm volatile("" ::: "memory"); } while (0)
    unsigned koff[4];
    { const int x = ((q32 & 3) << 2) | ((q32 >> 2) & 3);
#pragma unroll
      for (int d0 = 0; d0 < 4; ++d0) koff[d0] = lds0 + (unsigned)(q32 * 256 + (((mp * 8 + 2 * d0 + hi) ^ x) << 4)); }
    unsigned vofs[4][2];
    { const int qq = (lane & 15) >> 2, cl = 2 * ((lane >> 4) & 1) + ((lane & 3) >> 1), sub = 8 * (lane & 1);
#pragma unroll
      for (int dvb = 0; dvb < 4; ++dvb)
#pragma unroll
          for (int hf = 0; hf < 2; ++hf) vofs[dvb][hf] = lds0 + (unsigned)((8 * hf + 4 * hi + qq) * 256 + ((((dvb ^ qq) << 2) | (cl ^ (2 * hf + hi))) << 4) + sub); }
    {
        const bf16* qb_ = u.Q + (size_t)(128 * u.x + wid * 16) * 1024;
#pragma unroll
        for (int j = 0; j < 4; ++j) { const int row = 4 * j + (lane >> 4), x = ((row & 3) << 2) | ((row >> 2) & 3), c = (lane & 15) ^ x;
            glds16(qb_ + row * 1024 + u.h * 128 + c * 8, (unsigned)__builtin_amdgcn_readfirstlane((int)(lds0 + OFF_Q + wid * 4096 + j * 1024))); }
    }
    ATT_ISSUE_K(0, OFF_K0); ATT_ISSUE_V(0, OFF_V0); if (NT > 1) ATT_ISSUE_K(1, OFF_K1);
    ATT_WAITBAR();
    f32x16 O[4];
#pragma unroll
    for (int i = 0; i < 4; ++i)
#pragma unroll
        for (int r = 0; r < 16; ++r) O[i][r] = 0.f;
    float m = 0.f, l = 0.f;
    f32x16 SA0, SA1, SB0, SB1;
    const f32x16 zero16 = {0.f, 0.f, 0.f, 0.f, 0.f, 0.f, 0.f, 0.f, 0.f, 0.f, 0.f, 0.f, 0.f, 0.f, 0.f, 0.f};
#define ATT_SB() __builtin_amdgcn_sched_barrier(0)
#define ATT_QK(S0_, S1_, kbufoff) do { unsigned qsh_ = (unsigned)(OFF_Q + rg * 8192); asm volatile("" : "+s"(qsh_));     \
        bf16x8 kfa[4], kfb[4], qfr[4]; \
        _Pragma("unroll") for (int d0 = 0; d0 < 4; ++d0) { kfa[d0] = *(const LAS bf16x8*)(size_t)(koff[d0] + (unsigned)(kbufoff)); kfb[d0] = *(const LAS bf16x8*)(size_t)(koff[d0] + (unsigned)(kbufoff) + 8192u); qfr[d0] = *(const LAS bf16x8*)(size_t)(koff[d0] + qsh_); } \
        ATT_SB(); \
        S0_ = __builtin_amdgcn_mfma_f32_32x32x16_bf16(kfa[0], qfr[0], zero16, 0, 0, 0); S1_ = __builtin_amdgcn_mfma_f32_32x32x16_bf16(kfb[0], qfr[0], zero16, 0, 0, 0); \
        _Pragma("unroll") for (int d0 = 1; d0 < 4; ++d0) { S0_ = __builtin_amdgcn_mfma_f32_32x32x16_bf16(kfa[d0], qfr[d0], S0_, 0, 0, 0); S1_ = __builtin_amdgcn_mfma_f32_32x32x16_bf16(kfb[d0], qfr[d0], S1_, 0, 0, 0); } } while (0)
#define ATT_VLD(bank, ks) do { _Pragma("unroll") for (int dvb = 0; dvb < 4; ++dvb) { bank[dvb][0] = vtr((const LAS unsigned char*)(size_t)(vofs[dvb][0] + vb_ + (unsigned)((ks) * 4096))); bank[dvb][1] = vtr((const LAS unsigned char*)(size_t)(vofs[dvb][1] + vb_ + (unsigned)((ks) * 4096))); } } while (0)
#define ATT_PV(bank, ks, C0, C1) do { const bf16x8 pb = pack8(((ks) < 2) ? C0 : C1, 8 * ((ks) & 1)); \
        _Pragma("unroll") for (int dvb = 0; dvb < 4; ++dvb) { const bf16x8 vf = (bf16x8){bank[dvb][0][0], bank[dvb][0][1], bank[dvb][0][2], bank[dvb][0][3], bank[dvb][1][0], bank[dvb][1][1], bank[dvb][1][2], bank[dvb][1][3]}; \
            O[dvb] = __builtin_amdgcn_mfma_f32_32x32x16_bf16(vf, pb, O[dvb], 0, 0, 0); } } while (0)
#define ATT_STEP(C0, C1, N0, N1, t_, PAR) do { const int t = (t_); constexpr int cur = (PAR); \
        if (t + 2 < NT) ATT_ISSUE_K(t + 2, cur ? OFF_K1 : OFF_K0); \
        if (t + 1 < NT) ATT_ISSUE_V(t + 1, cur ? OFF_V0 : OFF_V1); \
        { \
            const int k0 = t * 64; \
            if (k0 + 154 > eq0) { const LAS float* bt_ = BT + (k0 - eq + 192 + 4 * hi); \
                _Pragma("unroll") for (int r = 0; r < 16; ++r) { C0[r] += bt_[(r & 3) + 8 * (r >> 2)]; } \
                ATT_SB(); \
                _Pragma("unroll") for (int r = 0; r < 16; ++r) { C1[r] += bt_[32 + (r & 3) + 8 * (r >> 2)]; } } \
            if (t >= NTw - 1) { const bool all_ = t >= NTw; _Pragma("unroll") for (int r = 0; r < 16; ++r) { if (r >= 8 || all_) C0[r] = NEG; C1[r] = NEG; } } \
            if (__any(m != 0.f)) { _Pragma("unroll") for (int r = 0; r < 16; ++r) { C0[r] -= m; C1[r] -= m; } } \
            float mx = max3f(C0[0], C1[0], C0[1]), mx2 = max3f(C1[1], C0[2], C1[2]); \
            _Pragma("unroll") for (int r = 3; r < 15; r += 2) { mx = max3f(mx, C0[r], C1[r]); mx2 = max3f(mx2, C0[r + 1], C1[r + 1]); } \
            mx = max3f(mx, mx2, C0[15]); mx = fmaxf(mx, C1[15]); \
            mx = swapmax(mx); \
            if (__any(mx > THR || (t == 0 && mx < -THR))) { const float dl = (t == 0) ? mx : fmaxf(mx, 0.f); m += dl; const float f = (t == 0) ? 1.f : __builtin_amdgcn_exp2f(-dl); l *= f; \
                _Pragma("unroll") for (int r = 0; r < 16; ++r) { C0[r] -= dl; C1[r] -= dl; } \
                _Pragma("unroll") for (int i = 0; i < 4; ++i) _Pragma("unroll") for (int r = 0; r < 16; ++r) O[i][r] *= f; } \
        } \
        ATT_SB(); \
        if (t + 1 < NT) ATT_QK(N0, N1, cur ? OFF_K0 : OFF_K1); \
        ATT_SB(); \
        { \
            constexpr unsigned vb_ = (unsigned)(cur ? OFF_V1 : OFF_V0); \
            s16x4 vA[4][2], vB[4][2]; \
            ATT_VLD(vA, 0); \
            ATT_SB(); \
            float ls = 0.f; \
            _Pragma("unroll") for (int r = 0; r < 16; ++r) { C0[r] = __builtin_amdgcn_exp2f(C0[r]); C1[r] = __builtin_amdgcn_exp2f(C1[r]); ls += C0[r]; ls += C1[r]; } \
            l += ls; \
            ATT_SB(); \
            ATT_VLD(vB, 1); ATT_SB(); ATT_PV(vA, 0, C0, C1); ATT_SB(); \
            ATT_VLD(vA, 2); ATT_SB(); ATT_PV(vB, 1, C0, C1); ATT_SB(); \
            ATT_VLD(vB, 3); ATT_SB(); ATT_PV(vA, 2, C0, C1); ATT_SB(); \
            ATT_PV(vB, 3, C0, C1); \
        } \
        ATT_WAITBAR(); } while (0)
    ATT_QK(SA0, SA1, OFF_K0);
    ATT_WAITBAR();
    for (int tt = 0; tt < NT; tt += 2) { ATT_STEP(SA0, SA1, SB0, SB1, tt, 0); if (tt + 1 < NT) ATT_STEP(SB0, SB1, SA0, SA1, tt + 1, 1); }
#undef ATT_STEP
#undef ATT_QK
#undef ATT_VLD
#undef ATT_PV
#undef ATT_SB
#undef ATT_WAITBAR
#undef ATT_ISSUE_K
#undef ATT_ISSUE_V
#undef ATT_DMA
    const int tid2_ = mk_tid(wv);
    const int lane2 = tid2_ & 63, q32b = lane2 & 31, hib = lane2 >> 5;
    float lam;
    { float s1 = lq1[lane2] * lk1[lane2], s2 = lq2[lane2] * lk2[lane2]; s1 = wave_sum(s1); s2 = wave_sum(s2); lam = expf(s1) - expf(s2) + (layer_a == 0 ? 0.2f : 0.47071302f); }
    l = swapsum(l); const float inv = active ? 1.0f / l : 0.f;
    LAS float* xb = (LAS float*)(lds + rg * XB);
    if (mp == 1) { const float f = inv * lam;
#pragma unroll
        for (int i = 0; i < 4; ++i)
#pragma unroll
            for (int r = 0; r < 16; ++r) xb[(i * 16 + r) * 64 + lane2] = O[i][r] * f; }
    __syncthreads();
    if (mp == 0 && active) {
        float ss = 0.f;
#pragma unroll
        for (int i = 0; i < 4; ++i)
#pragma unroll
            for (int r = 0; r < 16; ++r) { const float o = O[i][r] * inv - xb[(i * 16 + r) * 64 + lane2]; O[i][r] = o; ss += o * o; }
        ss = swapsum(ss); const float rs = 1.0f / sqrtf(ss * (1.f / 128.f) + SUBLN_EPS);
        asm volatile("s_waitcnt lgkmcnt(0)" ::: "memory");
        LAS unsigned char* stg = (LAS unsigned char*)xb;
#pragma unroll
        for (int i = 0; i < 4; ++i)
#pragma unroll
            for (int r4 = 0; r4 < 4; ++r4) { const int dv0 = 32 * i + 8 * r4 + 4 * hib; const f32x4 gg = *(const LAS f32x4*)(GT + dv0);
                u32x2 w; w.x = cvtpk(O[i][4 * r4] * rs * gg.x, O[i][4 * r4 + 1] * rs * gg.y); w.y = cvtpk(O[i][4 * r4 + 2] * rs * gg.z, O[i][4 * r4 + 3] * rs * gg.w);
                *(LAS u32x2*)(stg + q32b * KSTR + dv0 * 2) = w; }
        asm volatile("s_waitcnt lgkmcnt(0)" ::: "memory");
        bf16* og = u.O + (size_t)(128 * u.x + rg * 32) * 1024 + u.h * 128;
#pragma unroll
        for (int i = 0; i < 8; ++i) { const int row = i * 4 + (lane2 >> 4), c16 = lane2 & 15; const u32x4 v = *(const LAS u32x4*)(stg + row * KSTR + c16 * 16);
            if (rg * 32 + row < vrows) *(u32x4*)(og + (size_t)row * 1024 + c16 * 8) = v; }
    }
    __syncthreads();
}
__device__ __forceinline__ void attn_phase(ArgsRef A, Frame& F, int a) {
    const bf16* QB = (const bf16*)(F.ws + WS_QB); bf16* OB = (bf16*)(F.ws + WS_XN); const bf16* KX = (const bf16*)(F.ws + WS_KX); const bf16* VX = (const bf16*)(F.ws + WS_VX);
    const bf16* KXS = (const bf16*)(F.ws + WS_KXS) + (size_t)a * KXS_LAYER; const bf16* VXS = (const bf16*)(F.ws + WS_VXS) + (size_t)a * KXS_LAYER;
    { const int gt = blockIdx.x * 512 + mk_tid(F.wave);
      for (int i = gt; i < 65536; i += F.G * 512) { const int c4 = i & 255, r = (i >> 8) & 15, b = (i >> 12) & 7, kv = i >> 15;
          const f32x4 v = *(const f32x4*)((const float*)(F.ws + (kv ? WS_MFV : WS_MFK)) + r * 1024 + c4 * 4);
          *(f32x4*)(F.out + (kv ? OFF_VP : OFF_KP) + (size_t)a * 8 * EXT_P * 1024 + (size_t)(b * EXT_P + r) * 1024 + c4 * 4) = v; } }
    for (int n = F.vcu; n < 4168; n += F.G) {
        AUnit u; u.KM = (const bf16*)(F.ws + WS_KXM); u.VM = (const bf16*)(F.ws + WS_VXM);
        if (n < 4096) { const int i = n >> 8, v = n & 255, c = v & 31, bh = (v >> 5) * 8 + (i >> 1); const int x = (i & 1) ? 63 - c : c; const int b = bh >> 3;
            u.K = KX + (size_t)b * EXT_P * 1024; u.V = VX + (size_t)b * EXT_P * 1024; u.Q = QB + (size_t)b * 8192 * 1024; u.O = OB + (size_t)b * 8192 * 1024; u.P = 16; u.L = 8192; u.x = x; u.h = bh & 7; }
        else if (n < 4160) { const int j = n - 4096, b = j >> 3; u.K = KXS + (size_t)b * EXT_S * 1024; u.V = VXS + (size_t)b * EXT_S * 1024; u.Q = QB + (size_t)(ROW_S + b * 64) * 1024; u.O = OB + (size_t)(ROW_S + b * 64) * 1024; u.P = 1040; u.L = 64; u.x = 0; u.h = j & 7; }
        else { u.K = (const bf16*)(F.ws + WS_KXM); u.V = (const bf16*)(F.ws + WS_VXM); u.Q = QB + (size_t)ROW_M * 1024; u.O = OB + (size_t)ROW_M * 1024; u.P = 0; u.L = 16; u.x = 0; u.h = n - 4160; }
        attn_unit(F.wave, F.lds, u, A.in[12] + a * 64, A.in[13] + a * 64, A.in[14] + a * 64, A.in[15] + a * 64, a, A.in[6], A.in[16] + a * 128);
    }
}
}

#define XB_TMO      128
#define XB_XCNT(j)  (256  + 64 * (j))
#define XB_XSUB(j)  (1280 + 64 * (j))
#define XB_XGEN(j)  (2304 + 64 * (j))
#define XB_TOP      3328
#define XB_TOPGEN   3392
#define XCD_BAR_WORDS 3456
#define XB_SPIN_CAP (1u << 18)

__device__ __forceinline__ unsigned xb_ld(unsigned* p)              { return __hip_atomic_load(p, __ATOMIC_RELAXED, __HIP_MEMORY_SCOPE_AGENT); }
__device__ __forceinline__ unsigned xb_add(unsigned* p, unsigned v) { return __hip_atomic_fetch_add(p, v, __ATOMIC_RELAXED, __HIP_MEMORY_SCOPE_AGENT); }
__device__ __forceinline__ unsigned xb_xcc_id() { return (unsigned)__builtin_amdgcn_s_getreg((3 << 11) | 20) & 0xFu; }
#define XB_SPIN(cond, bar) do { unsigned _sp = 0; while (cond) { __builtin_amdgcn_s_sleep(1); \
    if ((++_sp & 255u) == 0u) { if (xb_ld(&(bar)[XB_TMO])) break; if (_sp > XB_SPIN_CAP) { atomicAdd(&(bar)[XB_TMO], 1u); break; } } } } while (0)

struct XcdBarrier {
    bool leader; unsigned* bar; unsigned x;
    volatile LAS unsigned* st;
};

__device__ __forceinline__ XcdBarrier xcd_barrier_post(unsigned* bar, volatile LAS unsigned* st) {
    XcdBarrier b; b.bar = bar; b.x = xb_xcc_id(); b.st = st;
    b.leader = (threadIdx.x == 0);
    if (b.leader) (void)xb_add(&bar[XB_XCNT(b.x)], 1u);
    return b;
}
__device__ __forceinline__ void xcd_barrier_complete(unsigned* bar, unsigned x, unsigned& nloc, unsigned& nx) {
    const unsigned G = gridDim.x * gridDim.y * gridDim.z;
    unsigned sum, cnt, mine, sp = 0u;
    for (;;) {
        sum = 0u; cnt = 0u; mine = 0u;
#pragma unroll
        for (unsigned j = 0; j < 16; ++j) { const unsigned c = xb_ld(&bar[XB_XCNT(j)]); sum += c; cnt += (c > 0u) ? 1u : 0u; mine = (j == x) ? c : mine; }
        if (sum == G) break;
        __builtin_amdgcn_s_sleep(1);
        if ((++sp & 255u) == 0u) { if (xb_ld(&bar[XB_TMO])) break; if (sp > XB_SPIN_CAP) { atomicAdd(&bar[XB_TMO], 1u); break; } }
    }
    nloc = mine > 0u ? mine : 1u; nx = cnt > 0u ? cnt : 1u;
}

__device__ __forceinline__ void xcd_barrier(const XcdBarrier& b) {
    asm volatile("s_waitcnt vmcnt(0)" ::: "memory");
    __syncthreads();
    if (b.leader) {
        unsigned* bar = b.bar;
        __builtin_amdgcn_s_waitcnt(0);
        unsigned nloc = b.st[0], nx = b.st[1];
        if (nloc == 0u) { xcd_barrier_complete(bar, b.x, nloc, nx); b.st[0] = nloc; b.st[1] = nx; }
        const unsigned old = xb_add(&bar[XB_XSUB(b.x)], 1u);
        const unsigned gen = old / nloc;
        if (old + 1u == (gen + 1u) * nloc) {
            __builtin_amdgcn_fence(__ATOMIC_RELEASE, "agent");
            asm volatile("s_waitcnt vmcnt(0)" ::: "memory");
            const unsigned og = xb_add(&bar[XB_TOP], 1u);
            const unsigned tg = og / nx;
            if (og + 1u == (tg + 1u) * nx) xb_add(&bar[XB_TOPGEN], 1u);
            else XB_SPIN(xb_ld(&bar[XB_TOPGEN]) == tg, bar);
            __builtin_amdgcn_fence(__ATOMIC_ACQUIRE, "agent");
            xb_add(&bar[XB_XGEN(b.x)], 1u);
            asm volatile("s_waitcnt vmcnt(0)" ::: "memory");
        } else {
            XB_SPIN(xb_ld(&bar[XB_XGEN(b.x)]) == gen, bar);
            __builtin_amdgcn_fence(__ATOMIC_ACQUIRE, "agent");
            asm volatile("s_waitcnt vmcnt(0)" ::: "memory");
        }
    }
    __syncthreads();
}

__device__ __forceinline__ void run_step(ArgsRef args, const int step, const int wv) {
    extern __shared__ __attribute__((aligned(16))) unsigned char lds_raw[];
    Frame F;
    F.lds = (LAS unsigned char*)lds_raw; F.tid = 0; F.lane = 0; F.wave = wv;
    F.G = gridDim.x; { const int bx = blockIdx.x; F.vcu = (F.G % 8 == 0) ? (bx % 8) * (F.G / 8) + bx / 8 : bx; }
    F.out = args.out; F.ws = args.ws;
    bf16* XN = (bf16*)(F.ws + WS_XN); bf16* QB = (bf16*)(F.ws + WS_QB); bf16* YB = (bf16*)(F.ws + WS_YB); bf16* U = (bf16*)(F.ws + WS_U);
    int layer = 0, k = -1;
    if (step > 0) { const int s = step - 1; if (s < 7) { layer = 0; k = s; } else if (s < 13) { layer = 1; k = s - 7; } else if (s < 20) { layer = 2; k = s - 13; } else { layer = 3; k = s - 20; } }
    const bool attn = (layer & 1) == 0; const int a = layer >> 1;
    int type;
    if (step == 0) type = 0; else if (attn) type = k == 0 ? 1 : k == 1 ? 2 : k == 2 ? 4 : k == 3 ? 5 : k == 4 ? 6 : k == 5 ? 7 : 8;
    else type = k == 0 ? 3 : k == 1 ? 4 : k == 2 ? 5 : k == 3 ? 6 : k == 4 ? 7 : 8;
    if (type == 0) prologue(args, F);
    else if (type == 1) {
        pg8::Gemm g{XN, (const bf16*)(F.ws + WS_WQKV) + (size_t)a * 3072 * D, MPAD, 3072, D, D, D, 0}; pg8::StaticOrder S; S.init(MPAD, 3072, F.G, (int)blockIdx.x, D);
        pg8::EpiQKV E{F.ws, F.out, a};
        pg8::gemm_phase<pg8::EpiQKV, pg8::StaticOrder, true, true>(F.lds, g, S, E, mk_tid(F.wave));
    } else if (type == 2) { att::attn_phase(args, F, a); }
    else if (type == 3) { pool_phase(args, F, a); }
    else if (type == 4 || type == 7) {
        pg8::Gemm g;
        if (type == 7) g = pg8::Gemm{U, (const bf16*)(F.ws + WS_WDN) + (size_t)layer * D * FF, MPAD, D, FF, FF, FF, 0};
        else if (attn) g = pg8::Gemm{XN, (const bf16*)(F.ws + WS_WO) + (size_t)a * D * D, MPAD, D, D, D, D, 0};
        else g = pg8::Gemm{QB, (const bf16*)(F.ws + WS_WPOOL) + (size_t)a * 4 * 65536, MPAD, D, 256, D, 256, 512};
        pg8::TailOrder S; S.init(D, F.G, (int)blockIdx.x, g.K, type == 7 ? 16 : (attn ? 4 : 1));
        pg8::EpiBf16<0> E{YB, D, (float*)(F.ws + WS_YF)};
        pg8::gemm_phase<pg8::EpiBf16<0>, pg8::TailOrder, true, true>(F.lds, g, S, E, mk_tid(F.wave));
    } else if (type == 5) { fin_phase(args, F, layer == 0, attn ? 4 : 0, args.in[8] + layer * D, args.in[9] + layer * D); }
    else if (type == 6) {
        pg8::Gemm g{XN, (const bf16*)(F.ws + WS_WUP) + (size_t)layer * D * FF, MPAD, FF, D, D, D, 0}; pg8::StaticOrder S; S.init(MPAD, FF, F.G, (int)blockIdx.x, D);
        pg8::EpiBf16<2> E{U, FF, nullptr};
        pg8::gemm_phase<pg8::EpiBf16<2>, pg8::StaticOrder, true, true>(F.lds, g, S, E, mk_tid(F.wave));
    } else { fin_phase(args, F, false, 16, args.in[10] + layer * D, layer < 3 ? args.in[7] + (layer + 1) * D : nullptr); }
}
__global__ void __launch_bounds__(512, 2) fwd_kernel(Args args_) {
    const int lo = args_.lo, hi = args_.hi;
    const int wv = __builtin_amdgcn_readfirstlane((int)threadIdx.x >> 6);
    extern __shared__ __attribute__((aligned(16))) unsigned char lds_raw[];
    volatile LAS unsigned* bst = (volatile LAS unsigned*)((LAS unsigned char*)lds_raw + 139264);
    if (threadIdx.x < 2) bst[threadIdx.x] = 0u;
    __syncthreads();
    XcdBarrier bar = xcd_barrier_post((unsigned*)args_.ws + 4096, bst);
    int probe_rep = 0; (void)probe_rep;
    for (int step = lo; step < hi; ++step) {
        const __attribute__((address_space(4))) Args* ap = (const __attribute__((address_space(4))) Args*)__builtin_amdgcn_kernarg_segment_ptr();
        asm volatile("" : "+s"(ap));
        run_step(*ap, step, wv);
#if defined(PROBE_MASK)
        {
            int ty = 0; if (step > 0) { const int s = step - 1; const int k = s < 7 ? s : s < 13 ? s - 7 : s < 20 ? s - 13 : s - 20; const bool at = (s < 7) || (s >= 13 && s < 20);
                ty = at ? (k == 0 ? 1 : k == 1 ? 2 : k == 2 ? 4 : k == 3 ? 5 : k == 4 ? 6 : k == 5 ? 7 : 8) : (k == 0 ? 3 : k == 1 ? 4 : k == 2 ? 5 : k == 3 ? 6 : k == 4 ? 7 : 8); }
            if (((PROBE_MASK >> ty) & 1) && !probe_rep) { probe_rep = 1; --step; __syncthreads(); continue; }
            probe_rep = 0; }
#endif
        if (step + 1 < hi) { if (lo < 0) { __threadfence(); cg::this_grid().sync(); }
            else { xcd_barrier(bar);
#if defined(PROBE_BAR2)
 xcd_barrier(bar);
#endif
 } }
    }
}

extern "C" void kernel_launch(void* const* d_in, const int* in_sizes, int n_in, void* d_out, int out_size, void* d_ws, size_t ws_size, hipStream_t stream) {
    static int grid = 0;
    if (grid == 0) {
        if (n_in != 22 || (size_t)out_size != OUT_TOTAL || ws_size < WS_END) { fprintf(stderr, "kernel_launch: unexpected shapes n_in %d out %d ws %zu\n", n_in, out_size, ws_size); grid = -1; return; }
        int dev = 0, cus = 0, per_cu = 0;
        hipGetDevice(&dev); hipDeviceGetAttribute(&cus, hipDeviceAttributeMultiprocessorCount, dev);
        hipFuncSetAttribute((const void*)fwd_kernel, hipFuncAttributeMaxDynamicSharedMemorySize, LDS_BYTES);
        hipOccupancyMaxActiveBlocksPerMultiprocessor(&per_cu, (const void*)fwd_kernel, 512, LDS_BYTES);
        if (per_cu < 1) { fprintf(stderr, "kernel_launch: occupancy query says %d blocks/CU\n", per_cu); per_cu = 1; }
        (void)hipGetLastError();
        grid = cus;
    }
    if (grid < 0) return;
    if (hipMemsetAsync(d_ws, 0, 65536, stream) != hipSuccess) { fprintf(stderr, "kernel_launch: memset failed\n"); return; }
    Args a{};
    for (int i = 0; i < 22; ++i) a.in[i] = (const float*)d_in[i];
    a.out = (float*)d_out; a.ws = (unsigned char*)d_ws;
#if ONE_LAUNCH
    a.lo = 0; a.hi = NSTEPS;
    void* kargs[] = {&a};
    hipError_t e = hipLaunchCooperativeKernel((const void*)fwd_kernel, dim3(grid), dim3(512), kargs, LDS_BYTES, stream);
    if (e != hipSuccess) fprintf(stderr, "cooperative launch failed: %s (grid %d)\n", hipGetErrorString(e), grid);
#else
    for (int s = 0; s < NSTEPS; ++s) { a.lo = s; a.hi = s + 1; hipLaunchKernelGGL(fwd_kernel, dim3(grid), dim3(512), LDS_BYTES, stream, a); }
#endif
}
static_assert(WS_QB == 213 * MiB && WS_KX == 473 * MiB && WS_VX == 602 * MiB && WS_KXS == 731 * MiB && WS_VXS == 767 * MiB && WS_KXM == 803 * MiB && WS_VXM == 804 * MiB && KXS_LAYER == 9 * MiB && WS_MFK == 1323 * MiB && WS_MFV == 1324 * MiB, "EpiQKV hard-coded map");
static_assert(OFF_KP == 67633152 && OFF_VP == 202113024 && OFF_KS == 336838656 && OFF_VS == 337887232, "EpiQKV hard-coded output offsets");
```

```cpp
#include <hip/hip_runtime.h>
#include <hip/hip_cooperative_groups.h>
#include <hip/hip_bf16.h>
#include <cstdio>
#include <cstdint>
namespace cg = cooperative_groups;
namespace pg8 {
#define PG8_LAS __attribute__((address_space(3)))
typedef unsigned short bf16_t;
typedef short bf16x8 __attribute__((ext_vector_type(8)));
typedef float f32x4 __attribute__((ext_vector_type(4)));
typedef unsigned u32x4 __attribute__((ext_vector_type(4)));
constexpr int BM = 256, BK = 64, HALF = 128, HTB = HALF * BK * 2  , STAGE_BYTES = 8 * HTB, NXCD = 8, WGM = 8;

__host__ __device__ __forceinline__ int lds_byte(int r, int c) { const int st = (r >> 4) * 2 + (c >> 5), rr = r & 15, cc = c & 31, ob = rr * 64 + cc * 2; return st * 1024 + (ob ^ (((ob >> 9) & 1) << 5)); }
__host__ __device__ __forceinline__ void stage_rc(int b, int& R, int& C) { const int st = b / 1024, sb = b % 1024, swz = sb ^ (((sb >> 9) & 1) << 5); R = (st >> 1) * 16 + swz / 64; C = (st & 1) * 32 + (swz % 64) / 2; }
__host__ __device__ __forceinline__ int perm32(int rho) { const int n = rho >> 4, i = rho & 15; return 8 * (i >> 2) + 4 * n + (i & 3); }

struct Unit { int pm, pn, ko, nt, sp; };
struct Gemm { const bf16_t* A; const bf16_t* Bt; int M, N, K, lda, ldb, acs; };

struct StaticOrder {
    int nM, nN, nwg, G, c, ntf;
    __host__ __device__ void init(int M, int N, int G_, int c_, int K) { nM = M / BM; nN = N / BM; nwg = nM * nN; G = G_; c = c_; ntf = K / BK; }
    __host__ __device__ bool next(int i, Unit& u) const {
        const long L = (long)i * G + c; if (L >= nwg) return false;
        int wgid = (int)L; { const int q = nwg / NXCD, r = nwg % NXCD, xcd = wgid % NXCD, off = wgid / NXCD; wgid = (xcd < r ? xcd * (q + 1) : r * (q + 1) + (xcd - r) * q) + off; }
        const int nig = WGM * nN, gid = wgid / nig, fm = gid * WGM, gsz = (nM - fm) < WGM ? (nM - fm) : WGM;
        u.pm = fm + ((wgid % nig) % gsz); u.pn = (wgid % nig) / gsz; u.ko = 0; u.nt = ntf; u.sp = 0; return true;
    }
    __device__ __forceinline__ void a_ready(const Unit&) const {}
    __device__ __forceinline__ void done(const Unit&) const {}
};
struct TailOrder {
    StaticOrder mn; int KS, kc;
    __host__ __device__ void init(int N, int G_, int c_, int K, int KS_) { mn.init(65536, N, G_, c_, K); KS = KS_; kc = K / KS_; }
    __host__ __device__ bool next(int i, Unit& u) const {
        const long L = (long)i * mn.G + mn.c; if (L < mn.nwg) return mn.next(i, u);
        const int Lt = (int)(L - mn.nwg); if (Lt >= 3 * mn.nN * KS) return false;
        const int tile = Lt / KS, ks = Lt - tile * KS; u.pm = 256 + tile / mn.nN; u.pn = tile % mn.nN; u.ko = ks * kc; u.nt = kc / BK; u.sp = KS > 1 ? ks + 1 : 0; return true;
    }
    __device__ __forceinline__ void a_ready(const Unit&) const {}
    __device__ __forceinline__ void done(const Unit&) const {}
};

__device__ __forceinline__ unsigned cvt_pk_bf16(float lo, float hi) { unsigned r; asm volatile("v_cvt_pk_bf16_f32 %0, %1, %2" : "=v"(r) : "v"(lo), "v"(hi)); return r; }
template <int ACT  > struct EpiBf16 {
    static constexpr bool PERM = true, AFTER_DRAIN = false;
    bf16_t* O; int ldc; float* yf;
    __device__ __forceinline__ void operator()(const f32x4 (&acc)[2][2][4][2], const Unit& u, int wr, int wc, int fr, int fq) const {
        asm volatile("" : "+v"(fr), "+v"(fq));
        const int row0 = u.pm * BM + wr * 64 + fr; const int col0 = u.pn * BM + wc * 32 + 8 * fq;
#pragma unroll
        for (int ai = 0; ai < 2; ++ai)
#pragma unroll
            for (int m = 0; m < 4; ++m) { bf16_t* rowp = O + (size_t)(row0 + ai * HALF + m * 16) * ldc + col0;
#pragma unroll
                for (int bj = 0; bj < 2; ++bj) { f32x4 v0 = acc[ai][bj][m][0], v1 = acc[ai][bj][m][1];
                    if (ACT == 2) {
#pragma unroll
                        for (int e = 0; e < 4; ++e) { float a = fmaxf(v0[e], 0.f), b = fmaxf(v1[e], 0.f); v0[e] = a * a; v1[e] = b * b; } }
                    if (u.sp) { float* yr = yf + ((size_t)(u.sp - 1) * 768 + (size_t)(row0 + ai * HALF + m * 16 - 65536)) * 1024 + col0 + bj * HALF;
                        *(f32x4*)yr = v0; *(f32x4*)(yr + 4) = v1; }
                    else { u32x4 w; w.x = cvt_pk_bf16(v0[0], v0[1]); w.y = cvt_pk_bf16(v0[2], v0[3]); w.z = cvt_pk_bf16(v1[0], v1[1]); w.w = cvt_pk_bf16(v1[2], v1[3]);
                    *(u32x4*)(rowp + bj * HALF) = w; } } }
    }
};
struct EpiQKV {
    static constexpr bool PERM = true, AFTER_DRAIN = false;
    unsigned char* ws; float* out; int a;
    __device__ __forceinline__ void operator()(const f32x4 (&acc)[2][2][4][2], const Unit& u, int wr, int wc, int fr, int fq) const {
        const size_t MiB_ = 1u << 20;
        asm volatile("" : "+v"(fr), "+v"(fq));
        const int t3 = u.pn >> 2; const int colb = (u.pn & 3) * 256 + wc * 32 + 8 * fq;
        bf16_t* X; float* Fp = nullptr; int rbase, jump = 0, s0 = 0; float sc = 1.f;
        if (t3 == 0) { X = (bf16_t*)(ws + 213 * MiB_); rbase = u.pm * BM; sc = 0.125f * 1.4426950408889634f; }
        else if (u.pm < 256) { const int b = u.pm >> 5; rbase = b * 8208 + 16 + (u.pm & 31) * 256; X = (bf16_t*)(ws + (t3 == 1 ? 473 : 602) * MiB_);
            Fp = out + (t3 == 1 ? (size_t)67633152 : (size_t)202113024) + (size_t)a * 8 * 8208 * 1024 + (size_t)rbase * 1024; }
        else if (u.pm < 258) { s0 = (u.pm - 256) * 256; rbase = 1040 + s0; jump = 1040; X = (bf16_t*)(ws + (t3 == 1 ? 731 : 767) * MiB_) + (size_t)a * (9 * MiB_);
            Fp = out + (t3 == 1 ? (size_t)336838656 : (size_t)337887232) + (size_t)a * 512 * 1024 + (size_t)s0 * 1024; }
        else { rbase = 0; X = (bf16_t*)(ws + (t3 == 1 ? 803 : 804) * MiB_); Fp = (float*)(ws + (t3 == 1 ? 1323 : 1324) * MiB_); }
#pragma unroll
        for (int ai = 0; ai < 2; ++ai)
#pragma unroll
            for (int m = 0; m < 4; ++m) { const int rit = ai * HALF + wr * 64 + m * 16 + fr;
                bf16_t* xr = X + (unsigned)((rbase + rit + ((s0 + rit) >> 6) * jump) * 1024 + colb); float* fr_ = Fp + (unsigned)(rit * 1024 + colb);
#pragma unroll
                for (int bj = 0; bj < 2; ++bj) { const f32x4 v0 = acc[ai][bj][m][0], v1 = acc[ai][bj][m][1]; const f32x4 s0v = v0 * sc, s1v = v1 * sc;
                    u32x4 w; w.x = cvt_pk_bf16(s0v[0], s0v[1]); w.y = cvt_pk_bf16(s0v[2], s0v[3]); w.z = cvt_pk_bf16(s1v[0], s1v[1]); w.w = cvt_pk_bf16(s1v[2], s1v[3]);
                    *(u32x4*)(xr + bj * HALF) = w;
                    if (t3 != 0) { *(f32x4*)(fr_ + bj * HALF) = v0; *(f32x4*)(fr_ + bj * HALF + 4) = v1; } } }
    }
};
template <class Epi, class Sched, bool ALIGN_EPI = false, bool SP2 = false>
__device__ __forceinline__ void gemm_phase(PG8_LAS unsigned char* lds, const Gemm g, const Sched& S, const Epi& E, const int tid_in) {
    int tid_ = tid_in; asm volatile("" : "+v"(tid_));
    const int tid = tid_, wid = __builtin_amdgcn_readfirstlane(tid >> 6), lane = tid & 63, wr = wid >> 2, wc = wid & 3, fr = lane & 15, fq = lane >> 4;
    const int K = g.K; (void)K;
    unsigned voffA[2], voffB[2];
#pragma unroll
    for (int i = 0; i < 2; ++i) { int R, C; stage_rc(tid * 16 + i * 8192, R, C); const int Rb = Epi::PERM ? ((R & ~31) + perm32(R & 31)) : R;
        voffA[i] = (unsigned)(R * g.lda + C) * 2u; voffB[i] = (unsigned)(Rb * g.ldb + C) * 2u; }
    const size_t kstep = (size_t)(BK * 2);
    const size_t hstepA = (size_t)HALF * g.lda * 2, hstepB = (size_t)HALF * g.ldb * 2;
    const size_t tstepA = 2 * hstepA, tstepB = 2 * hstepB;
    const unsigned ldsw = (unsigned)wid * 1024u;
    const int aoff = lds_byte(wr * 64 + fr, fq * 8), boff = lds_byte(wc * 32 + fr, fq * 8);
#define PG8_SA(b, h) (((b) * 2 + (h)) * HTB)
#define PG8_SB(b, h) ((4 + (b) * 2 + (h)) * HTB)
#define PG8_STAGE(bufoff, gbase, voff) do { _Pragma("unroll") for (int _i = 0; _i < 2; ++_i) \
        __builtin_amdgcn_global_load_lds((const unsigned*)((const char*)(gbase) + (voff)[_i]), (PG8_LAS unsigned*)(lds + (bufoff) + ldsw + _i * 8192), 16, 0, 0); } while (0)
#define PG8_LDA(dst, b, h) do { _Pragma("unroll") for (int m = 0; m < 4; ++m) _Pragma("unroll") for (int k = 0; k < 2; ++k) dst[m][k] = *(const PG8_LAS bf16x8*)(lds + PG8_SA(b, h) + aoff + m * 2048 + k * 1024); } while (0)
#define PG8_LDB(dst, b, h) do { _Pragma("unroll") for (int n = 0; n < 2; ++n) _Pragma("unroll") for (int k = 0; k < 2; ++k) dst[n][k] = *(const PG8_LAS bf16x8*)(lds + PG8_SB(b, h) + boff + n * 2048 + k * 1024); } while (0)
#define PG8_MMA(ai, bj, At, Bt) do { __builtin_amdgcn_s_setprio(1); _Pragma("unroll") for (int m = 0; m < 4; ++m) _Pragma("unroll") for (int n = 0; n < 2; ++n) _Pragma("unroll") for (int k = 0; k < 2; ++k) \
        acc[ai][bj][m][n] = __builtin_amdgcn_mfma_f32_16x16x32_bf16(Bt[n][k], At[m][k], acc[ai][bj][m][n], 0, 0, 0); __builtin_amdgcn_s_setprio(0); } while (0)
#define PG8_WAIT_V(n) asm volatile("s_waitcnt vmcnt(" #n ")" ::: "memory")
#define PG8_WAIT_L(n) asm volatile("s_waitcnt lgkmcnt(" #n ")" ::: "memory")
#define PG8_BAR __builtin_amdgcn_s_barrier()
#define PG8_SCHED __builtin_amdgcn_sched_barrier(0)
    Unit cur, nxt; int ui = 0;
    if (!S.next(0, cur)) return;
    f32x4 acc[2][2][4][2];
#pragma unroll
    for (int a = 0; a < 2; ++a)
#pragma unroll
        for (int b = 0; b < 2; ++b)
#pragma unroll
            for (int m = 0; m < 4; ++m)
#pragma unroll
                for (int n = 0; n < 2; ++n) acc[a][b][m][n] = (f32x4){0.f, 0.f, 0.f, 0.f};
    bf16x8 At[4][2], B0[2][2], B1[2][2];
    const char* cA = (const char*)g.A + (size_t)cur.pm * tstepA + (size_t)cur.pn * g.acs + (size_t)cur.ko * 2; const char* cB = (const char*)g.Bt + (size_t)cur.pn * tstepB + (size_t)cur.ko * 2;
    S.a_ready(cur);
    if constexpr (SP2) {
        PG8_STAGE(PG8_SB(0, 0), cB, voffB); PG8_STAGE(PG8_SB(0, 1), cB + hstepB, voffB); PG8_STAGE(PG8_SA(0, 0), cA, voffA); PG8_STAGE(PG8_SA(0, 1), cA + hstepA, voffA);
        if (wr == 1) PG8_BAR;
        PG8_WAIT_V(2); PG8_BAR;
        PG8_STAGE(PG8_SB(1, 0), cB + kstep, voffB); PG8_STAGE(PG8_SA(1, 0), cA + kstep, voffA); PG8_STAGE(PG8_SB(1, 1), cB + hstepB + kstep, voffB);
        PG8_WAIT_V(6); PG8_BAR;
    } else {
        PG8_STAGE(PG8_SB(0, 0), cB, voffB); PG8_STAGE(PG8_SA(0, 0), cA, voffA); PG8_STAGE(PG8_SB(0, 1), cB + hstepB, voffB); PG8_STAGE(PG8_SA(0, 1), cA + hstepA, voffA);
        if (wr == 1) PG8_BAR;
        PG8_WAIT_V(4); PG8_BAR;
        PG8_STAGE(PG8_SB(1, 0), cB + kstep, voffB); PG8_STAGE(PG8_SA(1, 0), cA + kstep, voffA); PG8_STAGE(PG8_SB(1, 1), cB + hstepB + kstep, voffB);
        PG8_WAIT_V(6); PG8_BAR;
    }
    for (;;) {
        const bool has_next = S.next(ui + 1, nxt);
        const char* nA = has_next ? (const char*)g.A + (size_t)nxt.pm * tstepA + (size_t)nxt.pn * g.acs + (size_t)nxt.ko * 2 : cA; const char* nB = has_next ? (const char*)g.Bt + (size_t)nxt.pn * tstepB + (size_t)nxt.ko * 2 : cB;
        const int nt = cur.nt;
        for (int t = 0; t < nt; t += 2) {
            const bool last = (t == nt - 2);
            const char* a1 = cA + (size_t)(t + 1) * kstep;
            const char* a2 = last ? nA : cA + (size_t)(t + 2) * kstep; const char* b2 = last ? nB : cB + (size_t)(t + 2) * kstep;
            const char* a3 = a2 + kstep; const char* b3 = b2 + kstep;
            if (last && has_next) S.a_ready(nxt);
            if constexpr (SP2) {
            PG8_LDB(B0, 0, 0); PG8_LDB(B1, 0, 1); PG8_SCHED; PG8_LDA(At, 0, 0); PG8_STAGE(PG8_SA(1, 1), a1 + hstepA, voffA);
            PG8_WAIT_V(8); PG8_WAIT_L(0); PG8_BAR; PG8_MMA(0, 0, At, B0); PG8_MMA(0, 1, At, B1); PG8_BAR; PG8_SCHED;
            PG8_LDA(At, 0, 1); PG8_STAGE(PG8_SB(0, 0), b2, voffB); PG8_STAGE(PG8_SB(0, 1), b2 + hstepB, voffB); PG8_STAGE(PG8_SA(0, 0), a2, voffA);
            PG8_WAIT_V(8); PG8_WAIT_L(0); PG8_BAR; PG8_MMA(1, 0, At, B0); PG8_MMA(1, 1, At, B1); PG8_BAR; PG8_SCHED;
            PG8_LDB(B0, 1, 0); PG8_LDB(B1, 1, 1); PG8_SCHED; PG8_LDA(At, 1, 0); PG8_STAGE(PG8_SA(0, 1), a2 + hstepA, voffA);
            PG8_WAIT_V(8); PG8_WAIT_L(0); PG8_BAR; PG8_MMA(0, 0, At, B0); PG8_MMA(0, 1, At, B1); PG8_BAR; PG8_SCHED;
            PG8_LDA(At, 1, 1); PG8_STAGE(PG8_SB(1, 0), b3, voffB); PG8_STAGE(PG8_SB(1, 1), b3 + hstepB, voffB); PG8_STAGE(PG8_SA(1, 0), a3, voffA);
            PG8_WAIT_V(8); PG8_WAIT_L(0); PG8_BAR; PG8_MMA(1, 0, At, B0); PG8_MMA(1, 1, At, B1); PG8_BAR; PG8_SCHED;
            } else {
            PG8_LDB(B0, 0, 0); PG8_SCHED; PG8_LDA(At, 0, 0); PG8_STAGE(PG8_SA(1, 1), a1 + hstepA, voffA);
            PG8_WAIT_L(8); PG8_BAR; PG8_WAIT_L(0); PG8_MMA(0, 0, At, B0); PG8_BAR; PG8_SCHED;
            PG8_LDB(B1, 0, 1); PG8_STAGE(PG8_SB(0, 0), b2, voffB);
            PG8_BAR; PG8_WAIT_L(0); PG8_MMA(0, 1, At, B1); PG8_BAR;
            PG8_LDA(At, 0, 1); PG8_STAGE(PG8_SA(0, 0), a2, voffA);
            PG8_BAR; PG8_WAIT_L(0); PG8_MMA(1, 0, At, B0); PG8_BAR; PG8_SCHED;
            PG8_STAGE(PG8_SB(0, 1), b2 + hstepB, voffB);
            PG8_WAIT_V(6); PG8_BAR; PG8_MMA(1, 1, At, B1); PG8_BAR;
            PG8_LDB(B0, 1, 0); PG8_SCHED; PG8_LDA(At, 1, 0); PG8_STAGE(PG8_SA(0, 1), a2 + hstepA, voffA);
            PG8_WAIT_L(8); PG8_BAR; PG8_WAIT_L(0); PG8_MMA(0, 0, At, B0); PG8_BAR; PG8_SCHED;
            PG8_LDB(B1, 1, 1); PG8_STAGE(PG8_SB(1, 0), b3, voffB);
            PG8_BAR; PG8_WAIT_L(0); PG8_MMA(0, 1, At, B1); PG8_BAR;
            PG8_LDA(At, 1, 1); PG8_STAGE(PG8_SA(1, 0), a3, voffA);
            PG8_BAR; PG8_WAIT_L(0); PG8_MMA(1, 0, At, B0); PG8_BAR; PG8_SCHED;
            PG8_STAGE(PG8_SB(1, 1), b3 + hstepB, voffB);
            PG8_WAIT_V(6); PG8_BAR; PG8_MMA(1, 1, At, B1); PG8_BAR;
            }
        }
        if constexpr (ALIGN_EPI) { if (wr == 0) PG8_BAR; }
        if constexpr (!Epi::AFTER_DRAIN) { E(acc, cur, wr, wc, fr, fq); S.done(cur); }
        if (!has_next) break;
#pragma unroll
        for (int a = 0; a < 2; ++a)
#pragma unroll
            for (int b = 0; b < 2; ++b)
#pragma unroll
                for (int m = 0; m < 4; ++m)
#pragma unroll
                    for (int n = 0; n < 2; ++n) acc[a][b][m][n] = (f32x4){0.f, 0.f, 0.f, 0.f};
        cur = nxt; cA = nA; cB = nB; ++ui;
        if constexpr (ALIGN_EPI) { if (wr == 1) PG8_BAR; }
    }
    PG8_WAIT_V(0);
    if constexpr (!ALIGN_EPI) { if (wr == 0) PG8_BAR; }
    PG8_BAR;
    if constexpr (Epi::AFTER_DRAIN) { E.fused(acc, cur, wr, wc, fr, fq, lds, wid, lane); S.done(cur); }
#undef PG8_SA
#undef PG8_SB
#undef PG8_STAGE
#undef PG8_LDA
#undef PG8_LDB
#undef PG8_MMA
#undef PG8_WAIT_V
#undef PG8_WAIT_L
#undef PG8_BAR
#undef PG8_SCHED
}
}
#define LAS __attribute__((address_space(3)))
#define GAS __attribute__((address_space(1)))
typedef unsigned short bf16;
typedef unsigned u32x4 __attribute__((ext_vector_type(4)));
typedef unsigned u32x2 __attribute__((ext_vector_type(2)));
typedef float f32x4 __attribute__((ext_vector_type(4)));
typedef float f32x2 __attribute__((ext_vector_type(2)));
typedef float f32x16 __attribute__((ext_vector_type(16)));
typedef short bf16x8 __attribute__((ext_vector_type(8)));
typedef short s16x4 __attribute__((ext_vector_type(4)));
constexpr int D = 1024, FF = 4096, NH = 8;
constexpr int ROW_S = 65536, ROW_M = 66048, ROWS_VALID = 66064, MPAD = 66304;
constexpr int EXT_P = 8208, EXT_S = 1104;
constexpr float LOG2E = 1.4426950408889634f;
constexpr float QSCALE = 0.125f * LOG2E;
constexpr float EPS = 1e-6f, SUBLN_EPS = 1e-5f;
constexpr size_t OFF_YP = 0, OFF_YS = 67108864, OFF_KP = OFF_YS + 524288, OFF_VP = OFF_KP + 134479872, OFF_PP = OFF_VP + 134479872,
                 OFF_KS = OFF_PP + 245760, OFF_VS = OFF_KS + 1048576, OFF_PS = OFF_VS + 1048576, OUT_TOTAL = OFF_PS + 245760;
constexpr size_t MiB = 1u << 20;
constexpr size_t WS_WQKV = 1 * MiB, WS_WO = 13 * MiB, WS_WPOOL = 17 * MiB, WS_WUP = 18 * MiB, WS_WDN = 50 * MiB, WS_XM = 82 * MiB,
                 WS_XN = 83 * MiB, WS_QB = 213 * MiB, WS_YB = 343 * MiB, WS_KX = 473 * MiB, WS_VX = 602 * MiB, WS_KXS = 731 * MiB, WS_VXS = 767 * MiB,
                 WS_KXM = 803 * MiB, WS_VXM = 804 * MiB, WS_U = 805 * MiB, WS_MFK = 1323 * MiB, WS_MFV = 1324 * MiB, WS_YF = 1325 * MiB, WS_END = 1373 * MiB;
constexpr size_t KXS_LAYER = 18 * MiB / 2;
constexpr int LDS_BYTES = 147456;
constexpr int NSTEPS = 27;
#ifndef ONE_LAUNCH
#define ONE_LAUNCH 1
#endif

__device__ __forceinline__ unsigned f2bf(float f) { unsigned u = __builtin_bit_cast(unsigned, f); return (u + 0x7fffu + ((u >> 16) & 1u)) >> 16; }
__device__ __forceinline__ unsigned pk2(float lo, float hi) { return f2bf(lo) | (f2bf(hi) << 16); }
__device__ __forceinline__ float bflo(unsigned w) { return __builtin_bit_cast(float, w << 16); }
__device__ __forceinline__ float bfhi(unsigned w) { return __builtin_bit_cast(float, w & 0xffff0000u); }
__device__ __forceinline__ float wave_sum(float v) {
#pragma unroll
    for (int o = 1; o < 64; o <<= 1) v += __shfl_xor(v, o);
    return v;
}

struct Args { const float* in[22]; float* out; unsigned char* ws; int lo, hi; };
typedef const __attribute__((address_space(4))) Args& ArgsRef;
__device__ __forceinline__ int mk_tid(int wv) { int t; asm volatile("v_mbcnt_lo_u32_b32 %0, -1, 0\n\tv_mbcnt_hi_u32_b32 %0, -1, %0" : "=v"(t)); return wv * 64 + t; }
struct Frame {
    LAS unsigned char* lds; int tid, lane, wave, vcu, G;
    float* out; unsigned char* ws;
};

__device__ __forceinline__ void transpose_item(const float* W, int K, int N, bf16* WT, LAS float* scr, int item, int lane, const float* nscale) {
    const int nblk = N / 64, kb = item / nblk, nb = item % nblk, k0 = 64 * kb, n0 = 64 * nb;
    f32x4 v[16];
#pragma unroll
    for (int i = 0; i < 16; ++i) v[i] = *(const f32x4*)(W + (size_t)(k0 + 4 * i + (lane >> 4)) * N + n0 + 4 * (lane & 15));
#pragma unroll
    for (int i = 0; i < 16; ++i) { LAS float* d = scr + (4 * i + (lane >> 4)) * 65 + 4 * (lane & 15); d[0] = v[i].x; d[1] = v[i].y; d[2] = v[i].z; d[3] = v[i].w; }
    asm volatile("s_waitcnt lgkmcnt(0)" ::: "memory");
    const int c = lane & 7;
#pragma unroll
    for (int j = 0; j < 8; ++j) { const int n = (lane >> 3) + 8 * j; const LAS float* s = scr + (8 * c) * 65 + n; const float sc = nscale ? nscale[n0 + n] : 1.f;
        u32x4 o; o.x = pk2(s[0 * 65] * sc, s[1 * 65] * sc); o.y = pk2(s[2 * 65] * sc, s[3 * 65] * sc); o.z = pk2(s[4 * 65] * sc, s[5 * 65] * sc); o.w = pk2(s[6 * 65] * sc, s[7 * 65] * sc);
        *(u32x4*)(WT + (size_t)(n0 + n) * K + k0 + 8 * c) = o; }
    asm volatile("s_waitcnt lgkmcnt(0)" ::: "memory");
}
__device__ __forceinline__ const float* xin_row(ArgsRef A, int row) {
    return row < ROW_S ? A.in[0] + (size_t)row * D : row < ROW_M ? A.in[1] + (size_t)(row - ROW_S) * D : A.in[5] + (size_t)(row - ROW_M) * D;
}
__device__ __forceinline__ float* xres_row(const Frame& F, int row) {
    return row < ROW_S ? F.out + OFF_YP + (size_t)row * D : row < ROW_M ? F.out + OFF_YS + (size_t)(row - ROW_S) * D : (float*)(F.ws + WS_XM) + (size_t)(row - ROW_M) * D;
}
__device__ __forceinline__ void prologue(ArgsRef A, Frame& F) {
    { const int t_ = mk_tid(F.wave); F.tid = t_; F.lane = t_ & 63; }
    LAS float* scr = (LAS float*)(F.lds + F.wave * 16640);
    const int gw = F.vcu * 8 + F.wave, NGW = F.G * 8;
    constexpr int I_QKV = 16 * 48, I_O = 16 * 16, I_UP = 16 * 64, I_DN = 64 * 16, I_PL = 4 * 4;
    constexpr int NITEMS = 2 * I_QKV + 2 * I_O + 4 * I_UP + 4 * I_DN + 8 * I_PL;
    for (int it = gw; it < NITEMS; it += NGW) {
        int r = it;
        if (r < 2 * I_QKV) { const int a = r / I_QKV; transpose_item(A.in[11] + (size_t)a * D * 3072, D, 3072, (bf16*)(F.ws + WS_WQKV) + (size_t)a * 3072 * D, scr, r % I_QKV, F.lane, nullptr); continue; } r -= 2 * I_QKV;
        if (r < 2 * I_O) { const int a = r / I_O; transpose_item(A.in[17] + (size_t)a * D * D, D, D, (bf16*)(F.ws + WS_WO) + (size_t)a * D * D, scr, r % I_O, F.lane, nullptr); continue; } r -= 2 * I_O;
        if (r < 4 * I_UP) { const int i = r / I_UP; transpose_item(A.in[20] + (size_t)i * D * FF, D, FF, (bf16*)(F.ws + WS_WUP) + (size_t)i * D * FF, scr, r % I_UP, F.lane, nullptr); continue; } r -= 4 * I_UP;
        if (r < 4 * I_DN) { const int i = r / I_DN; transpose_item(A.in[21] + (size_t)i * D * FF, FF, D, (bf16*)(F.ws + WS_WDN) + (size_t)i * D * FF, scr, r % I_DN, F.lane, nullptr); continue; } r -= 4 * I_DN;
        { const int pg = r / I_PL; transpose_item(A.in[18] + (size_t)pg * 65536, 256, 256, (bf16*)(F.ws + WS_WPOOL) + (size_t)pg * 65536, scr, r % I_PL, F.lane, A.in[19] + pg * 256); }
    }
    for (int it0 = gw; it0 < 32768; it0 += 4 * NGW) {
        f32x4 v[4][4];
#pragma unroll
        for (int r4 = 0; r4 < 4; ++r4) { const int it = min(it0 + r4 * NGW, 32767); const int j = it & 1023, b = (it >> 10) & 7, kv = (it >> 13) & 1, a = it >> 14;
            const float* src = (kv ? A.in[3] : A.in[2]) + ((size_t)(a * 8 + b) * 1024 + j) * D;
#pragma unroll
            for (int q = 0; q < 4; ++q) v[r4][q] = *(const f32x4*)(src + 4 * F.lane + 256 * q); }
#pragma unroll
        for (int r4 = 0; r4 < 4; ++r4) { const int it = it0 + r4 * NGW; if (it < 32768) { const int j = it & 1023, b = (it >> 10) & 7, kv = (it >> 13) & 1, a = it >> 14;
            bf16* dst = (bf16*)(F.ws + (kv ? WS_VXS : WS_KXS)) + (size_t)a * KXS_LAYER + (size_t)(b * EXT_S + 16 + j) * D;
#pragma unroll
            for (int q = 0; q < 4; ++q) { u32x2 w; w.x = pk2(v[r4][q].x, v[r4][q].y); w.y = pk2(v[r4][q].z, v[r4][q].w); *(u32x2*)(dst + 4 * F.lane + 256 * q) = w; } } }
    }
    const float* g = A.in[7];
    for (int row = ROWS_VALID + gw; row < MPAD; row += NGW) { bf16* xn = (bf16*)(F.ws + WS_XN) + (size_t)row * D;
#pragma unroll
        for (int q = 0; q < 4; ++q) *(u32x2*)(xn + 4 * F.lane + 256 * q) = (u32x2){0u, 0u}; }
    const int RPC = (ROWS_VALID + F.G - 1) / F.G, rbeg = F.vcu * RPC, rend = min(rbeg + RPC, ROWS_VALID);
    for (int row0 = rbeg + F.wave; row0 < rend; row0 += 32) {
        f32x4 v[4][4]; float ss[4];
#pragma unroll
        for (int j = 0; j < 4; ++j) { const float* x = xin_row(A, min(row0 + j * 8, ROWS_VALID - 1)); ss[j] = 0.f;
#pragma unroll
            for (int q = 0; q < 4; ++q) v[j][q] = *(const f32x4*)(x + 4 * F.lane + 256 * q); }
#pragma unroll
        for (int j = 0; j < 4; ++j) {
#pragma unroll
            for (int q = 0; q < 4; ++q) ss[j] += v[j][q].x * v[j][q].x + v[j][q].y * v[j][q].y + v[j][q].z * v[j][q].z + v[j][q].w * v[j][q].w; }
#pragma unroll
        for (int o = 1; o < 64; o <<= 1) {
#pragma unroll
            for (int j = 0; j < 4; ++j) ss[j] += __shfl_xor(ss[j], o); }
#pragma unroll
        for (int j = 0; j < 4; ++j) { const int row = row0 + j * 8; const float r = 1.0f / sqrtf(ss[j] * (1.f / D) + EPS); bf16* xn = (bf16*)(F.ws + WS_XN) + (size_t)row * D;
#pragma unroll
            for (int q = 0; q < 4; ++q) { const f32x4 gg = *(const f32x4*)(g + 4 * F.lane + 256 * q); u32x2 w; w.x = pk2(v[j][q].x * r * gg.x, v[j][q].y * r * gg.y); w.y = pk2(v[j][q].z * r * gg.z, v[j][q].w * r * gg.w);
                if (row < rend) *(u32x2*)(xn + 4 * F.lane + 256 * q) = w; } }
    }
}
__device__ __forceinline__ void fin_phase(ArgsRef A, Frame& F, bool from_inputs, const int nks  , const float* gpost, const float* gnext) {
    { const int t_ = mk_tid(F.wave); F.tid = t_; F.lane = t_ & 63; }
    constexpr int FR = 4;
    const int gw = F.vcu * 8 + F.wave, NGW = F.G * 8;
    const bf16* YB = (const bf16*)(F.ws + WS_YB);
    const int lo4 = 4 * F.lane, lo8 = 8 * F.lane;
    const int RPC = (ROW_S + F.G - 1) / F.G, rbeg = F.vcu * RPC, rend = min(rbeg + RPC, ROW_S);
    for (int row0 = rbeg + F.wave; row0 < rend; row0 += 8 * FR) {
        f32x4 yv[FR][4], xv[FR][4]; float ss[FR];
#pragma unroll
        for (int j = 0; j < FR; ++j) { const int row = min(row0 + j * 8, ROWS_VALID - 1); const bf16* y = YB + (size_t)row * D; const float* xi = from_inputs ? xin_row(A, row) : xres_row(F, row); ss[j] = 0.f;
#pragma unroll
            for (int h = 0; h < 2; ++h) { const u32x4 w = *(const u32x4*)(y + lo8 + 512 * h);
                yv[j][2 * h] = (f32x4){bflo(w.x), bfhi(w.x), bflo(w.y), bfhi(w.y)}; yv[j][2 * h + 1] = (f32x4){bflo(w.z), bfhi(w.z), bflo(w.w), bfhi(w.w)}; }
#pragma unroll
            for (int q = 0; q < 4; ++q) xv[j][q] = *(const f32x4*)(xi + lo8 + 4 * (q & 1) + 512 * (q >> 1)); }
#pragma unroll
        for (int j = 0; j < FR; ++j) {
#pragma unroll
            for (int q = 0; q < 4; ++q) ss[j] += yv[j][q].x * yv[j][q].x + yv[j][q].y * yv[j][q].y + yv[j][q].z * yv[j][q].z + yv[j][q].w * yv[j][q].w; }
#pragma unroll
        for (int o = 1; o < 64; o <<= 1) {
#pragma unroll
            for (int j = 0; j < FR; ++j) ss[j] += __shfl_xor(ss[j], o); }
        float s2[FR];
#pragma unroll
        for (int j = 0; j < FR; ++j) { const int row = row0 + j * 8; const float r = 1.0f / sqrtf(ss[j] * (1.f / D) + EPS); s2[j] = 0.f;
#pragma unroll
            for (int q = 0; q < 4; ++q) { const int cq = lo8 + 4 * (q & 1) + 512 * (q >> 1); const f32x4 gg = *(const f32x4*)(gpost + cq); xv[j][q] = xv[j][q] + yv[j][q] * r * gg;
                if (row < rend) *(f32x4*)(xres_row(F, row) + cq) = xv[j][q];
                s2[j] += xv[j][q].x * xv[j][q].x + xv[j][q].y * xv[j][q].y + xv[j][q].z * xv[j][q].z + xv[j][q].w * xv[j][q].w; } }
        if (gnext) {
#pragma unroll
            for (int o = 1; o < 64; o <<= 1) {
#pragma unroll
                for (int j = 0; j < FR; ++j) s2[j] += __shfl_xor(s2[j], o); }
#pragma unroll
            for (int j = 0; j < FR; ++j) { const int row = row0 + j * 8; const float r2 = 1.0f / sqrtf(s2[j] * (1.f / D) + EPS); bf16* xn = (bf16*)(F.ws + WS_XN) + (size_t)row * D;
#pragma unroll
                for (int h = 0; h < 2; ++h) { const f32x4 g0 = *(const f32x4*)(gnext + lo8 + 512 * h), g1 = *(const f32x4*)(gnext + lo8 + 4 + 512 * h); const f32x4 a0 = xv[j][2 * h], a1 = xv[j][2 * h + 1];
                    u32x4 w; w.x = pk2(a0.x * r2 * g0.x, a0.y * r2 * g0.y); w.y = pk2(a0.z * r2 * g0.z, a0.w * r2 * g0.w); w.z = pk2(a1.x * r2 * g1.x, a1.y * r2 * g1.y); w.w = pk2(a1.z * r2 * g1.z, a1.w * r2 * g1.w);
                    if (row < rend) *(u32x4*)(xn + lo8 + 512 * h) = w; } }
        }
    }
    for (int row = ROW_S + gw; row < ROWS_VALID; row += NGW) {
        const float* xi = from_inputs ? xin_row(A, row) : xres_row(F, row); float* xo = xres_row(F, row);
        f32x4 yv[4], xv[4]; float ss = 0.f;
#pragma unroll
        for (int q = 0; q < 4; ++q) {
            if (nks == 0) { const u32x2 w = *(const u32x2*)(YB + (size_t)row * D + lo4 + 256 * q); yv[q] = (f32x4){bflo(w.x), bfhi(w.x), bflo(w.y), bfhi(w.y)}; }
            else { const float* yf = (const float*)(F.ws + WS_YF) + (size_t)(row - ROW_S) * D + lo4 + 256 * q; yv[q] = *(const f32x4*)yf; for (int k = 1; k < nks; ++k) yv[q] += *(const f32x4*)(yf + (size_t)k * 768 * D); }
            xv[q] = *(const f32x4*)(xi + lo4 + 256 * q); ss += yv[q].x * yv[q].x + yv[q].y * yv[q].y + yv[q].z * yv[q].z + yv[q].w * yv[q].w; }
        const float r = 1.0f / sqrtf(wave_sum(ss) * (1.f / D) + EPS); float s2 = 0.f;
#pragma unroll
        for (int q = 0; q < 4; ++q) { const f32x4 gg = *(const f32x4*)(gpost + lo4 + 256 * q); xv[q] = xv[q] + yv[q] * r * gg; *(f32x4*)(xo + lo4 + 256 * q) = xv[q];
            s2 += xv[q].x * xv[q].x + xv[q].y * xv[q].y + xv[q].z * xv[q].z + xv[q].w * xv[q].w; }
        if (gnext) { const float r2 = 1.0f / sqrtf(wave_sum(s2) * (1.f / D) + EPS); bf16* xn = (bf16*)(F.ws + WS_XN) + (size_t)row * D;
#pragma unroll
            for (int q = 0; q < 4; ++q) { const f32x4 gg = *(const f32x4*)(gnext + lo4 + 256 * q); u32x2 w; w.x = pk2(xv[q].x * r2 * gg.x, xv[q].y * r2 * gg.y); w.y = pk2(xv[q].z * r2 * gg.z, xv[q].w * r2 * gg.w);
                *(u32x2*)(xn + lo4 + 256 * q) = w; } }
    }
}
__device__ __forceinline__ u32x4 pool_h8(ArgsRef A, const Frame& F, int grp, int b, int t, int col, int p) {
    const bf16* XN = (const bf16*)(F.ws + WS_XN);
    if (t >= 0) { const int row = grp == 0 ? b * 8192 + t : grp == 1 ? ROW_S + b * 64 + t : ROW_M + t; return *(const u32x4*)(XN + (size_t)row * D + col); }
    if (grp == 0) return *(const u32x4*)(XN + (size_t)(ROW_M + 16 + t) * D + col);
    if (grp == 1) { const float* s = A.in[4] + ((size_t)(p * 8 + b) * 15 + 15 + t) * D + col; const f32x4 a0 = *(const f32x4*)s, a1 = *(const f32x4*)(s + 4);
        u32x4 w; w.x = pk2(a0.x, a0.y); w.y = pk2(a0.z, a0.w); w.z = pk2(a1.x, a1.y); w.w = pk2(a1.z, a1.w); return w; }
    return (u32x4){0u, 0u, 0u, 0u};
}
__device__ __forceinline__ void pool_phase(ArgsRef A, Frame& F, int p) {
    { const int t_ = mk_tid(F.wave); F.tid = t_; F.lane = t_ & 63; }
    bf16* DB = (bf16*)(F.ws + WS_QB);
    const int col = 8 * (F.tid & 127), rgq = F.tid >> 7, w = 2 << (col >> 8);
    for (int it = F.vcu; it < 1033; it += F.G) {
        int grp, b, t0, nr;
        if (it < 1024) { grp = 0; b = it >> 7; t0 = (it & 127) * 64; nr = 64; } else if (it < 1032) { grp = 1; b = it - 1024; t0 = 0; nr = 64; } else { grp = 2; b = 0; t0 = 0; nr = 16; }
        const int tb = t0 + 16 * rgq;
        if (16 * rgq >= nr) continue;
        u32x4 h[31];
#pragma unroll
        for (int i = 0; i < 31; ++i) h[i] = pool_h8(A, F, grp, b, tb - 15 + i, col, p);
        float sum[8];
#pragma unroll
        for (int e = 0; e < 8; ++e) sum[e] = 0.f;
#pragma unroll
        for (int j = 1; j < 16; ++j) { const float k = (j < w) ? 1.f : 0.f; const u32x4 v = h[15 - j];
            sum[0] += k * bflo(v.x); sum[1] += k * bfhi(v.x); sum[2] += k * bflo(v.y); sum[3] += k * bfhi(v.y); sum[4] += k * bflo(v.z); sum[5] += k * bfhi(v.z); sum[6] += k * bflo(v.w); sum[7] += k * bfhi(v.w); }
#pragma unroll
        for (int i = 0; i < 16; ++i) { const int t = tb + i;
            const u32x4 cv = h[15 + i]; const float cur[8] = {bflo(cv.x), bfhi(cv.x), bflo(cv.y), bfhi(cv.y), bflo(cv.z), bfhi(cv.z), bflo(cv.w), bfhi(cv.w)};
            const float inv = 1.0f / (float)(grp == 2 ? min(t + 1, w) : w);
            float d[8];
#pragma unroll
            for (int e = 0; e < 8; ++e) { sum[e] += cur[e]; d[e] = sum[e] * inv - cur[e]; }
            const int row = grp == 0 ? b * 8192 + t : grp == 1 ? ROW_S + b * 64 + t : ROW_M + t;
            u32x4 o; o.x = pk2(d[0], d[1]); o.y = pk2(d[2], d[3]); o.z = pk2(d[4], d[5]); o.w = pk2(d[6], d[7]);
            *(u32x4*)(DB + (size_t)row * D + col) = o;
            const u32x4 a1 = h[15 + i - 1], a3 = h[15 + i - 3], a7 = h[15 + i - 7], a15 = h[15 + i - 15];
            u32x4 ov; ov.x = (w == 2) ? a1.x : (w == 4) ? a3.x : (w == 8) ? a7.x : a15.x; ov.y = (w == 2) ? a1.y : (w == 4) ? a3.y : (w == 8) ? a7.y : a15.y;
            ov.z = (w == 2) ? a1.z : (w == 4) ? a3.z : (w == 8) ? a7.z : a15.z; ov.w = (w == 2) ? a1.w : (w == 4) ? a3.w : (w == 8) ? a7.w : a15.w;
            sum[0] -= bflo(ov.x); sum[1] -= bfhi(ov.x); sum[2] -= bflo(ov.y); sum[3] -= bfhi(ov.y); sum[4] -= bflo(ov.z); sum[5] -= bfhi(ov.z); sum[6] -= bflo(ov.w); sum[7] -= bfhi(ov.w);
            float* tp = nullptr;
            if (grp == 0 && t >= 8177) tp = F.out + OFF_PP + ((size_t)(p * 8 + b) * 15 + (t - 8177)) * D + col;
            if (grp == 1 && t >= 49) tp = F.out + OFF_PS + ((size_t)(p * 8 + b) * 15 + (t - 49)) * D + col;
            if (tp) { *(f32x4*)tp = (f32x4){cur[0], cur[1], cur[2], cur[3]}; *(f32x4*)(tp + 4) = (f32x4){cur[4], cur[5], cur[6], cur[7]}; }
        }
    }
}

namespace att {
constexpr int KSTR = 272;
constexpr int TB = 16384;
constexpr int OFF_K0 = 0, OFF_K1 = TB, OFF_V0 = 2 * TB, OFF_V1 = 3 * TB, OFF_BT = 4 * TB, OFF_GT = OFF_BT + 2048, OFF_Q = 5 * TB, XB = 16384;
static_assert(OFF_BT >= 4 * XB && OFF_GT + 512 <= OFF_Q && OFF_Q + 2 * TB <= 131072, "attention LDS map");
constexpr float THR = 48.0f;
constexpr float NEG = -1e30f;
struct AUnit { const bf16* K; const bf16* V; const bf16* KM; const bf16* VM; const bf16* Q; bf16* O; int P, L, x, h; };
__device__ __forceinline__ float max3f(float a, float b, float c) { float r; asm("v_max3_f32 %0, %1, %2, %3" : "=v"(r) : "v"(a), "v"(b), "v"(c)); return r; }
__device__ __forceinline__ float swapmax(float v) { auto rr = __builtin_amdgcn_permlane32_swap(__float_as_uint(v), __float_as_uint(v), false, false); return fmaxf(__uint_as_float(rr[0]), __uint_as_float(rr[1])); }
__device__ __forceinline__ float swapsum(float v) { auto rr = __builtin_amdgcn_permlane32_swap(__float_as_uint(v), __float_as_uint(v), false, false); return __uint_as_float(rr[0]) + __uint_as_float(rr[1]); }
typedef __bf16 bf16x2_t __attribute__((ext_vector_type(2)));
__device__ __forceinline__ unsigned cvtpk(float lo, float hi) { f32x2 v = {lo, hi}; bf16x2_t b = __builtin_convertvector(v, bf16x2_t); return __builtin_bit_cast(unsigned, b); }
__device__ __forceinline__ s16x4 vtr(const LAS unsigned char* p) { return __builtin_bit_cast(s16x4, __builtin_amdgcn_ds_read_tr16_b64_v4i16((LAS s16x4*)p)); }
__device__ __forceinline__ void glds16(const void* gsrc, unsigned lds_dst) { unsigned keep;
    asm volatile("s_mov_b32 %0, m0\n\ts_mov_b32 m0, %2\n\ts_nop 0\n\tglobal_load_lds_dwordx4 %1, off\n\ts_mov_b32 m0, %0" : "=&s"(keep) : "v"(gsrc), "s"(lds_dst) : "memory"); }
__device__ __forceinline__ bf16x8 pack8(const f32x16& S, int o) {
    u32x4 w; w.x = cvtpk(S[o], S[o + 1]); w.y = cvtpk(S[o + 2], S[o + 3]); w.z = cvtpk(S[o + 4], S[o + 5]); w.w = cvtpk(S[o + 6], S[o + 7]); return __builtin_bit_cast(bf16x8, w);
}

__device__ __forceinline__ void attn_unit(const int wv, LAS unsigned char* lds, const AUnit& u, const float* lq1, const float* lk1, const float* lq2, const float* lk2, const int layer_a, const float* relb, const float* subg) {
    const int tid = mk_tid(wv), lane = tid & 63, wid = wv, mp = wid >> 2, rg = wid & 3, q32 = lane & 31, hi = lane >> 5;
    LAS float* BT = (LAS float*)(lds + OFF_BT); LAS float* GT = (LAS float*)(lds + OFF_GT);
    {
        const float b15 = relb[15 * 8 + u.h];
        if (tid < 448) { const int rel = tid - 192, n = rel < 0 ? -rel : rel;
            int bk = n < 8 ? n : n < 12 ? 8 : n < 16 ? 9 : n < 23 ? 10 : n < 32 ? 11 : n < 46 ? 12 : n < 64 ? 13 : n < 91 ? 14 : 15; if (rel > 0) bk += 16;
            BT[tid] = (relb[bk * 8 + u.h] - b15) * LOG2E; }
        if (tid >= 384) GT[tid - 384] = subg[tid - 384] * (layer_a == 0 ? 0.8f : 0.52928698f);
    }
    const int vrows = min(128, u.L - 128 * u.x);
    const bool active = rg * 32 < vrows;
    const int ch = rg >> 1;
    const int NTw = active ? (u.P + min((2 * u.x + ch + 1) * 64, u.L) + 48) >> 6 : 0;
    const int NT = (u.P + min((2 * u.x + 2) * 64, u.L) + 48) >> 6;
    const int eq0 = u.P + 128 * u.x + rg * 32, eq = eq0 + q32;
    const unsigned lds0 = (unsigned)(size_t)lds;
    unsigned goff[2];
#pragma unroll
    for (int j = 0; j < 2; ++j) { const int row = wid * 8 + 4 * j + (lane >> 4), x = ((row & 3) << 2) | ((row >> 2) & 3), c = (lane & 15) ^ x; goff[j] = (unsigned)(row * 1024 + u.h * 128 + c * 8); }
    const unsigned ldst = (unsigned)wid * 2048u;
#define ATT_DMA(base, bufoff) do { _Pragma("unroll") for (int j_ = 0; j_ < 2; ++j_) \
        glds16((base) + goff[j_], (unsigned)__builtin_amdgcn_readfirstlane((int)(lds0 + (unsigned)(bufoff) + ldst + j_ * 1024))); } while (0)
#define ATT_ISSUE_K(t, bufoff) do { const bf16* b_ = ((t) == 0 && wid < 2) ? u.KM : u.K + (size_t)(t) * 65536; ATT_DMA(b_, bufoff); } while (0)
#define ATT_ISSUE_V(t, bufoff) do { const bf16* b_ = ((t) == 0 && wid < 2) ? u.VM : u.V + (size_t)(t) * 65536; ATT_DMA(b_, bufoff); } while (0)
#define ATT_WAITBAR() do { asm volatile("s_waitcnt vmcnt(0) lgkmcnt(0)" ::: "memory"); __builtin_amdgcn_s_barrier(); asm volatile("" ::: "memory"); } while (0)
    unsigned koff[4];
    { const int x = ((q32 & 3) << 2) | ((q32 >> 2) & 3);
#pragma unroll
      for (int d0 = 0; d0 < 4; ++d0) koff[d0] = lds0 + (unsigned)(q32 * 256 + (((mp * 8 + 2 * d0 + hi) ^ x) << 4)); }
    unsigned vofs[4][2];
    { const int qq = (lane & 15) >> 2, cl = 2 * ((lane >> 4) & 1) + ((lane & 3) >> 1), sub = 8 * (lane & 1);
#pragma unroll
      for (int dvb = 0; dvb < 4; ++dvb)
#pragma unroll
          for (int hf = 0; hf < 2; ++hf) vofs[dvb][hf] = lds0 + (unsigned)((8 * hf + 4 * hi + qq) * 256 + ((((dvb ^ qq) << 2) | (cl ^ (2 * hf + hi))) << 4) + sub); }
    {
        const bf16* qb_ = u.Q + (size_t)(128 * u.x + wid * 16) * 1024;
#pragma unroll
        for (int j = 0; j < 4; ++j) { const int row = 4 * j + (lane >> 4), x = ((row & 3) << 2) | ((row >> 2) & 3), c = (lane & 15) ^ x;
            glds16(qb_ + row * 1024 + u.h * 128 + c * 8, (unsigned)__builtin_amdgcn_readfirstlane((int)(lds0 + OFF_Q + wid * 4096 + j * 1024))); }
    }
    ATT_ISSUE_K(0, OFF_K0); ATT_ISSUE_V(0, OFF_V0); if (NT > 1) ATT_ISSUE_K(1, OFF_K1);
    ATT_WAITBAR();
    f32x16 O[4];
#pragma unroll
    for (int i = 0; i < 4; ++i)
#pragma unroll
        for (int r = 0; r < 16; ++r) O[i][r] = 0.f;
    float m = 0.f, l = 0.f;
    f32x16 SA0, SA1, SB0, SB1;
    const f32x16 zero16 = {0.f, 0.f, 0.f, 0.f, 0.f, 0.f, 0.f, 0.f, 0.f, 0.f, 0.f, 0.f, 0.f, 0.f, 0.f, 0.f};
#define ATT_SB() __builtin_amdgcn_sched_barrier(0)
#define ATT_QK(S0_, S1_, kbufoff) do { unsigned qsh_ = (unsigned)(OFF_Q + rg * 8192); asm volatile("" : "+s"(qsh_));     \
        bf16x8 kfa[4], kfb[4], qfr[4]; \
        _Pragma("unroll") for (int d0 = 0; d0 < 4; ++d0) { kfa[d0] = *(const LAS bf16x8*)(size_t)(koff[d0] + (unsigned)(kbufoff)); kfb[d0] = *(const LAS bf16x8*)(size_t)(koff[d0] + (unsigned)(kbufoff) + 8192u); qfr[d0] = *(const LAS bf16x8*)(size_t)(koff[d0] + qsh_); } \
        ATT_SB(); \
        S0_ = __builtin_amdgcn_mfma_f32_32x32x16_bf16(kfa[0], qfr[0], zero16, 0, 0, 0); S1_ = __builtin_amdgcn_mfma_f32_32x32x16_bf16(kfb[0], qfr[0], zero16, 0, 0, 0); \
        _Pragma("unroll") for (int d0 = 1; d0 < 4; ++d0) { S0_ = __builtin_amdgcn_mfma_f32_32x32x16_bf16(kfa[d0], qfr[d0], S0_, 0, 0, 0); S1_ = __builtin_amdgcn_mfma_f32_32x32x16_bf16(kfb[d0], qfr[d0], S1_, 0, 0, 0); } } while (0)
#define ATT_VLD(bank, ks) do { _Pragma("unroll") for (int dvb = 0; dvb < 4; ++dvb) { bank[dvb][0] = vtr((const LAS unsigned char*)(size_t)(vofs[dvb][0] + vb_ + (unsigned)((ks) * 4096))); bank[dvb][1] = vtr((const LAS unsigned char*)(size_t)(vofs[dvb][1] + vb_ + (unsigned)((ks) * 4096))); } } while (0)
#define ATT_PV(bank, ks, C0, C1) do { const bf16x8 pb = pack8(((ks) < 2) ? C0 : C1, 8 * ((ks) & 1)); \
        _Pragma("unroll") for (int dvb = 0; dvb < 4; ++dvb) { const bf16x8 vf = (bf16x8){bank[dvb][0][0], bank[dvb][0][1], bank[dvb][0][2], bank[dvb][0][3], bank[dvb][1][0], bank[dvb][1][1], bank[dvb][1][2], bank[dvb][1][3]}; \
            O[dvb] = __builtin_amdgcn_mfma_f32_32x32x16_bf16(vf, pb, O[dvb], 0, 0, 0); } } while (0)
#define ATT_STEP(C0, C1, N0, N1, t_, PAR) do { const int t = (t_); constexpr int cur = (PAR); \
        if (t + 2 < NT) ATT_ISSUE_K(t + 2, cur ? OFF_K1 : OFF_K0); \
        if (t + 1 < NT) ATT_ISSUE_V(t + 1, cur ? OFF_V0 : OFF_V1); \
        { \
            const int k0 = t * 64; \
            if (k0 + 154 > eq0) { const LAS float* bt_ = BT + (k0 - eq + 192 + 4 * hi); \
                _Pragma("unroll") for (int r = 0; r < 16; ++r) { C0[r] += bt_[(r & 3) + 8 * (r >> 2)]; } \
                ATT_SB(); \
                _Pragma("unroll") for (int r = 0; r < 16; ++r) { C1[r] += bt_[32 + (r & 3) + 8 * (r >> 2)]; } } \
            if (t >= NTw - 1) { const bool all_ = t >= NTw; _Pragma("unroll") for (int r = 0; r < 16; ++r) { if (r >= 8 || all_) C0[r] = NEG; C1[r] = NEG; } } \
            if (__any(m != 0.f)) { _Pragma("unroll") for (int r = 0; r < 16; ++r) { C0[r] -= m; C1[r] -= m; } } \
            float mx = max3f(C0[0], C1[0], C0[1]), mx2 = max3f(C1[1], C0[2], C1[2]); \
            _Pragma("unroll") for (int r = 3; r < 15; r += 2) { mx = max3f(mx, C0[r], C1[r]); mx2 = max3f(mx2, C0[r + 1], C1[r + 1]); } \
            mx = max3f(mx, mx2, C0[15]); mx = fmaxf(mx, C1[15]); \
            mx = swapmax(mx); \
            if (__any(mx > THR || (t == 0 && mx < -THR))) { const float dl = (t == 0) ? mx : fmaxf(mx, 0.f); m += dl; const float f = (t == 0) ? 1.f : __builtin_amdgcn_exp2f(-dl); l *= f; \
                _Pragma("unroll") for (int r = 0; r < 16; ++r) { C0[r] -= dl; C1[r] -= dl; } \
                _Pragma("unroll") for (int i = 0; i < 4; ++i) _Pragma("unroll") for (int r = 0; r < 16; ++r) O[i][r] *= f; } \
        } \
        ATT_SB(); \
        if (t + 1 < NT) ATT_QK(N0, N1, cur ? OFF_K0 : OFF_K1); \
        ATT_SB(); \
        { \
            constexpr unsigned vb_ = (unsigned)(cur ? OFF_V1 : OFF_V0); \
            s16x4 vA[4][2], vB[4][2]; \
            ATT_VLD(vA, 0); \
            ATT_SB(); \
            float ls = 0.f; \
            _Pragma("unroll") for (int r = 0; r < 16; ++r) { C0[r] = __builtin_amdgcn_exp2f(C0[r]); C1[r] = __builtin_amdgcn_exp2f(C1[r]); ls += C0[r]; ls += C1[r]; } \
            l += ls; \
            ATT_SB(); \
            ATT_VLD(vB, 1); ATT_SB(); ATT_PV(vA, 0, C0, C1); ATT_SB(); \
            ATT_VLD(vA, 2); ATT_SB(); ATT_PV(vB, 1, C0, C1); ATT_SB(); \
            ATT_VLD(vB, 3); ATT_SB(); ATT_PV(vA, 2, C0, C1); ATT_SB(); \
            ATT_PV(vB, 3, C0, C1); \
        } \
        ATT_WAITBAR(); } while (0)
    ATT_QK(SA0, SA1, OFF_K0);
    ATT_WAITBAR();
    for (int tt = 0; tt < NT; tt += 2) { ATT_STEP(SA0, SA1, SB0, SB1, tt, 0); if (tt + 1 < NT) ATT_STEP(SB0, SB1, SA0, SA1, tt + 1, 1); }
#undef ATT_STEP
#undef ATT_QK
#undef ATT_VLD
#undef ATT_PV
#undef ATT_SB
#undef ATT_WAITBAR
#undef ATT_ISSUE_K
#undef ATT_ISSUE_V
#undef ATT_DMA
    const int tid2_ = mk_tid(wv);
    const int lane2 = tid2_ & 63, q32b = lane2 & 31, hib = lane2 >> 5;
    float lam;
    { float s1 = lq1[lane2] * lk1[lane2], s2 = lq2[lane2] * lk2[lane2]; s1 = wave_sum(s1); s2 = wave_sum(s2); lam = expf(s1) - expf(s2) + (layer_a == 0 ? 0.2f : 0.47071302f); }
    l = swapsum(l); const float inv = active ? 1.0f / l : 0.f;
    LAS float* xb = (LAS float*)(lds + rg * XB);
    if (mp == 1) { const float f = inv * lam;
#pragma unroll
        for (int i = 0; i < 4; ++i)
#pragma unroll
            for (int r = 0; r < 16; ++r) xb[(i * 16 + r) * 64 + lane2] = O[i][r] * f; }
    __syncthreads();
    if (mp == 0 && active) {
        float ss = 0.f;
#pragma unroll
        for (int i = 0; i < 4; ++i)
#pragma unroll
            for (int r = 0; r < 16; ++r) { const float o = O[i][r] * inv - xb[(i * 16 + r) * 64 + lane2]; O[i][r] = o; ss += o * o; }
        ss = swapsum(ss); const float rs = 1.0f / sqrtf(ss * (1.f / 128.f) + SUBLN_EPS);
        asm volatile("s_waitcnt lgkmcnt(0)" ::: "memory");
        LAS unsigned char* stg = (LAS unsigned char*)xb;
#pragma unroll
        for (int i = 0; i < 4; ++i)
#pragma unroll
            for (int r4 = 0; r4 < 4; ++r4) { const int dv0 = 32 * i + 8 * r4 + 4 * hib; const f32x4 gg = *(const LAS f32x4*)(GT + dv0);
                u32x2 w; w.x = cvtpk(O[i][4 * r4] * rs * gg.x, O[i][4 * r4 + 1] * rs * gg.y); w.y = cvtpk(O[i][4 * r4 + 2] * rs * gg.z, O[i][4 * r4 + 3] * rs * gg.w);
                *(LAS u32x2*)(stg + q32b * KSTR + dv0 * 2) = w; }
        asm volatile("s_waitcnt lgkmcnt(0)" ::: "memory");
        bf16* og = u.O + (size_t)(128 * u.x + rg * 32) * 1024 + u.h * 128;
#pragma unroll
        for (int i = 0; i < 8; ++i) { const int row = i * 4 + (lane2 >> 4), c16 = lane2 & 15; const u32x4 v = *(const LAS u32x4*)(stg + row * KSTR + c16 * 16);
            if (rg * 32 + row < vrows) *(u32x4*)(og + (size_t)row * 1024 + c16 * 8) = v; }
    }
    __syncthreads();
}
__device__ __forceinline__ void attn_phase(ArgsRef A, Frame& F, int a) {
    const bf16* QB = (const bf16*)(F.ws + WS_QB); bf16* OB = (bf16*)(F.ws + WS_XN); const bf16* KX = (const bf16*)(F.ws + WS_KX); const bf16* VX = (const bf16*)(F.ws + WS_VX);
    const bf16* KXS = (const bf16*)(F.ws + WS_KXS) + (size_t)a * KXS_LAYER; const bf16* VXS = (const bf16*)(F.ws + WS_VXS) + (size_t)a * KXS_LAYER;
    { const int gt = blockIdx.x * 512 + mk_tid(F.wave);
      for (int i = gt; i < 65536; i += F.G * 512) { const int c4 = i & 255, r = (i >> 8) & 15, b = (i >> 12) & 7, kv = i >> 15;
          const f32x4 v = *(const f32x4*)((const float*)(F.ws + (kv ? WS_MFV : WS_MFK)) + r * 1024 + c4 * 4);
          *(f32x4*)(F.out + (kv ? OFF_VP : OFF_KP) + (size_t)a * 8 * EXT_P * 1024 + (size_t)(b * EXT_P + r) * 1024 + c4 * 4) = v; } }
    for (int n = F.vcu; n < 4168; n += F.G) {
        AUnit u; u.KM = (const bf16*)(F.ws + WS_KXM); u.VM = (const bf16*)(F.ws + WS_VXM);
        if (n < 4096) { const int i = n >> 8, v = n & 255, c = v & 31, bh = (v >> 5) * 8 + (i >> 1); const int x = (i & 1) ? 63 - c : c; const int b = bh >> 3;
            u.K = KX + (size_t)b * EXT_P * 1024; u.V = VX + (size_t)b * EXT_P * 1024; u.Q = QB + (size_t)b * 8192 * 1024; u.O = OB + (size_t)b * 8192 * 1024; u.P = 16; u.L = 8192; u.x = x; u.h = bh & 7; }
        else if (n < 4160) { const int j = n - 4096, b = j >> 3; u.K = KXS + (size_t)b * EXT_S * 1024; u.V = VXS + (size_t)b * EXT_S * 1024; u.Q = QB + (size_t)(ROW_S + b * 64) * 1024; u.O = OB + (size_t)(ROW_S + b * 64) * 1024; u.P = 1040; u.L = 64; u.x = 0; u.h = j & 7; }
        else { u.K = (const bf16*)(F.ws + WS_KXM); u.V = (const bf16*)(F.ws + WS_VXM); u.Q = QB + (size_t)ROW_M * 1024; u.O = OB + (size_t)ROW_M * 1024; u.P = 0; u.L = 16; u.x = 0; u.h = n - 4160; }
        attn_unit(F.wave, F.lds, u, A.in[12] + a * 64, A.in[13] + a * 64, A.in[14] + a * 64, A.in[15] + a * 64, a, A.in[6], A.in[16] + a * 128);
    }
}
}

#define XB_TMO      128
#define XB_XCNT(j)  (256  + 64 * (j))
#define XB_XSUB(j)  (1280 + 64 * (j))
#define XB_XGEN(j)  (2304 + 64 * (j))
#define XB_TOP      3328
#define XB_TOPGEN   3392
#define XCD_BAR_WORDS 3456
#define XB_SPIN_CAP (1u << 18)

__device__ __forceinline__ unsigned xb_ld(unsigned* p)              { return __hip_atomic_load(p, __ATOMIC_RELAXED, __HIP_MEMORY_SCOPE_AGENT); }
__device__ __forceinline__ unsigned xb_add(unsigned* p, unsigned v) { return __hip_atomic_fetch_add(p, v, __ATOMIC_RELAXED, __HIP_MEMORY_SCOPE_AGENT); }
__device__ __forceinline__ unsigned xb_xcc_id() { return (unsigned)__builtin_amdgcn_s_getreg((3 << 11) | 20) & 0xFu; }
#define XB_SPIN(cond, bar) do { unsigned _sp = 0; while (cond) { __builtin_amdgcn_s_sleep(1); \
    if ((++_sp & 255u) == 0u) { if (xb_ld(&(bar)[XB_TMO])) break; if (_sp > XB_SPIN_CAP) { atomicAdd(&(bar)[XB_TMO], 1u); break; } } } } while (0)

struct XcdBarrier {
    bool leader; unsigned* bar; unsigned x;
    volatile LAS unsigned* st;
};

__device__ __forceinline__ XcdBarrier xcd_barrier_post(unsigned* bar, volatile LAS unsigned* st) {
    XcdBarrier b; b.bar = bar; b.x = xb_xcc_id(); b.st = st;
    b.leader = (threadIdx.x == 0);
    if (b.leader) (void)xb_add(&bar[XB_XCNT(b.x)], 1u);
    return b;
}
__device__ __forceinline__ void xcd_barrier_complete(unsigned* bar, unsigned x, unsigned& nloc, unsigned& nx) {
    const unsigned G = gridDim.x * gridDim.y * gridDim.z;
    unsigned sum, cnt, mine, sp = 0u;
    for (;;) {
        sum = 0u; cnt = 0u; mine = 0u;
#pragma unroll
        for (unsigned j = 0; j < 16; ++j) { const unsigned c = xb_ld(&bar[XB_XCNT(j)]); sum += c; cnt += (c > 0u) ? 1u : 0u; mine = (j == x) ? c : mine; }
        if (sum == G) break;
        __builtin_amdgcn_s_sleep(1);
        if ((++sp & 255u) == 0u) { if (xb_ld(&bar[XB_TMO])) break; if (sp > XB_SPIN_CAP) { atomicAdd(&bar[XB_TMO], 1u); break; } }
    }
    nloc = mine > 0u ? mine : 1u; nx = cnt > 0u ? cnt : 1u;
}

__device__ __forceinline__ void xcd_barrier(const XcdBarrier& b) {
    asm volatile("s_waitcnt vmcnt(0)" ::: "memory");
    __syncthreads();
    if (b.leader) {
        unsigned* bar = b.bar;
        __builtin_amdgcn_s_waitcnt(0);
        unsigned nloc = b.st[0], nx = b.st[1];
        if (nloc == 0u) { xcd_barrier_complete(bar, b.x, nloc, nx); b.st[0] = nloc; b.st[1] = nx; }
        const unsigned old = xb_add(&bar[XB_XSUB(b.x)], 1u);
        const unsigned gen = old / nloc;
        if (old + 1u == (gen + 1u) * nloc) {
            __builtin_amdgcn_fence(__ATOMIC_RELEASE, "agent");
            asm volatile("s_waitcnt vmcnt(0)" ::: "memory");
            const unsigned og = xb_add(&bar[XB_TOP], 1u);
            const unsigned tg = og / nx;
            if (og + 1u == (tg + 1u) * nx) xb_add(&bar[XB_TOPGEN], 1u);
            else XB_SPIN(xb_ld(&bar[XB_TOPGEN]) == tg, bar);
            __builtin_amdgcn_fence(__ATOMIC_ACQUIRE, "agent");
            xb_add(&bar[XB_XGEN(b.x)], 1u);
            asm volatile("s_waitcnt vmcnt(0)" ::: "memory");
        } else {
            XB_SPIN(xb_ld(&bar[XB_XGEN(b.x)]) == gen, bar);
            __builtin_amdgcn_fence(__ATOMIC_ACQUIRE, "agent");
            asm volatile("s_waitcnt vmcnt(0)" ::: "memory");
        }
    }
    __syncthreads();
}

__device__ __forceinline__ void run_step(ArgsRef args, const int step, const int wv) {
    extern __shared__ __attribute__((aligned(16))) unsigned char lds_raw[];
    Frame F;
    F.lds = (LAS unsigned char*)lds_raw; F.tid = 0; F.lane = 0; F.wave = wv;
    F.G = gridDim.x; { const int bx = blockIdx.x; F.vcu = (F.G % 8 == 0) ? (bx % 8) * (F.G / 8) + bx / 8 : bx; }
    F.out = args.out; F.ws = args.ws;
    bf16* XN = (bf16*)(F.ws + WS_XN); bf16* QB = (bf16*)(F.ws + WS_QB); bf16* YB = (bf16*)(F.ws + WS_YB); bf16* U = (bf16*)(F.ws + WS_U);
    int layer = 0, k = -1;
    if (step > 0) { const int s = step - 1; if (s < 7) { layer = 0; k = s; } else if (s < 13) { layer = 1; k = s - 7; } else if (s < 20) { layer = 2; k = s - 13; } else { layer = 3; k = s - 20; } }
    const bool attn = (layer & 1) == 0; const int a = layer >> 1;
    int type;
    if (step == 0) type = 0; else if (attn) type = k == 0 ? 1 : k == 1 ? 2 : k == 2 ? 4 : k == 3 ? 5 : k == 4 ? 6 : k == 5 ? 7 : 8;
    else type = k == 0 ? 3 : k == 1 ? 4 : k == 2 ? 5 : k == 3 ? 6 : k == 4 ? 7 : 8;
    if (type == 0) prologue(args, F);
    else if (type == 1) {
        pg8::Gemm g{XN, (const bf16*)(F.ws + WS_WQKV) + (size_t)a * 3072 * D, MPAD, 3072, D, D, D, 0}; pg8::StaticOrder S; S.init(MPAD, 3072, F.G, (int)blockIdx.x, D);
        pg8::EpiQKV E{F.ws, F.out, a};
        pg8::gemm_phase<pg8::EpiQKV, pg8::StaticOrder, true, true>(F.lds, g, S, E, mk_tid(F.wave));
    } else if (type == 2) { att::attn_phase(args, F, a); }
    else if (type == 3) { pool_phase(args, F, a); }
    else if (type == 4 || type == 7) {
        pg8::Gemm g;
        if (type == 7) g = pg8::Gemm{U, (const bf16*)(F.ws + WS_WDN) + (size_t)layer * D * FF, MPAD, D, FF, FF, FF, 0};
        else if (attn) g = pg8::Gemm{XN, (const bf16*)(F.ws + WS_WO) + (size_t)a * D * D, MPAD, D, D, D, D, 0};
        else g = pg8::Gemm{QB, (const bf16*)(F.ws + WS_WPOOL) + (size_t)a * 4 * 65536, MPAD, D, 256, D, 256, 512};
        pg8::TailOrder S; S.init(D, F.G, (int)blockIdx.x, g.K, type == 7 ? 16 : (attn ? 4 : 1));
        pg8::EpiBf16<0> E{YB, D, (float*)(F.ws + WS_YF)};
        pg8::gemm_phase<pg8::EpiBf16<0>, pg8::TailOrder, true, true>(F.lds, g, S, E, mk_tid(F.wave));
    } else if (type == 5) { fin_phase(args, F, layer == 0, attn ? 4 : 0, args.in[8] + layer * D, args.in[9] + layer * D); }
    else if (type == 6) {
        pg8::Gemm g{XN, (const bf16*)(F.ws + WS_WUP) + (size_t)layer * D * FF, MPAD, FF, D, D, D, 0}; pg8::StaticOrder S; S.init(MPAD, FF, F.G, (int)blockIdx.x, D);
        pg8::EpiBf16<2> E{U, FF, nullptr};
        pg8::gemm_phase<pg8::EpiBf16<2>, pg8::StaticOrder, true, true>(F.lds, g, S, E, mk_tid(F.wave));
    } else { fin_phase(args, F, false, 16, args.in[10] + layer * D, layer < 3 ? args.in[7] + (layer + 1) * D : nullptr); }
}
__global__ void __launch_bounds__(512, 2) fwd_kernel(Args args_) {
    const int lo = args_.lo, hi = args_.hi;
    const int wv = __builtin_amdgcn_readfirstlane((int)threadIdx.x >> 6);
    extern __shared__ __attribute__((aligned(16))) unsigned char lds_raw[];
    volatile LAS unsigned* bst = (volatile LAS unsigned*)((LAS unsigned char*)lds_raw + 139264);
    if (threadIdx.x < 2) bst[threadIdx.x] = 0u;
    __syncthreads();
    XcdBarrier bar = xcd_barrier_post((unsigned*)args_.ws + 4096, bst);
    int probe_rep = 0; (void)probe_rep;
    for (int step = lo; step < hi; ++step) {
        const __attribute__((address_space(4))) Args* ap = (const __attribute__((address_space(4))) Args*)__builtin_amdgcn_kernarg_segment_ptr();
        asm volatile("" : "+s"(ap));
        run_step(*ap, step, wv);
#if defined(PROBE_MASK)
        {
            int ty = 0; if (step > 0) { const int s = step - 1; const int k = s < 7 ? s : s < 13 ? s - 7 : s < 20 ? s - 13 : s - 20; const bool at = (s < 7) || (s >= 13 && s < 20);
                ty = at ? (k == 0 ? 1 : k == 1 ? 2 : k == 2 ? 4 : k == 3 ? 5 : k == 4 ? 6 : k == 5 ? 7 : 8) : (k == 0 ? 3 : k == 1 ? 4 : k == 2 ? 5 : k == 3 ? 6 : k == 4 ? 7 : 8); }
            if (((PROBE_MASK >> ty) & 1) && !probe_rep) { probe_rep = 1; --step; __syncthreads(); continue; }
            probe_rep = 0; }
#endif
        if (step + 1 < hi) { if (lo < 0) { __threadfence(); cg::this_grid().sync(); }
            else { xcd_barrier(bar);
#if defined(PROBE_BAR2)
 xcd_barrier(bar);
#endif
 } }
    }
}

extern "C" void kernel_launch(void* const* d_in, const int* in_sizes, int n_in, void* d_out, int out_size, void* d_ws, size_t ws_size, hipStream_t stream) {
    static int grid = 0;
    if (grid == 0) {
        if (n_in != 22 || (size_t)out_size != OUT_TOTAL || ws_size < WS_END) { fprintf(stderr, "kernel_launch: unexpected shapes n_in %d out %d ws %zu\n", n_in, out_size, ws_size); grid = -1; return; }
        int dev = 0, cus = 0, per_cu = 0;
        hipGetDevice(&dev); hipDeviceGetAttribute(&cus, hipDeviceAttributeMultiprocessorCount, dev);
        hipFuncSetAttribute((const void*)fwd_kernel, hipFuncAttributeMaxDynamicSharedMemorySize, LDS_BYTES);
        hipOccupancyMaxActiveBlocksPerMultiprocessor(&per_cu, (const void*)fwd_kernel, 512, LDS_BYTES);
        if (per_cu < 1) { fprintf(stderr, "kernel_launch: occupancy query says %d blocks/CU\n", per_cu); per_cu = 1; }
        (void)hipGetLastError();
        grid = cus;
    }
    if (grid < 0) return;
    if (hipMemsetAsync(d_ws, 0, 65536, stream) != hipSuccess) { fprintf(stderr, "kernel_launch: memset failed\n"); return; }
    Args a{};
    for (int i = 0; i < 22; ++i) a.in[i] = (const float*)d_in[i];
    a.out = (float*)d_out; a.ws = (unsigned char*)d_ws;
#if ONE_LAUNCH
    a.lo = 0; a.hi = NSTEPS;
    void* kargs[] = {&a};
    hipError_t e = hipLaunchCooperativeKernel((const void*)fwd_kernel, dim3(grid), dim3(512), kargs, LDS_BYTES, stream);
    if (e != hipSuccess) fprintf(stderr, "cooperative launch failed: %s (grid %d)\n", hipGetErrorString(e), grid);
#else
    for (int s = 0; s < NSTEPS; ++s) { a.lo = s; a.hi = s + 1; hipLaunchKernelGGL(fwd_kernel, dim3(grid), dim3(512), LDS_BYTES, stream, a); }
#endif
}
static_assert(WS_QB == 213 * MiB && WS_KX == 473 * MiB && WS_VX == 602 * MiB && WS_KXS == 731 * MiB && WS_VXS == 767 * MiB && WS_KXM == 803 * MiB && WS_VXM == 804 * MiB && KXS_LAYER == 9 * MiB && WS_MFK == 1323 * MiB && WS_MFV == 1324 * MiB, "EpiQKV hard-coded map");
static_assert(OFF_KP == 67633152 && OFF_VP == 202113024 && OFF_KS == 336838656 && OFF_VS == 337887232, "EpiQKV hard-coded output offsets");
```

```cpp
#include <hip/hip_runtime.h>
#include <hip/hip_cooperative_groups.h>
#include <hip/hip_bf16.h>
#include <cstdio>
#include <cstdint>
namespace cg = cooperative_groups;
namespace pg8 {
#define PG8_LAS __attribute__((address_space(3)))
typedef unsigned short bf16_t;
typedef short bf16x8 __attribute__((ext_vector_type(8)));
typedef float f32x4 __attribute__((ext_vector_type(4)));
typedef unsigned u32x4 __attribute__((ext_vector_type(4)));
constexpr int BM = 256, BK = 64, HALF = 128, HTB = HALF * BK * 2  , STAGE_BYTES = 8 * HTB, NXCD = 8, WGM = 8;

__host__ __device__ __forceinline__ int lds_byte(int r, int c) { const int st = (r >> 4) * 2 + (c >> 5), rr = r & 15, cc = c & 31, ob = rr * 64 + cc * 2; return st * 1024 + (ob ^ (((ob >> 9) & 1) << 5)); }
__host__ __device__ __forceinline__ void stage_rc(int b, int& R, int& C) { const int st = b / 1024, sb = b % 1024, swz = sb ^ (((sb >> 9) & 1) << 5); R = (st >> 1) * 16 + swz / 64; C = (st & 1) * 32 + (swz % 64) / 2; }
__host__ __device__ __forceinline__ int perm32(int rho) { const int n = rho >> 4, i = rho & 15; return 8 * (i >> 2) + 4 * n + (i & 3); }

struct Unit { int pm, pn, ko, nt, sp; };
struct Gemm { const bf16_t* A; const bf16_t* Bt; int M, N, K, lda, ldb, acs; };

struct StaticOrder {
    int nM, nN, nwg, G, c, ntf;
    __host__ __device__ void init(int M, int N, int G_, int c_, int K) { nM = M / BM; nN = N / BM; nwg = nM * nN; G = G_; c = c_; ntf = K / BK; }
    __host__ __device__ bool next(int i, Unit& u) const {
        const long L = (long)i * G + c; if (L >= nwg) return false;
        int wgid = (int)L; { const int q = nwg / NXCD, r = nwg % NXCD, xcd = wgid % NXCD, off = wgid / NXCD; wgid = (xcd < r ? xcd * (q + 1) : r * (q + 1) + (xcd - r) * q) + off; }
        const int nig = WGM * nN, gid = wgid / nig, fm = gid * WGM, gsz = (nM - fm) < WGM ? (nM - fm) : WGM;
        u.pm = fm + ((wgid % nig) % gsz); u.pn = (wgid % nig) / gsz; u.ko = 0; u.nt = ntf; u.sp = 0; return true;
    }
    __device__ __forceinline__ void a_ready(const Unit&) const {}
    __device__ __forceinline__ void done(const Unit&) const {}
};
struct TailOrder {
    StaticOrder mn; int KS, kc;
    __host__ __device__ void init(int N, int G_, int c_, int K, int KS_) { mn.init(65536, N, G_, c_, K); KS = KS_; kc = K / KS_; }
    __host__ __device__ bool next(int i, Unit& u) const {
        const long L = (long)i * mn.G + mn.c; if (L < mn.nwg) return mn.next(i, u);
        const int Lt = (int)(L - mn.nwg); if (Lt >= 3 * mn.nN * KS) return false;
        const int tile = Lt / KS, ks = Lt - tile * KS; u.pm = 256 + tile / mn.nN; u.pn = tile % mn.nN; u.ko = ks * kc; u.nt = kc / BK; u.sp = KS > 1 ? ks + 1 : 0; return true;
    }
    __device__ __forceinline__ void a_ready(const Unit&) const {}
    __device__ __forceinline__ void done(const Unit&) const {}
};

__device__ __forceinline__ unsigned cvt_pk_bf16(float lo, float hi) { unsigned r; asm volatile("v_cvt_pk_bf16_f32 %0, %1, %2" : "=v"(r) : "v"(lo), "v"(hi)); return r; }
template <int ACT  > struct EpiBf16 {
    static constexpr bool PERM = true, AFTER_DRAIN = false;
    bf16_t* O; int ldc; float* yf;
    __device__ __forceinline__ void operator()(const f32x4 (&acc)[2][2][4][2], const Unit& u, int wr, int wc, int fr, int fq) const {
        asm volatile("" : "+v"(fr), "+v"(fq));
        const int row0 = u.pm * BM + wr * 64 + fr; const int col0 = u.pn * BM + wc * 32 + 8 * fq;
#pragma unroll
        for (int ai = 0; ai < 2; ++ai)
#pragma unroll
            for (int m = 0; m < 4; ++m) { bf16_t* rowp = O + (size_t)(row0 + ai * HALF + m * 16) * ldc + col0;
#pragma unroll
                for (int bj = 0; bj < 2; ++bj) { f32x4 v0 = acc[ai][bj][m][0], v1 = acc[ai][bj][m][1];
                    if (ACT == 2) {
#pragma unroll
                        for (int e = 0; e < 4; ++e) { float a = fmaxf(v0[e], 0.f), b = fmaxf(v1[e], 0.f); v0[e] = a * a; v1[e] = b * b; } }
                    if (u.sp) { float* yr = yf + ((size_t)(u.sp - 1) * 768 + (size_t)(row0 + ai * HALF + m * 16 - 65536)) * 1024 + col0 + bj * HALF;
                        *(f32x4*)yr = v0; *(f32x4*)(yr + 4) = v1; }
                    else { u32x4 w; w.x = cvt_pk_bf16(v0[0], v0[1]); w.y = cvt_pk_bf16(v0[2], v0[3]); w.z = cvt_pk_bf16(v1[0], v1[1]); w.w = cvt_pk_bf16(v1[2], v1[3]);
                    *(u32x4*)(rowp + bj * HALF) = w; } } }
    }
};
struct EpiQKV {
    static constexpr bool PERM = true, AFTER_DRAIN = false;
    unsigned char* ws; float* out; int a;
    __device__ __forceinline__ void operator()(const f32x4 (&acc)[2][2][4][2], const Unit& u, int wr, int wc, int fr, int fq) const {
        const size_t MiB_ = 1u << 20;
        asm volatile("" : "+v"(fr), "+v"(fq));
        const int t3 = u.pn >> 2; const int colb = (u.pn & 3) * 256 + wc * 32 + 8 * fq;
        bf16_t* X; float* Fp = nullptr; int rbase, jump = 0, s0 = 0; float sc = 1.f;
        if (t3 == 0) { X = (bf16_t*)(ws + 213 * MiB_); rbase = u.pm * BM; sc = 0.125f * 1.4426950408889634f; }
        else if (u.pm < 256) { const int b = u.pm >> 5; rbase = b * 8208 + 16 + (u.pm & 31) * 256; X = (bf16_t*)(ws + (t3 == 1 ? 473 : 602) * MiB_);
            Fp = out + (t3 == 1 ? (size_t)67633152 : (size_t)202113024) + (size_t)a * 8 * 8208 * 1024 + (size_t)rbase * 1024; }
        else if (u.pm < 258) { s0 = (u.pm - 256) * 256; rbase = 1040 + s0; jump = 1040; X = (bf16_t*)(ws + (t3 == 1 ? 731 : 767) * MiB_) + (size_t)a * (9 * MiB_);
            Fp = out + (t3 == 1 ? (size_t)336838656 : (size_t)337887232) + (size_t)a * 512 * 1024 + (size_t)s0 * 1024; }
        else { rbase = 0; X = (bf16_t*)(ws + (t3 == 1 ? 803 : 804) * MiB_); Fp = (float*)(ws + (t3 == 1 ? 1323 : 1324) * MiB_); }
#pragma unroll
        for (int ai = 0; ai < 2; ++ai)
#pragma unroll
            for (int m = 0; m < 4; ++m) { const int rit = ai * HALF + wr * 64 + m * 16 + fr;
                bf16_t* xr = X + (unsigned)((rbase + rit + ((s0 + rit) >> 6) * jump) * 1024 + colb); float* fr_ = Fp + (unsigned)(rit * 1024 + colb);
#pragma unroll
                for (int bj = 0; bj < 2; ++bj) { const f32x4 v0 = acc[ai][bj][m][0], v1 = acc[ai][bj][m][1]; const f32x4 s0v = v0 * sc, s1v = v1 * sc;
                    u32x4 w; w.x = cvt_pk_bf16(s0v[0], s0v[1]); w.y = cvt_pk_bf16(s0v[2], s0v[3]); w.z = cvt_pk_bf16(s1v[0], s1v[1]); w.w = cvt_pk_bf16(s1v[2], s1v[3]);
                    *(u32x4*)(xr + bj * HALF) = w;
                    if (t3 != 0) { *(f32x4*)(fr_ + bj * HALF) = v0; *(f32x4*)(fr_ + bj * HALF + 4) = v1; } } }
    }
};
template <class Epi, class Sched, bool ALIGN_EPI = false, bool SP2 = false>
__device__ __forceinline__ void gemm_phase(PG8_LAS unsigned char* lds, const Gemm g, const Sched& S, const Epi& E, const int tid_in) {
    int tid_ = tid_in; asm volatile("" : "+v"(tid_));
    const int tid = tid_, wid = __builtin_amdgcn_readfirstlane(tid >> 6), lane = tid & 63, wr = wid >> 2, wc = wid & 3, fr = lane & 15, fq = lane >> 4;
    const int K = g.K; (void)K;
    unsigned voffA[2], voffB[2];
#pragma unroll
    for (int i = 0; i < 2; ++i) { int R, C; stage_rc(tid * 16 + i * 8192, R, C); const int Rb = Epi::PERM ? ((R & ~31) + perm32(R & 31)) : R;
        voffA[i] = (unsigned)(R * g.lda + C) * 2u; voffB[i] = (unsigned)(Rb * g.ldb + C) * 2u; }
    const size_t kstep = (size_t)(BK * 2);
    const size_t hstepA = (size_t)HALF * g.lda * 2, hstepB = (size_t)HALF * g.ldb * 2;
    const size_t tstepA = 2 * hstepA, tstepB = 2 * hstepB;
    const unsigned ldsw = (unsigned)wid * 1024u;
    const int aoff = lds_byte(wr * 64 + fr, fq * 8), boff = lds_byte(wc * 32 + fr, fq * 8);
#define PG8_SA(b, h) (((b) * 2 + (h)) * HTB)
#define PG8_SB(b, h) ((4 + (b) * 2 + (h)) * HTB)
#define PG8_STAGE(bufoff, gbase, voff) do { _Pragma("unroll") for (int _i = 0; _i < 2; ++_i) \
        __builtin_amdgcn_global_load_lds((const unsigned*)((const char*)(gbase) + (voff)[_i]), (PG8_LAS unsigned*)(lds + (bufoff) + ldsw + _i * 8192), 16, 0, 0); } while (0)
#define PG8_LDA(dst, b, h) do { _Pragma("unroll") for (int m = 0; m < 4; ++m) _Pragma("unroll") for (int k = 0; k < 2; ++k) dst[m][k] = *(const PG8_LAS bf16x8*)(lds + PG8_SA(b, h) + aoff + m * 2048 + k * 1024); } while (0)
#define PG8_LDB(dst, b, h) do { _Pragma("unroll") for (int n = 0; n < 2; ++n) _Pragma("unroll") for (int k = 0; k < 2; ++k) dst[n][k] = *(const PG8_LAS bf16x8*)(lds + PG8_SB(b, h) + boff + n * 2048 + k * 1024); } while (0)
#define PG8_MMA(ai, bj, At, Bt) do { __builtin_amdgcn_s_setprio(1); _Pragma("unroll") for (int m = 0; m < 4; ++m) _Pragma("unroll") for (int n = 0; n < 2; ++n) _Pragma("unroll") for (int k = 0; k < 2; ++k) \
        acc[ai][bj][m][n] = __builtin_amdgcn_mfma_f32_16x16x32_bf16(Bt[n][k], At[m][k], acc[ai][bj][m][n], 0, 0, 0); __builtin_amdgcn_s_setprio(0); } while (0)
#define PG8_WAIT_V(n) asm volatile("s_waitcnt vmcnt(" #n ")" ::: "memory")
#define PG8_WAIT_L(n) asm volatile("s_waitcnt lgkmcnt(" #n ")" ::: "memory")
#define PG8_BAR __builtin_amdgcn_s_barrier()
#define PG8_SCHED __builtin_amdgcn_sched_barrier(0)
    Unit cur, nxt; int ui = 0;
    if (!S.next(0, cur)) return;
    f32x4 acc[2][2][4][2];
#pragma unroll
    for (int a = 0; a < 2; ++a)
#pragma unroll
        for (int b = 0; b < 2; ++b)
#pragma unroll
            for (int m = 0; m < 4; ++m)
#pragma unroll
                for (int n = 0; n < 2; ++n) acc[a][b][m][n] = (f32x4){0.f, 0.f, 0.f, 0.f};
    bf16x8 At[4][2], B0[2][2], B1[2][2];
    const char* cA = (const char*)g.A + (size_t)cur.pm * tstepA + (size_t)cur.pn * g.acs + (size_t)cur.ko * 2; const char* cB = (const char*)g.Bt + (size_t)cur.pn * tstepB + (size_t)cur.ko * 2;
    S.a_ready(cur);
    if constexpr (SP2) {
        PG8_STAGE(PG8_SB(0, 0), cB, voffB); PG8_STAGE(PG8_SB(0, 1), cB + hstepB, voffB); PG8_STAGE(PG8_SA(0, 0), cA, voffA); PG8_STAGE(PG8_SA(0, 1), cA + hstepA, voffA);
        if (wr == 1) PG8_BAR;
        PG8_WAIT_V(2); PG8_BAR;
        PG8_STAGE(PG8_SB(1, 0), cB + kstep, voffB); PG8_STAGE(PG8_SA(1, 0), cA + kstep, voffA); PG8_STAGE(PG8_SB(1, 1), cB + hstepB + kstep, voffB);
        PG8_WAIT_V(6); PG8_BAR;
    } else {
        PG8_STAGE(PG8_SB(0, 0), cB, voffB); PG8_STAGE(PG8_SA(0, 0), cA, voffA); PG8_STAGE(PG8_SB(0, 1), cB + hstepB, voffB); PG8_STAGE(PG8_SA(0, 1), cA + hstepA, voffA);
        if (wr == 1) PG8_BAR;
        PG8_WAIT_V(4); PG8_BAR;
        PG8_STAGE(PG8_SB(1, 0), cB + kstep, voffB); PG8_STAGE(PG8_SA(1, 0), cA + kstep, voffA); PG8_STAGE(PG8_SB(1, 1), cB + hstepB + kstep, voffB);
        PG8_WAIT_V(6); PG8_BAR;
    }
    for (;;) {
        const bool has_next = S.next(ui + 1, nxt);
        const char* nA = has_next ? (const char*)g.A + (size_t)nxt.pm * tstepA + (size_t)nxt.pn * g.acs + (size_t)nxt.ko * 2 : cA; const char* nB = has_next ? (const char*)g.Bt + (size_t)nxt.pn * tstepB + (size_t)nxt.ko * 2 : cB;
        const int nt = cur.nt;
        for (int t = 0; t < nt; t += 2) {
            const bool last = (t == nt - 2);
            const char* a1 = cA + (size_t)(t + 1) * kstep;
            const char* a2 = last ? nA : cA + (size_t)(t + 2) * kstep; const char* b2 = last ? nB : cB + (size_t)(t + 2) * kstep;
            const char* a3 = a2 + kstep; const char* b3 = b2 + kstep;
            if (last && has_next) S.a_ready(nxt);
            if constexpr (SP2) {
            PG8_LDB(B0, 0, 0); PG8_LDB(B1, 0, 1); PG8_SCHED; PG8_LDA(At, 0, 0); PG8_STAGE(PG8_SA(1, 1), a1 + hstepA, voffA);
            PG8_WAIT_V(8); PG8_WAIT_L(0); PG8_BAR; PG8_MMA(0, 0, At, B0); PG8_MMA(0, 1, At, B1); PG8_BAR; PG8_SCHED;
            PG8_LDA(At, 0, 1); PG8_STAGE(PG8_SB(0, 0), b2, voffB); PG8_STAGE(PG8_SB(0, 1), b2 + hstepB, voffB); PG8_STAGE(PG8_SA(0, 0), a2, voffA);
            PG8_WAIT_V(8); PG8_WAIT_L(0); PG8_BAR; PG8_MMA(1, 0, At, B0); PG8_MMA(1, 1, At, B1); PG8_BAR; PG8_SCHED;
            PG8_LDB(B0, 1, 0); PG8_LDB(B1, 1, 1); PG8_SCHED; PG8_LDA(At, 1, 0); PG8_STAGE(PG8_SA(0, 1), a2 + hstepA, voffA);
            PG8_WAIT_V(8); PG8_WAIT_L(0); PG8_BAR; PG8_MMA(0, 0, At, B0); PG8_MMA(0, 1, At, B1); PG8_BAR; PG8_SCHED;
            PG8_LDA(At, 1, 1); PG8_STAGE(PG8_SB(1, 0), b3, voffB); PG8_STAGE(PG8_SB(1, 1), b3 + hstepB, voffB); PG8_STAGE(PG8_SA(1, 0), a3, voffA);
            PG8_WAIT_V(8); PG8_WAIT_L(0); PG8_BAR; PG8_MMA(1, 0, At, B0); PG8_MMA(1, 1, At, B1); PG8_BAR; PG8_SCHED;
            } else {
            PG8_LDB(B0, 0, 0); PG8_SCHED; PG8_LDA(At, 0, 0); PG8_STAGE(PG8_SA(1, 1), a1 + hstepA, voffA);
            PG8_WAIT_L(8); PG8_BAR; PG8_WAIT_L(0); PG8_MMA(0, 0, At, B0); PG8_BAR; PG8_SCHED;
            PG8_LDB(B1, 0, 1); PG8_STAGE(PG8_SB(0, 0), b2, voffB);
            PG8_BAR; PG8_WAIT_L(0); PG8_MMA(0, 1, At, B1); PG8_BAR;
            PG8_LDA(At, 0, 1); PG8_STAGE(PG8_SA(0, 0), a2, voffA);
            PG8_BAR; PG8_WAIT_L(0); PG8_MMA(1, 0, At, B0); PG8_BAR; PG8_SCHED;
            PG8_STAGE(PG8_SB(0, 1), b2 + hstepB, voffB);
            PG8_WAIT_V(6); PG8_BAR; PG8_MMA(1, 1, At, B1); PG8_BAR;
            PG8_LDB(B0, 1, 0); PG8_SCHED; PG8_LDA(At, 1, 0); PG8_STAGE(PG8_SA(0, 1), a2 + hstepA, voffA);
            PG8_WAIT_L(8); PG8_BAR; PG8_WAIT_L(0); PG8_MMA(0, 0, At, B0); PG8_BAR; PG8_SCHED;
            PG8_LDB(B1, 1, 1); PG8_STAGE(PG8_SB(1, 0), b3, voffB);
            PG8_BAR; PG8_WAIT_L(0); PG8_MMA(0, 1, At, B1); PG8_BAR;
            PG8_LDA(At, 1, 1); PG8_STAGE(PG8_SA(1, 0), a3, voffA);
            PG8_BAR; PG8_WAIT_L(0); PG8_MMA(1, 0, At, B0); PG8_BAR; PG8_SCHED;
            PG8_STAGE(PG8_SB(1, 1), b3 + hstepB, voffB);
            PG8_WAIT_V(6); PG8_BAR; PG8_MMA(1, 1, At, B1); PG8_BAR;
            }
        }
        if constexpr (ALIGN_EPI) { if (wr == 0) PG8_BAR; }
        if constexpr (!Epi::AFTER_DRAIN) { E(acc, cur, wr, wc, fr, fq); S.done(cur); }
        if (!has_next) break;
#pragma unroll
        for (int a = 0; a < 2; ++a)
#pragma unroll
            for (int b = 0; b < 2; ++b)
#pragma unroll
                for (int m = 0; m < 4; ++m)
#pragma unroll
                    for (int n = 0; n < 2; ++n) acc[a][b][m][n] = (f32x4){0.f, 0.f, 0.f, 0.f};
        cur = nxt; cA = nA; cB = nB; ++ui;
        if constexpr (ALIGN_EPI) { if (wr == 1) PG8_BAR; }
    }
    PG8_WAIT_V(0);
    if constexpr (!ALIGN_EPI) { if (wr == 0) PG8_BAR; }
    PG8_BAR;
    if constexpr (Epi::AFTER_DRAIN) { E.fused(acc, cur, wr, wc, fr, fq, lds, wid, lane); S.done(cur); }
#undef PG8_SA
#undef PG8_SB
#undef PG8_STAGE
#undef PG8_LDA
#undef PG8_LDB
#undef PG8_MMA
#undef PG8_WAIT_V
#undef PG8_WAIT_L
#undef PG8_BAR
#undef PG8_SCHED
}
}
#define LAS __attribute__((address_space(3)))
#define GAS __attribute__((address_space(1)))
typedef unsigned short bf16;
typedef unsigned u32x4 __attribute__((ext_vector_type(4)));
typedef unsigned u32x2 __attribute__((ext_vector_type(2)));
typedef float f32x4 __attribute__((ext_vector_type(4)));
typedef float f32x2 __attribute__((ext_vector_type(2)));
typedef float f32x16 __attribute__((ext_vector_type(16)));
typedef short bf16x8 __attribute__((ext_vector_type(8)));
typedef short s16x4 __attribute__((ext_vector_type(4)));
constexpr int D = 1024, FF = 4096, NH = 8;
constexpr int ROW_S = 65536, ROW_M = 66048, ROWS_VALID = 66064, MPAD = 66304;
constexpr int EXT_P = 8208, EXT_S = 1104;
constexpr float LOG2E = 1.4426950408889634f;
constexpr float QSCALE = 0.125f * LOG2E;
constexpr float EPS = 1e-6f, SUBLN_EPS = 1e-5f;
constexpr size_t OFF_YP = 0, OFF_YS = 67108864, OFF_KP = OFF_YS + 524288, OFF_VP = OFF_KP + 134479872, OFF_PP = OFF_VP + 134479872,
                 OFF_KS = OFF_PP + 245760, OFF_VS = OFF_KS + 1048576, OFF_PS = OFF_VS + 1048576, OUT_TOTAL = OFF_PS + 245760;
constexpr size_t MiB = 1u << 20;
constexpr size_t WS_WQKV = 1 * MiB, WS_WO = 13 * MiB, WS_WPOOL = 17 * MiB, WS_WUP = 18 * MiB, WS_WDN = 50 * MiB, WS_XM = 82 * MiB,
                 WS_XN = 83 * MiB, WS_QB = 213 * MiB, WS_YB = 343 * MiB, WS_KX = 473 * MiB, WS_VX = 602 * MiB, WS_KXS = 731 * MiB, WS_VXS = 767 * MiB,
                 WS_KXM = 803 * MiB, WS_VXM = 804 * MiB, WS_U = 805 * MiB, WS_MFK = 1323 * MiB, WS_MFV = 1324 * MiB, WS_YF = 1325 * MiB, WS_END = 1373 * MiB;
constexpr size_t KXS_LAYER = 18 * MiB / 2;
constexpr int LDS_BYTES = 147456;
constexpr int NSTEPS = 27;
#ifndef ONE_LAUNCH
#define ONE_LAUNCH 1
#endif

__device__ __forceinline__ unsigned f2bf(float f) { unsigned u = __builtin_bit_cast(unsigned, f); return (u + 0x7fffu + ((u >> 16) & 1u)) >> 16; }
__device__ __forceinline__ unsigned pk2(float lo, float hi) { return f2bf(lo) | (f2bf(hi) << 16); }
__device__ __forceinline__ float bflo(unsigned w) { return __builtin_bit_cast(float, w << 16); }
__device__ __forceinline__ float bfhi(unsigned w) { return __builtin_bit_cast(float, w & 0xffff0000u); }
__device__ __forceinline__ float wave_sum(float v) {
#pragma unroll
    for (int o = 1; o < 64; o <<= 1) v += __shfl_xor(v, o);
    return v;
}

struct Args { const float* in[22]; float* out; unsigned char* ws; int lo, hi; };
typedef const __attribute__((address_space(4))) Args& ArgsRef;
__device__ __forceinline__ int mk_tid(int wv) { int t; asm volatile("v_mbcnt_lo_u32_b32 %0, -1, 0\n\tv_mbcnt_hi_u32_b32 %0, -1, %0" : "=v"(t)); return wv * 64 + t; }
struct Frame {
    LAS unsigned char* lds; int tid, lane, wave, vcu, G;
    float* out; unsigned char* ws;
};

__device__ __forceinline__ void transpose_item(const float* W, int K, int N, bf16* WT, LAS float* scr, int item, int lane, const float* nscale) {
    const int nblk = N / 64, kb = item / nblk, nb = item % nblk, k0 = 64 * kb, n0 = 64 * nb;
    f32x4 v[16];
#pragma unroll
    for (int i = 0; i < 16; ++i) v[i] = *(const f32x4*)(W + (size_t)(k0 + 4 * i + (lane >> 4)) * N + n0 + 4 * (lane & 15));
#pragma unroll
    for (int i = 0; i < 16; ++i) { LAS float* d = scr + (4 * i + (lane >> 4)) * 65 + 4 * (lane & 15); d[0] = v[i].x; d[1] = v[i].y; d[2] = v[i].z; d[3] = v[i].w; }
    asm volatile("s_waitcnt lgkmcnt(0)" ::: "memory");
    const int c = lane & 7;
#pragma unroll
    for (int j = 0; j < 8; ++j) { const int n = (lane >> 3) + 8 * j; const LAS float* s = scr + (8 * c) * 65 + n; const float sc = nscale ? nscale[n0 + n] : 1.f;
        u32x4 o; o.x = pk2(s[0 * 65] * sc, s[1 * 65] * sc); o.y = pk2(s[2 * 65] * sc, s[3 * 65] * sc); o.z = pk2(s[4 * 65] * sc, s[5 * 65] * sc); o.w = pk2(s[6 * 65] * sc, s[7 * 65] * sc);
        *(u32x4*)(WT + (size_t)(n0 + n) * K + k0 + 8 * c) = o; }
    asm volatile("s_waitcnt lgkmcnt(0)" ::: "memory");
}
__device__ __forceinline__ const float* xin_row(ArgsRef A, int row) {
    return row < ROW_S ? A.in[0] + (size_t)row * D : row < ROW_M ? A.in[1] + (size_t)(row - ROW_S) * D : A.in[5] + (size_t)(row - ROW_M) * D;
}
__device__ __forceinline__ float* xres_row(const Frame& F, int row) {
    return row < ROW_S ? F.out + OFF_YP + (size_t)row * D : row < ROW_M ? F.out + OFF_YS + (size_t)(row - ROW_S) * D : (float*)(F.ws + WS_XM) + (size_t)(row - ROW_M) * D;
}
__device__ __forceinline__ void prologue(ArgsRef A, Frame& F) {
    { const int t_ = mk_tid(F.wave); F.tid = t_; F.lane = t_ & 63; }
    LAS float* scr = (LAS float*)(F.lds + F.wave * 16640);
    const int gw = F.vcu * 8 + F.wave, NGW = F.G * 8;
    constexpr int I_QKV = 16 * 48, I_O = 16 * 16, I_UP = 16 * 64, I_DN = 64 * 16, I_PL = 4 * 4;
    constexpr int NITEMS = 2 * I_QKV + 2 * I_O + 4 * I_UP + 4 * I_DN + 8 * I_PL;
    for (int it = gw; it < NITEMS; it += NGW) {
        int r = it;
        if (r < 2 * I_QKV) { const int a = r / I_QKV; transpose_item(A.in[11] + (size_t)a * D * 3072, D, 3072, (bf16*)(F.ws + WS_WQKV) + (size_t)a * 3072 * D, scr, r % I_QKV, F.lane, nullptr); continue; } r -= 2 * I_QKV;
        if (r < 2 * I_O) { const int a = r / I_O; transpose_item(A.in[17] + (size_t)a * D * D, D, D, (bf16*)(F.ws + WS_WO) + (size_t)a * D * D, scr, r % I_O, F.lane, nullptr); continue; } r -= 2 * I_O;
        if (r < 4 * I_UP) { const int i = r / I_UP; transpose_item(A.in[20] + (size_t)i * D * FF, D, FF, (bf16*)(F.ws + WS_WUP) + (size_t)i * D * FF, scr, r % I_UP, F.lane, nullptr); continue; } r -= 4 * I_UP;
        if (r < 4 * I_DN) { const int i = r / I_DN; transpose_item(A.in[21] + (size_t)i * D * FF, FF, D, (bf16*)(F.ws + WS_WDN) + (size_t)i * D * FF, scr, r % I_DN, F.lane, nullptr); continue; } r -= 4 * I_DN;
        { const int pg = r / I_PL; transpose_item(A.in[18] + (size_t)pg * 65536, 256, 256, (bf16*)(F.ws + WS_WPOOL) + (size_t)pg * 65536, scr, r % I_PL, F.lane, A.in[19] + pg * 256); }
    }
    for (int it0 = gw; it0 < 32768; it0 += 4 * NGW) {
        f32x4 v[4][4];
#pragma unroll
        for (int r4 = 0; r4 < 4; ++r4) { const int it = min(it0 + r4 * NGW, 32767); const int j = it & 1023, b = (it >> 10) & 7, kv = (it >> 13) & 1, a = it >> 14;
            const float* src = (kv ? A.in[3] : A.in[2]) + ((size_t)(a * 8 + b) * 1024 + j) * D;
#pragma unroll
            for (int q = 0; q < 4; ++q) v[r4][q] = *(const f32x4*)(src + 4 * F.lane + 256 * q); }
#pragma unroll
        for (int r4 = 0; r4 < 4; ++r4) { const int it = it0 + r4 * NGW; if (it < 32768) { const int j = it & 1023, b = (it >> 10) & 7, kv = (it >> 13) & 1, a = it >> 14;
            bf16* dst = (bf16*)(F.ws + (kv ? WS_VXS : WS_KXS)) + (size_t)a * KXS_LAYER + (size_t)(b * EXT_S + 16 + j) * D;
#pragma unroll
            for (int q = 0; q < 4; ++q) { u32x2 w; w.x = pk2(v[r4][q].x, v[r4][q].y); w.y = pk2(v[r4][q].z, v[r4][q].w); *(u32x2*)(dst + 4 * F.lane + 256 * q) = w; } } }
    }
    const float* g = A.in[7];
    for (int row = ROWS_VALID + gw; row < MPAD; row += NGW) { bf16* xn = (bf16*)(F.ws + WS_XN) + (size_t)row * D;
#pragma unroll
        for (int q = 0; q < 4; ++q) *(u32x2*)(xn + 4 * F.lane + 256 * q) = (u32x2){0u, 0u}; }
    const int RPC = (ROWS_VALID + F.G - 1) / F.G, rbeg = F.vcu * RPC, rend = min(rbeg + RPC, ROWS_VALID);
    for (int row0 = rbeg + F.wave; row0 < rend; row0 += 32) {
        f32x4 v[4][4]; float ss[4];
#pragma unroll
        for (int j = 0; j < 4; ++j) { const float* x = xin_row(A, min(row0 + j * 8, ROWS_VALID - 1)); ss[j] = 0.f;
#pragma unroll
            for (int q = 0; q < 4; ++q) v[j][q] = *(const f32x4*)(x + 4 * F.lane + 256 * q); }
#pragma unroll
        for (int j = 0; j < 4; ++j) {
#pragma unroll
            for (int q = 0; q < 4; ++q) ss[j] += v[j][q].x * v[j][q].x + v[j][q].y * v[j][q].y + v[j][q].z * v[j][q].z + v[j][q].w * v[j][q].w; }
#pragma unroll
        for (int o = 1; o < 64; o <<= 1) {
#pragma unroll
            for (int j = 0; j < 4; ++j) ss[j] += __shfl_xor(ss[j], o); }
#pragma unroll
        for (int j = 0; j < 4; ++j) { const int row = row0 + j * 8; const float r = 1.0f / sqrtf(ss[j] * (1.f / D) + EPS); bf16* xn = (bf16*)(F.ws + WS_XN) + (size_t)row * D;
#pragma unroll
            for (int q = 0; q < 4; ++q) { const f32x4 gg = *(const f32x4*)(g + 4 * F.lane + 256 * q); u32x2 w; w.x = pk2(v[j][q].x * r * gg.x, v[j][q].y * r * gg.y); w.y = pk2(v[j][q].z * r * gg.z, v[j][q].w * r * gg.w);
                if (row < rend) *(u32x2*)(xn + 4 * F.lane + 256 * q) = w; } }
    }
}
__device__ __forceinline__ void fin_phase(ArgsRef A, Frame& F, bool from_inputs, const int nks  , const float* gpost, const float* gnext) {
    { const int t_ = mk_tid(F.wave); F.tid = t_; F.lane = t_ & 63; }
    constexpr int FR = 4;
    const int gw = F.vcu * 8 + F.wave, NGW = F.G * 8;
    const bf16* YB = (const bf16*)(F.ws + WS_YB);
    const int lo4 = 4 * F.lane, lo8 = 8 * F.lane;
    const int RPC = (ROW_S + F.G - 1) / F.G, rbeg = F.vcu * RPC, rend = min(rbeg + RPC, ROW_S);
    f32x4 gp[4], gn[4];
#pragma unroll
    for (int q = 0; q < 4; ++q) { const int cq = lo8 + 4 * (q & 1) + 512 * (q >> 1); gp[q] = *(const f32x4*)(gpost + cq); gn[q] = gnext ? *(const f32x4*)(gnext + cq) : (f32x4){0.f, 0.f, 0.f, 0.f}; }
    for (int row0 = rbeg + F.wave; row0 < rend; row0 += 8 * FR) {
        f32x4 yv[FR][4], xv[FR][4]; float ss[FR];
#pragma unroll
        for (int j = 0; j < FR; ++j) { const int row = min(row0 + j * 8, ROWS_VALID - 1); const bf16* y = YB + (size_t)row * D; const float* xi = from_inputs ? xin_row(A, row) : xres_row(F, row); ss[j] = 0.f;
#pragma unroll
            for (int h = 0; h < 2; ++h) { const u32x4 w = *(const u32x4*)(y + lo8 + 512 * h);
                yv[j][2 * h] = (f32x4){bflo(w.x), bfhi(w.x), bflo(w.y), bfhi(w.y)}; yv[j][2 * h + 1] = (f32x4){bflo(w.z), bfhi(w.z), bflo(w.w), bfhi(w.w)}; }
#pragma unroll
            for (int q = 0; q < 4; ++q) xv[j][q] = *(const f32x4*)(xi + lo8 + 4 * (q & 1) + 512 * (q >> 1)); }
#pragma unroll
        for (int j = 0; j < FR; ++j) {
#pragma unroll
            for (int q = 0; q < 4; ++q) ss[j] += yv[j][q].x * yv[j][q].x + yv[j][q].y * yv[j][q].y + yv[j][q].z * yv[j][q].z + yv[j][q].w * yv[j][q].w; }
#pragma unroll
        for (int o = 1; o < 64; o <<= 1) {
#pragma unroll
            for (int j = 0; j < FR; ++j) ss[j] += __shfl_xor(ss[j], o); }
        float s2[FR];
#pragma unroll
        for (int j = 0; j < FR; ++j) { const int row = row0 + j * 8; const float r = 1.0f / sqrtf(ss[j] * (1.f / D) + EPS); s2[j] = 0.f;
#pragma unroll
            for (int q = 0; q < 4; ++q) { const int cq = lo8 + 4 * (q & 1) + 512 * (q >> 1); const f32x4 gg = gp[q]; xv[j][q] = xv[j][q] + yv[j][q] * r * gg;
                if (row < rend) *(f32x4*)(xres_row(F, row) + cq) = xv[j][q];
                s2[j] += xv[j][q].x * xv[j][q].x + xv[j][q].y * xv[j][q].y + xv[j][q].z * xv[j][q].z + xv[j][q].w * xv[j][q].w; } }
        if (gnext) {
#pragma unroll
            for (int o = 1; o < 64; o <<= 1) {
#pragma unroll
                for (int j = 0; j < FR; ++j) s2[j] += __shfl_xor(s2[j], o); }
#pragma unroll
            for (int j = 0; j < FR; ++j) { const int row = row0 + j * 8; const float r2 = 1.0f / sqrtf(s2[j] * (1.f / D) + EPS); bf16* xn = (bf16*)(F.ws + WS_XN) + (size_t)row * D;
#pragma unroll
                for (int h = 0; h < 2; ++h) { const f32x4 g0 = gn[2 * h], g1 = gn[2 * h + 1]; const f32x4 a0 = xv[j][2 * h], a1 = xv[j][2 * h + 1];
                    u32x4 w; w.x = pk2(a0.x * r2 * g0.x, a0.y * r2 * g0.y); w.y = pk2(a0.z * r2 * g0.z, a0.w * r2 * g0.w); w.z = pk2(a1.x * r2 * g1.x, a1.y * r2 * g1.y); w.w = pk2(a1.z * r2 * g1.z, a1.w * r2 * g1.w);
                    if (row < rend) *(u32x4*)(xn + lo8 + 512 * h) = w; } }
        }
    }
    for (int row = ROW_S + gw; row < ROWS_VALID; row += NGW) {
        const float* xi = from_inputs ? xin_row(A, row) : xres_row(F, row); float* xo = xres_row(F, row);
        f32x4 yv[4], xv[4]; float ss = 0.f;
#pragma unroll
        for (int q = 0; q < 4; ++q) {
            if (nks == 0) { const u32x2 w = *(const u32x2*)(YB + (size_t)row * D + lo4 + 256 * q); yv[q] = (f32x4){bflo(w.x), bfhi(w.x), bflo(w.y), bfhi(w.y)}; }
            else { const float* yf = (const float*)(F.ws + WS_YF) + (size_t)(row - ROW_S) * D + lo4 + 256 * q; yv[q] = *(const f32x4*)yf; for (int k = 1; k < nks; ++k) yv[q] += *(const f32x4*)(yf + (size_t)k * 768 * D); }
            xv[q] = *(const f32x4*)(xi + lo4 + 256 * q); ss += yv[q].x * yv[q].x + yv[q].y * yv[q].y + yv[q].z * yv[q].z + yv[q].w * yv[q].w; }
        const float r = 1.0f / sqrtf(wave_sum(ss) * (1.f / D) + EPS); float s2 = 0.f;
#pragma unroll
        for (int q = 0; q < 4; ++q) { const f32x4 gg = *(const f32x4*)(gpost + lo4 + 256 * q); xv[q] = xv[q] + yv[q] * r * gg; *(f32x4*)(xo + lo4 + 256 * q) = xv[q];
            s2 += xv[q].x * xv[q].x + xv[q].y * xv[q].y + xv[q].z * xv[q].z + xv[q].w * xv[q].w; }
        if (gnext) { const float r2 = 1.0f / sqrtf(wave_sum(s2) * (1.f / D) + EPS); bf16* xn = (bf16*)(F.ws + WS_XN) + (size_t)row * D;
#pragma unroll
            for (int q = 0; q < 4; ++q) { const f32x4 gg = *(const f32x4*)(gnext + lo4 + 256 * q); u32x2 w; w.x = pk2(xv[q].x * r2 * gg.x, xv[q].y * r2 * gg.y); w.y = pk2(xv[q].z * r2 * gg.z, xv[q].w * r2 * gg.w);
                *(u32x2*)(xn + lo4 + 256 * q) = w; } }
    }
}
__device__ __forceinline__ u32x4 pool_h8(ArgsRef A, const Frame& F, int grp, int b, int t, int col, int p) {
    const bf16* XN = (const bf16*)(F.ws + WS_XN);
    if (t >= 0) { const int row = grp == 0 ? b * 8192 + t : grp == 1 ? ROW_S + b * 64 + t : ROW_M + t; return *(const u32x4*)(XN + (size_t)row * D + col); }
    if (grp == 0) return *(const u32x4*)(XN + (size_t)(ROW_M + 16 + t) * D + col);
    if (grp == 1) { const float* s = A.in[4] + ((size_t)(p * 8 + b) * 15 + 15 + t) * D + col; const f32x4 a0 = *(const f32x4*)s, a1 = *(const f32x4*)(s + 4);
        u32x4 w; w.x = pk2(a0.x, a0.y); w.y = pk2(a0.z, a0.w); w.z = pk2(a1.x, a1.y); w.w = pk2(a1.z, a1.w); return w; }
    return (u32x4){0u, 0u, 0u, 0u};
}
__device__ __forceinline__ void pool_phase(ArgsRef A, Frame& F, int p) {
    { const int t_ = mk_tid(F.wave); F.tid = t_; F.lane = t_ & 63; }
    bf16* DB = (bf16*)(F.ws + WS_QB);
    const int col = 8 * (F.tid & 127), rgq = F.tid >> 7, w = 2 << (col >> 8);
    for (int it = F.vcu; it < 1033; it += F.G) {
        int grp, b, t0, nr;
        if (it < 1024) { grp = 0; b = it >> 7; t0 = (it & 127) * 64; nr = 64; } else if (it < 1032) { grp = 1; b = it - 1024; t0 = 0; nr = 64; } else { grp = 2; b = 0; t0 = 0; nr = 16; }
        const int tb = t0 + 16 * rgq;
        if (16 * rgq >= nr) continue;
        u32x4 h[31];
#pragma unroll
        for (int i = 0; i < 31; ++i) h[i] = pool_h8(A, F, grp, b, tb - 15 + i, col, p);
        float sum[8];
#pragma unroll
        for (int e = 0; e < 8; ++e) sum[e] = 0.f;
#pragma unroll
        for (int j = 1; j < 16; ++j) { const float k = (j < w) ? 1.f : 0.f; const u32x4 v = h[15 - j];
            sum[0] += k * bflo(v.x); sum[1] += k * bfhi(v.x); sum[2] += k * bflo(v.y); sum[3] += k * bfhi(v.y); sum[4] += k * bflo(v.z); sum[5] += k * bfhi(v.z); sum[6] += k * bflo(v.w); sum[7] += k * bfhi(v.w); }
#pragma unroll
        for (int i = 0; i < 16; ++i) { const int t = tb + i;
            const u32x4 cv = h[15 + i]; const float cur[8] = {bflo(cv.x), bfhi(cv.x), bflo(cv.y), bfhi(cv.y), bflo(cv.z), bfhi(cv.z), bflo(cv.w), bfhi(cv.w)};
            const float inv = 1.0f / (float)(grp == 2 ? min(t + 1, w) : w);
            float d[8];
#pragma unroll
            for (int e = 0; e < 8; ++e) { sum[e] += cur[e]; d[e] = sum[e] * inv - cur[e]; }
            const int row = grp == 0 ? b * 8192 + t : grp == 1 ? ROW_S + b * 64 + t : ROW_M + t;
            u32x4 o; o.x = pk2(d[0], d[1]); o.y = pk2(d[2], d[3]); o.z = pk2(d[4], d[5]); o.w = pk2(d[6], d[7]);
            *(u32x4*)(DB + (size_t)row * D + col) = o;
            const u32x4 a1 = h[15 + i - 1], a3 = h[15 + i - 3], a7 = h[15 + i - 7], a15 = h[15 + i - 15];
            u32x4 ov; ov.x = (w == 2) ? a1.x : (w == 4) ? a3.x : (w == 8) ? a7.x : a15.x; ov.y = (w == 2) ? a1.y : (w == 4) ? a3.y : (w == 8) ? a7.y : a15.y;
            ov.z = (w == 2) ? a1.z : (w == 4) ? a3.z : (w == 8) ? a7.z : a15.z; ov.w = (w == 2) ? a1.w : (w == 4) ? a3.w : (w == 8) ? a7.w : a15.w;
            sum[0] -= bflo(ov.x); sum[1] -= bfhi(ov.x); sum[2] -= bflo(ov.y); sum[3] -= bfhi(ov.y); sum[4] -= bflo(ov.z); sum[5] -= bfhi(ov.z); sum[6] -= bflo(ov.w); sum[7] -= bfhi(ov.w);
            float* tp = nullptr;
            if (grp == 0 && t >= 8177) tp = F.out + OFF_PP + ((size_t)(p * 8 + b) * 15 + (t - 8177)) * D + col;
            if (grp == 1 && t >= 49) tp = F.out + OFF_PS + ((size_t)(p * 8 + b) * 15 + (t - 49)) * D + col;
            if (tp) { *(f32x4*)tp = (f32x4){cur[0], cur[1], cur[2], cur[3]}; *(f32x4*)(tp + 4) = (f32x4){cur[4], cur[5], cur[6], cur[7]}; }
        }
    }
}

namespace att {
constexpr int KSTR = 272;
constexpr int TB = 16384;
constexpr int OFF_K0 = 0, OFF_K1 = TB, OFF_V0 = 2 * TB, OFF_V1 = 3 * TB, OFF_BT = 4 * TB, OFF_GT = OFF_BT + 2048, OFF_Q = 5 * TB, XB = 16384;
static_assert(OFF_BT >= 4 * XB && OFF_GT + 512 <= OFF_Q && OFF_Q + 2 * TB <= 131072, "attention LDS map");
constexpr float THR = 48.0f;
constexpr float NEG = -1e30f;
struct AUnit { const bf16* K; const bf16* V; const bf16* KM; const bf16* VM; const bf16* Q; bf16* O; int P, L, x, h; };
__device__ __forceinline__ float max3f(float a, float b, float c) { float r; asm("v_max3_f32 %0, %1, %2, %3" : "=v"(r) : "v"(a), "v"(b), "v"(c)); return r; }
__device__ __forceinline__ float swapmax(float v) { auto rr = __builtin_amdgcn_permlane32_swap(__float_as_uint(v), __float_as_uint(v), false, false); return fmaxf(__uint_as_float(rr[0]), __uint_as_float(rr[1])); }
__device__ __forceinline__ float swapsum(float v) { auto rr = __builtin_amdgcn_permlane32_swap(__float_as_uint(v), __float_as_uint(v), false, false); return __uint_as_float(rr[0]) + __uint_as_float(rr[1]); }
typedef __bf16 bf16x2_t __attribute__((ext_vector_type(2)));
__device__ __forceinline__ unsigned cvtpk(float lo, float hi) { f32x2 v = {lo, hi}; bf16x2_t b = __builtin_convertvector(v, bf16x2_t); return __builtin_bit_cast(unsigned, b); }
__device__ __forceinline__ s16x4 vtr(const LAS unsigned char* p) { return __builtin_bit_cast(s16x4, __builtin_amdgcn_ds_read_tr16_b64_v4i16((LAS s16x4*)p)); }
__device__ __forceinline__ void glds16(const void* gsrc, unsigned lds_dst) { unsigned keep;
    asm volatile("s_mov_b32 %0, m0\n\ts_mov_b32 m0, %2\n\ts_nop 0\n\tglobal_load_lds_dwordx4 %1, off\n\ts_mov_b32 m0, %0" : "=&s"(keep) : "v"(gsrc), "s"(lds_dst) : "memory"); }
__device__ __forceinline__ bf16x8 pack8(const f32x16& S, int o) {
    u32x4 w; w.x = cvtpk(S[o], S[o + 1]); w.y = cvtpk(S[o + 2], S[o + 3]); w.z = cvtpk(S[o + 4], S[o + 5]); w.w = cvtpk(S[o + 6], S[o + 7]); return __builtin_bit_cast(bf16x8, w);
}

__device__ __forceinline__ void attn_unit(const int wv, LAS unsigned char* lds, const AUnit& u, const float* lq1, const float* lk1, const float* lq2, const float* lk2, const int layer_a, const float* relb, const float* subg) {
    const int tid = mk_tid(wv), lane = tid & 63, wid = wv, mp = wid >> 2, rg = wid & 3, q32 = lane & 31, hi = lane >> 5;
    LAS float* BT = (LAS float*)(lds + OFF_BT); LAS float* GT = (LAS float*)(lds + OFF_GT);
    {
        const float b15 = relb[15 * 8 + u.h];
        if (tid < 448) { const int rel = tid - 192, n = rel < 0 ? -rel : rel;
            int bk = n < 8 ? n : n < 12 ? 8 : n < 16 ? 9 : n < 23 ? 10 : n < 32 ? 11 : n < 46 ? 12 : n < 64 ? 13 : n < 91 ? 14 : 15; if (rel > 0) bk += 16;
            BT[tid] = (relb[bk * 8 + u.h] - b15) * LOG2E; }
        if (tid >= 384) GT[tid - 384] = subg[tid - 384] * (layer_a == 0 ? 0.8f : 0.52928698f);
    }
    const int vrows = min(128, u.L - 128 * u.x);
    const bool active = rg * 32 < vrows;
    const int ch = rg >> 1;
    const int NTw = active ? (u.P + min((2 * u.x + ch + 1) * 64, u.L) + 48) >> 6 : 0;
    const int NT = (u.P + min((2 * u.x + 2) * 64, u.L) + 48) >> 6;
    const int eq0 = u.P + 128 * u.x + rg * 32, eq = eq0 + q32;
    const unsigned lds0 = (unsigned)(size_t)lds;
    unsigned goff[2];
#pragma unroll
    for (int j = 0; j < 2; ++j) { const int row = wid * 8 + 4 * j + (lane >> 4), x = ((row & 3) << 2) | ((row >> 2) & 3), c = (lane & 15) ^ x; goff[j] = (unsigned)(row * 1024 + u.h * 128 + c * 8); }
    const unsigned ldst = (unsigned)wid * 2048u;
#define ATT_DMA(base, bufoff) do { _Pragma("unroll") for (int j_ = 0; j_ < 2; ++j_) \
        glds16((base) + goff[j_], (unsigned)__builtin_amdgcn_readfirstlane((int)(lds0 + (unsigned)(bufoff) + ldst + j_ * 1024))); } while (0)
#define ATT_ISSUE_K(t, bufoff) do { const bf16* b_ = ((t) == 0 && wid < 2) ? u.KM : u.K + (size_t)(t) * 65536; ATT_DMA(b_, bufoff); } while (0)
#define ATT_ISSUE_V(t, bufoff) do { const bf16* b_ = ((t) == 0 && wid < 2) ? u.VM : u.V + (size_t)(t) * 65536; ATT_DMA(b_, bufoff); } while (0)
#define ATT_WAITBAR() do { asm volatile("s_waitcnt vmcnt(0) lgkmcnt(0)" ::: "memory"); __builtin_amdgcn_s_barrier(); asm volatile("" ::: "memory"); } while (0)
    unsigned koff[4];
    { const int x = ((q32 & 3) << 2) | ((q32 >> 2) & 3);
#pragma unroll
      for (int d0 = 0; d0 < 4; ++d0) koff[d0] = lds0 + (unsigned)(q32 * 256 + (((mp * 8 + 2 * d0 + hi) ^ x) << 4)); }
    unsigned vofs[4][2];
    { const int qq = (lane & 15) >> 2, cl = 2 * ((lane >> 4) & 1) + ((lane & 3) >> 1), sub = 8 * (lane & 1);
#pragma unroll
      for (int dvb = 0; dvb < 4; ++dvb)
#pragma unroll
          for (int hf = 0; hf < 2; ++hf) vofs[dvb][hf] = lds0 + (unsigned)((8 * hf + 4 * hi + qq) * 256 + ((((dvb ^ qq) << 2) | (cl ^ (2 * hf + hi))) << 4) + sub); }
    {
        const bf16* qb_ = u.Q + (size_t)(128 * u.x + wid * 16) * 1024;
#pragma unroll
        for (int j = 0; j < 4; ++j) { const int row = 4 * j + (lane >> 4), x = ((row & 3) << 2) | ((row >> 2) & 3), c = (lane & 15) ^ x;
            glds16(qb_ + row * 1024 + u.h * 128 + c * 8, (unsigned)__builtin_amdgcn_readfirstlane((int)(lds0 + OFF_Q + wid * 4096 + j * 1024))); }
    }
    ATT_ISSUE_K(0, OFF_K0); ATT_ISSUE_V(0, OFF_V0); if (NT > 1) ATT_ISSUE_K(1, OFF_K1);
    ATT_WAITBAR();
    f32x16 O[4];
#pragma unroll
    for (int i = 0; i < 4; ++i)
#pragma unroll
        for (int r = 0; r < 16; ++r) O[i][r] = 0.f;
    float m = 0.f, l = 0.f;
    f32x16 SA0, SA1, SB0, SB1;
    const f32x16 zero16 = {0.f, 0.f, 0.f, 0.f, 0.f, 0.f, 0.f, 0.f, 0.f, 0.f, 0.f, 0.f, 0.f, 0.f, 0.f, 0.f};
#define ATT_SB() __builtin_amdgcn_sched_barrier(0)
#define ATT_QK(S0_, S1_, kbufoff) do { unsigned qsh_ = (unsigned)(OFF_Q + rg * 8192); asm volatile("" : "+s"(qsh_));     \
        bf16x8 kfa[4], kfb[4], qfr[4]; \
        _Pragma("unroll") for (int d0 = 0; d0 < 4; ++d0) { kfa[d0] = *(const LAS bf16x8*)(size_t)(koff[d0] + (unsigned)(kbufoff)); kfb[d0] = *(const LAS bf16x8*)(size_t)(koff[d0] + (unsigned)(kbufoff) + 8192u); qfr[d0] = *(const LAS bf16x8*)(size_t)(koff[d0] + qsh_); } \
        ATT_SB(); \
        S0_ = __builtin_amdgcn_mfma_f32_32x32x16_bf16(kfa[0], qfr[0], zero16, 0, 0, 0); S1_ = __builtin_amdgcn_mfma_f32_32x32x16_bf16(kfb[0], qfr[0], zero16, 0, 0, 0); \
        _Pragma("unroll") for (int d0 = 1; d0 < 4; ++d0) { S0_ = __builtin_amdgcn_mfma_f32_32x32x16_bf16(kfa[d0], qfr[d0], S0_, 0, 0, 0); S1_ = __builtin_amdgcn_mfma_f32_32x32x16_bf16(kfb[d0], qfr[d0], S1_, 0, 0, 0); } } while (0)
#define ATT_VLD(bank, ks) do { _Pragma("unroll") for (int dvb = 0; dvb < 4; ++dvb) { bank[dvb][0] = vtr((const LAS unsigned char*)(size_t)(vofs[dvb][0] + vb_ + (unsigned)((ks) * 4096))); bank[dvb][1] = vtr((const LAS unsigned char*)(size_t)(vofs[dvb][1] + vb_ + (unsigned)((ks) * 4096))); } } while (0)
#define ATT_PV(bank, ks, C0, C1) do { const bf16x8 pb = pack8(((ks) < 2) ? C0 : C1, 8 * ((ks) & 1)); \
        _Pragma("unroll") for (int dvb = 0; dvb < 4; ++dvb) { const bf16x8 vf = (bf16x8){bank[dvb][0][0], bank[dvb][0][1], bank[dvb][0][2], bank[dvb][0][3], bank[dvb][1][0], bank[dvb][1][1], bank[dvb][1][2], bank[dvb][1][3]}; \
            O[dvb] = __builtin_amdgcn_mfma_f32_32x32x16_bf16(vf, pb, O[dvb], 0, 0, 0); } } while (0)
#define ATT_STEP(C0, C1, N0, N1, t_, PAR) do { const int t = (t_); constexpr int cur = (PAR); \
        if (t + 2 < NT) ATT_ISSUE_K(t + 2, cur ? OFF_K1 : OFF_K0); \
        if (t + 1 < NT) ATT_ISSUE_V(t + 1, cur ? OFF_V0 : OFF_V1); \
        { \
            const int k0 = t * 64; \
            if (k0 + 154 > eq0) { const LAS float* bt_ = BT + (k0 - eq + 192 + 4 * hi); \
                _Pragma("unroll") for (int r = 0; r < 16; ++r) { C0[r] += bt_[(r & 3) + 8 * (r >> 2)]; } \
                ATT_SB(); \
                _Pragma("unroll") for (int r = 0; r < 16; ++r) { C1[r] += bt_[32 + (r & 3) + 8 * (r >> 2)]; } } \
            if (t >= NTw - 1) { const bool all_ = t >= NTw; _Pragma("unroll") for (int r = 0; r < 16; ++r) { if (r >= 8 || all_) C0[r] = NEG; C1[r] = NEG; } } \
            if (__any(m != 0.f)) { _Pragma("unroll") for (int r = 0; r < 16; ++r) { C0[r] -= m; C1[r] -= m; } } \
            float mx = max3f(C0[0], C1[0], C0[1]), mx2 = max3f(C1[1], C0[2], C1[2]); \
            _Pragma("unroll") for (int r = 3; r < 15; r += 2) { mx = max3f(mx, C0[r], C1[r]); mx2 = max3f(mx2, C0[r + 1], C1[r + 1]); } \
            mx = max3f(mx, mx2, C0[15]); mx = fmaxf(mx, C1[15]); \
            mx = swapmax(mx); \
            if (__any(mx > THR || (t == 0 && mx < -THR))) { const float dl = (t == 0) ? mx : fmaxf(mx, 0.f); m += dl; const float f = (t == 0) ? 1.f : __builtin_amdgcn_exp2f(-dl); l *= f; \
                _Pragma("unroll") for (int r = 0; r < 16; ++r) { C0[r] -= dl; C1[r] -= dl; } \
                _Pragma("unroll") for (int i = 0; i < 4; ++i) _Pragma("unroll") for (int r = 0; r < 16; ++r) O[i][r] *= f; } \
        } \
        ATT_SB(); \
        if (t + 1 < NT) ATT_QK(N0, N1, cur ? OFF_K0 : OFF_K1); \
        ATT_SB(); \
        { \
            constexpr unsigned vb_ = (unsigned)(cur ? OFF_V1 : OFF_V0); \
            s16x4 vA[4][2], vB[4][2]; \
            ATT_VLD(vA, 0); \
            ATT_SB(); \
            float ls = 0.f; \
            _Pragma("unroll") for (int r = 0; r < 16; ++r) { C0[r] = __builtin_amdgcn_exp2f(C0[r]); C1[r] = __builtin_amdgcn_exp2f(C1[r]); ls += C0[r]; ls += C1[r]; } \
            l += ls; \
            ATT_SB(); \
            ATT_VLD(vB, 1); ATT_SB(); ATT_PV(vA, 0, C0, C1); ATT_SB(); \
            ATT_VLD(vA, 2); ATT_SB(); ATT_PV(vB, 1, C0, C1); ATT_SB(); \
            ATT_VLD(vB, 3); ATT_SB(); ATT_PV(vA, 2, C0, C1); ATT_SB(); \
            ATT_PV(vB, 3, C0, C1); \
        } \
        ATT_WAITBAR(); } while (0)
    ATT_QK(SA0, SA1, OFF_K0);
    ATT_WAITBAR();
    for (int tt = 0; tt < NT; tt += 2) { ATT_STEP(SA0, SA1, SB0, SB1, tt, 0); if (tt + 1 < NT) ATT_STEP(SB0, SB1, SA0, SA1, tt + 1, 1); }
#undef ATT_STEP
#undef ATT_QK
#undef ATT_VLD
#undef ATT_PV
#undef ATT_SB
#undef ATT_WAITBAR
#undef ATT_ISSUE_K
#undef ATT_ISSUE_V
#undef ATT_DMA
    const int tid2_ = mk_tid(wv);
    const int lane2 = tid2_ & 63, q32b = lane2 & 31, hib = lane2 >> 5;
    float lam;
    { float s1 = lq1[lane2] * lk1[lane2], s2 = lq2[lane2] * lk2[lane2]; s1 = wave_sum(s1); s2 = wave_sum(s2); lam = expf(s1) - expf(s2) + (layer_a == 0 ? 0.2f : 0.47071302f); }
    l = swapsum(l); const float inv = active ? 1.0f / l : 0.f;
    LAS float* xb = (LAS float*)(lds + rg * XB);
    if (mp == 1) { const float f = inv * lam;
#pragma unroll
        for (int i = 0; i < 4; ++i)
#pragma unroll
            for (int r = 0; r < 16; ++r) xb[(i * 16 + r) * 64 + lane2] = O[i][r] * f; }
    __syncthreads();
    if (mp == 0 && active) {
        float ss = 0.f;
#pragma unroll
        for (int i = 0; i < 4; ++i)
#pragma unroll
            for (int r = 0; r < 16; ++r) { const float o = O[i][r] * inv - xb[(i * 16 + r) * 64 + lane2]; O[i][r] = o; ss += o * o; }
        ss = swapsum(ss); const float rs = 1.0f / sqrtf(ss * (1.f / 128.f) + SUBLN_EPS);
        asm volatile("s_waitcnt lgkmcnt(0)" ::: "memory");
        LAS unsigned char* stg = (LAS unsigned char*)xb;
#pragma unroll
        for (int i = 0; i < 4; ++i)
#pragma unroll
            for (int r4 = 0; r4 < 4; ++r4) { const int dv0 = 32 * i + 8 * r4 + 4 * hib; const f32x4 gg = *(const LAS f32x4*)(GT + dv0);
                u32x2 w; w.x = cvtpk(O[i][4 * r4] * rs * gg.x, O[i][4 * r4 + 1] * rs * gg.y); w.y = cvtpk(O[i][4 * r4 + 2] * rs * gg.z, O[i][4 * r4 + 3] * rs * gg.w);
                *(LAS u32x2*)(stg + q32b * KSTR + dv0 * 2) = w; }
        asm volatile("s_waitcnt lgkmcnt(0)" ::: "memory");
        bf16* og = u.O + (size_t)(128 * u.x + rg * 32) * 1024 + u.h * 128;
#pragma unroll
        for (int i = 0; i < 8; ++i) { const int row = i * 4 + (lane2 >> 4), c16 = lane2 & 15; const u32x4 v = *(const LAS u32x4*)(stg + row * KSTR + c16 * 16);
            if (rg * 32 + row < vrows) *(u32x4*)(og + (size_t)row * 1024 + c16 * 8) = v; }
    }
    __syncthreads();
}
__device__ __forceinline__ void attn_phase(ArgsRef A, Frame& F, int a) {
    const bf16* QB = (const bf16*)(F.ws + WS_QB); bf16* OB = (bf16*)(F.ws + WS_XN); const bf16* KX = (const bf16*)(F.ws + WS_KX); const bf16* VX = (const bf16*)(F.ws + WS_VX);
    const bf16* KXS = (const bf16*)(F.ws + WS_KXS) + (size_t)a * KXS_LAYER; const bf16* VXS = (const bf16*)(F.ws + WS_VXS) + (size_t)a * KXS_LAYER;
    { const int gt = blockIdx.x * 512 + mk_tid(F.wave);
      for (int i = gt; i < 65536; i += F.G * 512) { const int c4 = i & 255, r = (i >> 8) & 15, b = (i >> 12) & 7, kv = i >> 15;
          const f32x4 v = *(const f32x4*)((const float*)(F.ws + (kv ? WS_MFV : WS_MFK)) + r * 1024 + c4 * 4);
          *(f32x4*)(F.out + (kv ? OFF_VP : OFF_KP) + (size_t)a * 8 * EXT_P * 1024 + (size_t)(b * EXT_P + r) * 1024 + c4 * 4) = v; } }
    for (int n = F.vcu; n < 4168; n += F.G) {
        AUnit u; u.KM = (const bf16*)(F.ws + WS_KXM); u.VM = (const bf16*)(F.ws + WS_VXM);
        if (n < 4096) { const int i = n >> 8, v = n & 255, c = v & 31, bh = (v >> 5) * 8 + (i >> 1); const int x = (i & 1) ? 63 - c : c; const int b = bh >> 3;
            u.K = KX + (size_t)b * EXT_P * 1024; u.V = VX + (size_t)b * EXT_P * 1024; u.Q = QB + (size_t)b * 8192 * 1024; u.O = OB + (size_t)b * 8192 * 1024; u.P = 16; u.L = 8192; u.x = x; u.h = bh & 7; }
        else if (n < 4160) { const int j = n - 4096, b = j >> 3; u.K = KXS + (size_t)b * EXT_S * 1024; u.V = VXS + (size_t)b * EXT_S * 1024; u.Q = QB + (size_t)(ROW_S + b * 64) * 1024; u.O = OB + (size_t)(ROW_S + b * 64) * 1024; u.P = 1040; u.L = 64; u.x = 0; u.h = j & 7; }
        else { u.K = (const bf16*)(F.ws + WS_KXM); u.V = (const bf16*)(F.ws + WS_VXM); u.Q = QB + (size_t)ROW_M * 1024; u.O = OB + (size_t)ROW_M * 1024; u.P = 0; u.L = 16; u.x = 0; u.h = n - 4160; }
        attn_unit(F.wave, F.lds, u, A.in[12] + a * 64, A.in[13] + a * 64, A.in[14] + a * 64, A.in[15] + a * 64, a, A.in[6], A.in[16] + a * 128);
    }
}
}

#define XB_TMO      128
#define XB_XCNT(j)  (256  + 64 * (j))
#define XB_XSUB(j)  (1280 + 64 * (j))
#define XB_XGEN(j)  (2304 + 64 * (j))
#define XB_TOP      3328
#define XB_TOPGEN   3392
#define XCD_BAR_WORDS 3456
#define XB_SPIN_CAP (1u << 18)

__device__ __forceinline__ unsigned xb_ld(unsigned* p)              { return __hip_atomic_load(p, __ATOMIC_RELAXED, __HIP_MEMORY_SCOPE_AGENT); }
__device__ __forceinline__ unsigned xb_add(unsigned* p, unsigned v) { return __hip_atomic_fetch_add(p, v, __ATOMIC_RELAXED, __HIP_MEMORY_SCOPE_AGENT); }
__device__ __forceinline__ unsigned xb_xcc_id() { return (unsigned)__builtin_amdgcn_s_getreg((3 << 11) | 20) & 0xFu; }
#define XB_SPIN(cond, bar) do { unsigned _sp = 0; while (cond) { __builtin_amdgcn_s_sleep(1); \
    if ((++_sp & 255u) == 0u) { if (xb_ld(&(bar)[XB_TMO])) break; if (_sp > XB_SPIN_CAP) { atomicAdd(&(bar)[XB_TMO], 1u); break; } } } } while (0)

struct XcdBarrier {
    bool leader; unsigned* bar; unsigned x;
    volatile LAS unsigned* st;
};

__device__ __forceinline__ XcdBarrier xcd_barrier_post(unsigned* bar, volatile LAS unsigned* st) {
    XcdBarrier b; b.bar = bar; b.x = xb_xcc_id(); b.st = st;
    b.leader = (threadIdx.x == 0);
    if (b.leader) (void)xb_add(&bar[XB_XCNT(b.x)], 1u);
    return b;
}
__device__ __forceinline__ void xcd_barrier_complete(unsigned* bar, unsigned x, unsigned& nloc, unsigned& nx) {
    const unsigned G = gridDim.x * gridDim.y * gridDim.z;
    unsigned sum, cnt, mine, sp = 0u;
    for (;;) {
        sum = 0u; cnt = 0u; mine = 0u;
#pragma unroll
        for (unsigned j = 0; j < 16; ++j) { const unsigned c = xb_ld(&bar[XB_XCNT(j)]); sum += c; cnt += (c > 0u) ? 1u : 0u; mine = (j == x) ? c : mine; }
        if (sum == G) break;
        __builtin_amdgcn_s_sleep(1);
        if ((++sp & 255u) == 0u) { if (xb_ld(&bar[XB_TMO])) break; if (sp > XB_SPIN_CAP) { atomicAdd(&bar[XB_TMO], 1u); break; } }
    }
    nloc = mine > 0u ? mine : 1u; nx = cnt > 0u ? cnt : 1u;
}

__device__ __forceinline__ void xcd_barrier(const XcdBarrier& b) {
    asm volatile("s_waitcnt vmcnt(0)" ::: "memory");
    __syncthreads();
    if (b.leader) {
        unsigned* bar = b.bar;
        __builtin_amdgcn_s_waitcnt(0);
        unsigned nloc = b.st[0], nx = b.st[1];
        if (nloc == 0u) { xcd_barrier_complete(bar, b.x, nloc, nx); b.st[0] = nloc; b.st[1] = nx; }
        const unsigned old = xb_add(&bar[XB_XSUB(b.x)], 1u);
        const unsigned gen = old / nloc;
        if (old + 1u == (gen + 1u) * nloc) {
            __builtin_amdgcn_fence(__ATOMIC_RELEASE, "agent");
            asm volatile("s_waitcnt vmcnt(0)" ::: "memory");
            const unsigned og = xb_add(&bar[XB_TOP], 1u);
            const unsigned tg = og / nx;
            if (og + 1u == (tg + 1u) * nx) xb_add(&bar[XB_TOPGEN], 1u);
            else XB_SPIN(xb_ld(&bar[XB_TOPGEN]) == tg, bar);
            __builtin_amdgcn_fence(__ATOMIC_ACQUIRE, "agent");
            xb_add(&bar[XB_XGEN(b.x)], 1u);
            asm volatile("s_waitcnt vmcnt(0)" ::: "memory");
        } else {
            XB_SPIN(xb_ld(&bar[XB_XGEN(b.x)]) == gen, bar);
            __builtin_amdgcn_fence(__ATOMIC_ACQUIRE, "agent");
            asm volatile("s_waitcnt vmcnt(0)" ::: "memory");
        }
    }
    __syncthreads();
}

__device__ __forceinline__ void run_step(ArgsRef args, const int step, const int wv) {
    extern __shared__ __attribute__((aligned(16))) unsigned char lds_raw[];
    Frame F;
    F.lds = (LAS unsigned char*)lds_raw; F.tid = 0; F.lane = 0; F.wave = wv;
    F.G = gridDim.x; { const int bx = blockIdx.x; F.vcu = (F.G % 8 == 0) ? (bx % 8) * (F.G / 8) + bx / 8 : bx; }
    F.out = args.out; F.ws = args.ws;
    bf16* XN = (bf16*)(F.ws + WS_XN); bf16* QB = (bf16*)(F.ws + WS_QB); bf16* YB = (bf16*)(F.ws + WS_YB); bf16* U = (bf16*)(F.ws + WS_U);
    int layer = 0, k = -1;
    if (step > 0) { const int s = step - 1; if (s < 7) { layer = 0; k = s; } else if (s < 13) { layer = 1; k = s - 7; } else if (s < 20) { layer = 2; k = s - 13; } else { layer = 3; k = s - 20; } }
    const bool attn = (layer & 1) == 0; const int a = layer >> 1;
    int type;
    if (step == 0) type = 0; else if (attn) type = k == 0 ? 1 : k == 1 ? 2 : k == 2 ? 4 : k == 3 ? 5 : k == 4 ? 6 : k == 5 ? 7 : 8;
    else type = k == 0 ? 3 : k == 1 ? 4 : k == 2 ? 5 : k == 3 ? 6 : k == 4 ? 7 : 8;
    if (type == 0) prologue(args, F);
    else if (type == 1) {
        pg8::Gemm g{XN, (const bf16*)(F.ws + WS_WQKV) + (size_t)a * 3072 * D, MPAD, 3072, D, D, D, 0}; pg8::StaticOrder S; S.init(MPAD, 3072, F.G, (int)blockIdx.x, D);
        pg8::EpiQKV E{F.ws, F.out, a};
        pg8::gemm_phase<pg8::EpiQKV, pg8::StaticOrder, true, true>(F.lds, g, S, E, mk_tid(F.wave));
    } else if (type == 2) { att::attn_phase(args, F, a); }
    else if (type == 3) { pool_phase(args, F, a); }
    else if (type == 4 || type == 7) {
        pg8::Gemm g;
        if (type == 7) g = pg8::Gemm{U, (const bf16*)(F.ws + WS_WDN) + (size_t)layer * D * FF, MPAD, D, FF, FF, FF, 0};
        else if (attn) g = pg8::Gemm{XN, (const bf16*)(F.ws + WS_WO) + (size_t)a * D * D, MPAD, D, D, D, D, 0};
        else g = pg8::Gemm{QB, (const bf16*)(F.ws + WS_WPOOL) + (size_t)a * 4 * 65536, MPAD, D, 256, D, 256, 512};
        pg8::TailOrder S; S.init(D, F.G, (int)blockIdx.x, g.K, type == 7 ? 16 : (attn ? 4 : 1));
        pg8::EpiBf16<0> E{YB, D, (float*)(F.ws + WS_YF)};
        pg8::gemm_phase<pg8::EpiBf16<0>, pg8::TailOrder, true, true>(F.lds, g, S, E, mk_tid(F.wave));
    } else if (type == 5) { fin_phase(args, F, layer == 0, attn ? 4 : 0, args.in[8] + layer * D, args.in[9] + layer * D); }
    else if (type == 6) {
        pg8::Gemm g{XN, (const bf16*)(F.ws + WS_WUP) + (size_t)layer * D * FF, MPAD, FF, D, D, D, 0}; pg8::StaticOrder S; S.init(MPAD, FF, F.G, (int)blockIdx.x, D);
        pg8::EpiBf16<2> E{U, FF, nullptr};
        pg8::gemm_phase<pg8::EpiBf16<2>, pg8::StaticOrder, true, true>(F.lds, g, S, E, mk_tid(F.wave));
    } else { fin_phase(args, F, false, 16, args.in[10] + layer * D, layer < 3 ? args.in[7] + (layer + 1) * D : nullptr); }
}
__global__ void __launch_bounds__(512, 2) fwd_kernel(Args args_) {
    const int lo = args_.lo, hi = args_.hi;
    const int wv = __builtin_amdgcn_readfirstlane((int)threadIdx.x >> 6);
    extern __shared__ __attribute__((aligned(16))) unsigned char lds_raw[];
    volatile LAS unsigned* bst = (volatile LAS unsigned*)((LAS unsigned char*)lds_raw + 139264);
    if (threadIdx.x < 2) bst[threadIdx.x] = 0u;
    __syncthreads();
    XcdBarrier bar = xcd_barrier_post((unsigned*)args_.ws + 4096, bst);
    int probe_rep = 0; (void)probe_rep;
    for (int step = lo; step < hi; ++step) {
        const __attribute__((address_space(4))) Args* ap = (const __attribute__((address_space(4))) Args*)__builtin_amdgcn_kernarg_segment_ptr();
        asm volatile("" : "+s"(ap));
        run_step(*ap, step, wv);
#if defined(PROBE_MASK)
        {
            int ty = 0; if (step > 0) { const int s = step - 1; const int k = s < 7 ? s : s < 13 ? s - 7 : s < 20 ? s - 13 : s - 20; const bool at = (s < 7) || (s >= 13 && s < 20);
                ty = at ? (k == 0 ? 1 : k == 1 ? 2 : k == 2 ? 4 : k == 3 ? 5 : k == 4 ? 6 : k == 5 ? 7 : 8) : (k == 0 ? 3 : k == 1 ? 4 : k == 2 ? 5 : k == 3 ? 6 : k == 4 ? 7 : 8); }
            if (((PROBE_MASK >> ty) & 1) && !probe_rep) { probe_rep = 1; --step; __syncthreads(); continue; }
            probe_rep = 0; }
#endif
        if (step + 1 < hi) { if (lo < 0) { __threadfence(); cg::this_grid().sync(); }
            else { xcd_barrier(bar);
#if defined(PROBE_BAR2)
 xcd_barrier(bar);
#endif
 } }
    }
}

extern "C" void kernel_launch(void* const* d_in, const int* in_sizes, int n_in, void* d_out, int out_size, void* d_ws, size_t ws_size, hipStream_t stream) {
    static int grid = 0;
    if (grid == 0) {
        if (n_in != 22 || (size_t)out_size != OUT_TOTAL || ws_size < WS_END) { fprintf(stderr, "kernel_launch: unexpected shapes n_in %d out %d ws %zu\n", n_in, out_size, ws_size); grid = -1; return; }
        int dev = 0, cus = 0, per_cu = 0;
        hipGetDevice(&dev); hipDeviceGetAttribute(&cus, hipDeviceAttributeMultiprocessorCount, dev);
        hipFuncSetAttribute((const void*)fwd_kernel, hipFuncAttributeMaxDynamicSharedMemorySize, LDS_BYTES);
        hipOccupancyMaxActiveBlocksPerMultiprocessor(&per_cu, (const void*)fwd_kernel, 512, LDS_BYTES);
        if (per_cu < 1) { fprintf(stderr, "kernel_launch: occupancy query says %d blocks/CU\n", per_cu); per_cu = 1; }
        (void)hipGetLastError();
        grid = cus;
    }
    if (grid < 0) return;
    if (hipMemsetAsync(d_ws, 0, 65536, stream) != hipSuccess) { fprintf(stderr, "kernel_launch: memset failed\n"); return; }
    Args a{};
    for (int i = 0; i < 22; ++i) a.in[i] = (const float*)d_in[i];
    a.out = (float*)d_out; a.ws = (unsigned char*)d_ws;
#if ONE_LAUNCH
    a.lo = 0; a.hi = NSTEPS;
    void* kargs[] = {&a};
    hipError_t e = hipLaunchCooperativeKernel((const void*)fwd_kernel, dim3(grid), dim3(512), kargs, LDS_BYTES, stream);
    if (e != hipSuccess) fprintf(stderr, "cooperative launch failed: %s (grid %d)\n", hipGetErrorString(e), grid);
#else
    for (int s = 0; s < NSTEPS; ++s) { a.lo = s; a.hi = s + 1; hipLaunchKernelGGL(fwd_kernel, dim3(grid), dim3(512), LDS_BYTES, stream, a); }
#endif
}
static_assert(WS_QB == 213 * MiB && WS_KX == 473 * MiB && WS_VX == 602 * MiB && WS_KXS == 731 * MiB && WS_VXS == 767 * MiB && WS_KXM == 803 * MiB && WS_VXM == 804 * MiB && KXS_LAYER == 9 * MiB && WS_MFK == 1323 * MiB && WS_MFV == 1324 * MiB, "EpiQKV hard-coded map");
static_assert(OFF_KP == 67633152 && OFF_VP == 202113024 && OFF_KS == 336838656 && OFF_VS == 337887232, "EpiQKV hard-coded output offsets");
```

```cpp
#include <hip/hip_runtime.h>
#include <hip/hip_cooperative_groups.h>
#include <hip/hip_bf16.h>
#include <cstdio>
#include <cstdint>
namespace cg = cooperative_groups;
namespace pg8 {
#define PG8_LAS __attribute__((address_space(3)))
typedef unsigned short bf16_t;
typedef short bf16x8 __attribute__((ext_vector_type(8)));
typedef float f32x4 __attribute__((ext_vector_type(4)));
typedef unsigned u32x4 __attribute__((ext_vector_type(4)));
constexpr int BM = 256, BK = 64, HALF = 128, HTB = HALF * BK * 2  , STAGE_BYTES = 8 * HTB, NXCD = 8, WGM = 8;

__host__ __device__ __forceinline__ int lds_byte(int r, int c) { const int st = (r >> 4) * 2 + (c >> 5), rr = r & 15, cc = c & 31, ob = rr * 64 + cc * 2; return st * 1024 + (ob ^ (((ob >> 9) & 1) << 5)); }
__host__ __device__ __forceinline__ void stage_rc(int b, int& R, int& C) { const int st = b / 1024, sb = b % 1024, swz = sb ^ (((sb >> 9) & 1) << 5); R = (st >> 1) * 16 + swz / 64; C = (st & 1) * 32 + (swz % 64) / 2; }
__host__ __device__ __forceinline__ int perm32(int rho) { const int n = rho >> 4, i = rho & 15; return 8 * (i >> 2) + 4 * n + (i & 3); }

struct Unit { int pm, pn, ko, nt, sp; };
struct Gemm { const bf16_t* A; const bf16_t* Bt; int M, N, K, lda, ldb, acs; };

struct StaticOrder {
    int nM, nN, nwg, G, c, ntf;
    __host__ __device__ void init(int M, int N, int G_, int c_, int K) { nM = M / BM; nN = N / BM; nwg = nM * nN; G = G_; c = c_; ntf = K / BK; }
    __host__ __device__ bool next(int i, Unit& u) const {
        const long L = (long)i * G + c; if (L >= nwg) return false;
        int wgid = (int)L; { const int q = nwg / NXCD, r = nwg % NXCD, xcd = wgid % NXCD, off = wgid / NXCD; wgid = (xcd < r ? xcd * (q + 1) : r * (q + 1) + (xcd - r) * q) + off; }
        const int nig = WGM * nN, gid = wgid / nig, fm = gid * WGM, gsz = (nM - fm) < WGM ? (nM - fm) : WGM;
        u.pm = fm + ((wgid % nig) % gsz); u.pn = (wgid % nig) / gsz; u.ko = 0; u.nt = ntf; u.sp = 0; return true;
    }
    __device__ __forceinline__ void a_ready(const Unit&) const {}
    __device__ __forceinline__ void done(const Unit&) const {}
};
struct TailOrder {
    StaticOrder mn; int KS, kc;
    __host__ __device__ void init(int N, int G_, int c_, int K, int KS_) { mn.init(65536, N, G_, c_, K); KS = KS_; kc = K / KS_; }
    __host__ __device__ bool next(int i, Unit& u) const {
        const long L = (long)i * mn.G + mn.c; if (L < mn.nwg) return mn.next(i, u);
        const int Lt = (int)(L - mn.nwg); if (Lt >= 3 * mn.nN * KS) return false;
        const int tile = Lt / KS, ks = Lt - tile * KS; u.pm = 256 + tile / mn.nN; u.pn = tile % mn.nN; u.ko = ks * kc; u.nt = kc / BK; u.sp = KS > 1 ? ks + 1 : 0; return true;
    }
    __device__ __forceinline__ void a_ready(const Unit&) const {}
    __device__ __forceinline__ void done(const Unit&) const {}
};

__device__ __forceinline__ unsigned cvt_pk_bf16(float lo, float hi) { unsigned r; asm volatile("v_cvt_pk_bf16_f32 %0, %1, %2" : "=v"(r) : "v"(lo), "v"(hi)); return r; }
template <int ACT  > struct EpiBf16 {
    static constexpr bool PERM = true, AFTER_DRAIN = false;
    bf16_t* O; int ldc; float* yf;
    __device__ __forceinline__ void operator()(const f32x4 (&acc)[2][2][4][2], const Unit& u, int wr, int wc, int fr, int fq) const {
        asm volatile("" : "+v"(fr), "+v"(fq));
        const int row0 = u.pm * BM + wr * 64 + fr; const int col0 = u.pn * BM + wc * 32 + 8 * fq;
#pragma unroll
        for (int ai = 0; ai < 2; ++ai)
#pragma unroll
            for (int m = 0; m < 4; ++m) { bf16_t* rowp = O + (size_t)(row0 + ai * HALF + m * 16) * ldc + col0;
#pragma unroll
                for (int bj = 0; bj < 2; ++bj) { f32x4 v0 = acc[ai][bj][m][0], v1 = acc[ai][bj][m][1];
                    if (ACT == 2) {
#pragma unroll
                        for (int e = 0; e < 4; ++e) { float a = fmaxf(v0[e], 0.f), b = fmaxf(v1[e], 0.f); v0[e] = a * a; v1[e] = b * b; } }
                    if (u.sp) { float* yr = yf + ((size_t)(u.sp - 1) * 768 + (size_t)(row0 + ai * HALF + m * 16 - 65536)) * 1024 + col0 + bj * HALF;
                        *(f32x4*)yr = v0; *(f32x4*)(yr + 4) = v1; }
                    else { u32x4 w; w.x = cvt_pk_bf16(v0[0], v0[1]); w.y = cvt_pk_bf16(v0[2], v0[3]); w.z = cvt_pk_bf16(v1[0], v1[1]); w.w = cvt_pk_bf16(v1[2], v1[3]);
                    *(u32x4*)(rowp + bj * HALF) = w; } } }
    }
};
struct EpiQKV {
    static constexpr bool PERM = true, AFTER_DRAIN = false;
    unsigned char* ws; float* out; int a;
    __device__ __forceinline__ void operator()(const f32x4 (&acc)[2][2][4][2], const Unit& u, int wr, int wc, int fr, int fq) const {
        const size_t MiB_ = 1u << 20;
        asm volatile("" : "+v"(fr), "+v"(fq));
        const int t3 = u.pn >> 2; const int colb = (u.pn & 3) * 256 + wc * 32 + 8 * fq;
        bf16_t* X; float* Fp = nullptr; int rbase, jump = 0, s0 = 0; float sc = 1.f;
        if (t3 == 0) { X = (bf16_t*)(ws + 213 * MiB_); rbase = u.pm * BM; sc = 0.125f * 1.4426950408889634f; }
        else if (u.pm < 256) { const int b = u.pm >> 5; rbase = b * 8208 + 16 + (u.pm & 31) * 256; X = (bf16_t*)(ws + (t3 == 1 ? 473 : 602) * MiB_);
            Fp = out + (t3 == 1 ? (size_t)67633152 : (size_t)202113024) + (size_t)a * 8 * 8208 * 1024 + (size_t)rbase * 1024; }
        else if (u.pm < 258) { s0 = (u.pm - 256) * 256; rbase = 1040 + s0; jump = 1040; X = (bf16_t*)(ws + (t3 == 1 ? 731 : 767) * MiB_) + (size_t)a * (9 * MiB_);
            Fp = out + (t3 == 1 ? (size_t)336838656 : (size_t)337887232) + (size_t)a * 512 * 1024 + (size_t)s0 * 1024; }
        else { rbase = 0; X = (bf16_t*)(ws + (t3 == 1 ? 803 : 804) * MiB_); Fp = (float*)(ws + (t3 == 1 ? 1323 : 1324) * MiB_); }
#pragma unroll
        for (int ai = 0; ai < 2; ++ai)
#pragma unroll
            for (int m = 0; m < 4; ++m) { const int rit = ai * HALF + wr * 64 + m * 16 + fr;
                bf16_t* xr = X + (unsigned)((rbase + rit + ((s0 + rit) >> 6) * jump) * 1024 + colb); float* fr_ = Fp + (unsigned)(rit * 1024 + colb);
#pragma unroll
                for (int bj = 0; bj < 2; ++bj) { const f32x4 v0 = acc[ai][bj][m][0], v1 = acc[ai][bj][m][1]; const f32x4 s0v = v0 * sc, s1v = v1 * sc;
                    u32x4 w; w.x = cvt_pk_bf16(s0v[0], s0v[1]); w.y = cvt_pk_bf16(s0v[2], s0v[3]); w.z = cvt_pk_bf16(s1v[0], s1v[1]); w.w = cvt_pk_bf16(s1v[2], s1v[3]);
                    *(u32x4*)(xr + bj * HALF) = w;
                    if (t3 != 0) { *(f32x4*)(fr_ + bj * HALF) = v0; *(f32x4*)(fr_ + bj * HALF + 4) = v1; } } }
    }
};
template <class Epi, class Sched, bool ALIGN_EPI = false, bool SP2 = false>
__device__ __forceinline__ void gemm_phase(PG8_LAS unsigned char* lds, const Gemm g, const Sched& S, const Epi& E, const int tid_in) {
    int tid_ = tid_in; asm volatile("" : "+v"(tid_));
    const int tid = tid_, wid = __builtin_amdgcn_readfirstlane(tid >> 6), lane = tid & 63, wr = wid >> 2, wc = wid & 3, fr = lane & 15, fq = lane >> 4;
    const int K = g.K; (void)K;
    unsigned voffA[2], voffB[2];
#pragma unroll
    for (int i = 0; i < 2; ++i) { int R, C; stage_rc(tid * 16 + i * 8192, R, C); const int Rb = Epi::PERM ? ((R & ~31) + perm32(R & 31)) : R;
        voffA[i] = (unsigned)(R * g.lda + C) * 2u; voffB[i] = (unsigned)(Rb * g.ldb + C) * 2u; }
    const size_t kstep = (size_t)(BK * 2);
    const size_t hstepA = (size_t)HALF * g.lda * 2, hstepB = (size_t)HALF * g.ldb * 2;
    const size_t tstepA = 2 * hstepA, tstepB = 2 * hstepB;
    const unsigned ldsw = (unsigned)wid * 1024u;
    const int aoff = lds_byte(wr * 64 + fr, fq * 8), boff = lds_byte(wc * 32 + fr, fq * 8);
#define PG8_SA(b, h) (((b) * 2 + (h)) * HTB)
#define PG8_SB(b, h) ((4 + (b) * 2 + (h)) * HTB)
#define PG8_STAGE(bufoff, gbase, voff) do { _Pragma("unroll") for (int _i = 0; _i < 2; ++_i) \
        __builtin_amdgcn_global_load_lds((const unsigned*)((const char*)(gbase) + (voff)[_i]), (PG8_LAS unsigned*)(lds + (bufoff) + ldsw + _i * 8192), 16, 0, 0); } while (0)
#define PG8_LDA(dst, b, h) do { _Pragma("unroll") for (int m = 0; m < 4; ++m) _Pragma("unroll") for (int k = 0; k < 2; ++k) dst[m][k] = *(const PG8_LAS bf16x8*)(lds + PG8_SA(b, h) + aoff + m * 2048 + k * 1024); } while (0)
#define PG8_LDB(dst, b, h) do { _Pragma("unroll") for (int n = 0; n < 2; ++n) _Pragma("unroll") for (int k = 0; k < 2; ++k) dst[n][k] = *(const PG8_LAS bf16x8*)(lds + PG8_SB(b, h) + boff + n * 2048 + k * 1024); } while (0)
#define PG8_MMA(ai, bj, At, Bt) do { __builtin_amdgcn_s_setprio(1); _Pragma("unroll") for (int m = 0; m < 4; ++m) _Pragma("unroll") for (int n = 0; n < 2; ++n) _Pragma("unroll") for (int k = 0; k < 2; ++k) \
        acc[ai][bj][m][n] = __builtin_amdgcn_mfma_f32_16x16x32_bf16(Bt[n][k], At[m][k], acc[ai][bj][m][n], 0, 0, 0); __builtin_amdgcn_s_setprio(0); } while (0)
#define PG8_WAIT_V(n) asm volatile("s_waitcnt vmcnt(" #n ")" ::: "memory")
#define PG8_WAIT_L(n) asm volatile("s_waitcnt lgkmcnt(" #n ")" ::: "memory")
#define PG8_BAR __builtin_amdgcn_s_barrier()
#define PG8_SCHED __builtin_amdgcn_sched_barrier(0)
    Unit cur, nxt; int ui = 0;
    if (!S.next(0, cur)) return;
    f32x4 acc[2][2][4][2];
#pragma unroll
    for (int a = 0; a < 2; ++a)
#pragma unroll
        for (int b = 0; b < 2; ++b)
#pragma unroll
            for (int m = 0; m < 4; ++m)
#pragma unroll
                for (int n = 0; n < 2; ++n) acc[a][b][m][n] = (f32x4){0.f, 0.f, 0.f, 0.f};
    bf16x8 At[4][2], B0[2][2], B1[2][2];
    const char* cA = (const char*)g.A + (size_t)cur.pm * tstepA + (size_t)cur.pn * g.acs + (size_t)cur.ko * 2; const char* cB = (const char*)g.Bt + (size_t)cur.pn * tstepB + (size_t)cur.ko * 2;
    S.a_ready(cur);
    if constexpr (SP2) {
        PG8_STAGE(PG8_SB(0, 0), cB, voffB); PG8_STAGE(PG8_SB(0, 1), cB + hstepB, voffB); PG8_STAGE(PG8_SA(0, 0), cA, voffA); PG8_STAGE(PG8_SA(0, 1), cA + hstepA, voffA);
        if (wr == 1) PG8_BAR;
        PG8_WAIT_V(2); PG8_BAR;
        PG8_STAGE(PG8_SB(1, 0), cB + kstep, voffB); PG8_STAGE(PG8_SA(1, 0), cA + kstep, voffA); PG8_STAGE(PG8_SB(1, 1), cB + hstepB + kstep, voffB);
        PG8_WAIT_V(6); PG8_BAR;
    } else {
        PG8_STAGE(PG8_SB(0, 0), cB, voffB); PG8_STAGE(PG8_SA(0, 0), cA, voffA); PG8_STAGE(PG8_SB(0, 1), cB + hstepB, voffB); PG8_STAGE(PG8_SA(0, 1), cA + hstepA, voffA);
        if (wr == 1) PG8_BAR;
        PG8_WAIT_V(4); PG8_BAR;
        PG8_STAGE(PG8_SB(1, 0), cB + kstep, voffB); PG8_STAGE(PG8_SA(1, 0), cA + kstep, voffA); PG8_STAGE(PG8_SB(1, 1), cB + hstepB + kstep, voffB);
        PG8_WAIT_V(6); PG8_BAR;
    }
    for (;;) {
        const bool has_next = S.next(ui + 1, nxt);
        const char* nA = has_next ? (const char*)g.A + (size_t)nxt.pm * tstepA + (size_t)nxt.pn * g.acs + (size_t)nxt.ko * 2 : cA; const char* nB = has_next ? (const char*)g.Bt + (size_t)nxt.pn * tstepB + (size_t)nxt.ko * 2 : cB;
        const int nt = cur.nt;
        for (int t = 0; t < nt; t += 2) {
            const bool last = (t == nt - 2);
            const char* a1 = cA + (size_t)(t + 1) * kstep;
            const char* a2 = last ? nA : cA + (size_t)(t + 2) * kstep; const char* b2 = last ? nB : cB + (size_t)(t + 2) * kstep;
            const char* a3 = a2 + kstep; const char* b3 = b2 + kstep;
            if (last && has_next) S.a_ready(nxt);
            if constexpr (SP2) {
            PG8_LDB(B0, 0, 0); PG8_LDB(B1, 0, 1); PG8_SCHED; PG8_LDA(At, 0, 0); PG8_STAGE(PG8_SA(1, 1), a1 + hstepA, voffA);
            PG8_WAIT_V(8); PG8_WAIT_L(0); PG8_BAR; PG8_MMA(0, 0, At, B0); PG8_MMA(0, 1, At, B1); PG8_BAR; PG8_SCHED;
            PG8_LDA(At, 0, 1); PG8_STAGE(PG8_SB(0, 0), b2, voffB); PG8_STAGE(PG8_SB(0, 1), b2 + hstepB, voffB); PG8_STAGE(PG8_SA(0, 0), a2, voffA);
            PG8_WAIT_V(8); PG8_WAIT_L(0); PG8_BAR; PG8_MMA(1, 0, At, B0); PG8_MMA(1, 1, At, B1); PG8_BAR; PG8_SCHED;
            PG8_LDB(B0, 1, 0); PG8_LDB(B1, 1, 1); PG8_SCHED; PG8_LDA(At, 1, 0); PG8_STAGE(PG8_SA(0, 1), a2 + hstepA, voffA);
            PG8_WAIT_V(8); PG8_WAIT_L(0); PG8_BAR; PG8_MMA(0, 0, At, B0); PG8_MMA(0, 1, At, B1); PG8_BAR; PG8_SCHED;
            PG8_LDA(At, 1, 1); PG8_STAGE(PG8_SB(1, 0), b3, voffB); PG8_STAGE(PG8_SB(1, 1), b3 + hstepB, voffB); PG8_STAGE(PG8_SA(1, 0), a3, voffA);
            PG8_WAIT_V(8); PG8_WAIT_L(0); PG8_BAR; PG8_MMA(1, 0, At, B0); PG8_MMA(1, 1, At, B1); PG8_BAR; PG8_SCHED;
            } else {
            PG8_LDB(B0, 0, 0); PG8_SCHED; PG8_LDA(At, 0, 0); PG8_STAGE(PG8_SA(1, 1), a1 + hstepA, voffA);
            PG8_WAIT_L(8); PG8_BAR; PG8_WAIT_L(0); PG8_MMA(0, 0, At, B0); PG8_BAR; PG8_SCHED;
            PG8_LDB(B1, 0, 1); PG8_STAGE(PG8_SB(0, 0), b2, voffB);
            PG8_BAR; PG8_WAIT_L(0); PG8_MMA(0, 1, At, B1); PG8_BAR;
            PG8_LDA(At, 0, 1); PG8_STAGE(PG8_SA(0, 0), a2, voffA);
            PG8_BAR; PG8_WAIT_L(0); PG8_MMA(1, 0, At, B0); PG8_BAR; PG8_SCHED;
            PG8_STAGE(PG8_SB(0, 1), b2 + hstepB, voffB);
            PG8_WAIT_V(6); PG8_BAR; PG8_MMA(1, 1, At, B1); PG8_BAR;
            PG8_LDB(B0, 1, 0); PG8_SCHED; PG8_LDA(At, 1, 0); PG8_STAGE(PG8_SA(0, 1), a2 + hstepA, voffA);
            PG8_WAIT_L(8); PG8_BAR; PG8_WAIT_L(0); PG8_MMA(0, 0, At, B0); PG8_BAR; PG8_SCHED;
            PG8_LDB(B1, 1, 1); PG8_STAGE(PG8_SB(1, 0), b3, voffB);
            PG8_BAR; PG8_WAIT_L(0); PG8_MMA(0, 1, At, B1); PG8_BAR;
            PG8_LDA(At, 1, 1); PG8_STAGE(PG8_SA(1, 0), a3, voffA);
            PG8_BAR; PG8_WAIT_L(0); PG8_MMA(1, 0, At, B0); PG8_BAR; PG8_SCHED;
            PG8_STAGE(PG8_SB(1, 1), b3 + hstepB, voffB);
            PG8_WAIT_V(6); PG8_BAR; PG8_MMA(1, 1, At, B1); PG8_BAR;
            }
        }
        if constexpr (ALIGN_EPI) { if (wr == 0) PG8_BAR; }
        if constexpr (!Epi::AFTER_DRAIN) { E(acc, cur, wr, wc, fr, fq); S.done(cur); }
        if (!has_next) break;
#pragma unroll
        for (int a = 0; a < 2; ++a)
#pragma unroll
            for (int b = 0; b < 2; ++b)
#pragma unroll
                for (int m = 0; m < 4; ++m)
#pragma unroll
                    for (int n = 0; n < 2; ++n) acc[a][b][m][n] = (f32x4){0.f, 0.f, 0.f, 0.f};
        cur = nxt; cA = nA; cB = nB; ++ui;
        if constexpr (ALIGN_EPI) { if (wr == 1) PG8_BAR; }
    }
    PG8_WAIT_V(0);
    if constexpr (!ALIGN_EPI) { if (wr == 0) PG8_BAR; }
    PG8_BAR;
    if constexpr (Epi::AFTER_DRAIN) { E.fused(acc, cur, wr, wc, fr, fq, lds, wid, lane); S.done(cur); }
#undef PG8_SA
#undef PG8_SB
#undef PG8_STAGE
#undef PG8_LDA
#undef PG8_LDB
#undef PG8_MMA
#undef PG8_WAIT_V
#undef PG8_WAIT_L
#undef PG8_BAR
#undef PG8_SCHED
}
}
#define LAS __attribute__((address_space(3)))
#define GAS __attribute__((address_space(1)))
typedef unsigned short bf16;
typedef unsigned u32x4 __attribute__((ext_vector_type(4)));
typedef unsigned u32x2 __attribute__((ext_vector_type(2)));
typedef float f32x4 __attribute__((ext_vector_type(4)));
typedef float f32x2 __attribute__((ext_vector_type(2)));
typedef float f32x16 __attribute__((ext_vector_type(16)));
typedef short bf16x8 __attribute__((ext_vector_type(8)));
typedef short s16x4 __attribute__((ext_vector_type(4)));
constexpr int D = 1024, FF = 4096, NH = 8;
constexpr int ROW_S = 65536, ROW_M = 66048, ROWS_VALID = 66064, MPAD = 66304;
constexpr int EXT_P = 8208, EXT_S = 1104;
constexpr float LOG2E = 1.4426950408889634f;
constexpr float QSCALE = 0.125f * LOG2E;
constexpr float EPS = 1e-6f, SUBLN_EPS = 1e-5f;
constexpr size_t OFF_YP = 0, OFF_YS = 67108864, OFF_KP = OFF_YS + 524288, OFF_VP = OFF_KP + 134479872, OFF_PP = OFF_VP + 134479872,
                 OFF_KS = OFF_PP + 245760, OFF_VS = OFF_KS + 1048576, OFF_PS = OFF_VS + 1048576, OUT_TOTAL = OFF_PS + 245760;
constexpr size_t MiB = 1u << 20;
constexpr size_t WS_WQKV = 1 * MiB, WS_WO = 13 * MiB, WS_WPOOL = 17 * MiB, WS_WUP = 18 * MiB, WS_WDN = 50 * MiB, WS_XM = 82 * MiB,
                 WS_XN = 83 * MiB, WS_QB = 213 * MiB, WS_YB = 343 * MiB, WS_KX = 473 * MiB, WS_VX = 602 * MiB, WS_KXS = 731 * MiB, WS_VXS = 767 * MiB,
                 WS_KXM = 803 * MiB, WS_VXM = 804 * MiB, WS_U = 805 * MiB, WS_MFK = 1323 * MiB, WS_MFV = 1324 * MiB, WS_YF = 1325 * MiB, WS_X16 = 1373 * MiB, WS_END = 1503 * MiB;
constexpr size_t KXS_LAYER = 18 * MiB / 2;
constexpr int LDS_BYTES = 147456;
constexpr int NSTEPS = 27;
#ifndef ONE_LAUNCH
#define ONE_LAUNCH 1
#endif

__device__ __forceinline__ unsigned f2bf(float f) { unsigned u = __builtin_bit_cast(unsigned, f); return (u + 0x7fffu + ((u >> 16) & 1u)) >> 16; }
__device__ __forceinline__ unsigned pk2(float lo, float hi) { return f2bf(lo) | (f2bf(hi) << 16); }
__device__ __forceinline__ float bflo(unsigned w) { return __builtin_bit_cast(float, w << 16); }
__device__ __forceinline__ float bfhi(unsigned w) { return __builtin_bit_cast(float, w & 0xffff0000u); }
__device__ __forceinline__ float wave_sum(float v) {
#pragma unroll
    for (int o = 1; o < 64; o <<= 1) v += __shfl_xor(v, o);
    return v;
}

struct Args { const float* in[22]; float* out; unsigned char* ws; int lo, hi; };
typedef const __attribute__((address_space(4))) Args& ArgsRef;
__device__ __forceinline__ int mk_tid(int wv) { int t; asm volatile("v_mbcnt_lo_u32_b32 %0, -1, 0\n\tv_mbcnt_hi_u32_b32 %0, -1, %0" : "=v"(t)); return wv * 64 + t; }
struct Frame {
    LAS unsigned char* lds; int tid, lane, wave, vcu, G;
    float* out; unsigned char* ws;
};

__device__ __forceinline__ void transpose_item(const float* W, int K, int N, bf16* WT, LAS float* scr, int item, int lane, const float* nscale) {
    const int nblk = N / 64, kb = item / nblk, nb = item % nblk, k0 = 64 * kb, n0 = 64 * nb;
    f32x4 v[16];
#pragma unroll
    for (int i = 0; i < 16; ++i) v[i] = *(const f32x4*)(W + (size_t)(k0 + 4 * i + (lane >> 4)) * N + n0 + 4 * (lane & 15));
#pragma unroll
    for (int i = 0; i < 16; ++i) { LAS float* d = scr + (4 * i + (lane >> 4)) * 65 + 4 * (lane & 15); d[0] = v[i].x; d[1] = v[i].y; d[2] = v[i].z; d[3] = v[i].w; }
    asm volatile("s_waitcnt lgkmcnt(0)" ::: "memory");
    const int c = lane & 7;
#pragma unroll
    for (int j = 0; j < 8; ++j) { const int n = (lane >> 3) + 8 * j; const LAS float* s = scr + (8 * c) * 65 + n; const float sc = nscale ? nscale[n0 + n] : 1.f;
        u32x4 o; o.x = pk2(s[0 * 65] * sc, s[1 * 65] * sc); o.y = pk2(s[2 * 65] * sc, s[3 * 65] * sc); o.z = pk2(s[4 * 65] * sc, s[5 * 65] * sc); o.w = pk2(s[6 * 65] * sc, s[7 * 65] * sc);
        *(u32x4*)(WT + (size_t)(n0 + n) * K + k0 + 8 * c) = o; }
    asm volatile("s_waitcnt lgkmcnt(0)" ::: "memory");
}
__device__ __forceinline__ const float* xin_row(ArgsRef A, int row) {
    return row < ROW_S ? A.in[0] + (size_t)row * D : row < ROW_M ? A.in[1] + (size_t)(row - ROW_S) * D : A.in[5] + (size_t)(row - ROW_M) * D;
}
__device__ __forceinline__ float* xres_row(const Frame& F, int row) {
    return row < ROW_S ? F.out + OFF_YP + (size_t)row * D : row < ROW_M ? F.out + OFF_YS + (size_t)(row - ROW_S) * D : (float*)(F.ws + WS_XM) + (size_t)(row - ROW_M) * D;
}
__device__ __forceinline__ void prologue(ArgsRef A, Frame& F) {
    { const int t_ = mk_tid(F.wave); F.tid = t_; F.lane = t_ & 63; }
    LAS float* scr = (LAS float*)(F.lds + F.wave * 16640);
    const int gw = F.vcu * 8 + F.wave, NGW = F.G * 8;
    constexpr int I_QKV = 16 * 48, I_O = 16 * 16, I_UP = 16 * 64, I_DN = 64 * 16, I_PL = 4 * 4;
    constexpr int NITEMS = 2 * I_QKV + 2 * I_O + 4 * I_UP + 4 * I_DN + 8 * I_PL;
    for (int it = gw; it < NITEMS; it += NGW) {
        int r = it;
        if (r < 2 * I_QKV) { const int a = r / I_QKV; transpose_item(A.in[11] + (size_t)a * D * 3072, D, 3072, (bf16*)(F.ws + WS_WQKV) + (size_t)a * 3072 * D, scr, r % I_QKV, F.lane, nullptr); continue; } r -= 2 * I_QKV;
        if (r < 2 * I_O) { const int a = r / I_O; transpose_item(A.in[17] + (size_t)a * D * D, D, D, (bf16*)(F.ws + WS_WO) + (size_t)a * D * D, scr, r % I_O, F.lane, nullptr); continue; } r -= 2 * I_O;
        if (r < 4 * I_UP) { const int i = r / I_UP; transpose_item(A.in[20] + (size_t)i * D * FF, D, FF, (bf16*)(F.ws + WS_WUP) + (size_t)i * D * FF, scr, r % I_UP, F.lane, nullptr); continue; } r -= 4 * I_UP;
        if (r < 4 * I_DN) { const int i = r / I_DN; transpose_item(A.in[21] + (size_t)i * D * FF, FF, D, (bf16*)(F.ws + WS_WDN) + (size_t)i * D * FF, scr, r % I_DN, F.lane, nullptr); continue; } r -= 4 * I_DN;
        { const int pg = r / I_PL; transpose_item(A.in[18] + (size_t)pg * 65536, 256, 256, (bf16*)(F.ws + WS_WPOOL) + (size_t)pg * 65536, scr, r % I_PL, F.lane, A.in[19] + pg * 256); }
    }
    for (int it0 = gw; it0 < 32768; it0 += 4 * NGW) {
        f32x4 v[4][4];
#pragma unroll
        for (int r4 = 0; r4 < 4; ++r4) { const int it = min(it0 + r4 * NGW, 32767); const int j = it & 1023, b = (it >> 10) & 7, kv = (it >> 13) & 1, a = it >> 14;
            const float* src = (kv ? A.in[3] : A.in[2]) + ((size_t)(a * 8 + b) * 1024 + j) * D;
#pragma unroll
            for (int q = 0; q < 4; ++q) v[r4][q] = *(const f32x4*)(src + 4 * F.lane + 256 * q); }
#pragma unroll
        for (int r4 = 0; r4 < 4; ++r4) { const int it = it0 + r4 * NGW; if (it < 32768) { const int j = it & 1023, b = (it >> 10) & 7, kv = (it >> 13) & 1, a = it >> 14;
            bf16* dst = (bf16*)(F.ws + (kv ? WS_VXS : WS_KXS)) + (size_t)a * KXS_LAYER + (size_t)(b * EXT_S + 16 + j) * D;
#pragma unroll
            for (int q = 0; q < 4; ++q) { u32x2 w; w.x = pk2(v[r4][q].x, v[r4][q].y); w.y = pk2(v[r4][q].z, v[r4][q].w); *(u32x2*)(dst + 4 * F.lane + 256 * q) = w; } } }
    }
    const float* g = A.in[7];
    for (int row = ROWS_VALID + gw; row < MPAD; row += NGW) { bf16* xn = (bf16*)(F.ws + WS_XN) + (size_t)row * D;
#pragma unroll
        for (int q = 0; q < 4; ++q) *(u32x2*)(xn + 4 * F.lane + 256 * q) = (u32x2){0u, 0u}; }
    const int RPC = (ROWS_VALID + F.G - 1) / F.G, rbeg = F.vcu * RPC, rend = min(rbeg + RPC, ROWS_VALID);
    for (int row0 = rbeg + F.wave; row0 < rend; row0 += 32) {
        f32x4 v[4][4]; float ss[4];
#pragma unroll
        for (int j = 0; j < 4; ++j) { const float* x = xin_row(A, min(row0 + j * 8, ROWS_VALID - 1)); ss[j] = 0.f;
#pragma unroll
            for (int q = 0; q < 4; ++q) v[j][q] = *(const f32x4*)(x + 4 * F.lane + 256 * q); }
#pragma unroll
        for (int j = 0; j < 4; ++j) {
#pragma unroll
            for (int q = 0; q < 4; ++q) ss[j] += v[j][q].x * v[j][q].x + v[j][q].y * v[j][q].y + v[j][q].z * v[j][q].z + v[j][q].w * v[j][q].w; }
#pragma unroll
        for (int o = 1; o < 64; o <<= 1) {
#pragma unroll
            for (int j = 0; j < 4; ++j) ss[j] += __shfl_xor(ss[j], o); }
#pragma unroll
        for (int j = 0; j < 4; ++j) { const int row = row0 + j * 8; const float r = 1.0f / sqrtf(ss[j] * (1.f / D) + EPS); bf16* xn = (bf16*)(F.ws + WS_XN) + (size_t)row * D;
#pragma unroll
            for (int q = 0; q < 4; ++q) { const f32x4 gg = *(const f32x4*)(g + 4 * F.lane + 256 * q); u32x2 w; w.x = pk2(v[j][q].x * r * gg.x, v[j][q].y * r * gg.y); w.y = pk2(v[j][q].z * r * gg.z, v[j][q].w * r * gg.w);
                if (row < rend) *(u32x2*)(xn + 4 * F.lane + 256 * q) = w; } }
    }
}
__device__ __forceinline__ void fin_phase(ArgsRef A, Frame& F, bool from_inputs, const int nks  , const float* gpost, const float* gnext) {
    { const int t_ = mk_tid(F.wave); F.tid = t_; F.lane = t_ & 63; }
    constexpr int FR = 4;
    const int gw = F.vcu * 8 + F.wave, NGW = F.G * 8;
    const bf16* YB = (const bf16*)(F.ws + WS_YB);
    const int lo4 = 4 * F.lane, lo8 = 8 * F.lane;
    const int RPC = (ROW_S + F.G - 1) / F.G, rbeg = F.vcu * RPC, rend = min(rbeg + RPC, ROW_S);
    f32x4 gp[4], gn[4];
#pragma unroll
    for (int q = 0; q < 4; ++q) { const int cq = lo8 + 4 * (q & 1) + 512 * (q >> 1); gp[q] = *(const f32x4*)(gpost + cq); gn[q] = gnext ? *(const f32x4*)(gnext + cq) : (f32x4){0.f, 0.f, 0.f, 0.f}; }
    for (int row0 = rbeg + F.wave; row0 < rend; row0 += 8 * FR) {
        f32x4 yv[FR][4], xv[FR][4]; float ss[FR];
#pragma unroll
        for (int j = 0; j < FR; ++j) { const int row = min(row0 + j * 8, ROWS_VALID - 1); const bf16* y = YB + (size_t)row * D; const float* xi = xin_row(A, row); const bf16* x16 = (const bf16*)(F.ws + WS_X16) + (size_t)row * D; ss[j] = 0.f;
#pragma unroll
            for (int h = 0; h < 2; ++h) { const u32x4 w = *(const u32x4*)(y + lo8 + 512 * h);
                yv[j][2 * h] = (f32x4){bflo(w.x), bfhi(w.x), bflo(w.y), bfhi(w.y)}; yv[j][2 * h + 1] = (f32x4){bflo(w.z), bfhi(w.z), bflo(w.w), bfhi(w.w)}; }
#pragma unroll
            for (int h = 0; h < 2; ++h) {
                if (from_inputs) { xv[j][2 * h] = *(const f32x4*)(xi + lo8 + 512 * h); xv[j][2 * h + 1] = *(const f32x4*)(xi + lo8 + 4 + 512 * h); }
                else { const u32x4 w = *(const u32x4*)(x16 + lo8 + 512 * h); xv[j][2 * h] = (f32x4){bflo(w.x), bfhi(w.x), bflo(w.y), bfhi(w.y)}; xv[j][2 * h + 1] = (f32x4){bflo(w.z), bfhi(w.z), bflo(w.w), bfhi(w.w)}; } } }
#pragma unroll
        for (int j = 0; j < FR; ++j) {
#pragma unroll
            for (int q = 0; q < 4; ++q) ss[j] += yv[j][q].x * yv[j][q].x + yv[j][q].y * yv[j][q].y + yv[j][q].z * yv[j][q].z + yv[j][q].w * yv[j][q].w; }
#pragma unroll
        for (int o = 1; o < 64; o <<= 1) {
#pragma unroll
            for (int j = 0; j < FR; ++j) ss[j] += __shfl_xor(ss[j], o); }
        float s2[FR];
#pragma unroll
        for (int j = 0; j < FR; ++j) { const int row = row0 + j * 8; const float r = 1.0f / sqrtf(ss[j] * (1.f / D) + EPS); s2[j] = 0.f;
#pragma unroll
            for (int q = 0; q < 4; ++q) { const int cq = lo8 + 4 * (q & 1) + 512 * (q >> 1); const f32x4 gg = gp[q]; xv[j][q] = xv[j][q] + yv[j][q] * r * gg;
                if (!gnext && row < rend) *(f32x4*)(xres_row(F, row) + cq) = xv[j][q];
                s2[j] += xv[j][q].x * xv[j][q].x + xv[j][q].y * xv[j][q].y + xv[j][q].z * xv[j][q].z + xv[j][q].w * xv[j][q].w; }
            if (gnext && row < rend) {
#pragma unroll
                for (int h = 0; h < 2; ++h) { const f32x4 a0 = xv[j][2 * h], a1 = xv[j][2 * h + 1]; u32x4 w; w.x = pk2(a0.x, a0.y); w.y = pk2(a0.z, a0.w); w.z = pk2(a1.x, a1.y); w.w = pk2(a1.z, a1.w);
                    *(u32x4*)((bf16*)(F.ws + WS_X16) + (size_t)row * D + lo8 + 512 * h) = w; } } }
        if (gnext) {
#pragma unroll
            for (int o = 1; o < 64; o <<= 1) {
#pragma unroll
                for (int j = 0; j < FR; ++j) s2[j] += __shfl_xor(s2[j], o); }
#pragma unroll
            for (int j = 0; j < FR; ++j) { const int row = row0 + j * 8; const float r2 = 1.0f / sqrtf(s2[j] * (1.f / D) + EPS); bf16* xn = (bf16*)(F.ws + WS_XN) + (size_t)row * D;
#pragma unroll
                for (int h = 0; h < 2; ++h) { const f32x4 g0 = gn[2 * h], g1 = gn[2 * h + 1]; const f32x4 a0 = xv[j][2 * h], a1 = xv[j][2 * h + 1];
                    u32x4 w; w.x = pk2(a0.x * r2 * g0.x, a0.y * r2 * g0.y); w.y = pk2(a0.z * r2 * g0.z, a0.w * r2 * g0.w); w.z = pk2(a1.x * r2 * g1.x, a1.y * r2 * g1.y); w.w = pk2(a1.z * r2 * g1.z, a1.w * r2 * g1.w);
                    if (row < rend) *(u32x4*)(xn + lo8 + 512 * h) = w; } }
        }
    }
    for (int row = ROW_S + gw; row < ROWS_VALID; row += NGW) {
        const float* xi = xin_row(A, row); float* xo = xres_row(F, row); bf16* x16 = (bf16*)(F.ws + WS_X16) + (size_t)row * D;
        f32x4 yv[4], xv[4]; float ss = 0.f;
#pragma unroll
        for (int q = 0; q < 4; ++q) {
            if (nks == 0) { const u32x2 w = *(const u32x2*)(YB + (size_t)row * D + lo4 + 256 * q); yv[q] = (f32x4){bflo(w.x), bfhi(w.x), bflo(w.y), bfhi(w.y)}; }
            else { const float* yf = (const float*)(F.ws + WS_YF) + (size_t)(row - ROW_S) * D + lo4 + 256 * q; yv[q] = *(const f32x4*)yf; for (int k = 1; k < nks; ++k) yv[q] += *(const f32x4*)(yf + (size_t)k * 768 * D); }
            if (from_inputs) xv[q] = *(const f32x4*)(xi + lo4 + 256 * q); else { const u32x2 xw = *(const u32x2*)(x16 + lo4 + 256 * q); xv[q] = (f32x4){bflo(xw.x), bfhi(xw.x), bflo(xw.y), bfhi(xw.y)}; }
            ss += yv[q].x * yv[q].x + yv[q].y * yv[q].y + yv[q].z * yv[q].z + yv[q].w * yv[q].w; }
        const float r = 1.0f / sqrtf(wave_sum(ss) * (1.f / D) + EPS); float s2 = 0.f;
#pragma unroll
        for (int q = 0; q < 4; ++q) { const f32x4 gg = *(const f32x4*)(gpost + lo4 + 256 * q); xv[q] = xv[q] + yv[q] * r * gg; if (!gnext) { if (row < ROW_M) *(f32x4*)(xo + lo4 + 256 * q) = xv[q]; } else { u32x2 xw; xw.x = pk2(xv[q].x, xv[q].y); xw.y = pk2(xv[q].z, xv[q].w); *(u32x2*)(x16 + lo4 + 256 * q) = xw; }
            s2 += xv[q].x * xv[q].x + xv[q].y * xv[q].y + xv[q].z * xv[q].z + xv[q].w * xv[q].w; }
        if (gnext) { const float r2 = 1.0f / sqrtf(wave_sum(s2) * (1.f / D) + EPS); bf16* xn = (bf16*)(F.ws + WS_XN) + (size_t)row * D;
#pragma unroll
            for (int q = 0; q < 4; ++q) { const f32x4 gg = *(const f32x4*)(gnext + lo4 + 256 * q); u32x2 w; w.x = pk2(xv[q].x * r2 * gg.x, xv[q].y * r2 * gg.y); w.y = pk2(xv[q].z * r2 * gg.z, xv[q].w * r2 * gg.w);
                *(u32x2*)(xn + lo4 + 256 * q) = w; } }
    }
}
__device__ __forceinline__ u32x4 pool_h8(ArgsRef A, const Frame& F, int grp, int b, int t, int col, int p) {
    const bf16* XN = (const bf16*)(F.ws + WS_XN);
    if (t >= 0) { const int row = grp == 0 ? b * 8192 + t : grp == 1 ? ROW_S + b * 64 + t : ROW_M + t; return *(const u32x4*)(XN + (size_t)row * D + col); }
    if (grp == 0) return *(const u32x4*)(XN + (size_t)(ROW_M + 16 + t) * D + col);
    if (grp == 1) { const float* s = A.in[4] + ((size_t)(p * 8 + b) * 15 + 15 + t) * D + col; const f32x4 a0 = *(const f32x4*)s, a1 = *(const f32x4*)(s + 4);
        u32x4 w; w.x = pk2(a0.x, a0.y); w.y = pk2(a0.z, a0.w); w.z = pk2(a1.x, a1.y); w.w = pk2(a1.z, a1.w); return w; }
    return (u32x4){0u, 0u, 0u, 0u};
}
__device__ __forceinline__ void pool_phase(ArgsRef A, Frame& F, int p) {
    { const int t_ = mk_tid(F.wave); F.tid = t_; F.lane = t_ & 63; }
    bf16* DB = (bf16*)(F.ws + WS_QB);
    const int col = 8 * (F.tid & 127), rgq = F.tid >> 7, w = 2 << (col >> 8);
    for (int it = F.vcu; it < 1033; it += F.G) {
        int grp, b, t0, nr;
        if (it < 1024) { grp = 0; b = it >> 7; t0 = (it & 127) * 64; nr = 64; } else if (it < 1032) { grp = 1; b = it - 1024; t0 = 0; nr = 64; } else { grp = 2; b = 0; t0 = 0; nr = 16; }
        const int tb = t0 + 16 * rgq;
        if (16 * rgq >= nr) continue;
        u32x4 h[31];
#pragma unroll
        for (int i = 0; i < 31; ++i) h[i] = pool_h8(A, F, grp, b, tb - 15 + i, col, p);
        float sum[8];
#pragma unroll
        for (int e = 0; e < 8; ++e) sum[e] = 0.f;
#pragma unroll
        for (int j = 1; j < 16; ++j) { const float k = (j < w) ? 1.f : 0.f; const u32x4 v = h[15 - j];
            sum[0] += k * bflo(v.x); sum[1] += k * bfhi(v.x); sum[2] += k * bflo(v.y); sum[3] += k * bfhi(v.y); sum[4] += k * bflo(v.z); sum[5] += k * bfhi(v.z); sum[6] += k * bflo(v.w); sum[7] += k * bfhi(v.w); }
#pragma unroll
        for (int i = 0; i < 16; ++i) { const int t = tb + i;
            const u32x4 cv = h[15 + i]; const float cur[8] = {bflo(cv.x), bfhi(cv.x), bflo(cv.y), bfhi(cv.y), bflo(cv.z), bfhi(cv.z), bflo(cv.w), bfhi(cv.w)};
            const float inv = 1.0f / (float)(grp == 2 ? min(t + 1, w) : w);
            float d[8];
#pragma unroll
            for (int e = 0; e < 8; ++e) { sum[e] += cur[e]; d[e] = sum[e] * inv - cur[e]; }
            const int row = grp == 0 ? b * 8192 + t : grp == 1 ? ROW_S + b * 64 + t : ROW_M + t;
            u32x4 o; o.x = pk2(d[0], d[1]); o.y = pk2(d[2], d[3]); o.z = pk2(d[4], d[5]); o.w = pk2(d[6], d[7]);
            *(u32x4*)(DB + (size_t)row * D + col) = o;
            const u32x4 a1 = h[15 + i - 1], a3 = h[15 + i - 3], a7 = h[15 + i - 7], a15 = h[15 + i - 15];
            u32x4 ov; ov.x = (w == 2) ? a1.x : (w == 4) ? a3.x : (w == 8) ? a7.x : a15.x; ov.y = (w == 2) ? a1.y : (w == 4) ? a3.y : (w == 8) ? a7.y : a15.y;
            ov.z = (w == 2) ? a1.z : (w == 4) ? a3.z : (w == 8) ? a7.z : a15.z; ov.w = (w == 2) ? a1.w : (w == 4) ? a3.w : (w == 8) ? a7.w : a15.w;
            sum[0] -= bflo(ov.x); sum[1] -= bfhi(ov.x); sum[2] -= bflo(ov.y); sum[3] -= bfhi(ov.y); sum[4] -= bflo(ov.z); sum[5] -= bfhi(ov.z); sum[6] -= bflo(ov.w); sum[7] -= bfhi(ov.w);
            float* tp = nullptr;
            if (grp == 0 && t >= 8177) tp = F.out + OFF_PP + ((size_t)(p * 8 + b) * 15 + (t - 8177)) * D + col;
            if (grp == 1 && t >= 49) tp = F.out + OFF_PS + ((size_t)(p * 8 + b) * 15 + (t - 49)) * D + col;
            if (tp) { *(f32x4*)tp = (f32x4){cur[0], cur[1], cur[2], cur[3]}; *(f32x4*)(tp + 4) = (f32x4){cur[4], cur[5], cur[6], cur[7]}; }
        }
    }
}

namespace att {
constexpr int KSTR = 272;
constexpr int TB = 16384;
constexpr int OFF_K0 = 0, OFF_K1 = TB, OFF_V0 = 2 * TB, OFF_V1 = 3 * TB, OFF_BT = 4 * TB, OFF_GT = OFF_BT + 2048, OFF_Q = 5 * TB, XB = 16384;
static_assert(OFF_BT >= 4 * XB && OFF_GT + 512 <= OFF_Q && OFF_Q + 2 * TB <= 131072, "attention LDS map");
constexpr float THR = 48.0f;
constexpr float NEG = -1e30f;
struct AUnit { const bf16* K; const bf16* V; const bf16* KM; const bf16* VM; const bf16* Q; bf16* O; int P, L, x, h; };
__device__ __forceinline__ float max3f(float a, float b, float c) { float r; asm("v_max3_f32 %0, %1, %2, %3" : "=v"(r) : "v"(a), "v"(b), "v"(c)); return r; }
__device__ __forceinline__ float swapmax(float v) { auto rr = __builtin_amdgcn_permlane32_swap(__float_as_uint(v), __float_as_uint(v), false, false); return fmaxf(__uint_as_float(rr[0]), __uint_as_float(rr[1])); }
__device__ __forceinline__ float swapsum(float v) { auto rr = __builtin_amdgcn_permlane32_swap(__float_as_uint(v), __float_as_uint(v), false, false); return __uint_as_float(rr[0]) + __uint_as_float(rr[1]); }
typedef __bf16 bf16x2_t __attribute__((ext_vector_type(2)));
__device__ __forceinline__ unsigned cvtpk(float lo, float hi) { f32x2 v = {lo, hi}; bf16x2_t b = __builtin_convertvector(v, bf16x2_t); return __builtin_bit_cast(unsigned, b); }
__device__ __forceinline__ s16x4 vtr(const LAS unsigned char* p) { return __builtin_bit_cast(s16x4, __builtin_amdgcn_ds_read_tr16_b64_v4i16((LAS s16x4*)p)); }
__device__ __forceinline__ void glds16(const void* gsrc, unsigned lds_dst) { unsigned keep;
    asm volatile("s_mov_b32 %0, m0\n\ts_mov_b32 m0, %2\n\ts_nop 0\n\tglobal_load_lds_dwordx4 %1, off\n\ts_mov_b32 m0, %0" : "=&s"(keep) : "v"(gsrc), "s"(lds_dst) : "memory"); }
__device__ __forceinline__ bf16x8 pack8(const f32x16& S, int o) {
    u32x4 w; w.x = cvtpk(S[o], S[o + 1]); w.y = cvtpk(S[o + 2], S[o + 3]); w.z = cvtpk(S[o + 4], S[o + 5]); w.w = cvtpk(S[o + 6], S[o + 7]); return __builtin_bit_cast(bf16x8, w);
}

__device__ __forceinline__ void attn_unit(const int wv, LAS unsigned char* lds, const AUnit& u, const float* lq1, const float* lk1, const float* lq2, const float* lk2, const int layer_a, const float* relb, const float* subg) {
    const int tid = mk_tid(wv), lane = tid & 63, wid = wv, mp = wid >> 2, rg = wid & 3, q32 = lane & 31, hi = lane >> 5;
    LAS float* BT = (LAS float*)(lds + OFF_BT); LAS float* GT = (LAS float*)(lds + OFF_GT);
    {
        const float b15 = relb[15 * 8 + u.h];
        if (tid < 448) { const int rel = tid - 192, n = rel < 0 ? -rel : rel;
            int bk = n < 8 ? n : n < 12 ? 8 : n < 16 ? 9 : n < 23 ? 10 : n < 32 ? 11 : n < 46 ? 12 : n < 64 ? 13 : n < 91 ? 14 : 15; if (rel > 0) bk += 16;
            BT[tid] = (relb[bk * 8 + u.h] - b15) * LOG2E; }
        if (tid >= 384) GT[tid - 384] = subg[tid - 384] * (layer_a == 0 ? 0.8f : 0.52928698f);
    }
    const int vrows = min(128, u.L - 128 * u.x);
    const bool active = rg * 32 < vrows;
    const int ch = rg >> 1;
    const int NTw = active ? (u.P + min((2 * u.x + ch + 1) * 64, u.L) + 48) >> 6 : 0;
    const int NT = (u.P + min((2 * u.x + 2) * 64, u.L) + 48) >> 6;
    const int eq0 = u.P + 128 * u.x + rg * 32, eq = eq0 + q32;
    const unsigned lds0 = (unsigned)(size_t)lds;
    unsigned goff[2];
#pragma unroll
    for (int j = 0; j < 2; ++j) { const int row = wid * 8 + 4 * j + (lane >> 4), x = ((row & 3) << 2) | ((row >> 2) & 3), c = (lane & 15) ^ x; goff[j] = (unsigned)(row * 1024 + u.h * 128 + c * 8); }
    const unsigned ldst = (unsigned)wid * 2048u;
#define ATT_DMA(base, bufoff) do { _Pragma("unroll") for (int j_ = 0; j_ < 2; ++j_) \
        glds16((base) + goff[j_], (unsigned)__builtin_amdgcn_readfirstlane((int)(lds0 + (unsigned)(bufoff) + ldst + j_ * 1024))); } while (0)
#define ATT_ISSUE_K(t, bufoff) do { const bf16* b_ = ((t) == 0 && wid < 2) ? u.KM : u.K + (size_t)(t) * 65536; ATT_DMA(b_, bufoff); } while (0)
#define ATT_ISSUE_V(t, bufoff) do { const bf16* b_ = ((t) == 0 && wid < 2) ? u.VM : u.V + (size_t)(t) * 65536; ATT_DMA(b_, bufoff); } while (0)
#define ATT_WAITBAR() do { asm volatile("s_waitcnt vmcnt(0) lgkmcnt(0)" ::: "memory"); __builtin_amdgcn_s_barrier(); asm volatile("" ::: "memory"); } while (0)
    unsigned koff[4];
    { const int x = ((q32 & 3) << 2) | ((q32 >> 2) & 3);
#pragma unroll
      for (int d0 = 0; d0 < 4; ++d0) koff[d0] = lds0 + (unsigned)(q32 * 256 + (((mp * 8 + 2 * d0 + hi) ^ x) << 4)); }
    unsigned vofs[4][2];
    { const int qq = (lane & 15) >> 2, cl = 2 * ((lane >> 4) & 1) + ((lane & 3) >> 1), sub = 8 * (lane & 1);
#pragma unroll
      for (int dvb = 0; dvb < 4; ++dvb)
#pragma unroll
          for (int hf = 0; hf < 2; ++hf) vofs[dvb][hf] = lds0 + (unsigned)((8 * hf + 4 * hi + qq) * 256 + ((((dvb ^ qq) << 2) | (cl ^ (2 * hf + hi))) << 4) + sub); }
    {
        const bf16* qb_ = u.Q + (size_t)(128 * u.x + wid * 16) * 1024;
#pragma unroll
        for (int j = 0; j < 4; ++j) { const int row = 4 * j + (lane >> 4), x = ((row & 3) << 2) | ((row >> 2) & 3), c = (lane & 15) ^ x;
            glds16(qb_ + row * 1024 + u.h * 128 + c * 8, (unsigned)__builtin_amdgcn_readfirstlane((int)(lds0 + OFF_Q + wid * 4096 + j * 1024))); }
    }
    ATT_ISSUE_K(0, OFF_K0); ATT_ISSUE_V(0, OFF_V0); if (NT > 1) ATT_ISSUE_K(1, OFF_K1);
    ATT_WAITBAR();
    f32x16 O[4];
#pragma unroll
    for (int i = 0; i < 4; ++i)
#pragma unroll
        for (int r = 0; r < 16; ++r) O[i][r] = 0.f;
    float m = 0.f, l = 0.f;
    f32x16 SA0, SA1, SB0, SB1;
    const f32x16 zero16 = {0.f, 0.f, 0.f, 0.f, 0.f, 0.f, 0.f, 0.f, 0.f, 0.f, 0.f, 0.f, 0.f, 0.f, 0.f, 0.f};
#define ATT_SB() __builtin_amdgcn_sched_barrier(0)
#define ATT_QK(S0_, S1_, kbufoff) do { unsigned qsh_ = (unsigned)(OFF_Q + rg * 8192); asm volatile("" : "+s"(qsh_));     \
        bf16x8 kfa[4], kfb[4], qfr[4]; \
        _Pragma("unroll") for (int d0 = 0; d0 < 4; ++d0) { kfa[d0] = *(const LAS bf16x8*)(size_t)(koff[d0] + (unsigned)(kbufoff)); kfb[d0] = *(const LAS bf16x8*)(size_t)(koff[d0] + (unsigned)(kbufoff) + 8192u); qfr[d0] = *(const LAS bf16x8*)(size_t)(koff[d0] + qsh_); } \
        ATT_SB(); \
        S0_ = __builtin_amdgcn_mfma_f32_32x32x16_bf16(kfa[0], qfr[0], zero16, 0, 0, 0); S1_ = __builtin_amdgcn_mfma_f32_32x32x16_bf16(kfb[0], qfr[0], zero16, 0, 0, 0); \
        _Pragma("unroll") for (int d0 = 1; d0 < 4; ++d0) { S0_ = __builtin_amdgcn_mfma_f32_32x32x16_bf16(kfa[d0], qfr[d0], S0_, 0, 0, 0); S1_ = __builtin_amdgcn_mfma_f32_32x32x16_bf16(kfb[d0], qfr[d0], S1_, 0, 0, 0); } } while (0)
#define ATT_VLD(bank, ks) do { _Pragma("unroll") for (int dvb = 0; dvb < 4; ++dvb) { bank[dvb][0] = vtr((const LAS unsigned char*)(size_t)(vofs[dvb][0] + vb_ + (unsigned)((ks) * 4096))); bank[dvb][1] = vtr((const LAS unsigned char*)(size_t)(vofs[dvb][1] + vb_ + (unsigned)((ks) * 4096))); } } while (0)
#define ATT_PV(bank, ks, C0, C1) do { const bf16x8 pb = pack8(((ks) < 2) ? C0 : C1, 8 * ((ks) & 1)); \
        _Pragma("unroll") for (int dvb = 0; dvb < 4; ++dvb) { const bf16x8 vf = (bf16x8){bank[dvb][0][0], bank[dvb][0][1], bank[dvb][0][2], bank[dvb][0][3], bank[dvb][1][0], bank[dvb][1][1], bank[dvb][1][2], bank[dvb][1][3]}; \
            O[dvb] = __builtin_amdgcn_mfma_f32_32x32x16_bf16(vf, pb, O[dvb], 0, 0, 0); } } while (0)
#define ATT_STEP(C0, C1, N0, N1, t_, PAR) do { const int t = (t_); constexpr int cur = (PAR); \
        if (t + 2 < NT) ATT_ISSUE_K(t + 2, cur ? OFF_K1 : OFF_K0); \
        if (t + 1 < NT) ATT_ISSUE_V(t + 1, cur ? OFF_V0 : OFF_V1); \
        { \
            const int k0 = t * 64; \
            if (k0 + 154 > eq0) { const LAS float* bt_ = BT + (k0 - eq + 192 + 4 * hi); \
                _Pragma("unroll") for (int r = 0; r < 16; ++r) { C0[r] += bt_[(r & 3) + 8 * (r >> 2)]; } \
                ATT_SB(); \
                _Pragma("unroll") for (int r = 0; r < 16; ++r) { C1[r] += bt_[32 + (r & 3) + 8 * (r >> 2)]; } } \
            if (t >= NTw - 1) { const bool all_ = t >= NTw; _Pragma("unroll") for (int r = 0; r < 16; ++r) { if (r >= 8 || all_) C0[r] = NEG; C1[r] = NEG; } } \
            if (__any(m != 0.f)) { _Pragma("unroll") for (int r = 0; r < 16; ++r) { C0[r] -= m; C1[r] -= m; } } \
            float mx = max3f(C0[0], C1[0], C0[1]), mx2 = max3f(C1[1], C0[2], C1[2]); \
            _Pragma("unroll") for (int r = 3; r < 15; r += 2) { mx = max3f(mx, C0[r], C1[r]); mx2 = max3f(mx2, C0[r + 1], C1[r + 1]); } \
            mx = max3f(mx, mx2, C0[15]); mx = fmaxf(mx, C1[15]); \
            mx = swapmax(mx); \
            if (__any(mx > THR || (t == 0 && mx < -THR))) { const float dl = (t == 0) ? mx : fmaxf(mx, 0.f); m += dl; const float f = (t == 0) ? 1.f : __builtin_amdgcn_exp2f(-dl); l *= f; \
                _Pragma("unroll") for (int r = 0; r < 16; ++r) { C0[r] -= dl; C1[r] -= dl; } \
                _Pragma("unroll") for (int i = 0; i < 4; ++i) _Pragma("unroll") for (int r = 0; r < 16; ++r) O[i][r] *= f; } \
        } \
        ATT_SB(); \
        if (t + 1 < NT) ATT_QK(N0, N1, cur ? OFF_K0 : OFF_K1); \
        ATT_SB(); \
        { \
            constexpr unsigned vb_ = (unsigned)(cur ? OFF_V1 : OFF_V0); \
            s16x4 vA[4][2], vB[4][2]; \
            ATT_VLD(vA, 0); \
            ATT_SB(); \
            float ls = 0.f; \
            _Pragma("unroll") for (int r = 0; r < 16; ++r) { C0[r] = __builtin_amdgcn_exp2f(C0[r]); C1[r] = __builtin_amdgcn_exp2f(C1[r]); ls += C0[r]; ls += C1[r]; } \
            l += ls; \
            ATT_SB(); \
            ATT_VLD(vB, 1); ATT_SB(); ATT_PV(vA, 0, C0, C1); ATT_SB(); \
            ATT_VLD(vA, 2); ATT_SB(); ATT_PV(vB, 1, C0, C1); ATT_SB(); \
            ATT_VLD(vB, 3); ATT_SB(); ATT_PV(vA, 2, C0, C1); ATT_SB(); \
            ATT_PV(vB, 3, C0, C1); \
        } \
        ATT_WAITBAR(); } while (0)
    ATT_QK(SA0, SA1, OFF_K0);
    ATT_WAITBAR();
    for (int tt = 0; tt < NT; tt += 2) { ATT_STEP(SA0, SA1, SB0, SB1, tt, 0); if (tt + 1 < NT) ATT_STEP(SB0, SB1, SA0, SA1, tt + 1, 1); }
#undef ATT_STEP
#undef ATT_QK
#undef ATT_VLD
#undef ATT_PV
#undef ATT_SB
#undef ATT_WAITBAR
#undef ATT_ISSUE_K
#undef ATT_ISSUE_V
#undef ATT_DMA
    const int tid2_ = mk_tid(wv);
    const int lane2 = tid2_ & 63, q32b = lane2 & 31, hib = lane2 >> 5;
    float lam;
    { float s1 = lq1[lane2] * lk1[lane2], s2 = lq2[lane2] * lk2[lane2]; s1 = wave_sum(s1); s2 = wave_sum(s2); lam = expf(s1) - expf(s2) + (layer_a == 0 ? 0.2f : 0.47071302f); }
    l = swapsum(l); const float inv = active ? 1.0f / l : 0.f;
    LAS float* xb = (LAS float*)(lds + rg * XB);
    if (mp == 1) { const float f = inv * lam;
#pragma unroll
        for (int i = 0; i < 4; ++i)
#pragma unroll
            for (int r = 0; r < 16; ++r) xb[(i * 16 + r) * 64 + lane2] = O[i][r] * f; }
    __syncthreads();
    if (mp == 0 && active) {
        float ss = 0.f;
#pragma unroll
        for (int i = 0; i < 4; ++i)
#pragma unroll
            for (int r = 0; r < 16; ++r) { const float o = O[i][r] * inv - xb[(i * 16 + r) * 64 + lane2]; O[i][r] = o; ss += o * o; }
        ss = swapsum(ss); const float rs = 1.0f / sqrtf(ss * (1.f / 128.f) + SUBLN_EPS);
        asm volatile("s_waitcnt lgkmcnt(0)" ::: "memory");
        LAS unsigned char* stg = (LAS unsigned char*)xb;
#pragma unroll
        for (int i = 0; i < 4; ++i)
#pragma unroll
            for (int r4 = 0; r4 < 4; ++r4) { const int dv0 = 32 * i + 8 * r4 + 4 * hib; const f32x4 gg = *(const LAS f32x4*)(GT + dv0);
                u32x2 w; w.x = cvtpk(O[i][4 * r4] * rs * gg.x, O[i][4 * r4 + 1] * rs * gg.y); w.y = cvtpk(O[i][4 * r4 + 2] * rs * gg.z, O[i][4 * r4 + 3] * rs * gg.w);
                *(LAS u32x2*)(stg + q32b * KSTR + dv0 * 2) = w; }
        asm volatile("s_waitcnt lgkmcnt(0)" ::: "memory");
        bf16* og = u.O + (size_t)(128 * u.x + rg * 32) * 1024 + u.h * 128;
#pragma unroll
        for (int i = 0; i < 8; ++i) { const int row = i * 4 + (lane2 >> 4), c16 = lane2 & 15; const u32x4 v = *(const LAS u32x4*)(stg + row * KSTR + c16 * 16);
            if (rg * 32 + row < vrows) *(u32x4*)(og + (size_t)row * 1024 + c16 * 8) = v; }
    }
    __syncthreads();
}
__device__ __forceinline__ void attn_phase(ArgsRef A, Frame& F, int a) {
    const bf16* QB = (const bf16*)(F.ws + WS_QB); bf16* OB = (bf16*)(F.ws + WS_XN); const bf16* KX = (const bf16*)(F.ws + WS_KX); const bf16* VX = (const bf16*)(F.ws + WS_VX);
    const bf16* KXS = (const bf16*)(F.ws + WS_KXS) + (size_t)a * KXS_LAYER; const bf16* VXS = (const bf16*)(F.ws + WS_VXS) + (size_t)a * KXS_LAYER;
    { const int gt = blockIdx.x * 512 + mk_tid(F.wave);
      for (int i = gt; i < 65536; i += F.G * 512) { const int c4 = i & 255, r = (i >> 8) & 15, b = (i >> 12) & 7, kv = i >> 15;
          const f32x4 v = *(const f32x4*)((const float*)(F.ws + (kv ? WS_MFV : WS_MFK)) + r * 1024 + c4 * 4);
          *(f32x4*)(F.out + (kv ? OFF_VP : OFF_KP) + (size_t)a * 8 * EXT_P * 1024 + (size_t)(b * EXT_P + r) * 1024 + c4 * 4) = v; } }
    for (int n = F.vcu; n < 4168; n += F.G) {
        AUnit u; u.KM = (const bf16*)(F.ws + WS_KXM); u.VM = (const bf16*)(F.ws + WS_VXM);
        if (n < 4096) { const int i = n >> 8, v = n & 255, c = v & 31, bh = (v >> 5) * 8 + (i >> 1); const int x = (i & 1) ? 63 - c : c; const int b = bh >> 3;
            u.K = KX + (size_t)b * EXT_P * 1024; u.V = VX + (size_t)b * EXT_P * 1024; u.Q = QB + (size_t)b * 8192 * 1024; u.O = OB + (size_t)b * 8192 * 1024; u.P = 16; u.L = 8192; u.x = x; u.h = bh & 7; }
        else if (n < 4160) { const int j = n - 4096, b = j >> 3; u.K = KXS + (size_t)b * EXT_S * 1024; u.V = VXS + (size_t)b * EXT_S * 1024; u.Q = QB + (size_t)(ROW_S + b * 64) * 1024; u.O = OB + (size_t)(ROW_S + b * 64) * 1024; u.P = 1040; u.L = 64; u.x = 0; u.h = j & 7; }
        else { u.K = (const bf16*)(F.ws + WS_KXM); u.V = (const bf16*)(F.ws + WS_VXM); u.Q = QB + (size_t)ROW_M * 1024; u.O = OB + (size_t)ROW_M * 1024; u.P = 0; u.L = 16; u.x = 0; u.h = n - 4160; }
        attn_unit(F.wave, F.lds, u, A.in[12] + a * 64, A.in[13] + a * 64, A.in[14] + a * 64, A.in[15] + a * 64, a, A.in[6], A.in[16] + a * 128);
    }
}
}

#define XB_TMO      128
#define XB_XCNT(j)  (256  + 64 * (j))
#define XB_XSUB(j)  (1280 + 64 * (j))
#define XB_XGEN(j)  (2304 + 64 * (j))
#define XB_TOP      3328
#define XB_TOPGEN   3392
#define XCD_BAR_WORDS 3456
#define XB_SPIN_CAP (1u << 18)

__device__ __forceinline__ unsigned xb_ld(unsigned* p)              { return __hip_atomic_load(p, __ATOMIC_RELAXED, __HIP_MEMORY_SCOPE_AGENT); }
__device__ __forceinline__ unsigned xb_add(unsigned* p, unsigned v) { return __hip_atomic_fetch_add(p, v, __ATOMIC_RELAXED, __HIP_MEMORY_SCOPE_AGENT); }
__device__ __forceinline__ unsigned xb_xcc_id() { return (unsigned)__builtin_amdgcn_s_getreg((3 << 11) | 20) & 0xFu; }
#define XB_SPIN(cond, bar) do { unsigned _sp = 0; while (cond) { __builtin_amdgcn_s_sleep(1); \
    if ((++_sp & 255u) == 0u) { if (xb_ld(&(bar)[XB_TMO])) break; if (_sp > XB_SPIN_CAP) { atomicAdd(&(bar)[XB_TMO], 1u); break; } } } } while (0)

struct XcdBarrier {
    bool leader; unsigned* bar; unsigned x;
    volatile LAS unsigned* st;
};

__device__ __forceinline__ XcdBarrier xcd_barrier_post(unsigned* bar, volatile LAS unsigned* st) {
    XcdBarrier b; b.bar = bar; b.x = xb_xcc_id(); b.st = st;
    b.leader = (threadIdx.x == 0);
    if (b.leader) (void)xb_add(&bar[XB_XCNT(b.x)], 1u);
    return b;
}
__device__ __forceinline__ void xcd_barrier_complete(unsigned* bar, unsigned x, unsigned& nloc, unsigned& nx) {
    const unsigned G = gridDim.x * gridDim.y * gridDim.z;
    unsigned sum, cnt, mine, sp = 0u;
    for (;;) {
        sum = 0u; cnt = 0u; mine = 0u;
#pragma unroll
        for (unsigned j = 0; j < 16; ++j) { const unsigned c = xb_ld(&bar[XB_XCNT(j)]); sum += c; cnt += (c > 0u) ? 1u : 0u; mine = (j == x) ? c : mine; }
        if (sum == G) break;
        __builtin_amdgcn_s_sleep(1);
        if ((++sp & 255u) == 0u) { if (xb_ld(&bar[XB_TMO])) break; if (sp > XB_SPIN_CAP) { atomicAdd(&bar[XB_TMO], 1u); break; } }
    }
    nloc = mine > 0u ? mine : 1u; nx = cnt > 0u ? cnt : 1u;
}

__device__ __forceinline__ void xcd_barrier(const XcdBarrier& b) {
    asm volatile("s_waitcnt vmcnt(0)" ::: "memory");
    __syncthreads();
    if (b.leader) {
        unsigned* bar = b.bar;
        __builtin_amdgcn_s_waitcnt(0);
        unsigned nloc = b.st[0], nx = b.st[1];
        if (nloc == 0u) { xcd_barrier_complete(bar, b.x, nloc, nx); b.st[0] = nloc; b.st[1] = nx; }
        const unsigned old = xb_add(&bar[XB_XSUB(b.x)], 1u);
        const unsigned gen = old / nloc;
        if (old + 1u == (gen + 1u) * nloc) {
            __builtin_amdgcn_fence(__ATOMIC_RELEASE, "agent");
            asm volatile("s_waitcnt vmcnt(0)" ::: "memory");
            const unsigned og = xb_add(&bar[XB_TOP], 1u);
            const unsigned tg = og / nx;
            if (og + 1u == (tg + 1u) * nx) xb_add(&bar[XB_TOPGEN], 1u);
            else XB_SPIN(xb_ld(&bar[XB_TOPGEN]) == tg, bar);
            __builtin_amdgcn_fence(__ATOMIC_ACQUIRE, "agent");
            xb_add(&bar[XB_XGEN(b.x)], 1u);
            asm volatile("s_waitcnt vmcnt(0)" ::: "memory");
        } else {
            XB_SPIN(xb_ld(&bar[XB_XGEN(b.x)]) == gen, bar);
            __builtin_amdgcn_fence(__ATOMIC_ACQUIRE, "agent");
            asm volatile("s_waitcnt vmcnt(0)" ::: "memory");
        }
    }
    __syncthreads();
}

__device__ __forceinline__ void run_step(ArgsRef args, const int step, const int wv) {
    extern __shared__ __attribute__((aligned(16))) unsigned char lds_raw[];
    Frame F;
    F.lds = (LAS unsigned char*)lds_raw; F.tid = 0; F.lane = 0; F.wave = wv;
    F.G = gridDim.x; { const int bx = blockIdx.x; F.vcu = (F.G % 8 == 0) ? (bx % 8) * (F.G / 8) + bx / 8 : bx; }
    F.out = args.out; F.ws = args.ws;
    bf16* XN = (bf16*)(F.ws + WS_XN); bf16* QB = (bf16*)(F.ws + WS_QB); bf16* YB = (bf16*)(F.ws + WS_YB); bf16* U = (bf16*)(F.ws + WS_U);
    int layer = 0, k = -1;
    if (step > 0) { const int s = step - 1; if (s < 7) { layer = 0; k = s; } else if (s < 13) { layer = 1; k = s - 7; } else if (s < 20) { layer = 2; k = s - 13; } else { layer = 3; k = s - 20; } }
    const bool attn = (layer & 1) == 0; const int a = layer >> 1;
    int type;
    if (step == 0) type = 0; else if (attn) type = k == 0 ? 1 : k == 1 ? 2 : k == 2 ? 4 : k == 3 ? 5 : k == 4 ? 6 : k == 5 ? 7 : 8;
    else type = k == 0 ? 3 : k == 1 ? 4 : k == 2 ? 5 : k == 3 ? 6 : k == 4 ? 7 : 8;
    if (type == 0) prologue(args, F);
    else if (type == 1) {
        pg8::Gemm g{XN, (const bf16*)(F.ws + WS_WQKV) + (size_t)a * 3072 * D, MPAD, 3072, D, D, D, 0}; pg8::StaticOrder S; S.init(MPAD, 3072, F.G, (int)blockIdx.x, D);
        pg8::EpiQKV E{F.ws, F.out, a};
        pg8::gemm_phase<pg8::EpiQKV, pg8::StaticOrder, true, true>(F.lds, g, S, E, mk_tid(F.wave));
    } else if (type == 2) { att::attn_phase(args, F, a); }
    else if (type == 3) { pool_phase(args, F, a); }
    else if (type == 4 || type == 7) {
        pg8::Gemm g;
        if (type == 7) g = pg8::Gemm{U, (const bf16*)(F.ws + WS_WDN) + (size_t)layer * D * FF, MPAD, D, FF, FF, FF, 0};
        else if (attn) g = pg8::Gemm{XN, (const bf16*)(F.ws + WS_WO) + (size_t)a * D * D, MPAD, D, D, D, D, 0};
        else g = pg8::Gemm{QB, (const bf16*)(F.ws + WS_WPOOL) + (size_t)a * 4 * 65536, MPAD, D, 256, D, 256, 512};
        pg8::TailOrder S; S.init(D, F.G, (int)blockIdx.x, g.K, type == 7 ? 16 : (attn ? 4 : 1));
        pg8::EpiBf16<0> E{YB, D, (float*)(F.ws + WS_YF)};
        pg8::gemm_phase<pg8::EpiBf16<0>, pg8::TailOrder, true, true>(F.lds, g, S, E, mk_tid(F.wave));
    } else if (type == 5) { fin_phase(args, F, layer == 0, attn ? 4 : 0, args.in[8] + layer * D, args.in[9] + layer * D); }
    else if (type == 6) {
        pg8::Gemm g{XN, (const bf16*)(F.ws + WS_WUP) + (size_t)layer * D * FF, MPAD, FF, D, D, D, 0}; pg8::StaticOrder S; S.init(MPAD, FF, F.G, (int)blockIdx.x, D);
        pg8::EpiBf16<2> E{U, FF, nullptr};
        pg8::gemm_phase<pg8::EpiBf16<2>, pg8::StaticOrder, true, true>(F.lds, g, S, E, mk_tid(F.wave));
    } else { fin_phase(args, F, false, 16, args.in[10] + layer * D, layer < 3 ? args.in[7] + (layer + 1) * D : nullptr); }
}
__global__ void __launch_bounds__(512, 2) fwd_kernel(Args args_) {
    const int lo = args_.lo, hi = args_.hi;
    const int wv = __builtin_amdgcn_readfirstlane((int)threadIdx.x >> 6);
    extern __shared__ __attribute__((aligned(16))) unsigned char lds_raw[];
    volatile LAS unsigned* bst = (volatile LAS unsigned*)((LAS unsigned char*)lds_raw + 139264);
    if (threadIdx.x < 2) bst[threadIdx.x] = 0u;
    __syncthreads();
    XcdBarrier bar = xcd_barrier_post((unsigned*)args_.ws + 4096, bst);
    int probe_rep = 0; (void)probe_rep;
    for (int step = lo; step < hi; ++step) {
        const __attribute__((address_space(4))) Args* ap = (const __attribute__((address_space(4))) Args*)__builtin_amdgcn_kernarg_segment_ptr();
        asm volatile("" : "+s"(ap));
        run_step(*ap, step, wv);
#if defined(PROBE_MASK)
        {
            int ty = 0; if (step > 0) { const int s = step - 1; const int k = s < 7 ? s : s < 13 ? s - 7 : s < 20 ? s - 13 : s - 20; const bool at = (s < 7) || (s >= 13 && s < 20);
                ty = at ? (k == 0 ? 1 : k == 1 ? 2 : k == 2 ? 4 : k == 3 ? 5 : k == 4 ? 6 : k == 5 ? 7 : 8) : (k == 0 ? 3 : k == 1 ? 4 : k == 2 ? 5 : k == 3 ? 6 : k == 4 ? 7 : 8); }
            if (((PROBE_MASK >> ty) & 1) && !probe_rep) { probe_rep = 1; --step; __syncthreads(); continue; }
            probe_rep = 0; }
#endif
        if (step + 1 < hi) { if (lo < 0) { __threadfence(); cg::this_grid().sync(); }
            else { xcd_barrier(bar);
#if defined(PROBE_BAR2)
 xcd_barrier(bar);
#endif
 } }
    }
}

extern "C" void kernel_launch(void* const* d_in, const int* in_sizes, int n_in, void* d_out, int out_size, void* d_ws, size_t ws_size, hipStream_t stream) {
    static int grid = 0;
    if (grid == 0) {
        if (n_in != 22 || (size_t)out_size != OUT_TOTAL || ws_size < WS_END) { fprintf(stderr, "kernel_launch: unexpected shapes n_in %d out %d ws %zu\n", n_in, out_size, ws_size); grid = -1; return; }
        int dev = 0, cus = 0, per_cu = 0;
        hipGetDevice(&dev); hipDeviceGetAttribute(&cus, hipDeviceAttributeMultiprocessorCount, dev);
        hipFuncSetAttribute((const void*)fwd_kernel, hipFuncAttributeMaxDynamicSharedMemorySize, LDS_BYTES);
        hipOccupancyMaxActiveBlocksPerMultiprocessor(&per_cu, (const void*)fwd_kernel, 512, LDS_BYTES);
        if (per_cu < 1) { fprintf(stderr, "kernel_launch: occupancy query says %d blocks/CU\n", per_cu); per_cu = 1; }
        (void)hipGetLastError();
        grid = cus;
    }
    if (grid < 0) return;
    if (hipMemsetAsync(d_ws, 0, 65536, stream) != hipSuccess) { fprintf(stderr, "kernel_launch: memset failed\n"); return; }
    Args a{};
    for (int i = 0; i < 22; ++i) a.in[i] = (const float*)d_in[i];
    a.out = (float*)d_out; a.ws = (unsigned char*)d_ws;
#if ONE_LAUNCH
    a.lo = 0; a.hi = NSTEPS;
    void* kargs[] = {&a};
    hipError_t e = hipLaunchCooperativeKernel((const void*)fwd_kernel, dim3(grid), dim3(512), kargs, LDS_BYTES, stream);
    if (e != hipSuccess) fprintf(stderr, "cooperative launch failed: %s (grid %d)\n", hipGetErrorString(e), grid);
#else
    for (int s = 0; s < NSTEPS; ++s) { a.lo = s; a.hi = s + 1; hipLaunchKernelGGL(fwd_kernel, dim3(grid), dim3(512), LDS_BYTES, stream, a); }
#endif
}
static_assert(WS_QB == 213 * MiB && WS_KX == 473 * MiB && WS_VX == 602 * MiB && WS_KXS == 731 * MiB && WS_VXS == 767 * MiB && WS_KXM == 803 * MiB && WS_VXM == 804 * MiB && KXS_LAYER == 9 * MiB && WS_MFK == 1323 * MiB && WS_MFV == 1324 * MiB, "EpiQKV hard-coded map");
static_assert(OFF_KP == 67633152 && OFF_VP == 202113024 && OFF_KS == 336838656 && OFF_VS == 337887232, "EpiQKV hard-coded output offsets");
```

```cpp
#include <hip/hip_runtime.h>
#include <hip/hip_cooperative_groups.h>
#include <hip/hip_bf16.h>
#include <cstdio>
#include <cstdint>
namespace cg = cooperative_groups;
namespace pg8 {
#define PG8_LAS __attribute__((address_space(3)))
typedef unsigned short bf16_t;
typedef short bf16x8 __attribute__((ext_vector_type(8)));
typedef float f32x4 __attribute__((ext_vector_type(4)));
typedef unsigned u32x4 __attribute__((ext_vector_type(4)));
constexpr int BM = 256, BK = 64, HALF = 128, HTB = HALF * BK * 2  , STAGE_BYTES = 8 * HTB, NXCD = 8, WGM = 8;

__host__ __device__ __forceinline__ int lds_byte(int r, int c) { const int st = (r >> 4) * 2 + (c >> 5), rr = r & 15, cc = c & 31, ob = rr * 64 + cc * 2; return st * 1024 + (ob ^ (((ob >> 9) & 1) << 5)); }
__host__ __device__ __forceinline__ void stage_rc(int b, int& R, int& C) { const int st = b / 1024, sb = b % 1024, swz = sb ^ (((sb >> 9) & 1) << 5); R = (st >> 1) * 16 + swz / 64; C = (st & 1) * 32 + (swz % 64) / 2; }
__host__ __device__ __forceinline__ int perm32(int rho) { const int n = rho >> 4, i = rho & 15; return 8 * (i >> 2) + 4 * n + (i & 3); }

struct Unit { int pm, pn, ko, nt, sp; };
struct Gemm { const bf16_t* A; const bf16_t* Bt; int M, N, K, lda, ldb, acs; };

struct StaticOrder {
    int nM, nN, nwg, G, c, ntf;
    __host__ __device__ void init(int M, int N, int G_, int c_, int K) { nM = M / BM; nN = N / BM; nwg = nM * nN; G = G_; c = c_; ntf = K / BK; }
    __host__ __device__ bool next(int i, Unit& u) const {
        const long L = (long)i * G + c; if (L >= nwg) return false;
        int wgid = (int)L; { const int q = nwg / NXCD, r = nwg % NXCD, xcd = wgid % NXCD, off = wgid / NXCD; wgid = (xcd < r ? xcd * (q + 1) : r * (q + 1) + (xcd - r) * q) + off; }
        const int nig = WGM * nN, gid = wgid / nig, fm = gid * WGM, gsz = (nM - fm) < WGM ? (nM - fm) : WGM;
        u.pm = fm + ((wgid % nig) % gsz); u.pn = (wgid % nig) / gsz; u.ko = 0; u.nt = ntf; u.sp = 0; return true;
    }
    __device__ __forceinline__ void a_ready(const Unit&) const {}
    __device__ __forceinline__ void done(const Unit&) const {}
};
struct TailOrder {
    StaticOrder mn; int KS, kc;
    __host__ __device__ void init(int N, int G_, int c_, int K, int KS_) { mn.init(65536, N, G_, c_, K); KS = KS_; kc = K / KS_; }
    __host__ __device__ bool next(int i, Unit& u) const {
        const long L = (long)i * mn.G + mn.c; if (L < mn.nwg) return mn.next(i, u);
        const int Lt = (int)(L - mn.nwg); if (Lt >= 3 * mn.nN * KS) return false;
        const int tile = Lt / KS, ks = Lt - tile * KS; u.pm = 256 + tile / mn.nN; u.pn = tile % mn.nN; u.ko = ks * kc; u.nt = kc / BK; u.sp = KS > 1 ? ks + 1 : 0; return true;
    }
    __device__ __forceinline__ void a_ready(const Unit&) const {}
    __device__ __forceinline__ void done(const Unit&) const {}
};

__device__ __forceinline__ unsigned cvt_pk_bf16(float lo, float hi) { unsigned r; asm volatile("v_cvt_pk_bf16_f32 %0, %1, %2" : "=v"(r) : "v"(lo), "v"(hi)); return r; }
template <int ACT  > struct EpiBf16 {
    static constexpr bool PERM = true, AFTER_DRAIN = false;
    bf16_t* O; int ldc; float* yf;
    __device__ __forceinline__ void operator()(const f32x4 (&acc)[2][2][4][2], const Unit& u, int wr, int wc, int fr, int fq) const {
        asm volatile("" : "+v"(fr), "+v"(fq));
        const int row0 = u.pm * BM + wr * 64 + fr; const int col0 = u.pn * BM + wc * 32 + 8 * fq;
#pragma unroll
        for (int ai = 0; ai < 2; ++ai)
#pragma unroll
            for (int m = 0; m < 4; ++m) { bf16_t* rowp = O + (size_t)(row0 + ai * HALF + m * 16) * ldc + col0;
#pragma unroll
                for (int bj = 0; bj < 2; ++bj) { f32x4 v0 = acc[ai][bj][m][0], v1 = acc[ai][bj][m][1];
                    if (ACT == 2) {
#pragma unroll
                        for (int e = 0; e < 4; ++e) { float a = fmaxf(v0[e], 0.f), b = fmaxf(v1[e], 0.f); v0[e] = a * a; v1[e] = b * b; } }
                    if (u.sp) { float* yr = yf + ((size_t)(u.sp - 1) * 768 + (size_t)(row0 + ai * HALF + m * 16 - 65536)) * 1024 + col0 + bj * HALF;
                        *(f32x4*)yr = v0; *(f32x4*)(yr + 4) = v1; }
                    else { u32x4 w; w.x = cvt_pk_bf16(v0[0], v0[1]); w.y = cvt_pk_bf16(v0[2], v0[3]); w.z = cvt_pk_bf16(v1[0], v1[1]); w.w = cvt_pk_bf16(v1[2], v1[3]);
                    *(u32x4*)(rowp + bj * HALF) = w; } } }
    }
};
struct EpiQKV {
    static constexpr bool PERM = true, AFTER_DRAIN = false;
    unsigned char* ws; float* out; int a;
    __device__ __forceinline__ void operator()(const f32x4 (&acc)[2][2][4][2], const Unit& u, int wr, int wc, int fr, int fq) const {
        const size_t MiB_ = 1u << 20;
        asm volatile("" : "+v"(fr), "+v"(fq));
        const int t3 = u.pn >> 2; const int colb = (u.pn & 3) * 256 + wc * 32 + 8 * fq;
        bf16_t* X; float* Fp = nullptr; int rbase, jump = 0, s0 = 0; float sc = 1.f;
        if (t3 == 0) { X = (bf16_t*)(ws + 213 * MiB_); rbase = u.pm * BM; sc = 0.125f * 1.4426950408889634f; }
        else if (u.pm < 256) { const int b = u.pm >> 5; rbase = b * 8208 + 16 + (u.pm & 31) * 256; X = (bf16_t*)(ws + (t3 == 1 ? 473 : 602) * MiB_);
            Fp = out + (t3 == 1 ? (size_t)67633152 : (size_t)202113024) + (size_t)a * 8 * 8208 * 1024 + (size_t)rbase * 1024; }
        else if (u.pm < 258) { s0 = (u.pm - 256) * 256; rbase = 1040 + s0; jump = 1040; X = (bf16_t*)(ws + (t3 == 1 ? 731 : 767) * MiB_) + (size_t)a * (9 * MiB_);
            Fp = out + (t3 == 1 ? (size_t)336838656 : (size_t)337887232) + (size_t)a * 512 * 1024 + (size_t)s0 * 1024; }
        else { rbase = 0; X = (bf16_t*)(ws + (t3 == 1 ? 803 : 804) * MiB_); Fp = (float*)(ws + (t3 == 1 ? 1323 : 1324) * MiB_); }
#pragma unroll
        for (int ai = 0; ai < 2; ++ai)
#pragma unroll
            for (int m = 0; m < 4; ++m) { const int rit = ai * HALF + wr * 64 + m * 16 + fr;
                bf16_t* xr = X + (unsigned)((rbase + rit + ((s0 + rit) >> 6) * jump) * 1024 + colb); float* fr_ = Fp + (unsigned)(rit * 1024 + colb);
#pragma unroll
                for (int bj = 0; bj < 2; ++bj) { const f32x4 v0 = acc[ai][bj][m][0], v1 = acc[ai][bj][m][1]; const f32x4 s0v = v0 * sc, s1v = v1 * sc;
                    u32x4 w; w.x = cvt_pk_bf16(s0v[0], s0v[1]); w.y = cvt_pk_bf16(s0v[2], s0v[3]); w.z = cvt_pk_bf16(s1v[0], s1v[1]); w.w = cvt_pk_bf16(s1v[2], s1v[3]);
                    *(u32x4*)(xr + bj * HALF) = w;
                    if (t3 != 0) { *(f32x4*)(fr_ + bj * HALF) = v0; *(f32x4*)(fr_ + bj * HALF + 4) = v1; } } }
    }
};
template <class Epi, class Sched, bool ALIGN_EPI = false, bool SP2 = false>
__device__ __forceinline__ void gemm_phase(PG8_LAS unsigned char* lds, const Gemm g, const Sched& S, const Epi& E, const int tid_in) {
    int tid_ = tid_in; asm volatile("" : "+v"(tid_));
    const int tid = tid_, wid = __builtin_amdgcn_readfirstlane(tid >> 6), lane = tid & 63, wr = wid >> 2, wc = wid & 3, fr = lane & 15, fq = lane >> 4;
    const int K = g.K; (void)K;
    unsigned voffA[2], voffB[2];
#pragma unroll
    for (int i = 0; i < 2; ++i) { int R, C; stage_rc(tid * 16 + i * 8192, R, C); const int Rb = Epi::PERM ? ((R & ~31) + perm32(R & 31)) : R;
        voffA[i] = (unsigned)(R * g.lda + C) * 2u; voffB[i] = (unsigned)(Rb * g.ldb + C) * 2u; }
    const size_t kstep = (size_t)(BK * 2);
    const size_t hstepA = (size_t)HALF * g.lda * 2, hstepB = (size_t)HALF * g.ldb * 2;
    const size_t tstepA = 2 * hstepA, tstepB = 2 * hstepB;
    const unsigned ldsw = (unsigned)wid * 1024u;
    const int aoff = lds_byte(wr * 64 + fr, fq * 8), boff = lds_byte(wc * 32 + fr, fq * 8);
#define PG8_SA(b, h) (((b) * 2 + (h)) * HTB)
#define PG8_SB(b, h) ((4 + (b) * 2 + (h)) * HTB)
#define PG8_STAGE(bufoff, gbase, voff) do { _Pragma("unroll") for (int _i = 0; _i < 2; ++_i) \
        __builtin_amdgcn_global_load_lds((const unsigned*)((const char*)(gbase) + (voff)[_i]), (PG8_LAS unsigned*)(lds + (bufoff) + ldsw + _i * 8192), 16, 0, 0); } while (0)
#define PG8_LDA(dst, b, h) do { _Pragma("unroll") for (int m = 0; m < 4; ++m) _Pragma("unroll") for (int k = 0; k < 2; ++k) dst[m][k] = *(const PG8_LAS bf16x8*)(lds + PG8_SA(b, h) + aoff + m * 2048 + k * 1024); } while (0)
#define PG8_LDB(dst, b, h) do { _Pragma("unroll") for (int n = 0; n < 2; ++n) _Pragma("unroll") for (int k = 0; k < 2; ++k) dst[n][k] = *(const PG8_LAS bf16x8*)(lds + PG8_SB(b, h) + boff + n * 2048 + k * 1024); } while (0)
#define PG8_MMA(ai, bj, At, Bt) do { __builtin_amdgcn_s_setprio(1); _Pragma("unroll") for (int m = 0; m < 4; ++m) _Pragma("unroll") for (int n = 0; n < 2; ++n) _Pragma("unroll") for (int k = 0; k < 2; ++k) \
        acc[ai][bj][m][n] = __builtin_amdgcn_mfma_f32_16x16x32_bf16(Bt[n][k], At[m][k], acc[ai][bj][m][n], 0, 0, 0); __builtin_amdgcn_s_setprio(0); } while (0)
#define PG8_WAIT_V(n) asm volatile("s_waitcnt vmcnt(" #n ")" ::: "memory")
#define PG8_WAIT_L(n) asm volatile("s_waitcnt lgkmcnt(" #n ")" ::: "memory")
#define PG8_BAR __builtin_amdgcn_s_barrier()
#define PG8_SCHED __builtin_amdgcn_sched_barrier(0)
    Unit cur, nxt; int ui = 0;
    if (!S.next(0, cur)) return;
    f32x4 acc[2][2][4][2];
#pragma unroll
    for (int a = 0; a < 2; ++a)
#pragma unroll
        for (int b = 0; b < 2; ++b)
#pragma unroll
            for (int m = 0; m < 4; ++m)
#pragma unroll
                for (int n = 0; n < 2; ++n) acc[a][b][m][n] = (f32x4){0.f, 0.f, 0.f, 0.f};
    bf16x8 At[4][2], B0[2][2], B1[2][2];
    const char* cA = (const char*)g.A + (size_t)cur.pm * tstepA + (size_t)cur.pn * g.acs + (size_t)cur.ko * 2; const char* cB = (const char*)g.Bt + (size_t)cur.pn * tstepB + (size_t)cur.ko * 2;
    S.a_ready(cur);
    if constexpr (SP2) {
        PG8_STAGE(PG8_SB(0, 0), cB, voffB); PG8_STAGE(PG8_SB(0, 1), cB + hstepB, voffB); PG8_STAGE(PG8_SA(0, 0), cA, voffA); PG8_STAGE(PG8_SA(0, 1), cA + hstepA, voffA);
        if (wr == 1) PG8_BAR;
        PG8_WAIT_V(2); PG8_BAR;
        PG8_STAGE(PG8_SB(1, 0), cB + kstep, voffB); PG8_STAGE(PG8_SA(1, 0), cA + kstep, voffA); PG8_STAGE(PG8_SB(1, 1), cB + hstepB + kstep, voffB);
        PG8_WAIT_V(6); PG8_BAR;
    } else {
        PG8_STAGE(PG8_SB(0, 0), cB, voffB); PG8_STAGE(PG8_SA(0, 0), cA, voffA); PG8_STAGE(PG8_SB(0, 1), cB + hstepB, voffB); PG8_STAGE(PG8_SA(0, 1), cA + hstepA, voffA);
        if (wr == 1) PG8_BAR;
        PG8_WAIT_V(4); PG8_BAR;
        PG8_STAGE(PG8_SB(1, 0), cB + kstep, voffB); PG8_STAGE(PG8_SA(1, 0), cA + kstep, voffA); PG8_STAGE(PG8_SB(1, 1), cB + hstepB + kstep, voffB);
        PG8_WAIT_V(6); PG8_BAR;
    }
    for (;;) {
        const bool has_next = S.next(ui + 1, nxt);
        const char* nA = has_next ? (const char*)g.A + (size_t)nxt.pm * tstepA + (size_t)nxt.pn * g.acs + (size_t)nxt.ko * 2 : cA; const char* nB = has_next ? (const char*)g.Bt + (size_t)nxt.pn * tstepB + (size_t)nxt.ko * 2 : cB;
        const int nt = cur.nt;
        for (int t = 0; t < nt; t += 2) {
            const bool last = (t == nt - 2);
            const char* a1 = cA + (size_t)(t + 1) * kstep;
            const char* a2 = last ? nA : cA + (size_t)(t + 2) * kstep; const char* b2 = last ? nB : cB + (size_t)(t + 2) * kstep;
            const char* a3 = a2 + kstep; const char* b3 = b2 + kstep;
            if (last && has_next) S.a_ready(nxt);
            if constexpr (SP2) {
            PG8_LDB(B0, 0, 0); PG8_LDB(B1, 0, 1); PG8_SCHED; PG8_LDA(At, 0, 0); PG8_STAGE(PG8_SA(1, 1), a1 + hstepA, voffA);
            PG8_WAIT_V(8); PG8_WAIT_L(0); PG8_BAR; PG8_MMA(0, 0, At, B0); PG8_MMA(0, 1, At, B1); PG8_BAR; PG8_SCHED;
            PG8_LDA(At, 0, 1); PG8_STAGE(PG8_SB(0, 0), b2, voffB); PG8_STAGE(PG8_SB(0, 1), b2 + hstepB, voffB); PG8_STAGE(PG8_SA(0, 0), a2, voffA);
            PG8_WAIT_V(8); PG8_WAIT_L(0); PG8_BAR; PG8_MMA(1, 0, At, B0); PG8_MMA(1, 1, At, B1); PG8_BAR; PG8_SCHED;
            PG8_LDB(B0, 1, 0); PG8_LDB(B1, 1, 1); PG8_SCHED; PG8_LDA(At, 1, 0); PG8_STAGE(PG8_SA(0, 1), a2 + hstepA, voffA);
            PG8_WAIT_V(8); PG8_WAIT_L(0); PG8_BAR; PG8_MMA(0, 0, At, B0); PG8_MMA(0, 1, At, B1); PG8_BAR; PG8_SCHED;
            PG8_LDA(At, 1, 1); PG8_STAGE(PG8_SB(1, 0), b3, voffB); PG8_STAGE(PG8_SB(1, 1), b3 + hstepB, voffB); PG8_STAGE(PG8_SA(1, 0), a3, voffA);
            PG8_WAIT_V(8); PG8_WAIT_L(0); PG8_BAR; PG8_MMA(1, 0, At, B0); PG8_MMA(1, 1, At, B1); PG8_BAR; PG8_SCHED;
            } else {
            PG8_LDB(B0, 0, 0); PG8_SCHED; PG8_LDA(At, 0, 0); PG8_STAGE(PG8_SA(1, 1), a1 + hstepA, voffA);
            PG8_WAIT_L(8); PG8_BAR; PG8_WAIT_L(0); PG8_MMA(0, 0, At, B0); PG8_BAR; PG8_SCHED;
            PG8_LDB(B1, 0, 1); PG8_STAGE(PG8_SB(0, 0), b2, voffB);
            PG8_BAR; PG8_WAIT_L(0); PG8_MMA(0, 1, At, B1); PG8_BAR;
            PG8_LDA(At, 0, 1); PG8_STAGE(PG8_SA(0, 0), a2, voffA);
            PG8_BAR; PG8_WAIT_L(0); PG8_MMA(1, 0, At, B0); PG8_BAR; PG8_SCHED;
            PG8_STAGE(PG8_SB(0, 1), b2 + hstepB, voffB);
            PG8_WAIT_V(6); PG8_BAR; PG8_MMA(1, 1, At, B1); PG8_BAR;
            PG8_LDB(B0, 1, 0); PG8_SCHED; PG8_LDA(At, 1, 0); PG8_STAGE(PG8_SA(0, 1), a2 + hstepA, voffA);
            PG8_WAIT_L(8); PG8_BAR; PG8_WAIT_L(0); PG8_MMA(0, 0, At, B0); PG8_BAR; PG8_SCHED;
            PG8_LDB(B1, 1, 1); PG8_STAGE(PG8_SB(1, 0), b3, voffB);
            PG8_BAR; PG8_WAIT_L(0); PG8_MMA(0, 1, At, B1); PG8_BAR;
            PG8_LDA(At, 1, 1); PG8_STAGE(PG8_SA(1, 0), a3, voffA);
            PG8_BAR; PG8_WAIT_L(0); PG8_MMA(1, 0, At, B0); PG8_BAR; PG8_SCHED;
            PG8_STAGE(PG8_SB(1, 1), b3 + hstepB, voffB);
            PG8_WAIT_V(6); PG8_BAR; PG8_MMA(1, 1, At, B1); PG8_BAR;
            }
        }
        if constexpr (ALIGN_EPI) { if (wr == 0) PG8_BAR; }
        if constexpr (!Epi::AFTER_DRAIN) { E(acc, cur, wr, wc, fr, fq); S.done(cur); }
        if (!has_next) break;
#pragma unroll
        for (int a = 0; a < 2; ++a)
#pragma unroll
            for (int b = 0; b < 2; ++b)
#pragma unroll
                for (int m = 0; m < 4; ++m)
#pragma unroll
                    for (int n = 0; n < 2; ++n) acc[a][b][m][n] = (f32x4){0.f, 0.f, 0.f, 0.f};
        cur = nxt; cA = nA; cB = nB; ++ui;
        if constexpr (ALIGN_EPI) { if (wr == 1) PG8_BAR; }
    }
    PG8_WAIT_V(0);
    if constexpr (!ALIGN_EPI) { if (wr == 0) PG8_BAR; }
    PG8_BAR;
    if constexpr (Epi::AFTER_DRAIN) { E.fused(acc, cur, wr, wc, fr, fq, lds, wid, lane); S.done(cur); }
#undef PG8_SA
#undef PG8_SB
#undef PG8_STAGE
#undef PG8_LDA
#undef PG8_LDB
#undef PG8_MMA
#undef PG8_WAIT_V
#undef PG8_WAIT_L
#undef PG8_BAR
#undef PG8_SCHED
}
}
#define LAS __attribute__((address_space(3)))
#define GAS __attribute__((address_space(1)))
typedef unsigned short bf16;
typedef unsigned u32x4 __attribute__((ext_vector_type(4)));
typedef unsigned u32x2 __attribute__((ext_vector_type(2)));
typedef float f32x4 __attribute__((ext_vector_type(4)));
typedef float f32x2 __attribute__((ext_vector_type(2)));
typedef float f32x16 __attribute__((ext_vector_type(16)));
typedef short bf16x8 __attribute__((ext_vector_type(8)));
typedef short s16x4 __attribute__((ext_vector_type(4)));
constexpr int D = 1024, FF = 4096, NH = 8;
constexpr int ROW_S = 65536, ROW_M = 66048, ROWS_VALID = 66064, MPAD = 66304;
constexpr int EXT_P = 8208, EXT_S = 1104;
constexpr float LOG2E = 1.4426950408889634f;
constexpr float QSCALE = 0.125f * LOG2E;
constexpr float EPS = 1e-6f, SUBLN_EPS = 1e-5f;
constexpr size_t OFF_YP = 0, OFF_YS = 67108864, OFF_KP = OFF_YS + 524288, OFF_VP = OFF_KP + 134479872, OFF_PP = OFF_VP + 134479872,
                 OFF_KS = OFF_PP + 245760, OFF_VS = OFF_KS + 1048576, OFF_PS = OFF_VS + 1048576, OUT_TOTAL = OFF_PS + 245760;
constexpr size_t MiB = 1u << 20;
constexpr size_t WS_WQKV = 1 * MiB, WS_WO = 13 * MiB, WS_WPOOL = 17 * MiB, WS_WUP = 18 * MiB, WS_WDN = 50 * MiB, WS_XM = 82 * MiB,
                 WS_XN = 83 * MiB, WS_QB = 213 * MiB, WS_YB = 343 * MiB, WS_KX = 473 * MiB, WS_VX = 602 * MiB, WS_KXS = 731 * MiB, WS_VXS = 767 * MiB,
                 WS_KXM = 803 * MiB, WS_VXM = 804 * MiB, WS_U = 805 * MiB, WS_MFK = 1323 * MiB, WS_MFV = 1324 * MiB, WS_YF = 1325 * MiB, WS_X16 = 1373 * MiB, WS_END = 1503 * MiB;
constexpr size_t KXS_LAYER = 18 * MiB / 2;
constexpr int LDS_BYTES = 147456;
constexpr int NSTEPS = 27;
#ifndef ONE_LAUNCH
#define ONE_LAUNCH 1
#endif

__device__ __forceinline__ unsigned f2bf(float f) { unsigned u = __builtin_bit_cast(unsigned, f); return (u + 0x7fffu + ((u >> 16) & 1u)) >> 16; }
__device__ __forceinline__ unsigned pk2(float lo, float hi) { return f2bf(lo) | (f2bf(hi) << 16); }
__device__ __forceinline__ float bflo(unsigned w) { return __builtin_bit_cast(float, w << 16); }
__device__ __forceinline__ float bfhi(unsigned w) { return __builtin_bit_cast(float, w & 0xffff0000u); }
__device__ __forceinline__ float wave_sum(float v) {
#pragma unroll
    for (int o = 1; o < 64; o <<= 1) v += __shfl_xor(v, o);
    return v;
}

struct Args { const float* in[22]; float* out; unsigned char* ws; int lo, hi; };
typedef const __attribute__((address_space(4))) Args& ArgsRef;
__device__ __forceinline__ int mk_tid(int wv) { int t; asm volatile("v_mbcnt_lo_u32_b32 %0, -1, 0\n\tv_mbcnt_hi_u32_b32 %0, -1, %0" : "=v"(t)); return wv * 64 + t; }
struct Frame {
    LAS unsigned char* lds; int tid, lane, wave, vcu, G;
    float* out; unsigned char* ws;
};

__device__ __forceinline__ void transpose_item(const float* W, int K, int N, bf16* WT, LAS float* scr, int item, int lane, const float* nscale) {
    const int nblk = N / 64, kb = item / nblk, nb = item % nblk, k0 = 64 * kb, n0 = 64 * nb;
    f32x4 v[16];
#pragma unroll
    for (int i = 0; i < 16; ++i) v[i] = *(const f32x4*)(W + (size_t)(k0 + 4 * i + (lane >> 4)) * N + n0 + 4 * (lane & 15));
#pragma unroll
    for (int i = 0; i < 16; ++i) { LAS float* d = scr + (4 * i + (lane >> 4)) * 65 + 4 * (lane & 15); d[0] = v[i].x; d[1] = v[i].y; d[2] = v[i].z; d[3] = v[i].w; }
    asm volatile("s_waitcnt lgkmcnt(0)" ::: "memory");
    const int c = lane & 7;
#pragma unroll
    for (int j = 0; j < 8; ++j) { const int n = (lane >> 3) + 8 * j; const LAS float* s = scr + (8 * c) * 65 + n; const float sc = nscale ? nscale[n0 + n] : 1.f;
        u32x4 o; o.x = pk2(s[0 * 65] * sc, s[1 * 65] * sc); o.y = pk2(s[2 * 65] * sc, s[3 * 65] * sc); o.z = pk2(s[4 * 65] * sc, s[5 * 65] * sc); o.w = pk2(s[6 * 65] * sc, s[7 * 65] * sc);
        *(u32x4*)(WT + (size_t)(n0 + n) * K + k0 + 8 * c) = o; }
    asm volatile("s_waitcnt lgkmcnt(0)" ::: "memory");
}
__device__ __forceinline__ const float* xin_row(ArgsRef A, int row) {
    return row < ROW_S ? A.in[0] + (size_t)row * D : row < ROW_M ? A.in[1] + (size_t)(row - ROW_S) * D : A.in[5] + (size_t)(row - ROW_M) * D;
}
__device__ __forceinline__ float* xres_row(const Frame& F, int row) {
    return row < ROW_S ? F.out + OFF_YP + (size_t)row * D : row < ROW_M ? F.out + OFF_YS + (size_t)(row - ROW_S) * D : (float*)(F.ws + WS_XM) + (size_t)(row - ROW_M) * D;
}
__device__ __forceinline__ void prologue(ArgsRef A, Frame& F) {
    { const int t_ = mk_tid(F.wave); F.tid = t_; F.lane = t_ & 63; }
    LAS float* scr = (LAS float*)(F.lds + F.wave * 16640);
    const int gw = F.vcu * 8 + F.wave, NGW = F.G * 8;
    constexpr int I_QKV = 16 * 48, I_O = 16 * 16, I_UP = 16 * 64, I_DN = 64 * 16, I_PL = 4 * 4;
    constexpr int NITEMS = 2 * I_QKV + 2 * I_O + 4 * I_UP + 4 * I_DN + 8 * I_PL;
    for (int it = gw; it < NITEMS; it += NGW) {
        int r = it;
        if (r < 2 * I_QKV) { const int a = r / I_QKV; transpose_item(A.in[11] + (size_t)a * D * 3072, D, 3072, (bf16*)(F.ws + WS_WQKV) + (size_t)a * 3072 * D, scr, r % I_QKV, F.lane, nullptr); continue; } r -= 2 * I_QKV;
        if (r < 2 * I_O) { const int a = r / I_O; transpose_item(A.in[17] + (size_t)a * D * D, D, D, (bf16*)(F.ws + WS_WO) + (size_t)a * D * D, scr, r % I_O, F.lane, nullptr); continue; } r -= 2 * I_O;
        if (r < 4 * I_UP) { const int i = r / I_UP; transpose_item(A.in[20] + (size_t)i * D * FF, D, FF, (bf16*)(F.ws + WS_WUP) + (size_t)i * D * FF, scr, r % I_UP, F.lane, nullptr); continue; } r -= 4 * I_UP;
        if (r < 4 * I_DN) { const int i = r / I_DN; transpose_item(A.in[21] + (size_t)i * D * FF, FF, D, (bf16*)(F.ws + WS_WDN) + (size_t)i * D * FF, scr, r % I_DN, F.lane, nullptr); continue; } r -= 4 * I_DN;
        { const int pg = r / I_PL; transpose_item(A.in[18] + (size_t)pg * 65536, 256, 256, (bf16*)(F.ws + WS_WPOOL) + (size_t)pg * 65536, scr, r % I_PL, F.lane, A.in[19] + pg * 256); }
    }
    for (int it0 = gw; it0 < 32768; it0 += 4 * NGW) {
        f32x4 v[4][4];
#pragma unroll
        for (int r4 = 0; r4 < 4; ++r4) { const int it = min(it0 + r4 * NGW, 32767); const int j = it & 1023, b = (it >> 10) & 7, kv = (it >> 13) & 1, a = it >> 14;
            const float* src = (kv ? A.in[3] : A.in[2]) + ((size_t)(a * 8 + b) * 1024 + j) * D;
#pragma unroll
            for (int q = 0; q < 4; ++q) v[r4][q] = *(const f32x4*)(src + 4 * F.lane + 256 * q); }
#pragma unroll
        for (int r4 = 0; r4 < 4; ++r4) { const int it = it0 + r4 * NGW; if (it < 32768) { const int j = it & 1023, b = (it >> 10) & 7, kv = (it >> 13) & 1, a = it >> 14;
            bf16* dst = (bf16*)(F.ws + (kv ? WS_VXS : WS_KXS)) + (size_t)a * KXS_LAYER + (size_t)(b * EXT_S + 16 + j) * D;
#pragma unroll
            for (int q = 0; q < 4; ++q) { u32x2 w; w.x = pk2(v[r4][q].x, v[r4][q].y); w.y = pk2(v[r4][q].z, v[r4][q].w); *(u32x2*)(dst + 4 * F.lane + 256 * q) = w; } } }
    }
    const float* g = A.in[7];
    for (int row = ROWS_VALID + gw; row < MPAD; row += NGW) { bf16* xn = (bf16*)(F.ws + WS_XN) + (size_t)row * D;
#pragma unroll
        for (int q = 0; q < 4; ++q) *(u32x2*)(xn + 4 * F.lane + 256 * q) = (u32x2){0u, 0u}; }
    const int RPC = (ROWS_VALID + F.G - 1) / F.G, rbeg = F.vcu * RPC, rend = min(rbeg + RPC, ROWS_VALID);
    for (int row0 = rbeg + F.wave; row0 < rend; row0 += 32) {
        f32x4 v[4][4]; float ss[4];
#pragma unroll
        for (int j = 0; j < 4; ++j) { const float* x = xin_row(A, min(row0 + j * 8, ROWS_VALID - 1)); ss[j] = 0.f;
#pragma unroll
            for (int q = 0; q < 4; ++q) v[j][q] = *(const f32x4*)(x + 4 * F.lane + 256 * q); }
#pragma unroll
        for (int j = 0; j < 4; ++j) {
#pragma unroll
            for (int q = 0; q < 4; ++q) ss[j] += v[j][q].x * v[j][q].x + v[j][q].y * v[j][q].y + v[j][q].z * v[j][q].z + v[j][q].w * v[j][q].w; }
#pragma unroll
        for (int o = 1; o < 64; o <<= 1) {
#pragma unroll
            for (int j = 0; j < 4; ++j) ss[j] += __shfl_xor(ss[j], o); }
#pragma unroll
        for (int j = 0; j < 4; ++j) { const int row = row0 + j * 8; const float r = 1.0f / sqrtf(ss[j] * (1.f / D) + EPS); bf16* xn = (bf16*)(F.ws + WS_XN) + (size_t)row * D;
#pragma unroll
            for (int q = 0; q < 4; ++q) { const f32x4 gg = *(const f32x4*)(g + 4 * F.lane + 256 * q); u32x2 w; w.x = pk2(v[j][q].x * r * gg.x, v[j][q].y * r * gg.y); w.y = pk2(v[j][q].z * r * gg.z, v[j][q].w * r * gg.w);
                if (row < rend) *(u32x2*)(xn + 4 * F.lane + 256 * q) = w; } }
    }
}
__device__ __forceinline__ void fin_phase(ArgsRef A, Frame& F, bool from_inputs, const int nks  , const float* gpost, const float* gnext) {
    { const int t_ = mk_tid(F.wave); F.tid = t_; F.lane = t_ & 63; }
    constexpr int FR = 4;
    const int gw = F.vcu * 8 + F.wave, NGW = F.G * 8;
    const bf16* YB = (const bf16*)(F.ws + WS_YB);
    const int lo4 = 4 * F.lane, lo8 = 8 * F.lane;
    const int RPC = (ROW_S + F.G - 1) / F.G, rbeg = F.vcu * RPC, rend = min(rbeg + RPC, ROW_S);
    f32x4 gp[4], gn[4];
#pragma unroll
    for (int q = 0; q < 4; ++q) { const int cq = lo8 + 4 * (q & 1) + 512 * (q >> 1); gp[q] = *(const f32x4*)(gpost + cq); gn[q] = gnext ? *(const f32x4*)(gnext + cq) : (f32x4){0.f, 0.f, 0.f, 0.f}; }
    for (int row0 = rbeg + F.wave; row0 < rend; row0 += 8 * FR) {
        f32x4 yv[FR][4], xv[FR][4]; float ss[FR];
#pragma unroll
        for (int j = 0; j < FR; ++j) { const int row = min(row0 + j * 8, ROWS_VALID - 1); const bf16* y = YB + (size_t)row * D; const float* xi = xin_row(A, row); const bf16* x16 = (const bf16*)(F.ws + WS_X16) + (size_t)row * D; ss[j] = 0.f;
#pragma unroll
            for (int h = 0; h < 2; ++h) { const u32x4 w = *(const u32x4*)(y + lo8 + 512 * h);
                yv[j][2 * h] = (f32x4){bflo(w.x), bfhi(w.x), bflo(w.y), bfhi(w.y)}; yv[j][2 * h + 1] = (f32x4){bflo(w.z), bfhi(w.z), bflo(w.w), bfhi(w.w)}; }
#pragma unroll
            for (int h = 0; h < 2; ++h) {
                if (from_inputs) { xv[j][2 * h] = *(const f32x4*)(xi + lo8 + 512 * h); xv[j][2 * h + 1] = *(const f32x4*)(xi + lo8 + 4 + 512 * h); }
                else { const u32x4 w = *(const u32x4*)(x16 + lo8 + 512 * h); xv[j][2 * h] = (f32x4){bflo(w.x), bfhi(w.x), bflo(w.y), bfhi(w.y)}; xv[j][2 * h + 1] = (f32x4){bflo(w.z), bfhi(w.z), bflo(w.w), bfhi(w.w)}; } } }
#pragma unroll
        for (int j = 0; j < FR; ++j) {
#pragma unroll
            for (int q = 0; q < 4; ++q) ss[j] += yv[j][q].x * yv[j][q].x + yv[j][q].y * yv[j][q].y + yv[j][q].z * yv[j][q].z + yv[j][q].w * yv[j][q].w; }
#pragma unroll
        for (int o = 1; o < 64; o <<= 1) {
#pragma unroll
            for (int j = 0; j < FR; ++j) ss[j] += __shfl_xor(ss[j], o); }
        float s2[FR];
#pragma unroll
        for (int j = 0; j < FR; ++j) { const int row = row0 + j * 8; const float r = 1.0f / sqrtf(ss[j] * (1.f / D) + EPS); s2[j] = 0.f;
#pragma unroll
            for (int q = 0; q < 4; ++q) { const int cq = lo8 + 4 * (q & 1) + 512 * (q >> 1); const f32x4 gg = gp[q]; xv[j][q] = xv[j][q] + yv[j][q] * r * gg;
                if (!gnext && row < rend) *(f32x4*)(xres_row(F, row) + cq) = xv[j][q];
                s2[j] += xv[j][q].x * xv[j][q].x + xv[j][q].y * xv[j][q].y + xv[j][q].z * xv[j][q].z + xv[j][q].w * xv[j][q].w; }
            if (gnext && row < rend) {
#pragma unroll
                for (int h = 0; h < 2; ++h) { const f32x4 a0 = xv[j][2 * h], a1 = xv[j][2 * h + 1]; u32x4 w; w.x = pk2(a0.x, a0.y); w.y = pk2(a0.z, a0.w); w.z = pk2(a1.x, a1.y); w.w = pk2(a1.z, a1.w);
                    *(u32x4*)((bf16*)(F.ws + WS_X16) + (size_t)row * D + lo8 + 512 * h) = w; } } }
        if (gnext) {
#pragma unroll
            for (int o = 1; o < 64; o <<= 1) {
#pragma unroll
                for (int j = 0; j < FR; ++j) s2[j] += __shfl_xor(s2[j], o); }
#pragma unroll
            for (int j = 0; j < FR; ++j) { const int row = row0 + j * 8; const float r2 = 1.0f / sqrtf(s2[j] * (1.f / D) + EPS); bf16* xn = (bf16*)(F.ws + WS_XN) + (size_t)row * D;
#pragma unroll
                for (int h = 0; h < 2; ++h) { const f32x4 g0 = gn[2 * h], g1 = gn[2 * h + 1]; const f32x4 a0 = xv[j][2 * h], a1 = xv[j][2 * h + 1];
                    u32x4 w; w.x = pk2(a0.x * r2 * g0.x, a0.y * r2 * g0.y); w.y = pk2(a0.z * r2 * g0.z, a0.w * r2 * g0.w); w.z = pk2(a1.x * r2 * g1.x, a1.y * r2 * g1.y); w.w = pk2(a1.z * r2 * g1.z, a1.w * r2 * g1.w);
                    if (row < rend) *(u32x4*)(xn + lo8 + 512 * h) = w; } }
        }
    }
    for (int row = ROW_S + gw; row < ROWS_VALID; row += NGW) {
        const float* xi = xin_row(A, row); float* xo = xres_row(F, row); bf16* x16 = (bf16*)(F.ws + WS_X16) + (size_t)row * D;
        f32x4 yv[4], xv[4]; float ss = 0.f;
#pragma unroll
        for (int q = 0; q < 4; ++q) {
            if (nks == 0) { const u32x2 w = *(const u32x2*)(YB + (size_t)row * D + lo4 + 256 * q); yv[q] = (f32x4){bflo(w.x), bfhi(w.x), bflo(w.y), bfhi(w.y)}; }
            else { const float* yf = (const float*)(F.ws + WS_YF) + (size_t)(row - ROW_S) * D + lo4 + 256 * q; f32x4 part[16];
#pragma unroll
                for (int k = 0; k < 16; ++k) part[k] = (k < nks) ? *(const f32x4*)(yf + (size_t)k * 768 * D) : (f32x4){0.f, 0.f, 0.f, 0.f};
                yv[q] = part[0];
#pragma unroll
                for (int k = 1; k < 16; ++k) yv[q] += part[k]; }
            if (from_inputs) xv[q] = *(const f32x4*)(xi + lo4 + 256 * q); else { const u32x2 xw = *(const u32x2*)(x16 + lo4 + 256 * q); xv[q] = (f32x4){bflo(xw.x), bfhi(xw.x), bflo(xw.y), bfhi(xw.y)}; }
            ss += yv[q].x * yv[q].x + yv[q].y * yv[q].y + yv[q].z * yv[q].z + yv[q].w * yv[q].w; }
        const float r = 1.0f / sqrtf(wave_sum(ss) * (1.f / D) + EPS); float s2 = 0.f;
#pragma unroll
        for (int q = 0; q < 4; ++q) { const f32x4 gg = *(const f32x4*)(gpost + lo4 + 256 * q); xv[q] = xv[q] + yv[q] * r * gg; if (!gnext) { if (row < ROW_M) *(f32x4*)(xo + lo4 + 256 * q) = xv[q]; } else { u32x2 xw; xw.x = pk2(xv[q].x, xv[q].y); xw.y = pk2(xv[q].z, xv[q].w); *(u32x2*)(x16 + lo4 + 256 * q) = xw; }
            s2 += xv[q].x * xv[q].x + xv[q].y * xv[q].y + xv[q].z * xv[q].z + xv[q].w * xv[q].w; }
        if (gnext) { const float r2 = 1.0f / sqrtf(wave_sum(s2) * (1.f / D) + EPS); bf16* xn = (bf16*)(F.ws + WS_XN) + (size_t)row * D;
#pragma unroll
            for (int q = 0; q < 4; ++q) { const f32x4 gg = *(const f32x4*)(gnext + lo4 + 256 * q); u32x2 w; w.x = pk2(xv[q].x * r2 * gg.x, xv[q].y * r2 * gg.y); w.y = pk2(xv[q].z * r2 * gg.z, xv[q].w * r2 * gg.w);
                *(u32x2*)(xn + lo4 + 256 * q) = w; } }
    }
}
__device__ __forceinline__ u32x4 pool_h8(ArgsRef A, const Frame& F, int grp, int b, int t, int col, int p) {
    const bf16* XN = (const bf16*)(F.ws + WS_XN);
    if (t >= 0) { const int row = grp == 0 ? b * 8192 + t : grp == 1 ? ROW_S + b * 64 + t : ROW_M + t; return *(const u32x4*)(XN + (size_t)row * D + col); }
    if (grp == 0) return *(const u32x4*)(XN + (size_t)(ROW_M + 16 + t) * D + col);
    if (grp == 1) { const float* s = A.in[4] + ((size_t)(p * 8 + b) * 15 + 15 + t) * D + col; const f32x4 a0 = *(const f32x4*)s, a1 = *(const f32x4*)(s + 4);
        u32x4 w; w.x = pk2(a0.x, a0.y); w.y = pk2(a0.z, a0.w); w.z = pk2(a1.x, a1.y); w.w = pk2(a1.z, a1.w); return w; }
    return (u32x4){0u, 0u, 0u, 0u};
}
__device__ __forceinline__ void pool_phase(ArgsRef A, Frame& F, int p) {
    { const int t_ = mk_tid(F.wave); F.tid = t_; F.lane = t_ & 63; }
    bf16* DB = (bf16*)(F.ws + WS_QB);
    const int col = 8 * (F.tid & 127), rgq = F.tid >> 7, w = 2 << (col >> 8);
    for (int it = F.vcu; it < 1033; it += F.G) {
        int grp, b, t0, nr;
        if (it < 1024) { grp = 0; b = it >> 7; t0 = (it & 127) * 64; nr = 64; } else if (it < 1032) { grp = 1; b = it - 1024; t0 = 0; nr = 64; } else { grp = 2; b = 0; t0 = 0; nr = 16; }
        const int tb = t0 + 16 * rgq;
        if (16 * rgq >= nr) continue;
        u32x4 h[31];
#pragma unroll
        for (int i = 0; i < 31; ++i) h[i] = pool_h8(A, F, grp, b, tb - 15 + i, col, p);
        float sum[8];
#pragma unroll
        for (int e = 0; e < 8; ++e) sum[e] = 0.f;
#pragma unroll
        for (int j = 1; j < 16; ++j) { const float k = (j < w) ? 1.f : 0.f; const u32x4 v = h[15 - j];
            sum[0] += k * bflo(v.x); sum[1] += k * bfhi(v.x); sum[2] += k * bflo(v.y); sum[3] += k * bfhi(v.y); sum[4] += k * bflo(v.z); sum[5] += k * bfhi(v.z); sum[6] += k * bflo(v.w); sum[7] += k * bfhi(v.w); }
#pragma unroll
        for (int i = 0; i < 16; ++i) { const int t = tb + i;
            const u32x4 cv = h[15 + i]; const float cur[8] = {bflo(cv.x), bfhi(cv.x), bflo(cv.y), bfhi(cv.y), bflo(cv.z), bfhi(cv.z), bflo(cv.w), bfhi(cv.w)};
            const float inv = 1.0f / (float)(grp == 2 ? min(t + 1, w) : w);
            float d[8];
#pragma unroll
            for (int e = 0; e < 8; ++e) { sum[e] += cur[e]; d[e] = sum[e] * inv - cur[e]; }
            const int row = grp == 0 ? b * 8192 + t : grp == 1 ? ROW_S + b * 64 + t : ROW_M + t;
            u32x4 o; o.x = pk2(d[0], d[1]); o.y = pk2(d[2], d[3]); o.z = pk2(d[4], d[5]); o.w = pk2(d[6], d[7]);
            *(u32x4*)(DB + (size_t)row * D + col) = o;
            const u32x4 a1 = h[15 + i - 1], a3 = h[15 + i - 3], a7 = h[15 + i - 7], a15 = h[15 + i - 15];
            u32x4 ov; ov.x = (w == 2) ? a1.x : (w == 4) ? a3.x : (w == 8) ? a7.x : a15.x; ov.y = (w == 2) ? a1.y : (w == 4) ? a3.y : (w == 8) ? a7.y : a15.y;
            ov.z = (w == 2) ? a1.z : (w == 4) ? a3.z : (w == 8) ? a7.z : a15.z; ov.w = (w == 2) ? a1.w : (w == 4) ? a3.w : (w == 8) ? a7.w : a15.w;
            sum[0] -= bflo(ov.x); sum[1] -= bfhi(ov.x); sum[2] -= bflo(ov.y); sum[3] -= bfhi(ov.y); sum[4] -= bflo(ov.z); sum[5] -= bfhi(ov.z); sum[6] -= bflo(ov.w); sum[7] -= bfhi(ov.w);
            float* tp = nullptr;
            if (grp == 0 && t >= 8177) tp = F.out + OFF_PP + ((size_t)(p * 8 + b) * 15 + (t - 8177)) * D + col;
            if (grp == 1 && t >= 49) tp = F.out + OFF_PS + ((size_t)(p * 8 + b) * 15 + (t - 49)) * D + col;
            if (tp) { *(f32x4*)tp = (f32x4){cur[0], cur[1], cur[2], cur[3]}; *(f32x4*)(tp + 4) = (f32x4){cur[4], cur[5], cur[6], cur[7]}; }
        }
    }
}

namespace att {
constexpr int KSTR = 272;
constexpr int TB = 16384;
constexpr int OFF_K0 = 0, OFF_K1 = TB, OFF_V0 = 2 * TB, OFF_V1 = 3 * TB, OFF_BT = 4 * TB, OFF_GT = OFF_BT + 2048, OFF_Q = 5 * TB, XB = 16384;
static_assert(OFF_BT >= 4 * XB && OFF_GT + 512 <= OFF_Q && OFF_Q + 2 * TB <= 131072, "attention LDS map");
constexpr float THR = 48.0f;
constexpr float NEG = -1e30f;
struct AUnit { const bf16* K; const bf16* V; const bf16* KM; const bf16* VM; const bf16* Q; bf16* O; int P, L, x, h; };
__device__ __forceinline__ float max3f(float a, float b, float c) { float r; asm("v_max3_f32 %0, %1, %2, %3" : "=v"(r) : "v"(a), "v"(b), "v"(c)); return r; }
__device__ __forceinline__ float swapmax(float v) { auto rr = __builtin_amdgcn_permlane32_swap(__float_as_uint(v), __float_as_uint(v), false, false); return fmaxf(__uint_as_float(rr[0]), __uint_as_float(rr[1])); }
__device__ __forceinline__ float swapsum(float v) { auto rr = __builtin_amdgcn_permlane32_swap(__float_as_uint(v), __float_as_uint(v), false, false); return __uint_as_float(rr[0]) + __uint_as_float(rr[1]); }
typedef __bf16 bf16x2_t __attribute__((ext_vector_type(2)));
__device__ __forceinline__ unsigned cvtpk(float lo, float hi) { f32x2 v = {lo, hi}; bf16x2_t b = __builtin_convertvector(v, bf16x2_t); return __builtin_bit_cast(unsigned, b); }
__device__ __forceinline__ s16x4 vtr(const LAS unsigned char* p) { return __builtin_bit_cast(s16x4, __builtin_amdgcn_ds_read_tr16_b64_v4i16((LAS s16x4*)p)); }
__device__ __forceinline__ void glds16(const void* gsrc, unsigned lds_dst) { unsigned keep;
    asm volatile("s_mov_b32 %0, m0\n\ts_mov_b32 m0, %2\n\ts_nop 0\n\tglobal_load_lds_dwordx4 %1, off\n\ts_mov_b32 m0, %0" : "=&s"(keep) : "v"(gsrc), "s"(lds_dst) : "memory"); }
__device__ __forceinline__ bf16x8 pack8(const f32x16& S, int o) {
    u32x4 w; w.x = cvtpk(S[o], S[o + 1]); w.y = cvtpk(S[o + 2], S[o + 3]); w.z = cvtpk(S[o + 4], S[o + 5]); w.w = cvtpk(S[o + 6], S[o + 7]); return __builtin_bit_cast(bf16x8, w);
}

__device__ __forceinline__ void attn_unit(const int wv, LAS unsigned char* lds, const AUnit& u, const float* lq1, const float* lk1, const float* lq2, const float* lk2, const int layer_a, const float* relb, const float* subg) {
    const int tid = mk_tid(wv), lane = tid & 63, wid = wv, mp = wid >> 2, rg = wid & 3, q32 = lane & 31, hi = lane >> 5;
    LAS float* BT = (LAS float*)(lds + OFF_BT); LAS float* GT = (LAS float*)(lds + OFF_GT);
    {
        const float b15 = relb[15 * 8 + u.h];
        if (tid < 448) { const int rel = tid - 192, n = rel < 0 ? -rel : rel;
            int bk = n < 8 ? n : n < 12 ? 8 : n < 16 ? 9 : n < 23 ? 10 : n < 32 ? 11 : n < 46 ? 12 : n < 64 ? 13 : n < 91 ? 14 : 15; if (rel > 0) bk += 16;
            BT[tid] = (relb[bk * 8 + u.h] - b15) * LOG2E; }
        if (tid >= 384) GT[tid - 384] = subg[tid - 384] * (layer_a == 0 ? 0.8f : 0.52928698f);
    }
    const int vrows = min(128, u.L - 128 * u.x);
    const bool active = rg * 32 < vrows;
    const int ch = rg >> 1;
    const int NTw = active ? (u.P + min((2 * u.x + ch + 1) * 64, u.L) + 48) >> 6 : 0;
    const int NT = (u.P + min((2 * u.x + 2) * 64, u.L) + 48) >> 6;
    const int eq0 = u.P + 128 * u.x + rg * 32, eq = eq0 + q32;
    const unsigned lds0 = (unsigned)(size_t)lds;
    unsigned goff[2];
#pragma unroll
    for (int j = 0; j < 2; ++j) { const int row = wid * 8 + 4 * j + (lane >> 4), x = ((row & 3) << 2) | ((row >> 2) & 3), c = (lane & 15) ^ x; goff[j] = (unsigned)(row * 1024 + u.h * 128 + c * 8); }
    const unsigned ldst = (unsigned)wid * 2048u;
#define ATT_DMA(base, bufoff) do { _Pragma("unroll") for (int j_ = 0; j_ < 2; ++j_) \
        glds16((base) + goff[j_], (unsigned)__builtin_amdgcn_readfirstlane((int)(lds0 + (unsigned)(bufoff) + ldst + j_ * 1024))); } while (0)
#define ATT_ISSUE_K(t, bufoff) do { const bf16* b_ = ((t) == 0 && wid < 2) ? u.KM : u.K + (size_t)(t) * 65536; ATT_DMA(b_, bufoff); } while (0)
#define ATT_ISSUE_V(t, bufoff) do { const bf16* b_ = ((t) == 0 && wid < 2) ? u.VM : u.V + (size_t)(t) * 65536; ATT_DMA(b_, bufoff); } while (0)
#define ATT_WAITBAR() do { asm volatile("s_waitcnt vmcnt(0) lgkmcnt(0)" ::: "memory"); __builtin_amdgcn_s_barrier(); asm volatile("" ::: "memory"); } while (0)
    unsigned koff[4];
    { const int x = ((q32 & 3) << 2) | ((q32 >> 2) & 3);
#pragma unroll
      for (int d0 = 0; d0 < 4; ++d0) koff[d0] = lds0 + (unsigned)(q32 * 256 + (((mp * 8 + 2 * d0 + hi) ^ x) << 4)); }
    unsigned vofs[4][2];
    { const int qq = (lane & 15) >> 2, cl = 2 * ((lane >> 4) & 1) + ((lane & 3) >> 1), sub = 8 * (lane & 1);
#pragma unroll
      for (int dvb = 0; dvb < 4; ++dvb)
#pragma unroll
          for (int hf = 0; hf < 2; ++hf) vofs[dvb][hf] = lds0 + (unsigned)((8 * hf + 4 * hi + qq) * 256 + ((((dvb ^ qq) << 2) | (cl ^ (2 * hf + hi))) << 4) + sub); }
    {
        const bf16* qb_ = u.Q + (size_t)(128 * u.x + wid * 16) * 1024;
#pragma unroll
        for (int j = 0; j < 4; ++j) { const int row = 4 * j + (lane >> 4), x = ((row & 3) << 2) | ((row >> 2) & 3), c = (lane & 15) ^ x;
            glds16(qb_ + row * 1024 + u.h * 128 + c * 8, (unsigned)__builtin_amdgcn_readfirstlane((int)(lds0 + OFF_Q + wid * 4096 + j * 1024))); }
    }
    ATT_ISSUE_K(0, OFF_K0); ATT_ISSUE_V(0, OFF_V0); if (NT > 1) ATT_ISSUE_K(1, OFF_K1);
    ATT_WAITBAR();
    f32x16 O[4];
#pragma unroll
    for (int i = 0; i < 4; ++i)
#pragma unroll
        for (int r = 0; r < 16; ++r) O[i][r] = 0.f;
    float m = 0.f, l = 0.f;
    f32x16 SA0, SA1, SB0, SB1;
    const f32x16 zero16 = {0.f, 0.f, 0.f, 0.f, 0.f, 0.f, 0.f, 0.f, 0.f, 0.f, 0.f, 0.f, 0.f, 0.f, 0.f, 0.f};
#define ATT_SB() __builtin_amdgcn_sched_barrier(0)
#define ATT_QK(S0_, S1_, kbufoff) do { unsigned qsh_ = (unsigned)(OFF_Q + rg * 8192); asm volatile("" : "+s"(qsh_));     \
        bf16x8 kfa[4], kfb[4], qfr[4]; \
        _Pragma("unroll") for (int d0 = 0; d0 < 4; ++d0) { kfa[d0] = *(const LAS bf16x8*)(size_t)(koff[d0] + (unsigned)(kbufoff)); kfb[d0] = *(const LAS bf16x8*)(size_t)(koff[d0] + (unsigned)(kbufoff) + 8192u); qfr[d0] = *(const LAS bf16x8*)(size_t)(koff[d0] + qsh_); } \
        ATT_SB(); \
        S0_ = __builtin_amdgcn_mfma_f32_32x32x16_bf16(kfa[0], qfr[0], zero16, 0, 0, 0); S1_ = __builtin_amdgcn_mfma_f32_32x32x16_bf16(kfb[0], qfr[0], zero16, 0, 0, 0); \
        _Pragma("unroll") for (int d0 = 1; d0 < 4; ++d0) { S0_ = __builtin_amdgcn_mfma_f32_32x32x16_bf16(kfa[d0], qfr[d0], S0_, 0, 0, 0); S1_ = __builtin_amdgcn_mfma_f32_32x32x16_bf16(kfb[d0], qfr[d0], S1_, 0, 0, 0); } } while (0)
#define ATT_VLD(bank, ks) do { _Pragma("unroll") for (int dvb = 0; dvb < 4; ++dvb) { bank[dvb][0] = vtr((const LAS unsigned char*)(size_t)(vofs[dvb][0] + vb_ + (unsigned)((ks) * 4096))); bank[dvb][1] = vtr((const LAS unsigned char*)(size_t)(vofs[dvb][1] + vb_ + (unsigned)((ks) * 4096))); } } while (0)
#define ATT_PV(bank, ks, C0, C1) do { const bf16x8 pb = pack8(((ks) < 2) ? C0 : C1, 8 * ((ks) & 1)); \
        _Pragma("unroll") for (int dvb = 0; dvb < 4; ++dvb) { const bf16x8 vf = (bf16x8){bank[dvb][0][0], bank[dvb][0][1], bank[dvb][0][2], bank[dvb][0][3], bank[dvb][1][0], bank[dvb][1][1], bank[dvb][1][2], bank[dvb][1][3]}; \
            O[dvb] = __builtin_amdgcn_mfma_f32_32x32x16_bf16(vf, pb, O[dvb], 0, 0, 0); } } while (0)
#define ATT_STEP(C0, C1, N0, N1, t_, PAR) do { const int t = (t_); constexpr int cur = (PAR); \
        if (t + 2 < NT) ATT_ISSUE_K(t + 2, cur ? OFF_K1 : OFF_K0); \
        if (t + 1 < NT) ATT_ISSUE_V(t + 1, cur ? OFF_V0 : OFF_V1); \
        { \
            const int k0 = t * 64; \
            if (k0 + 154 > eq0) { const LAS float* bt_ = BT + (k0 - eq + 192 + 4 * hi); \
                _Pragma("unroll") for (int r = 0; r < 16; ++r) { C0[r] += bt_[(r & 3) + 8 * (r >> 2)]; } \
                ATT_SB(); \
                _Pragma("unroll") for (int r = 0; r < 16; ++r) { C1[r] += bt_[32 + (r & 3) + 8 * (r >> 2)]; } } \
            if (t >= NTw - 1) { const bool all_ = t >= NTw; _Pragma("unroll") for (int r = 0; r < 16; ++r) { if (r >= 8 || all_) C0[r] = NEG; C1[r] = NEG; } } \
            if (__any(m != 0.f)) { _Pragma("unroll") for (int r = 0; r < 16; ++r) { C0[r] -= m; C1[r] -= m; } } \
            float mx = max3f(C0[0], C1[0], C0[1]), mx2 = max3f(C1[1], C0[2], C1[2]); \
            _Pragma("unroll") for (int r = 3; r < 15; r += 2) { mx = max3f(mx, C0[r], C1[r]); mx2 = max3f(mx2, C0[r + 1], C1[r + 1]); } \
            mx = max3f(mx, mx2, C0[15]); mx = fmaxf(mx, C1[15]); \
            mx = swapmax(mx); \
            if (__any(mx > THR || (t == 0 && mx < -THR))) { const float dl = (t == 0) ? mx : fmaxf(mx, 0.f); m += dl; const float f = (t == 0) ? 1.f : __builtin_amdgcn_exp2f(-dl); l *= f; \
                _Pragma("unroll") for (int r = 0; r < 16; ++r) { C0[r] -= dl; C1[r] -= dl; } \
                _Pragma("unroll") for (int i = 0; i < 4; ++i) _Pragma("unroll") for (int r = 0; r < 16; ++r) O[i][r] *= f; } \
        } \
        ATT_SB(); \
        if (t + 1 < NT) ATT_QK(N0, N1, cur ? OFF_K0 : OFF_K1); \
        ATT_SB(); \
        { \
            constexpr unsigned vb_ = (unsigned)(cur ? OFF_V1 : OFF_V0); \
            s16x4 vA[4][2], vB[4][2]; \
            ATT_VLD(vA, 0); \
            ATT_SB(); \
            float ls = 0.f; \
            _Pragma("unroll") for (int r = 0; r < 16; ++r) { C0[r] = __builtin_amdgcn_exp2f(C0[r]); C1[r] = __builtin_amdgcn_exp2f(C1[r]); ls += C0[r]; ls += C1[r]; } \
            l += ls; \
            ATT_SB(); \
            ATT_VLD(vB, 1); ATT_SB(); ATT_PV(vA, 0, C0, C1); ATT_SB(); \
            ATT_VLD(vA, 2); ATT_SB(); ATT_PV(vB, 1, C0, C1); ATT_SB(); \
            ATT_VLD(vB, 3); ATT_SB(); ATT_PV(vA, 2, C0, C1); ATT_SB(); \
            ATT_PV(vB, 3, C0, C1); \
        } \
        ATT_WAITBAR(); } while (0)
    ATT_QK(SA0, SA1, OFF_K0);
    ATT_WAITBAR();
    for (int tt = 0; tt < NT; tt += 2) { ATT_STEP(SA0, SA1, SB0, SB1, tt, 0); if (tt + 1 < NT) ATT_STEP(SB0, SB1, SA0, SA1, tt + 1, 1); }
#undef ATT_STEP
#undef ATT_QK
#undef ATT_VLD
#undef ATT_PV
#undef ATT_SB
#undef ATT_WAITBAR
#undef ATT_ISSUE_K
#undef ATT_ISSUE_V
#undef ATT_DMA
    const int tid2_ = mk_tid(wv);
    const int lane2 = tid2_ & 63, q32b = lane2 & 31, hib = lane2 >> 5;
    float lam;
    { float s1 = lq1[lane2] * lk1[lane2], s2 = lq2[lane2] * lk2[lane2]; s1 = wave_sum(s1); s2 = wave_sum(s2); lam = expf(s1) - expf(s2) + (layer_a == 0 ? 0.2f : 0.47071302f); }
    l = swapsum(l); const float inv = active ? 1.0f / l : 0.f;
    LAS float* xb = (LAS float*)(lds + rg * XB);
    if (mp == 1) { const float f = inv * lam;
#pragma unroll
        for (int i = 0; i < 4; ++i)
#pragma unroll
            for (int r = 0; r < 16; ++r) xb[(i * 16 + r) * 64 + lane2] = O[i][r] * f; }
    __syncthreads();
    if (mp == 0 && active) {
        float ss = 0.f;
#pragma unroll
        for (int i = 0; i < 4; ++i)
#pragma unroll
            for (int r = 0; r < 16; ++r) { const float o = O[i][r] * inv - xb[(i * 16 + r) * 64 + lane2]; O[i][r] = o; ss += o * o; }
        ss = swapsum(ss); const float rs = 1.0f / sqrtf(ss * (1.f / 128.f) + SUBLN_EPS);
        asm volatile("s_waitcnt lgkmcnt(0)" ::: "memory");
        LAS unsigned char* stg = (LAS unsigned char*)xb;
#pragma unroll
        for (int i = 0; i < 4; ++i)
#pragma unroll
            for (int r4 = 0; r4 < 4; ++r4) { const int dv0 = 32 * i + 8 * r4 + 4 * hib; const f32x4 gg = *(const LAS f32x4*)(GT + dv0);
                u32x2 w; w.x = cvtpk(O[i][4 * r4] * rs * gg.x, O[i][4 * r4 + 1] * rs * gg.y); w.y = cvtpk(O[i][4 * r4 + 2] * rs * gg.z, O[i][4 * r4 + 3] * rs * gg.w);
                *(LAS u32x2*)(stg + q32b * KSTR + dv0 * 2) = w; }
        asm volatile("s_waitcnt lgkmcnt(0)" ::: "memory");
        bf16* og = u.O + (size_t)(128 * u.x + rg * 32) * 1024 + u.h * 128;
#pragma unroll
        for (int i = 0; i < 8; ++i) { const int row = i * 4 + (lane2 >> 4), c16 = lane2 & 15; const u32x4 v = *(const LAS u32x4*)(stg + row * KSTR + c16 * 16);
            if (rg * 32 + row < vrows) *(u32x4*)(og + (size_t)row * 1024 + c16 * 8) = v; }
    }
    __syncthreads();
}
__device__ __forceinline__ void attn_phase(ArgsRef A, Frame& F, int a) {
    const bf16* QB = (const bf16*)(F.ws + WS_QB); bf16* OB = (bf16*)(F.ws + WS_XN); const bf16* KX = (const bf16*)(F.ws + WS_KX); const bf16* VX = (const bf16*)(F.ws + WS_VX);
    const bf16* KXS = (const bf16*)(F.ws + WS_KXS) + (size_t)a * KXS_LAYER; const bf16* VXS = (const bf16*)(F.ws + WS_VXS) + (size_t)a * KXS_LAYER;
    { const int gt = blockIdx.x * 512 + mk_tid(F.wave);
      for (int i = gt; i < 65536; i += F.G * 512) { const int c4 = i & 255, r = (i >> 8) & 15, b = (i >> 12) & 7, kv = i >> 15;
          const f32x4 v = *(const f32x4*)((const float*)(F.ws + (kv ? WS_MFV : WS_MFK)) + r * 1024 + c4 * 4);
          *(f32x4*)(F.out + (kv ? OFF_VP : OFF_KP) + (size_t)a * 8 * EXT_P * 1024 + (size_t)(b * EXT_P + r) * 1024 + c4 * 4) = v; } }
    for (int n = F.vcu; n < 4168; n += F.G) {
        AUnit u; u.KM = (const bf16*)(F.ws + WS_KXM); u.VM = (const bf16*)(F.ws + WS_VXM);
        if (n < 4096) { const int i = n >> 8, v = n & 255, c = v & 31, bh = (v >> 5) * 8 + (i >> 1); const int x = (i & 1) ? 63 - c : c; const int b = bh >> 3;
            u.K = KX + (size_t)b * EXT_P * 1024; u.V = VX + (size_t)b * EXT_P * 1024; u.Q = QB + (size_t)b * 8192 * 1024; u.O = OB + (size_t)b * 8192 * 1024; u.P = 16; u.L = 8192; u.x = x; u.h = bh & 7; }
        else if (n < 4160) { const int j = n - 4096, b = j >> 3; u.K = KXS + (size_t)b * EXT_S * 1024; u.V = VXS + (size_t)b * EXT_S * 1024; u.Q = QB + (size_t)(ROW_S + b * 64) * 1024; u.O = OB + (size_t)(ROW_S + b * 64) * 1024; u.P = 1040; u.L = 64; u.x = 0; u.h = j & 7; }
        else { u.K = (const bf16*)(F.ws + WS_KXM); u.V = (const bf16*)(F.ws + WS_VXM); u.Q = QB + (size_t)ROW_M * 1024; u.O = OB + (size_t)ROW_M * 1024; u.P = 0; u.L = 16; u.x = 0; u.h = n - 4160; }
        attn_unit(F.wave, F.lds, u, A.in[12] + a * 64, A.in[13] + a * 64, A.in[14] + a * 64, A.in[15] + a * 64, a, A.in[6], A.in[16] + a * 128);
    }
}
}

#define XB_TMO      128
#define XB_XCNT(j)  (256  + 64 * (j))
#define XB_XSUB(j)  (1280 + 64 * (j))
#define XB_XGEN(j)  (2304 + 64 * (j))
#define XB_TOP      3328
#define XB_TOPGEN   3392
#define XCD_BAR_WORDS 3456
#define XB_SPIN_CAP (1u << 18)

__device__ __forceinline__ unsigned xb_ld(unsigned* p)              { return __hip_atomic_load(p, __ATOMIC_RELAXED, __HIP_MEMORY_SCOPE_AGENT); }
__device__ __forceinline__ unsigned xb_add(unsigned* p, unsigned v) { return __hip_atomic_fetch_add(p, v, __ATOMIC_RELAXED, __HIP_MEMORY_SCOPE_AGENT); }
__device__ __forceinline__ unsigned xb_xcc_id() { return (unsigned)__builtin_amdgcn_s_getreg((3 << 11) | 20) & 0xFu; }
#define XB_SPIN(cond, bar) do { unsigned _sp = 0; while (cond) { __builtin_amdgcn_s_sleep(1); \
    if ((++_sp & 255u) == 0u) { if (xb_ld(&(bar)[XB_TMO])) break; if (_sp > XB_SPIN_CAP) { atomicAdd(&(bar)[XB_TMO], 1u); break; } } } } while (0)

struct XcdBarrier {
    bool leader; unsigned* bar; unsigned x;
    volatile LAS unsigned* st;
};

__device__ __forceinline__ XcdBarrier xcd_barrier_post(unsigned* bar, volatile LAS unsigned* st) {
    XcdBarrier b; b.bar = bar; b.x = xb_xcc_id(); b.st = st;
    b.leader = (threadIdx.x == 0);
    if (b.leader) (void)xb_add(&bar[XB_XCNT(b.x)], 1u);
    return b;
}
__device__ __forceinline__ void xcd_barrier_complete(unsigned* bar, unsigned x, unsigned& nloc, unsigned& nx) {
    const unsigned G = gridDim.x * gridDim.y * gridDim.z;
    unsigned sum, cnt, mine, sp = 0u;
    for (;;) {
        sum = 0u; cnt = 0u; mine = 0u;
#pragma unroll
        for (unsigned j = 0; j < 16; ++j) { const unsigned c = xb_ld(&bar[XB_XCNT(j)]); sum += c; cnt += (c > 0u) ? 1u : 0u; mine = (j == x) ? c : mine; }
        if (sum == G) break;
        __builtin_amdgcn_s_sleep(1);
        if ((++sp & 255u) == 0u) { if (xb_ld(&bar[XB_TMO])) break; if (sp > XB_SPIN_CAP) { atomicAdd(&bar[XB_TMO], 1u); break; } }
    }
    nloc = mine > 0u ? mine : 1u; nx = cnt > 0u ? cnt : 1u;
}

__device__ __forceinline__ void xcd_barrier(const XcdBarrier& b) {
    asm volatile("s_waitcnt vmcnt(0)" ::: "memory");
    __syncthreads();
    if (b.leader) {
        unsigned* bar = b.bar;
        __builtin_amdgcn_s_waitcnt(0);
        unsigned nloc = b.st[0], nx = b.st[1];
        if (nloc == 0u) { xcd_barrier_complete(bar, b.x, nloc, nx); b.st[0] = nloc; b.st[1] = nx; }
        const unsigned old = xb_add(&bar[XB_XSUB(b.x)], 1u);
        const unsigned gen = old / nloc;
        if (old + 1u == (gen + 1u) * nloc) {
            __builtin_amdgcn_fence(__ATOMIC_RELEASE, "agent");
            asm volatile("s_waitcnt vmcnt(0)" ::: "memory");
            const unsigned og = xb_add(&bar[XB_TOP], 1u);
            const unsigned tg = og / nx;
            if (og + 1u == (tg + 1u) * nx) xb_add(&bar[XB_TOPGEN], 1u);
            else XB_SPIN(xb_ld(&bar[XB_TOPGEN]) == tg, bar);
            __builtin_amdgcn_fence(__ATOMIC_ACQUIRE, "agent");
            xb_add(&bar[XB_XGEN(b.x)], 1u);
            asm volatile("s_waitcnt vmcnt(0)" ::: "memory");
        } else {
            XB_SPIN(xb_ld(&bar[XB_XGEN(b.x)]) == gen, bar);
            __builtin_amdgcn_fence(__ATOMIC_ACQUIRE, "agent");
            asm volatile("s_waitcnt vmcnt(0)" ::: "memory");
        }
    }
    __syncthreads();
}

__device__ __forceinline__ void run_step(ArgsRef args, const int step, const int wv) {
    extern __shared__ __attribute__((aligned(16))) unsigned char lds_raw[];
    Frame F;
    F.lds = (LAS unsigned char*)lds_raw; F.tid = 0; F.lane = 0; F.wave = wv;
    F.G = gridDim.x; { const int bx = blockIdx.x; F.vcu = (F.G % 8 == 0) ? (bx % 8) * (F.G / 8) + bx / 8 : bx; }
    F.out = args.out; F.ws = args.ws;
    bf16* XN = (bf16*)(F.ws + WS_XN); bf16* QB = (bf16*)(F.ws + WS_QB); bf16* YB = (bf16*)(F.ws + WS_YB); bf16* U = (bf16*)(F.ws + WS_U);
    int layer = 0, k = -1;
    if (step > 0) { const int s = step - 1; if (s < 7) { layer = 0; k = s; } else if (s < 13) { layer = 1; k = s - 7; } else if (s < 20) { layer = 2; k = s - 13; } else { layer = 3; k = s - 20; } }
    const bool attn = (layer & 1) == 0; const int a = layer >> 1;
    int type;
    if (step == 0) type = 0; else if (attn) type = k == 0 ? 1 : k == 1 ? 2 : k == 2 ? 4 : k == 3 ? 5 : k == 4 ? 6 : k == 5 ? 7 : 8;
    else type = k == 0 ? 3 : k == 1 ? 4 : k == 2 ? 5 : k == 3 ? 6 : k == 4 ? 7 : 8;
    if (type == 0) prologue(args, F);
    else if (type == 1) {
        pg8::Gemm g{XN, (const bf16*)(F.ws + WS_WQKV) + (size_t)a * 3072 * D, MPAD, 3072, D, D, D, 0}; pg8::StaticOrder S; S.init(MPAD, 3072, F.G, (int)blockIdx.x, D);
        pg8::EpiQKV E{F.ws, F.out, a};
        pg8::gemm_phase<pg8::EpiQKV, pg8::StaticOrder, true, true>(F.lds, g, S, E, mk_tid(F.wave));
    } else if (type == 2) { att::attn_phase(args, F, a); }
    else if (type == 3) { pool_phase(args, F, a); }
    else if (type == 4 || type == 7) {
        pg8::Gemm g;
        if (type == 7) g = pg8::Gemm{U, (const bf16*)(F.ws + WS_WDN) + (size_t)layer * D * FF, MPAD, D, FF, FF, FF, 0};
        else if (attn) g = pg8::Gemm{XN, (const bf16*)(F.ws + WS_WO) + (size_t)a * D * D, MPAD, D, D, D, D, 0};
        else g = pg8::Gemm{QB, (const bf16*)(F.ws + WS_WPOOL) + (size_t)a * 4 * 65536, MPAD, D, 256, D, 256, 512};
        pg8::TailOrder S; S.init(D, F.G, (int)blockIdx.x, g.K, type == 7 ? 16 : (attn ? 4 : 1));
        pg8::EpiBf16<0> E{YB, D, (float*)(F.ws + WS_YF)};
        pg8::gemm_phase<pg8::EpiBf16<0>, pg8::TailOrder, true, true>(F.lds, g, S, E, mk_tid(F.wave));
    } else if (type == 5) { fin_phase(args, F, layer == 0, attn ? 4 : 0, args.in[8] + layer * D, args.in[9] + layer * D); }
    else if (type == 6) {
        pg8::Gemm g{XN, (const bf16*)(F.ws + WS_WUP) + (size_t)layer * D * FF, MPAD, FF, D, D, D, 0}; pg8::StaticOrder S; S.init(MPAD, FF, F.G, (int)blockIdx.x, D);
        pg8::EpiBf16<2> E{U, FF, nullptr};
        pg8::gemm_phase<pg8::EpiBf16<2>, pg8::StaticOrder, true, true>(F.lds, g, S, E, mk_tid(F.wave));
    } else { fin_phase(args, F, false, 16, args.in[10] + layer * D, layer < 3 ? args.in[7] + (layer + 1) * D : nullptr); }
}
__global__ void __launch_bounds__(512, 2) fwd_kernel(Args args_) {
    const int lo = args_.lo, hi = args_.hi;
    const int wv = __builtin_amdgcn_readfirstlane((int)threadIdx.x >> 6);
    extern __shared__ __attribute__((aligned(16))) unsigned char lds_raw[];
    volatile LAS unsigned* bst = (volatile LAS unsigned*)((LAS unsigned char*)lds_raw + 139264);
    if (threadIdx.x < 2) bst[threadIdx.x] = 0u;
    __syncthreads();
    XcdBarrier bar = xcd_barrier_post((unsigned*)args_.ws + 4096, bst);
    int probe_rep = 0; (void)probe_rep;
    for (int step = lo; step < hi; ++step) {
        const __attribute__((address_space(4))) Args* ap = (const __attribute__((address_space(4))) Args*)__builtin_amdgcn_kernarg_segment_ptr();
        asm volatile("" : "+s"(ap));
        run_step(*ap, step, wv);
#if defined(PROBE_MASK)
        {
            int ty = 0; if (step > 0) { const int s = step - 1; const int k = s < 7 ? s : s < 13 ? s - 7 : s < 20 ? s - 13 : s - 20; const bool at = (s < 7) || (s >= 13 && s < 20);
                ty = at ? (k == 0 ? 1 : k == 1 ? 2 : k == 2 ? 4 : k == 3 ? 5 : k == 4 ? 6 : k == 5 ? 7 : 8) : (k == 0 ? 3 : k == 1 ? 4 : k == 2 ? 5 : k == 3 ? 6 : k == 4 ? 7 : 8); }
            if (((PROBE_MASK >> ty) & 1) && !probe_rep) { probe_rep = 1; --step; __syncthreads(); continue; }
            probe_rep = 0; }
#endif
        if (step + 1 < hi) { if (lo < 0) { __threadfence(); cg::this_grid().sync(); }
            else { xcd_barrier(bar);
#if defined(PROBE_BAR2)
 xcd_barrier(bar);
#endif
 } }
    }
}

extern "C" void kernel_launch(void* const* d_in, const int* in_sizes, int n_in, void* d_out, int out_size, void* d_ws, size_t ws_size, hipStream_t stream) {
    static int grid = 0;
    if (grid == 0) {
        if (n_in != 22 || (size_t)out_size != OUT_TOTAL || ws_size < WS_END) { fprintf(stderr, "kernel_launch: unexpected shapes n_in %d out %d ws %zu\n", n_in, out_size, ws_size); grid = -1; return; }
        int dev = 0, cus = 0, per_cu = 0;
        hipGetDevice(&dev); hipDeviceGetAttribute(&cus, hipDeviceAttributeMultiprocessorCount, dev);
        hipFuncSetAttribute((const void*)fwd_kernel, hipFuncAttributeMaxDynamicSharedMemorySize, LDS_BYTES);
        hipOccupancyMaxActiveBlocksPerMultiprocessor(&per_cu, (const void*)fwd_kernel, 512, LDS_BYTES);
        if (per_cu < 1) { fprintf(stderr, "kernel_launch: occupancy query says %d blocks/CU\n", per_cu); per_cu = 1; }
        (void)hipGetLastError();
        grid = cus;
    }
    if (grid < 0) return;
    if (hipMemsetAsync(d_ws, 0, 65536, stream) != hipSuccess) { fprintf(stderr, "kernel_launch: memset failed\n"); return; }
    Args a{};
    for (int i = 0; i < 22; ++i) a.in[i] = (const float*)d_in[i];
    a.out = (float*)d_out; a.ws = (unsigned char*)d_ws;
#if ONE_LAUNCH
    a.lo = 0; a.hi = NSTEPS;
    void* kargs[] = {&a};
    hipError_t e = hipLaunchCooperativeKernel((const void*)fwd_kernel, dim3(grid), dim3(512), kargs, LDS_BYTES, stream);
    if (e != hipSuccess) fprintf(stderr, "cooperative launch failed: %s (grid %d)\n", hipGetErrorString(e), grid);
#else
    for (int s = 0; s < NSTEPS; ++s) { a.lo = s; a.hi = s + 1; hipLaunchKernelGGL(fwd_kernel, dim3(grid), dim3(512), LDS_BYTES, stream, a); }
#endif
}
static_assert(WS_QB == 213 * MiB && WS_KX == 473 * MiB && WS_VX == 602 * MiB && WS_KXS == 731 * MiB && WS_VXS == 767 * MiB && WS_KXM == 803 * MiB && WS_VXM == 804 * MiB && KXS_LAYER == 9 * MiB && WS_MFK == 1323 * MiB && WS_MFV == 1324 * MiB, "EpiQKV hard-coded map");
static_assert(OFF_KP == 67633152 && OFF_VP == 202113024 && OFF_KS == 336838656 && OFF_VS == 337887232, "EpiQKV hard-coded output offsets");
```

```cpp
#include <hip/hip_runtime.h>
#include <hip/hip_cooperative_groups.h>
#include <hip/hip_bf16.h>
#include <cstdio>
#include <cstdint>
namespace cg = cooperative_groups;
namespace pg8 {
#define PG8_LAS __attribute__((address_space(3)))
typedef unsigned short bf16_t;
typedef short bf16x8 __attribute__((ext_vector_type(8)));
typedef float f32x4 __attribute__((ext_vector_type(4)));
typedef unsigned u32x4 __attribute__((ext_vector_type(4)));
constexpr int BM = 256, BK = 64, HALF = 128, HTB = HALF * BK * 2  , STAGE_BYTES = 8 * HTB, NXCD = 8, WGM = 4;

__host__ __device__ __forceinline__ int lds_byte(int r, int c) { const int st = (r >> 4) * 2 + (c >> 5), rr = r & 15, cc = c & 31, ob = rr * 64 + cc * 2; return st * 1024 + (ob ^ (((ob >> 9) & 1) << 5)); }
__host__ __device__ __forceinline__ void stage_rc(int b, int& R, int& C) { const int st = b / 1024, sb = b % 1024, swz = sb ^ (((sb >> 9) & 1) << 5); R = (st >> 1) * 16 + swz / 64; C = (st & 1) * 32 + (swz % 64) / 2; }
__host__ __device__ __forceinline__ int perm32(int rho) { const int n = rho >> 4, i = rho & 15; return 8 * (i >> 2) + 4 * n + (i & 3); }

struct Unit { int pm, pn, ko, nt, sp; };
struct Gemm { const bf16_t* A; const bf16_t* Bt; int M, N, K, lda, ldb, acs; };

struct StaticOrder {
    int nM, nN, nwg, G, c, ntf;
    __host__ __device__ void init(int M, int N, int G_, int c_, int K) { nM = M / BM; nN = N / BM; nwg = nM * nN; G = G_; c = c_; ntf = K / BK; }
    __host__ __device__ bool next(int i, Unit& u) const {
        const long L = (long)i * G + c; if (L >= nwg) return false;
        int wgid = (int)L; { const int q = nwg / NXCD, r = nwg % NXCD, xcd = wgid % NXCD, off = wgid / NXCD; wgid = (xcd < r ? xcd * (q + 1) : r * (q + 1) + (xcd - r) * q) + off; }
        const int nig = WGM * nN, gid = wgid / nig, fm = gid * WGM, gsz = (nM - fm) < WGM ? (nM - fm) : WGM;
        u.pm = fm + ((wgid % nig) % gsz); u.pn = (wgid % nig) / gsz; u.ko = 0; u.nt = ntf; u.sp = 0; return true;
    }
    __device__ __forceinline__ void a_ready(const Unit&) const {}
    __device__ __forceinline__ void done(const Unit&) const {}
};
struct TailOrder {
    StaticOrder mn; int KS, kc;
    __host__ __device__ void init(int N, int G_, int c_, int K, int KS_) { mn.init(65536, N, G_, c_, K); KS = KS_; kc = K / KS_; }
    __host__ __device__ bool next(int i, Unit& u) const {
        const long L = (long)i * mn.G + mn.c; if (L < mn.nwg) return mn.next(i, u);
        const int Lt = (int)(L - mn.nwg); if (Lt >= 3 * mn.nN * KS) return false;
        const int tile = Lt / KS, ks = Lt - tile * KS; u.pm = 256 + tile / mn.nN; u.pn = tile % mn.nN; u.ko = ks * kc; u.nt = kc / BK; u.sp = KS > 1 ? ks + 1 : 0; return true;
    }
    __device__ __forceinline__ void a_ready(const Unit&) const {}
    __device__ __forceinline__ void done(const Unit&) const {}
};

__device__ __forceinline__ unsigned cvt_pk_bf16(float lo, float hi) { unsigned r; asm volatile("v_cvt_pk_bf16_f32 %0, %1, %2" : "=v"(r) : "v"(lo), "v"(hi)); return r; }
template <int ACT  > struct EpiBf16 {
    static constexpr bool PERM = true, AFTER_DRAIN = false;
    bf16_t* O; int ldc; float* yf;
    __device__ __forceinline__ void operator()(const f32x4 (&acc)[2][2][4][2], const Unit& u, int wr, int wc, int fr, int fq) const {
        asm volatile("" : "+v"(fr), "+v"(fq));
        const int row0 = u.pm * BM + wr * 64 + fr; const int col0 = u.pn * BM + wc * 32 + 8 * fq;
#pragma unroll
        for (int ai = 0; ai < 2; ++ai)
#pragma unroll
            for (int m = 0; m < 4; ++m) { bf16_t* rowp = O + (size_t)(row0 + ai * HALF + m * 16) * ldc + col0;
#pragma unroll
                for (int bj = 0; bj < 2; ++bj) { f32x4 v0 = acc[ai][bj][m][0], v1 = acc[ai][bj][m][1];
                    if (ACT == 2) {
#pragma unroll
                        for (int e = 0; e < 4; ++e) { float a = fmaxf(v0[e], 0.f), b = fmaxf(v1[e], 0.f); v0[e] = a * a; v1[e] = b * b; } }
                    if (u.sp) { float* yr = yf + ((size_t)(u.sp - 1) * 768 + (size_t)(row0 + ai * HALF + m * 16 - 65536)) * 1024 + col0 + bj * HALF;
                        *(f32x4*)yr = v0; *(f32x4*)(yr + 4) = v1; }
                    else { u32x4 w; w.x = cvt_pk_bf16(v0[0], v0[1]); w.y = cvt_pk_bf16(v0[2], v0[3]); w.z = cvt_pk_bf16(v1[0], v1[1]); w.w = cvt_pk_bf16(v1[2], v1[3]);
                    *(u32x4*)(rowp + bj * HALF) = w; } } }
    }
};
struct EpiQKV {
    static constexpr bool PERM = true, AFTER_DRAIN = false;
    unsigned char* ws; float* out; int a;
    __device__ __forceinline__ void operator()(const f32x4 (&acc)[2][2][4][2], const Unit& u, int wr, int wc, int fr, int fq) const {
        const size_t MiB_ = 1u << 20;
        asm volatile("" : "+v"(fr), "+v"(fq));
        const int t3 = u.pn >> 2; const int colb = (u.pn & 3) * 256 + wc * 32 + 8 * fq;
        bf16_t* X; float* Fp = nullptr; int rbase, jump = 0, s0 = 0; float sc = 1.f;
        if (t3 == 0) { X = (bf16_t*)(ws + 213 * MiB_); rbase = u.pm * BM; sc = 0.125f * 1.4426950408889634f; }
        else if (u.pm < 256) { const int b = u.pm >> 5; rbase = b * 8208 + 16 + (u.pm & 31) * 256; X = (bf16_t*)(ws + (t3 == 1 ? 473 : 602) * MiB_);
            Fp = out + (t3 == 1 ? (size_t)67633152 : (size_t)202113024) + (size_t)a * 8 * 8208 * 1024 + (size_t)rbase * 1024; }
        else if (u.pm < 258) { s0 = (u.pm - 256) * 256; rbase = 1040 + s0; jump = 1040; X = (bf16_t*)(ws + (t3 == 1 ? 731 : 767) * MiB_) + (size_t)a * (9 * MiB_);
            Fp = out + (t3 == 1 ? (size_t)336838656 : (size_t)337887232) + (size_t)a * 512 * 1024 + (size_t)s0 * 1024; }
        else { rbase = 0; X = (bf16_t*)(ws + (t3 == 1 ? 803 : 804) * MiB_); Fp = (float*)(ws + (t3 == 1 ? 1323 : 1324) * MiB_); }
#pragma unroll
        for (int ai = 0; ai < 2; ++ai)
#pragma unroll
            for (int m = 0; m < 4; ++m) { const int rit = ai * HALF + wr * 64 + m * 16 + fr;
                bf16_t* xr = X + (unsigned)((rbase + rit + ((s0 + rit) >> 6) * jump) * 1024 + colb); float* fr_ = Fp + (unsigned)(rit * 1024 + colb);
#pragma unroll
                for (int bj = 0; bj < 2; ++bj) { const f32x4 v0 = acc[ai][bj][m][0], v1 = acc[ai][bj][m][1]; const f32x4 s0v = v0 * sc, s1v = v1 * sc;
                    u32x4 w; w.x = cvt_pk_bf16(s0v[0], s0v[1]); w.y = cvt_pk_bf16(s0v[2], s0v[3]); w.z = cvt_pk_bf16(s1v[0], s1v[1]); w.w = cvt_pk_bf16(s1v[2], s1v[3]);
                    *(u32x4*)(xr + bj * HALF) = w;
                    if (t3 != 0) { *(f32x4*)(fr_ + bj * HALF) = v0; *(f32x4*)(fr_ + bj * HALF + 4) = v1; } } }
    }
};
template <class Epi, class Sched, bool ALIGN_EPI = false, bool SP2 = false>
__device__ __forceinline__ void gemm_phase(PG8_LAS unsigned char* lds, const Gemm g, const Sched& S, const Epi& E, const int tid_in) {
    int tid_ = tid_in; asm volatile("" : "+v"(tid_));
    const int tid = tid_, wid = __builtin_amdgcn_readfirstlane(tid >> 6), lane = tid & 63, wr = wid >> 2, wc = wid & 3, fr = lane & 15, fq = lane >> 4;
    const int K = g.K; (void)K;
    unsigned voffA[2], voffB[2];
#pragma unroll
    for (int i = 0; i < 2; ++i) { int R, C; stage_rc(tid * 16 + i * 8192, R, C); const int Rb = Epi::PERM ? ((R & ~31) + perm32(R & 31)) : R;
        voffA[i] = (unsigned)(R * g.lda + C) * 2u; voffB[i] = (unsigned)(Rb * g.ldb + C) * 2u; }
    const size_t kstep = (size_t)(BK * 2);
    const size_t hstepA = (size_t)HALF * g.lda * 2, hstepB = (size_t)HALF * g.ldb * 2;
    const size_t tstepA = 2 * hstepA, tstepB = 2 * hstepB;
    const unsigned ldsw = (unsigned)wid * 1024u;
    const int aoff = lds_byte(wr * 64 + fr, fq * 8), boff = lds_byte(wc * 32 + fr, fq * 8);
#define PG8_SA(b, h) (((b) * 2 + (h)) * HTB)
#define PG8_SB(b, h) ((4 + (b) * 2 + (h)) * HTB)
#define PG8_STAGE(bufoff, gbase, voff) do { _Pragma("unroll") for (int _i = 0; _i < 2; ++_i) \
        __builtin_amdgcn_global_load_lds((const unsigned*)((const char*)(gbase) + (voff)[_i]), (PG8_LAS unsigned*)(lds + (bufoff) + ldsw + _i * 8192), 16, 0, 0); } while (0)
#define PG8_LDA(dst, b, h) do { _Pragma("unroll") for (int m = 0; m < 4; ++m) _Pragma("unroll") for (int k = 0; k < 2; ++k) dst[m][k] = *(const PG8_LAS bf16x8*)(lds + PG8_SA(b, h) + aoff + m * 2048 + k * 1024); } while (0)
#define PG8_LDB(dst, b, h) do { _Pragma("unroll") for (int n = 0; n < 2; ++n) _Pragma("unroll") for (int k = 0; k < 2; ++k) dst[n][k] = *(const PG8_LAS bf16x8*)(lds + PG8_SB(b, h) + boff + n * 2048 + k * 1024); } while (0)
#define PG8_MMA(ai, bj, At, Bt) do { __builtin_amdgcn_s_setprio(1); _Pragma("unroll") for (int m = 0; m < 4; ++m) _Pragma("unroll") for (int n = 0; n < 2; ++n) _Pragma("unroll") for (int k = 0; k < 2; ++k) \
        acc[ai][bj][m][n] = __builtin_amdgcn_mfma_f32_16x16x32_bf16(Bt[n][k], At[m][k], acc[ai][bj][m][n], 0, 0, 0); __builtin_amdgcn_s_setprio(0); } while (0)
#define PG8_WAIT_V(n) asm volatile("s_waitcnt vmcnt(" #n ")" ::: "memory")
#define PG8_WAIT_L(n) asm volatile("s_waitcnt lgkmcnt(" #n ")" ::: "memory")
#define PG8_BAR __builtin_amdgcn_s_barrier()
#define PG8_SCHED __builtin_amdgcn_sched_barrier(0)
    Unit cur, nxt; int ui = 0;
    if (!S.next(0, cur)) return;
    f32x4 acc[2][2][4][2];
#pragma unroll
    for (int a = 0; a < 2; ++a)
#pragma unroll
        for (int b = 0; b < 2; ++b)
#pragma unroll
            for (int m = 0; m < 4; ++m)
#pragma unroll
                for (int n = 0; n < 2; ++n) acc[a][b][m][n] = (f32x4){0.f, 0.f, 0.f, 0.f};
    bf16x8 At[4][2], B0[2][2], B1[2][2];
    const char* cA = (const char*)g.A + (size_t)cur.pm * tstepA + (size_t)cur.pn * g.acs + (size_t)cur.ko * 2; const char* cB = (const char*)g.Bt + (size_t)cur.pn * tstepB + (size_t)cur.ko * 2;
    S.a_ready(cur);
    if constexpr (SP2) {
        PG8_STAGE(PG8_SB(0, 0), cB, voffB); PG8_STAGE(PG8_SB(0, 1), cB + hstepB, voffB); PG8_STAGE(PG8_SA(0, 0), cA, voffA); PG8_STAGE(PG8_SA(0, 1), cA + hstepA, voffA);
        if (wr == 1) PG8_BAR;
        PG8_WAIT_V(2); PG8_BAR;
        PG8_STAGE(PG8_SB(1, 0), cB + kstep, voffB); PG8_STAGE(PG8_SA(1, 0), cA + kstep, voffA); PG8_STAGE(PG8_SB(1, 1), cB + hstepB + kstep, voffB);
        PG8_WAIT_V(6); PG8_BAR;
    } else {
        PG8_STAGE(PG8_SB(0, 0), cB, voffB); PG8_STAGE(PG8_SA(0, 0), cA, voffA); PG8_STAGE(PG8_SB(0, 1), cB + hstepB, voffB); PG8_STAGE(PG8_SA(0, 1), cA + hstepA, voffA);
        if (wr == 1) PG8_BAR;
        PG8_WAIT_V(4); PG8_BAR;
        PG8_STAGE(PG8_SB(1, 0), cB + kstep, voffB); PG8_STAGE(PG8_SA(1, 0), cA + kstep, voffA); PG8_STAGE(PG8_SB(1, 1), cB + hstepB + kstep, voffB);
        PG8_WAIT_V(6); PG8_BAR;
    }
    for (;;) {
        const bool has_next = S.next(ui + 1, nxt);
        const char* nA = has_next ? (const char*)g.A + (size_t)nxt.pm * tstepA + (size_t)nxt.pn * g.acs + (size_t)nxt.ko * 2 : cA; const char* nB = has_next ? (const char*)g.Bt + (size_t)nxt.pn * tstepB + (size_t)nxt.ko * 2 : cB;
        const int nt = cur.nt;
        for (int t = 0; t < nt; t += 2) {
            const bool last = (t == nt - 2);
            const char* a1 = cA + (size_t)(t + 1) * kstep;
            const char* a2 = last ? nA : cA + (size_t)(t + 2) * kstep; const char* b2 = last ? nB : cB + (size_t)(t + 2) * kstep;
            const char* a3 = a2 + kstep; const char* b3 = b2 + kstep;
            if (last && has_next) S.a_ready(nxt);
            if constexpr (SP2) {
            PG8_LDB(B0, 0, 0); PG8_LDB(B1, 0, 1); PG8_SCHED; PG8_LDA(At, 0, 0); PG8_STAGE(PG8_SA(1, 1), a1 + hstepA, voffA);
            PG8_WAIT_V(8); PG8_WAIT_L(0); PG8_BAR; PG8_MMA(0, 0, At, B0); PG8_MMA(0, 1, At, B1); PG8_BAR; PG8_SCHED;
            PG8_LDA(At, 0, 1); PG8_STAGE(PG8_SB(0, 0), b2, voffB); PG8_STAGE(PG8_SB(0, 1), b2 + hstepB, voffB); PG8_STAGE(PG8_SA(0, 0), a2, voffA);
            PG8_WAIT_V(8); PG8_WAIT_L(0); PG8_BAR; PG8_MMA(1, 0, At, B0); PG8_MMA(1, 1, At, B1); PG8_BAR; PG8_SCHED;
            PG8_LDB(B0, 1, 0); PG8_LDB(B1, 1, 1); PG8_SCHED; PG8_LDA(At, 1, 0); PG8_STAGE(PG8_SA(0, 1), a2 + hstepA, voffA);
            PG8_WAIT_V(8); PG8_WAIT_L(0); PG8_BAR; PG8_MMA(0, 0, At, B0); PG8_MMA(0, 1, At, B1); PG8_BAR; PG8_SCHED;
            PG8_LDA(At, 1, 1); PG8_STAGE(PG8_SB(1, 0), b3, voffB); PG8_STAGE(PG8_SB(1, 1), b3 + hstepB, voffB); PG8_STAGE(PG8_SA(1, 0), a3, voffA);
            PG8_WAIT_V(8); PG8_WAIT_L(0); PG8_BAR; PG8_MMA(1, 0, At, B0); PG8_MMA(1, 1, At, B1); PG8_BAR; PG8_SCHED;
            } else {
            PG8_LDB(B0, 0, 0); PG8_SCHED; PG8_LDA(At, 0, 0); PG8_STAGE(PG8_SA(1, 1), a1 + hstepA, voffA);
            PG8_WAIT_L(8); PG8_BAR; PG8_WAIT_L(0); PG8_MMA(0, 0, At, B0); PG8_BAR; PG8_SCHED;
            PG8_LDB(B1, 0, 1); PG8_STAGE(PG8_SB(0, 0), b2, voffB);
            PG8_BAR; PG8_WAIT_L(0); PG8_MMA(0, 1, At, B1); PG8_BAR;
            PG8_LDA(At, 0, 1); PG8_STAGE(PG8_SA(0, 0), a2, voffA);
            PG8_BAR; PG8_WAIT_L(0); PG8_MMA(1, 0, At, B0); PG8_BAR; PG8_SCHED;
            PG8_STAGE(PG8_SB(0, 1), b2 + hstepB, voffB);
            PG8_WAIT_V(6); PG8_BAR; PG8_MMA(1, 1, At, B1); PG8_BAR;
            PG8_LDB(B0, 1, 0); PG8_SCHED; PG8_LDA(At, 1, 0); PG8_STAGE(PG8_SA(0, 1), a2 + hstepA, voffA);
            PG8_WAIT_L(8); PG8_BAR; PG8_WAIT_L(0); PG8_MMA(0, 0, At, B0); PG8_BAR; PG8_SCHED;
            PG8_LDB(B1, 1, 1); PG8_STAGE(PG8_SB(1, 0), b3, voffB);
            PG8_BAR; PG8_WAIT_L(0); PG8_MMA(0, 1, At, B1); PG8_BAR;
            PG8_LDA(At, 1, 1); PG8_STAGE(PG8_SA(1, 0), a3, voffA);
            PG8_BAR; PG8_WAIT_L(0); PG8_MMA(1, 0, At, B0); PG8_BAR; PG8_SCHED;
            PG8_STAGE(PG8_SB(1, 1), b3 + hstepB, voffB);
            PG8_WAIT_V(6); PG8_BAR; PG8_MMA(1, 1, At, B1); PG8_BAR;
            }
        }
        if constexpr (ALIGN_EPI) { if (wr == 0) PG8_BAR; }
        if constexpr (!Epi::AFTER_DRAIN) { E(acc, cur, wr, wc, fr, fq); S.done(cur); }
        if (!has_next) break;
#pragma unroll
        for (int a = 0; a < 2; ++a)
#pragma unroll
            for (int b = 0; b < 2; ++b)
#pragma unroll
                for (int m = 0; m < 4; ++m)
#pragma unroll
                    for (int n = 0; n < 2; ++n) acc[a][b][m][n] = (f32x4){0.f, 0.f, 0.f, 0.f};
        cur = nxt; cA = nA; cB = nB; ++ui;
        if constexpr (ALIGN_EPI) { if (wr == 1) PG8_BAR; }
    }
    PG8_WAIT_V(0);
    if constexpr (!ALIGN_EPI) { if (wr == 0) PG8_BAR; }
    PG8_BAR;
    if constexpr (Epi::AFTER_DRAIN) { E.fused(acc, cur, wr, wc, fr, fq, lds, wid, lane); S.done(cur); }
#undef PG8_SA
#undef PG8_SB
#undef PG8_STAGE
#undef PG8_LDA
#undef PG8_LDB
#undef PG8_MMA
#undef PG8_WAIT_V
#undef PG8_WAIT_L
#undef PG8_BAR
#undef PG8_SCHED
}
}
#define LAS __attribute__((address_space(3)))
#define GAS __attribute__((address_space(1)))
typedef unsigned short bf16;
typedef unsigned u32x4 __attribute__((ext_vector_type(4)));
typedef unsigned u32x2 __attribute__((ext_vector_type(2)));
typedef float f32x4 __attribute__((ext_vector_type(4)));
typedef float f32x2 __attribute__((ext_vector_type(2)));
typedef float f32x16 __attribute__((ext_vector_type(16)));
typedef short bf16x8 __attribute__((ext_vector_type(8)));
typedef short s16x4 __attribute__((ext_vector_type(4)));
constexpr int D = 1024, FF = 4096, NH = 8;
constexpr int ROW_S = 65536, ROW_M = 66048, ROWS_VALID = 66064, MPAD = 66304;
constexpr int EXT_P = 8208, EXT_S = 1104;
constexpr float LOG2E = 1.4426950408889634f;
constexpr float QSCALE = 0.125f * LOG2E;
constexpr float EPS = 1e-6f, SUBLN_EPS = 1e-5f;
constexpr size_t OFF_YP = 0, OFF_YS = 67108864, OFF_KP = OFF_YS + 524288, OFF_VP = OFF_KP + 134479872, OFF_PP = OFF_VP + 134479872,
                 OFF_KS = OFF_PP + 245760, OFF_VS = OFF_KS + 1048576, OFF_PS = OFF_VS + 1048576, OUT_TOTAL = OFF_PS + 245760;
constexpr size_t MiB = 1u << 20;
constexpr size_t WS_WQKV = 1 * MiB, WS_WO = 13 * MiB, WS_WPOOL = 17 * MiB, WS_WUP = 18 * MiB, WS_WDN = 50 * MiB, WS_XM = 82 * MiB,
                 WS_XN = 83 * MiB, WS_QB = 213 * MiB, WS_YB = 343 * MiB, WS_KX = 473 * MiB, WS_VX = 602 * MiB, WS_KXS = 731 * MiB, WS_VXS = 767 * MiB,
                 WS_KXM = 803 * MiB, WS_VXM = 804 * MiB, WS_U = 805 * MiB, WS_MFK = 1323 * MiB, WS_MFV = 1324 * MiB, WS_YF = 1325 * MiB, WS_X16 = 1373 * MiB, WS_END = 1503 * MiB;
constexpr size_t KXS_LAYER = 18 * MiB / 2;
constexpr int LDS_BYTES = 147456;
constexpr int NSTEPS = 27;
#ifndef ONE_LAUNCH
#define ONE_LAUNCH 1
#endif

__device__ __forceinline__ unsigned f2bf(float f) { unsigned u = __builtin_bit_cast(unsigned, f); return (u + 0x7fffu + ((u >> 16) & 1u)) >> 16; }
__device__ __forceinline__ unsigned pk2(float lo, float hi) { return f2bf(lo) | (f2bf(hi) << 16); }
__device__ __forceinline__ float bflo(unsigned w) { return __builtin_bit_cast(float, w << 16); }
__device__ __forceinline__ float bfhi(unsigned w) { return __builtin_bit_cast(float, w & 0xffff0000u); }
__device__ __forceinline__ float wave_sum(float v) {
#pragma unroll
    for (int o = 1; o < 64; o <<= 1) v += __shfl_xor(v, o);
    return v;
}

struct Args { const float* in[22]; float* out; unsigned char* ws; int lo, hi; };
typedef const __attribute__((address_space(4))) Args& ArgsRef;
__device__ __forceinline__ int mk_tid(int wv) { int t; asm volatile("v_mbcnt_lo_u32_b32 %0, -1, 0\n\tv_mbcnt_hi_u32_b32 %0, -1, %0" : "=v"(t)); return wv * 64 + t; }
struct Frame {
    LAS unsigned char* lds; int tid, lane, wave, vcu, G;
    float* out; unsigned char* ws;
};

__device__ __forceinline__ void transpose_item(const float* W, int K, int N, bf16* WT, LAS float* scr, int item, int lane, const float* nscale) {
    const int nblk = N / 64, kb = item / nblk, nb = item % nblk, k0 = 64 * kb, n0 = 64 * nb;
    f32x4 v[16];
#pragma unroll
    for (int i = 0; i < 16; ++i) v[i] = *(const f32x4*)(W + (size_t)(k0 + 4 * i + (lane >> 4)) * N + n0 + 4 * (lane & 15));
#pragma unroll
    for (int i = 0; i < 16; ++i) { LAS float* d = scr + (4 * i + (lane >> 4)) * 65 + 4 * (lane & 15); d[0] = v[i].x; d[1] = v[i].y; d[2] = v[i].z; d[3] = v[i].w; }
    asm volatile("s_waitcnt lgkmcnt(0)" ::: "memory");
    const int c = lane & 7;
#pragma unroll
    for (int j = 0; j < 8; ++j) { const int n = (lane >> 3) + 8 * j; const LAS float* s = scr + (8 * c) * 65 + n; const float sc = nscale ? nscale[n0 + n] : 1.f;
        u32x4 o; o.x = pk2(s[0 * 65] * sc, s[1 * 65] * sc); o.y = pk2(s[2 * 65] * sc, s[3 * 65] * sc); o.z = pk2(s[4 * 65] * sc, s[5 * 65] * sc); o.w = pk2(s[6 * 65] * sc, s[7 * 65] * sc);
        *(u32x4*)(WT + (size_t)(n0 + n) * K + k0 + 8 * c) = o; }
    asm volatile("s_waitcnt lgkmcnt(0)" ::: "memory");
}
__device__ __forceinline__ const float* xin_row(ArgsRef A, int row) {
    return row < ROW_S ? A.in[0] + (size_t)row * D : row < ROW_M ? A.in[1] + (size_t)(row - ROW_S) * D : A.in[5] + (size_t)(row - ROW_M) * D;
}
__device__ __forceinline__ float* xres_row(const Frame& F, int row) {
    return row < ROW_S ? F.out + OFF_YP + (size_t)row * D : row < ROW_M ? F.out + OFF_YS + (size_t)(row - ROW_S) * D : (float*)(F.ws + WS_XM) + (size_t)(row - ROW_M) * D;
}
__device__ __forceinline__ void prologue(ArgsRef A, Frame& F) {
    { const int t_ = mk_tid(F.wave); F.tid = t_; F.lane = t_ & 63; }
    LAS float* scr = (LAS float*)(F.lds + F.wave * 16640);
    const int gw = F.vcu * 8 + F.wave, NGW = F.G * 8;
    constexpr int I_QKV = 16 * 48, I_O = 16 * 16, I_UP = 16 * 64, I_DN = 64 * 16, I_PL = 4 * 4;
    constexpr int NITEMS = 2 * I_QKV + 2 * I_O + 4 * I_UP + 4 * I_DN + 8 * I_PL;
    for (int it = gw; it < NITEMS; it += NGW) {
        int r = it;
        if (r < 2 * I_QKV) { const int a = r / I_QKV; transpose_item(A.in[11] + (size_t)a * D * 3072, D, 3072, (bf16*)(F.ws + WS_WQKV) + (size_t)a * 3072 * D, scr, r % I_QKV, F.lane, nullptr); continue; } r -= 2 * I_QKV;
        if (r < 2 * I_O) { const int a = r / I_O; transpose_item(A.in[17] + (size_t)a * D * D, D, D, (bf16*)(F.ws + WS_WO) + (size_t)a * D * D, scr, r % I_O, F.lane, nullptr); continue; } r -= 2 * I_O;
        if (r < 4 * I_UP) { const int i = r / I_UP; transpose_item(A.in[20] + (size_t)i * D * FF, D, FF, (bf16*)(F.ws + WS_WUP) + (size_t)i * D * FF, scr, r % I_UP, F.lane, nullptr); continue; } r -= 4 * I_UP;
        if (r < 4 * I_DN) { const int i = r / I_DN; transpose_item(A.in[21] + (size_t)i * D * FF, FF, D, (bf16*)(F.ws + WS_WDN) + (size_t)i * D * FF, scr, r % I_DN, F.lane, nullptr); continue; } r -= 4 * I_DN;
        { const int pg = r / I_PL; transpose_item(A.in[18] + (size_t)pg * 65536, 256, 256, (bf16*)(F.ws + WS_WPOOL) + (size_t)pg * 65536, scr, r % I_PL, F.lane, A.in[19] + pg * 256); }
    }
    for (int it0 = gw; it0 < 32768; it0 += 4 * NGW) {
        f32x4 v[4][4];
#pragma unroll
        for (int r4 = 0; r4 < 4; ++r4) { const int it = min(it0 + r4 * NGW, 32767); const int j = it & 1023, b = (it >> 10) & 7, kv = (it >> 13) & 1, a = it >> 14;
            const float* src = (kv ? A.in[3] : A.in[2]) + ((size_t)(a * 8 + b) * 1024 + j) * D;
#pragma unroll
            for (int q = 0; q < 4; ++q) v[r4][q] = *(const f32x4*)(src + 4 * F.lane + 256 * q); }
#pragma unroll
        for (int r4 = 0; r4 < 4; ++r4) { const int it = it0 + r4 * NGW; if (it < 32768) { const int j = it & 1023, b = (it >> 10) & 7, kv = (it >> 13) & 1, a = it >> 14;
            bf16* dst = (bf16*)(F.ws + (kv ? WS_VXS : WS_KXS)) + (size_t)a * KXS_LAYER + (size_t)(b * EXT_S + 16 + j) * D;
#pragma unroll
            for (int q = 0; q < 4; ++q) { u32x2 w; w.x = pk2(v[r4][q].x, v[r4][q].y); w.y = pk2(v[r4][q].z, v[r4][q].w); *(u32x2*)(dst + 4 * F.lane + 256 * q) = w; } } }
    }
    const float* g = A.in[7];
    for (int row = ROWS_VALID + gw; row < MPAD; row += NGW) { bf16* xn = (bf16*)(F.ws + WS_XN) + (size_t)row * D;
#pragma unroll
        for (int q = 0; q < 4; ++q) *(u32x2*)(xn + 4 * F.lane + 256 * q) = (u32x2){0u, 0u}; }
    const int RPC = (ROWS_VALID + F.G - 1) / F.G, rbeg = F.vcu * RPC, rend = min(rbeg + RPC, ROWS_VALID);
    for (int row0 = rbeg + F.wave; row0 < rend; row0 += 32) {
        f32x4 v[4][4]; float ss[4];
#pragma unroll
        for (int j = 0; j < 4; ++j) { const float* x = xin_row(A, min(row0 + j * 8, ROWS_VALID - 1)); ss[j] = 0.f;
#pragma unroll
            for (int q = 0; q < 4; ++q) v[j][q] = *(const f32x4*)(x + 4 * F.lane + 256 * q); }
#pragma unroll
        for (int j = 0; j < 4; ++j) {
#pragma unroll
            for (int q = 0; q < 4; ++q) ss[j] += v[j][q].x * v[j][q].x + v[j][q].y * v[j][q].y + v[j][q].z * v[j][q].z + v[j][q].w * v[j][q].w; }
#pragma unroll
        for (int o = 1; o < 64; o <<= 1) {
#pragma unroll
            for (int j = 0; j < 4; ++j) ss[j] += __shfl_xor(ss[j], o); }
#pragma unroll
        for (int j = 0; j < 4; ++j) { const int row = row0 + j * 8; const float r = 1.0f / sqrtf(ss[j] * (1.f / D) + EPS); bf16* xn = (bf16*)(F.ws + WS_XN) + (size_t)row * D;
#pragma unroll
            for (int q = 0; q < 4; ++q) { const f32x4 gg = *(const f32x4*)(g + 4 * F.lane + 256 * q); u32x2 w; w.x = pk2(v[j][q].x * r * gg.x, v[j][q].y * r * gg.y); w.y = pk2(v[j][q].z * r * gg.z, v[j][q].w * r * gg.w);
                if (row < rend) *(u32x2*)(xn + 4 * F.lane + 256 * q) = w; } }
    }
}
__device__ __forceinline__ void fin_phase(ArgsRef A, Frame& F, bool from_inputs, const int nks  , const float* gpost, const float* gnext) {
    { const int t_ = mk_tid(F.wave); F.tid = t_; F.lane = t_ & 63; }
    constexpr int FR = 4;
    const int gw = F.vcu * 8 + F.wave, NGW = F.G * 8;
    const bf16* YB = (const bf16*)(F.ws + WS_YB);
    const int lo4 = 4 * F.lane, lo8 = 8 * F.lane;
    const int RPC = (ROW_S + F.G - 1) / F.G, rbeg = F.vcu * RPC, rend = min(rbeg + RPC, ROW_S);
    f32x4 gp[4], gn[4];
#pragma unroll
    for (int q = 0; q < 4; ++q) { const int cq = lo8 + 4 * (q & 1) + 512 * (q >> 1); gp[q] = *(const f32x4*)(gpost + cq); gn[q] = gnext ? *(const f32x4*)(gnext + cq) : (f32x4){0.f, 0.f, 0.f, 0.f}; }
    for (int row0 = rbeg + F.wave; row0 < rend; row0 += 8 * FR) {
        f32x4 yv[FR][4], xv[FR][4]; float ss[FR];
#pragma unroll
        for (int j = 0; j < FR; ++j) { const int row = min(row0 + j * 8, ROWS_VALID - 1); const bf16* y = YB + (size_t)row * D; const float* xi = xin_row(A, row); const bf16* x16 = (const bf16*)(F.ws + WS_X16) + (size_t)row * D; ss[j] = 0.f;
#pragma unroll
            for (int h = 0; h < 2; ++h) { const u32x4 w = *(const u32x4*)(y + lo8 + 512 * h);
                yv[j][2 * h] = (f32x4){bflo(w.x), bfhi(w.x), bflo(w.y), bfhi(w.y)}; yv[j][2 * h + 1] = (f32x4){bflo(w.z), bfhi(w.z), bflo(w.w), bfhi(w.w)}; }
#pragma unroll
            for (int h = 0; h < 2; ++h) {
                if (from_inputs) { xv[j][2 * h] = *(const f32x4*)(xi + lo8 + 512 * h); xv[j][2 * h + 1] = *(const f32x4*)(xi + lo8 + 4 + 512 * h); }
                else { const u32x4 w = *(const u32x4*)(x16 + lo8 + 512 * h); xv[j][2 * h] = (f32x4){bflo(w.x), bfhi(w.x), bflo(w.y), bfhi(w.y)}; xv[j][2 * h + 1] = (f32x4){bflo(w.z), bfhi(w.z), bflo(w.w), bfhi(w.w)}; } } }
#pragma unroll
        for (int j = 0; j < FR; ++j) {
#pragma unroll
            for (int q = 0; q < 4; ++q) ss[j] += yv[j][q].x * yv[j][q].x + yv[j][q].y * yv[j][q].y + yv[j][q].z * yv[j][q].z + yv[j][q].w * yv[j][q].w; }
#pragma unroll
        for (int o = 1; o < 64; o <<= 1) {
#pragma unroll
            for (int j = 0; j < FR; ++j) ss[j] += __shfl_xor(ss[j], o); }
        float s2[FR];
#pragma unroll
        for (int j = 0; j < FR; ++j) { const int row = row0 + j * 8; const float r = 1.0f / sqrtf(ss[j] * (1.f / D) + EPS); s2[j] = 0.f;
#pragma unroll
            for (int q = 0; q < 4; ++q) { const int cq = lo8 + 4 * (q & 1) + 512 * (q >> 1); const f32x4 gg = gp[q]; xv[j][q] = xv[j][q] + yv[j][q] * r * gg;
                if (!gnext && row < rend) *(f32x4*)(xres_row(F, row) + cq) = xv[j][q];
                s2[j] += xv[j][q].x * xv[j][q].x + xv[j][q].y * xv[j][q].y + xv[j][q].z * xv[j][q].z + xv[j][q].w * xv[j][q].w; }
            if (gnext && row < rend) {
#pragma unroll
                for (int h = 0; h < 2; ++h) { const f32x4 a0 = xv[j][2 * h], a1 = xv[j][2 * h + 1]; u32x4 w; w.x = pk2(a0.x, a0.y); w.y = pk2(a0.z, a0.w); w.z = pk2(a1.x, a1.y); w.w = pk2(a1.z, a1.w);
                    *(u32x4*)((bf16*)(F.ws + WS_X16) + (size_t)row * D + lo8 + 512 * h) = w; } } }
        if (gnext) {
#pragma unroll
            for (int o = 1; o < 64; o <<= 1) {
#pragma unroll
                for (int j = 0; j < FR; ++j) s2[j] += __shfl_xor(s2[j], o); }
#pragma unroll
            for (int j = 0; j < FR; ++j) { const int row = row0 + j * 8; const float r2 = 1.0f / sqrtf(s2[j] * (1.f / D) + EPS); bf16* xn = (bf16*)(F.ws + WS_XN) + (size_t)row * D;
#pragma unroll
                for (int h = 0; h < 2; ++h) { const f32x4 g0 = gn[2 * h], g1 = gn[2 * h + 1]; const f32x4 a0 = xv[j][2 * h], a1 = xv[j][2 * h + 1];
                    u32x4 w; w.x = pk2(a0.x * r2 * g0.x, a0.y * r2 * g0.y); w.y = pk2(a0.z * r2 * g0.z, a0.w * r2 * g0.w); w.z = pk2(a1.x * r2 * g1.x, a1.y * r2 * g1.y); w.w = pk2(a1.z * r2 * g1.z, a1.w * r2 * g1.w);
                    if (row < rend) *(u32x4*)(xn + lo8 + 512 * h) = w; } }
        }
    }
    for (int row = ROW_S + gw; row < ROWS_VALID; row += NGW) {
        const float* xi = xin_row(A, row); float* xo = xres_row(F, row); bf16* x16 = (bf16*)(F.ws + WS_X16) + (size_t)row * D;
        f32x4 yv[4], xv[4]; float ss = 0.f;
#pragma unroll
        for (int q = 0; q < 4; ++q) {
            if (nks == 0) { const u32x2 w = *(const u32x2*)(YB + (size_t)row * D + lo4 + 256 * q); yv[q] = (f32x4){bflo(w.x), bfhi(w.x), bflo(w.y), bfhi(w.y)}; }
            else { const float* yf = (const float*)(F.ws + WS_YF) + (size_t)(row - ROW_S) * D + lo4 + 256 * q; f32x4 part[16];
#pragma unroll
                for (int k = 0; k < 16; ++k) part[k] = (k < nks) ? *(const f32x4*)(yf + (size_t)k * 768 * D) : (f32x4){0.f, 0.f, 0.f, 0.f};
                yv[q] = part[0];
#pragma unroll
                for (int k = 1; k < 16; ++k) yv[q] += part[k]; }
            if (from_inputs) xv[q] = *(const f32x4*)(xi + lo4 + 256 * q); else { const u32x2 xw = *(const u32x2*)(x16 + lo4 + 256 * q); xv[q] = (f32x4){bflo(xw.x), bfhi(xw.x), bflo(xw.y), bfhi(xw.y)}; }
            ss += yv[q].x * yv[q].x + yv[q].y * yv[q].y + yv[q].z * yv[q].z + yv[q].w * yv[q].w; }
        const float r = 1.0f / sqrtf(wave_sum(ss) * (1.f / D) + EPS); float s2 = 0.f;
#pragma unroll
        for (int q = 0; q < 4; ++q) { const f32x4 gg = *(const f32x4*)(gpost + lo4 + 256 * q); xv[q] = xv[q] + yv[q] * r * gg; if (!gnext) { if (row < ROW_M) *(f32x4*)(xo + lo4 + 256 * q) = xv[q]; } else { u32x2 xw; xw.x = pk2(xv[q].x, xv[q].y); xw.y = pk2(xv[q].z, xv[q].w); *(u32x2*)(x16 + lo4 + 256 * q) = xw; }
            s2 += xv[q].x * xv[q].x + xv[q].y * xv[q].y + xv[q].z * xv[q].z + xv[q].w * xv[q].w; }
        if (gnext) { const float r2 = 1.0f / sqrtf(wave_sum(s2) * (1.f / D) + EPS); bf16* xn = (bf16*)(F.ws + WS_XN) + (size_t)row * D;
#pragma unroll
            for (int q = 0; q < 4; ++q) { const f32x4 gg = *(const f32x4*)(gnext + lo4 + 256 * q); u32x2 w; w.x = pk2(xv[q].x * r2 * gg.x, xv[q].y * r2 * gg.y); w.y = pk2(xv[q].z * r2 * gg.z, xv[q].w * r2 * gg.w);
                *(u32x2*)(xn + lo4 + 256 * q) = w; } }
    }
}
__device__ __forceinline__ u32x4 pool_h8(ArgsRef A, const Frame& F, int grp, int b, int t, int col, int p) {
    const bf16* XN = (const bf16*)(F.ws + WS_XN);
    if (t >= 0) { const int row = grp == 0 ? b * 8192 + t : grp == 1 ? ROW_S + b * 64 + t : ROW_M + t; return *(const u32x4*)(XN + (size_t)row * D + col); }
    if (grp == 0) return *(const u32x4*)(XN + (size_t)(ROW_M + 16 + t) * D + col);
    if (grp == 1) { const float* s = A.in[4] + ((size_t)(p * 8 + b) * 15 + 15 + t) * D + col; const f32x4 a0 = *(const f32x4*)s, a1 = *(const f32x4*)(s + 4);
        u32x4 w; w.x = pk2(a0.x, a0.y); w.y = pk2(a0.z, a0.w); w.z = pk2(a1.x, a1.y); w.w = pk2(a1.z, a1.w); return w; }
    return (u32x4){0u, 0u, 0u, 0u};
}
__device__ __forceinline__ void pool_phase(ArgsRef A, Frame& F, int p) {
    { const int t_ = mk_tid(F.wave); F.tid = t_; F.lane = t_ & 63; }
    bf16* DB = (bf16*)(F.ws + WS_QB);
    const int col = 8 * (F.tid & 127), rgq = F.tid >> 7, w = 2 << (col >> 8);
    for (int it = F.vcu; it < 1033; it += F.G) {
        int grp, b, t0, nr;
        if (it < 1024) { grp = 0; b = it >> 7; t0 = (it & 127) * 64; nr = 64; } else if (it < 1032) { grp = 1; b = it - 1024; t0 = 0; nr = 64; } else { grp = 2; b = 0; t0 = 0; nr = 16; }
        const int tb = t0 + 16 * rgq;
        if (16 * rgq >= nr) continue;
        u32x4 h[31];
#pragma unroll
        for (int i = 0; i < 31; ++i) h[i] = pool_h8(A, F, grp, b, tb - 15 + i, col, p);
        float sum[8];
#pragma unroll
        for (int e = 0; e < 8; ++e) sum[e] = 0.f;
#pragma unroll
        for (int j = 1; j < 16; ++j) { const float k = (j < w) ? 1.f : 0.f; const u32x4 v = h[15 - j];
            sum[0] += k * bflo(v.x); sum[1] += k * bfhi(v.x); sum[2] += k * bflo(v.y); sum[3] += k * bfhi(v.y); sum[4] += k * bflo(v.z); sum[5] += k * bfhi(v.z); sum[6] += k * bflo(v.w); sum[7] += k * bfhi(v.w); }
#pragma unroll
        for (int i = 0; i < 16; ++i) { const int t = tb + i;
            const u32x4 cv = h[15 + i]; const float cur[8] = {bflo(cv.x), bfhi(cv.x), bflo(cv.y), bfhi(cv.y), bflo(cv.z), bfhi(cv.z), bflo(cv.w), bfhi(cv.w)};
            const float inv = 1.0f / (float)(grp == 2 ? min(t + 1, w) : w);
            float d[8];
#pragma unroll
            for (int e = 0; e < 8; ++e) { sum[e] += cur[e]; d[e] = sum[e] * inv - cur[e]; }
            const int row = grp == 0 ? b * 8192 + t : grp == 1 ? ROW_S + b * 64 + t : ROW_M + t;
            u32x4 o; o.x = pk2(d[0], d[1]); o.y = pk2(d[2], d[3]); o.z = pk2(d[4], d[5]); o.w = pk2(d[6], d[7]);
            *(u32x4*)(DB + (size_t)row * D + col) = o;
            const u32x4 a1 = h[15 + i - 1], a3 = h[15 + i - 3], a7 = h[15 + i - 7], a15 = h[15 + i - 15];
            u32x4 ov; ov.x = (w == 2) ? a1.x : (w == 4) ? a3.x : (w == 8) ? a7.x : a15.x; ov.y = (w == 2) ? a1.y : (w == 4) ? a3.y : (w == 8) ? a7.y : a15.y;
            ov.z = (w == 2) ? a1.z : (w == 4) ? a3.z : (w == 8) ? a7.z : a15.z; ov.w = (w == 2) ? a1.w : (w == 4) ? a3.w : (w == 8) ? a7.w : a15.w;
            sum[0] -= bflo(ov.x); sum[1] -= bfhi(ov.x); sum[2] -= bflo(ov.y); sum[3] -= bfhi(ov.y); sum[4] -= bflo(ov.z); sum[5] -= bfhi(ov.z); sum[6] -= bflo(ov.w); sum[7] -= bfhi(ov.w);
            float* tp = nullptr;
            if (grp == 0 && t >= 8177) tp = F.out + OFF_PP + ((size_t)(p * 8 + b) * 15 + (t - 8177)) * D + col;
            if (grp == 1 && t >= 49) tp = F.out + OFF_PS + ((size_t)(p * 8 + b) * 15 + (t - 49)) * D + col;
            if (tp) { *(f32x4*)tp = (f32x4){cur[0], cur[1], cur[2], cur[3]}; *(f32x4*)(tp + 4) = (f32x4){cur[4], cur[5], cur[6], cur[7]}; }
        }
    }
}

namespace att {
constexpr int KSTR = 272;
constexpr int TB = 16384;
constexpr int OFF_K0 = 0, OFF_K1 = TB, OFF_V0 = 2 * TB, OFF_V1 = 3 * TB, OFF_BT = 4 * TB, OFF_GT = OFF_BT + 2048, OFF_Q = 5 * TB, XB = 16384;
static_assert(OFF_BT >= 4 * XB && OFF_GT + 512 <= OFF_Q && OFF_Q + 2 * TB <= 131072, "attention LDS map");
constexpr float THR = 48.0f;
constexpr float NEG = -1e30f;
struct AUnit { const bf16* K; const bf16* V; const bf16* KM; const bf16* VM; const bf16* Q; bf16* O; int P, L, x, h; };
__device__ __forceinline__ float max3f(float a, float b, float c) { float r; asm("v_max3_f32 %0, %1, %2, %3" : "=v"(r) : "v"(a), "v"(b), "v"(c)); return r; }
__device__ __forceinline__ float swapmax(float v) { auto rr = __builtin_amdgcn_permlane32_swap(__float_as_uint(v), __float_as_uint(v), false, false); return fmaxf(__uint_as_float(rr[0]), __uint_as_float(rr[1])); }
__device__ __forceinline__ float swapsum(float v) { auto rr = __builtin_amdgcn_permlane32_swap(__float_as_uint(v), __float_as_uint(v), false, false); return __uint_as_float(rr[0]) + __uint_as_float(rr[1]); }
typedef __bf16 bf16x2_t __attribute__((ext_vector_type(2)));
__device__ __forceinline__ unsigned cvtpk(float lo, float hi) { f32x2 v = {lo, hi}; bf16x2_t b = __builtin_convertvector(v, bf16x2_t); return __builtin_bit_cast(unsigned, b); }
__device__ __forceinline__ s16x4 vtr(const LAS unsigned char* p) { return __builtin_bit_cast(s16x4, __builtin_amdgcn_ds_read_tr16_b64_v4i16((LAS s16x4*)p)); }
__device__ __forceinline__ void glds16(const void* gsrc, unsigned lds_dst) { unsigned keep;
    asm volatile("s_mov_b32 %0, m0\n\ts_mov_b32 m0, %2\n\ts_nop 0\n\tglobal_load_lds_dwordx4 %1, off\n\ts_mov_b32 m0, %0" : "=&s"(keep) : "v"(gsrc), "s"(lds_dst) : "memory"); }
__device__ __forceinline__ bf16x8 pack8(const f32x16& S, int o) {
    u32x4 w; w.x = cvtpk(S[o], S[o + 1]); w.y = cvtpk(S[o + 2], S[o + 3]); w.z = cvtpk(S[o + 4], S[o + 5]); w.w = cvtpk(S[o + 6], S[o + 7]); return __builtin_bit_cast(bf16x8, w);
}

__device__ __forceinline__ void attn_unit(const int wv, LAS unsigned char* lds, const AUnit& u, const float* lq1, const float* lk1, const float* lq2, const float* lk2, const int layer_a, const float* relb, const float* subg) {
    const int tid = mk_tid(wv), lane = tid & 63, wid = wv, mp = wid >> 2, rg = wid & 3, q32 = lane & 31, hi = lane >> 5;
    LAS float* BT = (LAS float*)(lds + OFF_BT); LAS float* GT = (LAS float*)(lds + OFF_GT);
    {
        const float b15 = relb[15 * 8 + u.h];
        if (tid < 448) { const int rel = tid - 192, n = rel < 0 ? -rel : rel;
            int bk = n < 8 ? n : n < 12 ? 8 : n < 16 ? 9 : n < 23 ? 10 : n < 32 ? 11 : n < 46 ? 12 : n < 64 ? 13 : n < 91 ? 14 : 15; if (rel > 0) bk += 16;
            BT[tid] = (relb[bk * 8 + u.h] - b15) * LOG2E; }
        if (tid >= 384) GT[tid - 384] = subg[tid - 384] * (layer_a == 0 ? 0.8f : 0.52928698f);
    }
    const int vrows = min(128, u.L - 128 * u.x);
    const bool active = rg * 32 < vrows;
    const int ch = rg >> 1;
    const int NTw = active ? (u.P + min((2 * u.x + ch + 1) * 64, u.L) + 48) >> 6 : 0;
    const int NT = (u.P + min((2 * u.x + 2) * 64, u.L) + 48) >> 6;
    const int eq0 = u.P + 128 * u.x + rg * 32, eq = eq0 + q32;
    const unsigned lds0 = (unsigned)(size_t)lds;
    unsigned goff[2];
#pragma unroll
    for (int j = 0; j < 2; ++j) { const int row = wid * 8 + 4 * j + (lane >> 4), x = ((row & 3) << 2) | ((row >> 2) & 3), c = (lane & 15) ^ x; goff[j] = (unsigned)(row * 1024 + u.h * 128 + c * 8); }
    const unsigned ldst = (unsigned)wid * 2048u;
#define ATT_DMA(base, bufoff) do { _Pragma("unroll") for (int j_ = 0; j_ < 2; ++j_) \
        glds16((base) + goff[j_], (unsigned)__builtin_amdgcn_readfirstlane((int)(lds0 + (unsigned)(bufoff) + ldst + j_ * 1024))); } while (0)
#define ATT_ISSUE_K(t, bufoff) do { const bf16* b_ = ((t) == 0 && wid < 2) ? u.KM : u.K + (size_t)(t) * 65536; ATT_DMA(b_, bufoff); } while (0)
#define ATT_ISSUE_V(t, bufoff) do { const bf16* b_ = ((t) == 0 && wid < 2) ? u.VM : u.V + (size_t)(t) * 65536; ATT_DMA(b_, bufoff); } while (0)
#define ATT_WAITBAR() do { asm volatile("s_waitcnt vmcnt(0) lgkmcnt(0)" ::: "memory"); __builtin_amdgcn_s_barrier(); asm volatile("" ::: "memory"); } while (0)
    unsigned koff[4];
    { const int x = ((q32 & 3) << 2) | ((q32 >> 2) & 3);
#pragma unroll
      for (int d0 = 0; d0 < 4; ++d0) koff[d0] = lds0 + (unsigned)(q32 * 256 + (((mp * 8 + 2 * d0 + hi) ^ x) << 4)); }
    unsigned vofs[4][2];
    { const int qq = (lane & 15) >> 2, cl = 2 * ((lane >> 4) & 1) + ((lane & 3) >> 1), sub = 8 * (lane & 1);
#pragma unroll
      for (int dvb = 0; dvb < 4; ++dvb)
#pragma unroll
          for (int hf = 0; hf < 2; ++hf) vofs[dvb][hf] = lds0 + (unsigned)((8 * hf + 4 * hi + qq) * 256 + ((((dvb ^ qq) << 2) | (cl ^ (2 * hf + hi))) << 4) + sub); }
    {
        const bf16* qb_ = u.Q + (size_t)(128 * u.x + wid * 16) * 1024;
#pragma unroll
        for (int j = 0; j < 4; ++j) { const int row = 4 * j + (lane >> 4), x = ((row & 3) << 2) | ((row >> 2) & 3), c = (lane & 15) ^ x;
            glds16(qb_ + row * 1024 + u.h * 128 + c * 8, (unsigned)__builtin_amdgcn_readfirstlane((int)(lds0 + OFF_Q + wid * 4096 + j * 1024))); }
    }
    ATT_ISSUE_K(0, OFF_K0); ATT_ISSUE_V(0, OFF_V0); if (NT > 1) ATT_ISSUE_K(1, OFF_K1);
    ATT_WAITBAR();
    f32x16 O[4];
#pragma unroll
    for (int i = 0; i < 4; ++i)
#pragma unroll
        for (int r = 0; r < 16; ++r) O[i][r] = 0.f;
    float m = 0.f, l = 0.f;
    f32x16 SA0, SA1, SB0, SB1;
    const f32x16 zero16 = {0.f, 0.f, 0.f, 0.f, 0.f, 0.f, 0.f, 0.f, 0.f, 0.f, 0.f, 0.f, 0.f, 0.f, 0.f, 0.f};
#define ATT_SB() __builtin_amdgcn_sched_barrier(0)
#define ATT_QK(S0_, S1_, kbufoff) do { unsigned qsh_ = (unsigned)(OFF_Q + rg * 8192); asm volatile("" : "+s"(qsh_));     \
        bf16x8 kfa[4], kfb[4], qfr[4]; \
        _Pragma("unroll") for (int d0 = 0; d0 < 4; ++d0) { kfa[d0] = *(const LAS bf16x8*)(size_t)(koff[d0] + (unsigned)(kbufoff)); kfb[d0] = *(const LAS bf16x8*)(size_t)(koff[d0] + (unsigned)(kbufoff) + 8192u); qfr[d0] = *(const LAS bf16x8*)(size_t)(koff[d0] + qsh_); } \
        ATT_SB(); \
        S0_ = __builtin_amdgcn_mfma_f32_32x32x16_bf16(kfa[0], qfr[0], zero16, 0, 0, 0); S1_ = __builtin_amdgcn_mfma_f32_32x32x16_bf16(kfb[0], qfr[0], zero16, 0, 0, 0); \
        _Pragma("unroll") for (int d0 = 1; d0 < 4; ++d0) { S0_ = __builtin_amdgcn_mfma_f32_32x32x16_bf16(kfa[d0], qfr[d0], S0_, 0, 0, 0); S1_ = __builtin_amdgcn_mfma_f32_32x32x16_bf16(kfb[d0], qfr[d0], S1_, 0, 0, 0); } } while (0)
#define ATT_VLD(bank, ks) do { _Pragma("unroll") for (int dvb = 0; dvb < 4; ++dvb) { bank[dvb][0] = vtr((const LAS unsigned char*)(size_t)(vofs[dvb][0] + vb_ + (unsigned)((ks) * 4096))); bank[dvb][1] = vtr((const LAS unsigned char*)(size_t)(vofs[dvb][1] + vb_ + (unsigned)((ks) * 4096))); } } while (0)
#define ATT_PV(bank, ks, C0, C1) do { const bf16x8 pb = pack8(((ks) < 2) ? C0 : C1, 8 * ((ks) & 1)); \
        _Pragma("unroll") for (int dvb = 0; dvb < 4; ++dvb) { const bf16x8 vf = (bf16x8){bank[dvb][0][0], bank[dvb][0][1], bank[dvb][0][2], bank[dvb][0][3], bank[dvb][1][0], bank[dvb][1][1], bank[dvb][1][2], bank[dvb][1][3]}; \
            O[dvb] = __builtin_amdgcn_mfma_f32_32x32x16_bf16(vf, pb, O[dvb], 0, 0, 0); } } while (0)
#define ATT_STEP(C0, C1, N0, N1, t_, PAR) do { const int t = (t_); constexpr int cur = (PAR); \
        if (t + 2 < NT) ATT_ISSUE_K(t + 2, cur ? OFF_K1 : OFF_K0); \
        if (t + 1 < NT) ATT_ISSUE_V(t + 1, cur ? OFF_V0 : OFF_V1); \
        { \
            const int k0 = t * 64; \
            if (k0 + 154 > eq0) { const LAS float* bt_ = BT + (k0 - eq + 192 + 4 * hi); \
                _Pragma("unroll") for (int r = 0; r < 16; ++r) { C0[r] += bt_[(r & 3) + 8 * (r >> 2)]; } \
                ATT_SB(); \
                _Pragma("unroll") for (int r = 0; r < 16; ++r) { C1[r] += bt_[32 + (r & 3) + 8 * (r >> 2)]; } } \
            if (t >= NTw - 1) { const bool all_ = t >= NTw; _Pragma("unroll") for (int r = 0; r < 16; ++r) { if (r >= 8 || all_) C0[r] = NEG; C1[r] = NEG; } } \
            if (__any(m != 0.f)) { _Pragma("unroll") for (int r = 0; r < 16; ++r) { C0[r] -= m; C1[r] -= m; } } \
            float mx = max3f(C0[0], C1[0], C0[1]), mx2 = max3f(C1[1], C0[2], C1[2]); \
            _Pragma("unroll") for (int r = 3; r < 15; r += 2) { mx = max3f(mx, C0[r], C1[r]); mx2 = max3f(mx2, C0[r + 1], C1[r + 1]); } \
            mx = max3f(mx, mx2, C0[15]); mx = fmaxf(mx, C1[15]); \
            mx = swapmax(mx); \
            if (__any(mx > THR || (t == 0 && mx < -THR))) { const float dl = (t == 0) ? mx : fmaxf(mx, 0.f); m += dl; const float f = (t == 0) ? 1.f : __builtin_amdgcn_exp2f(-dl); l *= f; \
                _Pragma("unroll") for (int r = 0; r < 16; ++r) { C0[r] -= dl; C1[r] -= dl; } \
                _Pragma("unroll") for (int i = 0; i < 4; ++i) _Pragma("unroll") for (int r = 0; r < 16; ++r) O[i][r] *= f; } \
        } \
        ATT_SB(); \
        if (t + 1 < NT) ATT_QK(N0, N1, cur ? OFF_K0 : OFF_K1); \
        ATT_SB(); \
        { \
            constexpr unsigned vb_ = (unsigned)(cur ? OFF_V1 : OFF_V0); \
            s16x4 vA[4][2], vB[4][2]; \
            ATT_VLD(vA, 0); \
            ATT_SB(); \
            float ls = 0.f; \
            _Pragma("unroll") for (int r = 0; r < 16; ++r) { C0[r] = __builtin_amdgcn_exp2f(C0[r]); C1[r] = __builtin_amdgcn_exp2f(C1[r]); ls += C0[r]; ls += C1[r]; } \
            l += ls; \
            ATT_SB(); \
            ATT_VLD(vB, 1); ATT_SB(); ATT_PV(vA, 0, C0, C1); ATT_SB(); \
            ATT_VLD(vA, 2); ATT_SB(); ATT_PV(vB, 1, C0, C1); ATT_SB(); \
            ATT_VLD(vB, 3); ATT_SB(); ATT_PV(vA, 2, C0, C1); ATT_SB(); \
            ATT_PV(vB, 3, C0, C1); \
        } \
        ATT_WAITBAR(); } while (0)
    ATT_QK(SA0, SA1, OFF_K0);
    ATT_WAITBAR();
    for (int tt = 0; tt < NT; tt += 2) { ATT_STEP(SA0, SA1, SB0, SB1, tt, 0); if (tt + 1 < NT) ATT_STEP(SB0, SB1, SA0, SA1, tt + 1, 1); }
#undef ATT_STEP
#undef ATT_QK
#undef ATT_VLD
#undef ATT_PV
#undef ATT_SB
#undef ATT_WAITBAR
#undef ATT_ISSUE_K
#undef ATT_ISSUE_V
#undef ATT_DMA
    const int tid2_ = mk_tid(wv);
    const int lane2 = tid2_ & 63, q32b = lane2 & 31, hib = lane2 >> 5;
    float lam;
    { float s1 = lq1[lane2] * lk1[lane2], s2 = lq2[lane2] * lk2[lane2]; s1 = wave_sum(s1); s2 = wave_sum(s2); lam = expf(s1) - expf(s2) + (layer_a == 0 ? 0.2f : 0.47071302f); }
    l = swapsum(l); const float inv = active ? 1.0f / l : 0.f;
    LAS float* xb = (LAS float*)(lds + rg * XB);
    if (mp == 1) { const float f = inv * lam;
#pragma unroll
        for (int i = 0; i < 4; ++i)
#pragma unroll
            for (int r = 0; r < 16; ++r) xb[(i * 16 + r) * 64 + lane2] = O[i][r] * f; }
    __syncthreads();
    if (mp == 0 && active) {
        float ss = 0.f;
#pragma unroll
        for (int i = 0; i < 4; ++i)
#pragma unroll
            for (int r = 0; r < 16; ++r) { const float o = O[i][r] * inv - xb[(i * 16 + r) * 64 + lane2]; O[i][r] = o; ss += o * o; }
        ss = swapsum(ss); const float rs = 1.0f / sqrtf(ss * (1.f / 128.f) + SUBLN_EPS);
        asm volatile("s_waitcnt lgkmcnt(0)" ::: "memory");
        LAS unsigned char* stg = (LAS unsigned char*)xb;
#pragma unroll
        for (int i = 0; i < 4; ++i)
#pragma unroll
            for (int r4 = 0; r4 < 4; ++r4) { const int dv0 = 32 * i + 8 * r4 + 4 * hib; const f32x4 gg = *(const LAS f32x4*)(GT + dv0);
                u32x2 w; w.x = cvtpk(O[i][4 * r4] * rs * gg.x, O[i][4 * r4 + 1] * rs * gg.y); w.y = cvtpk(O[i][4 * r4 + 2] * rs * gg.z, O[i][4 * r4 + 3] * rs * gg.w);
                *(LAS u32x2*)(stg + q32b * KSTR + dv0 * 2) = w; }
        asm volatile("s_waitcnt lgkmcnt(0)" ::: "memory");
        bf16* og = u.O + (size_t)(128 * u.x + rg * 32) * 1024 + u.h * 128;
#pragma unroll
        for (int i = 0; i < 8; ++i) { const int row = i * 4 + (lane2 >> 4), c16 = lane2 & 15; const u32x4 v = *(const LAS u32x4*)(stg + row * KSTR + c16 * 16);
            if (rg * 32 + row < vrows) *(u32x4*)(og + (size_t)row * 1024 + c16 * 8) = v; }
    }
    __syncthreads();
}
__device__ __forceinline__ void attn_phase(ArgsRef A, Frame& F, int a) {
    const bf16* QB = (const bf16*)(F.ws + WS_QB); bf16* OB = (bf16*)(F.ws + WS_XN); const bf16* KX = (const bf16*)(F.ws + WS_KX); const bf16* VX = (const bf16*)(F.ws + WS_VX);
    const bf16* KXS = (const bf16*)(F.ws + WS_KXS) + (size_t)a * KXS_LAYER; const bf16* VXS = (const bf16*)(F.ws + WS_VXS) + (size_t)a * KXS_LAYER;
    { const int gt = blockIdx.x * 512 + mk_tid(F.wave);
      for (int i = gt; i < 65536; i += F.G * 512) { const int c4 = i & 255, r = (i >> 8) & 15, b = (i >> 12) & 7, kv = i >> 15;
          const f32x4 v = *(const f32x4*)((const float*)(F.ws + (kv ? WS_MFV : WS_MFK)) + r * 1024 + c4 * 4);
          *(f32x4*)(F.out + (kv ? OFF_VP : OFF_KP) + (size_t)a * 8 * EXT_P * 1024 + (size_t)(b * EXT_P + r) * 1024 + c4 * 4) = v; } }
    for (int n = F.vcu; n < 4168; n += F.G) {
        AUnit u; u.KM = (const bf16*)(F.ws + WS_KXM); u.VM = (const bf16*)(F.ws + WS_VXM);
        if (n < 4096) { const int i = n >> 8, v = n & 255, c = v & 31, bh = (v >> 5) * 8 + (i >> 1); const int x = (i & 1) ? 63 - c : c; const int b = bh >> 3;
            u.K = KX + (size_t)b * EXT_P * 1024; u.V = VX + (size_t)b * EXT_P * 1024; u.Q = QB + (size_t)b * 8192 * 1024; u.O = OB + (size_t)b * 8192 * 1024; u.P = 16; u.L = 8192; u.x = x; u.h = bh & 7; }
        else if (n < 4160) { const int j = n - 4096, b = j >> 3; u.K = KXS + (size_t)b * EXT_S * 1024; u.V = VXS + (size_t)b * EXT_S * 1024; u.Q = QB + (size_t)(ROW_S + b * 64) * 1024; u.O = OB + (size_t)(ROW_S + b * 64) * 1024; u.P = 1040; u.L = 64; u.x = 0; u.h = j & 7; }
        else { u.K = (const bf16*)(F.ws + WS_KXM); u.V = (const bf16*)(F.ws + WS_VXM); u.Q = QB + (size_t)ROW_M * 1024; u.O = OB + (size_t)ROW_M * 1024; u.P = 0; u.L = 16; u.x = 0; u.h = n - 4160; }
        attn_unit(F.wave, F.lds, u, A.in[12] + a * 64, A.in[13] + a * 64, A.in[14] + a * 64, A.in[15] + a * 64, a, A.in[6], A.in[16] + a * 128);
    }
}
}

#define XB_TMO      128
#define XB_XCNT(j)  (256  + 64 * (j))
#define XB_XSUB(j)  (1280 + 64 * (j))
#define XB_XGEN(j)  (2304 + 64 * (j))
#define XB_TOP      3328
#define XB_TOPGEN   3392
#define XCD_BAR_WORDS 3456
#define XB_SPIN_CAP (1u << 18)

__device__ __forceinline__ unsigned xb_ld(unsigned* p)              { return __hip_atomic_load(p, __ATOMIC_RELAXED, __HIP_MEMORY_SCOPE_AGENT); }
__device__ __forceinline__ unsigned xb_add(unsigned* p, unsigned v) { return __hip_atomic_fetch_add(p, v, __ATOMIC_RELAXED, __HIP_MEMORY_SCOPE_AGENT); }
__device__ __forceinline__ unsigned xb_xcc_id() { return (unsigned)__builtin_amdgcn_s_getreg((3 << 11) | 20) & 0xFu; }
#define XB_SPIN(cond, bar) do { unsigned _sp = 0; while (cond) { __builtin_amdgcn_s_sleep(1); \
    if ((++_sp & 255u) == 0u) { if (xb_ld(&(bar)[XB_TMO])) break; if (_sp > XB_SPIN_CAP) { atomicAdd(&(bar)[XB_TMO], 1u); break; } } } } while (0)

struct XcdBarrier {
    bool leader; unsigned* bar; unsigned x;
    volatile LAS unsigned* st;
};

__device__ __forceinline__ XcdBarrier xcd_barrier_post(unsigned* bar, volatile LAS unsigned* st) {
    XcdBarrier b; b.bar = bar; b.x = xb_xcc_id(); b.st = st;
    b.leader = (threadIdx.x == 0);
    if (b.leader) (void)xb_add(&bar[XB_XCNT(b.x)], 1u);
    return b;
}
__device__ __forceinline__ void xcd_barrier_complete(unsigned* bar, unsigned x, unsigned& nloc, unsigned& nx) {
    const unsigned G = gridDim.x * gridDim.y * gridDim.z;
    unsigned sum, cnt, mine, sp = 0u;
    for (;;) {
        sum = 0u; cnt = 0u; mine = 0u;
#pragma unroll
        for (unsigned j = 0; j < 16; ++j) { const unsigned c = xb_ld(&bar[XB_XCNT(j)]); sum += c; cnt += (c > 0u) ? 1u : 0u; mine = (j == x) ? c : mine; }
        if (sum == G) break;
        __builtin_amdgcn_s_sleep(1);
        if ((++sp & 255u) == 0u) { if (xb_ld(&bar[XB_TMO])) break; if (sp > XB_SPIN_CAP) { atomicAdd(&bar[XB_TMO], 1u); break; } }
    }
    nloc = mine > 0u ? mine : 1u; nx = cnt > 0u ? cnt : 1u;
}

__device__ __forceinline__ void xcd_barrier(const XcdBarrier& b) {
    asm volatile("s_waitcnt vmcnt(0)" ::: "memory");
    __syncthreads();
    if (b.leader) {
        unsigned* bar = b.bar;
        __builtin_amdgcn_s_waitcnt(0);
        unsigned nloc = b.st[0], nx = b.st[1];
        if (nloc == 0u) { xcd_barrier_complete(bar, b.x, nloc, nx); b.st[0] = nloc; b.st[1] = nx; }
        const unsigned old = xb_add(&bar[XB_XSUB(b.x)], 1u);
        const unsigned gen = old / nloc;
        if (old + 1u == (gen + 1u) * nloc) {
            __builtin_amdgcn_fence(__ATOMIC_RELEASE, "agent");
            asm volatile("s_waitcnt vmcnt(0)" ::: "memory");
            const unsigned og = xb_add(&bar[XB_TOP], 1u);
            const unsigned tg = og / nx;
            if (og + 1u == (tg + 1u) * nx) xb_add(&bar[XB_TOPGEN], 1u);
            else XB_SPIN(xb_ld(&bar[XB_TOPGEN]) == tg, bar);
            __builtin_amdgcn_fence(__ATOMIC_ACQUIRE, "agent");
            xb_add(&bar[XB_XGEN(b.x)], 1u);
            asm volatile("s_waitcnt vmcnt(0)" ::: "memory");
        } else {
            XB_SPIN(xb_ld(&bar[XB_XGEN(b.x)]) == gen, bar);
            __builtin_amdgcn_fence(__ATOMIC_ACQUIRE, "agent");
            asm volatile("s_waitcnt vmcnt(0)" ::: "memory");
        }
    }
    __syncthreads();
}

__device__ __forceinline__ void run_step(ArgsRef args, const int step, const int wv) {
    extern __shared__ __attribute__((aligned(16))) unsigned char lds_raw[];
    Frame F;
    F.lds = (LAS unsigned char*)lds_raw; F.tid = 0; F.lane = 0; F.wave = wv;
    F.G = gridDim.x; { const int bx = blockIdx.x; F.vcu = (F.G % 8 == 0) ? (bx % 8) * (F.G / 8) + bx / 8 : bx; }
    F.out = args.out; F.ws = args.ws;
    bf16* XN = (bf16*)(F.ws + WS_XN); bf16* QB = (bf16*)(F.ws + WS_QB); bf16* YB = (bf16*)(F.ws + WS_YB); bf16* U = (bf16*)(F.ws + WS_U);
    int layer = 0, k = -1;
    if (step > 0) { const int s = step - 1; if (s < 7) { layer = 0; k = s; } else if (s < 13) { layer = 1; k = s - 7; } else if (s < 20) { layer = 2; k = s - 13; } else { layer = 3; k = s - 20; } }
    const bool attn = (layer & 1) == 0; const int a = layer >> 1;
    int type;
    if (step == 0) type = 0; else if (attn) type = k == 0 ? 1 : k == 1 ? 2 : k == 2 ? 4 : k == 3 ? 5 : k == 4 ? 6 : k == 5 ? 7 : 8;
    else type = k == 0 ? 3 : k == 1 ? 4 : k == 2 ? 5 : k == 3 ? 6 : k == 4 ? 7 : 8;
    if (type == 0) prologue(args, F);
    else if (type == 1) {
        pg8::Gemm g{XN, (const bf16*)(F.ws + WS_WQKV) + (size_t)a * 3072 * D, MPAD, 3072, D, D, D, 0}; pg8::StaticOrder S; S.init(MPAD, 3072, F.G, (int)blockIdx.x, D);
        pg8::EpiQKV E{F.ws, F.out, a};
        pg8::gemm_phase<pg8::EpiQKV, pg8::StaticOrder, true, true>(F.lds, g, S, E, mk_tid(F.wave));
    } else if (type == 2) { att::attn_phase(args, F, a); }
    else if (type == 3) { pool_phase(args, F, a); }
    else if (type == 4 || type == 7) {
        pg8::Gemm g;
        if (type == 7) g = pg8::Gemm{U, (const bf16*)(F.ws + WS_WDN) + (size_t)layer * D * FF, MPAD, D, FF, FF, FF, 0};
        else if (attn) g = pg8::Gemm{XN, (const bf16*)(F.ws + WS_WO) + (size_t)a * D * D, MPAD, D, D, D, D, 0};
        else g = pg8::Gemm{QB, (const bf16*)(F.ws + WS_WPOOL) + (size_t)a * 4 * 65536, MPAD, D, 256, D, 256, 512};
        pg8::TailOrder S; S.init(D, F.G, (int)blockIdx.x, g.K, type == 7 ? 16 : (attn ? 4 : 1));
        pg8::EpiBf16<0> E{YB, D, (float*)(F.ws + WS_YF)};
        pg8::gemm_phase<pg8::EpiBf16<0>, pg8::TailOrder, true, true>(F.lds, g, S, E, mk_tid(F.wave));
    } else if (type == 5) { fin_phase(args, F, layer == 0, attn ? 4 : 0, args.in[8] + layer * D, args.in[9] + layer * D); }
    else if (type == 6) {
        pg8::Gemm g{XN, (const bf16*)(F.ws + WS_WUP) + (size_t)layer * D * FF, MPAD, FF, D, D, D, 0}; pg8::StaticOrder S; S.init(MPAD, FF, F.G, (int)blockIdx.x, D);
        pg8::EpiBf16<2> E{U, FF, nullptr};
        pg8::gemm_phase<pg8::EpiBf16<2>, pg8::StaticOrder, true, true>(F.lds, g, S, E, mk_tid(F.wave));
    } else { fin_phase(args, F, false, 16, args.in[10] + layer * D, layer < 3 ? args.in[7] + (layer + 1) * D : nullptr); }
}
__global__ void __launch_bounds__(512, 2) fwd_kernel(Args args_) {
    const int lo = args_.lo, hi = args_.hi;
    const int wv = __builtin_amdgcn_readfirstlane((int)threadIdx.x >> 6);
    extern __shared__ __attribute__((aligned(16))) unsigned char lds_raw[];
    volatile LAS unsigned* bst = (volatile LAS unsigned*)((LAS unsigned char*)lds_raw + 139264);
    if (threadIdx.x < 2) bst[threadIdx.x] = 0u;
    __syncthreads();
    XcdBarrier bar = xcd_barrier_post((unsigned*)args_.ws + 4096, bst);
    int probe_rep = 0; (void)probe_rep;
    for (int step = lo; step < hi; ++step) {
        const __attribute__((address_space(4))) Args* ap = (const __attribute__((address_space(4))) Args*)__builtin_amdgcn_kernarg_segment_ptr();
        asm volatile("" : "+s"(ap));
        run_step(*ap, step, wv);
#if defined(PROBE_MASK)
        {
            int ty = 0; if (step > 0) { const int s = step - 1; const int k = s < 7 ? s : s < 13 ? s - 7 : s < 20 ? s - 13 : s - 20; const bool at = (s < 7) || (s >= 13 && s < 20);
                ty = at ? (k == 0 ? 1 : k == 1 ? 2 : k == 2 ? 4 : k == 3 ? 5 : k == 4 ? 6 : k == 5 ? 7 : 8) : (k == 0 ? 3 : k == 1 ? 4 : k == 2 ? 5 : k == 3 ? 6 : k == 4 ? 7 : 8); }
            if (((PROBE_MASK >> ty) & 1) && !probe_rep) { probe_rep = 1; --step; __syncthreads(); continue; }
            probe_rep = 0; }
#endif
        if (step + 1 < hi) { if (lo < 0) { __threadfence(); cg::this_grid().sync(); }
            else { xcd_barrier(bar);
#if defined(PROBE_BAR2)
 xcd_barrier(bar);
#endif
 } }
    }
}

extern "C" void kernel_launch(void* const* d_in, const int* in_sizes, int n_in, void* d_out, int out_size, void* d_ws, size_t ws_size, hipStream_t stream) {
    static int grid = 0;
    if (grid == 0) {
        if (n_in != 22 || (size_t)out_size != OUT_TOTAL || ws_size < WS_END) { fprintf(stderr, "kernel_launch: unexpected shapes n_in %d out %d ws %zu\n", n_in, out_size, ws_size); grid = -1; return; }
        int dev = 0, cus = 0, per_cu = 0;
        hipGetDevice(&dev); hipDeviceGetAttribute(&cus, hipDeviceAttributeMultiprocessorCount, dev);
        hipFuncSetAttribute((const void*)fwd_kernel, hipFuncAttributeMaxDynamicSharedMemorySize, LDS_BYTES);
        hipOccupancyMaxActiveBlocksPerMultiprocessor(&per_cu, (const void*)fwd_kernel, 512, LDS_BYTES);
        if (per_cu < 1) { fprintf(stderr, "kernel_launch: occupancy query says %d blocks/CU\n", per_cu); per_cu = 1; }
        (void)hipGetLastError();
        grid = cus;
    }
    if (grid < 0) return;
    if (hipMemsetAsync(d_ws, 0, 65536, stream) != hipSuccess) { fprintf(stderr, "kernel_launch: memset failed\n"); return; }
    Args a{};
    for (int i = 0; i < 22; ++i) a.in[i] = (const float*)d_in[i];
    a.out = (float*)d_out; a.ws = (unsigned char*)d_ws;
#if ONE_LAUNCH
    a.lo = 0; a.hi = NSTEPS;
    void* kargs[] = {&a};
    hipError_t e = hipLaunchCooperativeKernel((const void*)fwd_kernel, dim3(grid), dim3(512), kargs, LDS_BYTES, stream);
    if (e != hipSuccess) fprintf(stderr, "cooperative launch failed: %s (grid %d)\n", hipGetErrorString(e), grid);
#else
    for (int s = 0; s < NSTEPS; ++s) { a.lo = s; a.hi = s + 1; hipLaunchKernelGGL(fwd_kernel, dim3(grid), dim3(512), LDS_BYTES, stream, a); }
#endif
}
static_assert(WS_QB == 213 * MiB && WS_KX == 473 * MiB && WS_VX == 602 * MiB && WS_KXS == 731 * MiB && WS_VXS == 767 * MiB && WS_KXM == 803 * MiB && WS_VXM == 804 * MiB && KXS_LAYER == 9 * MiB && WS_MFK == 1323 * MiB && WS_MFV == 1324 * MiB, "EpiQKV hard-coded map");
static_assert(OFF_KP == 67633152 && OFF_VP == 202113024 && OFF_KS == 336838656 && OFF_VS == 337887232, "EpiQKV hard-coded output offsets");
```
